# Optimizing an MI355X kernel written in HIP

```python
import jax, jax.numpy as jnp
from jax import lax
import numpy as np

D_MODEL = 1024
BATCH = 16
SEQ = 2048
DEPTH = 2

N_MEM = 256
EPS = 1e-6

SB_HEADS = 8
SB_HEAD_DIM = 64
SB_WIDTH = SB_HEADS * SB_HEAD_DIM
SB_BLOCK = 128
SG_GROUPS = 4
SG_GROUP_DIM = 64
SG_WIDTH = SG_GROUPS * SG_GROUP_DIM
SG_CHUNK = 128
GLA_HEADS = 4
GLA_DK = 32
GLA_DV = 64
GLA_KEY_WIDTH = GLA_HEADS * GLA_DK
GLA_WIDTH = GLA_HEADS * GLA_DV
GLA_GATE_RANK = 16
GLA_TAU = 16.0
GLA_CHUNK = 128

MIX_WIDTH = SB_WIDTH + SG_WIDTH + GLA_WIDTH
IN_SPLITS = [SB_WIDTH, SB_WIDTH, SB_WIDTH,
             SG_WIDTH, SG_WIDTH,
             GLA_KEY_WIDTH, GLA_KEY_WIDTH,
             GLA_WIDTH, GLA_WIDTH,
             GLA_GATE_RANK]
IN_WIDTH = sum(IN_SPLITS)

X_HEADS = 4
X_HEAD_DIM = D_MODEL // X_HEADS

PEER_HEADS = 8
PEER_KEYS = 128
PEER_N = PEER_KEYS * PEER_KEYS
PEER_DQ = 128
PEER_TOPK = 16
PEER_TOKENS = 128

kernel_name = 'hybrid_sb_sgu_gla_peer_block'


def rmsnorm(x, gain):
    xf = x.astype(jnp.float32)
    y = xf * lax.rsqrt(jnp.mean(xf * xf, axis=-1, keepdims=True) + EPS)
    return (y * gain.astype(jnp.float32)).astype(x.dtype)


def stick_breaking_attention(q, k, v):
    S = q.shape[2]
    scale = SB_HEAD_DIM ** -0.5
    outs = []
    for start in range(0, S, SB_BLOCK):
        end = start + SB_BLOCK
        kb, vb = k[:, :, :end], v[:, :, :end]
        z = jnp.einsum('bhtd,bhsd->bhts', q[:, :, start:end], kb).astype(jnp.float32) * scale
        t_pos = start + jnp.arange(SB_BLOCK)[:, None]
        s_pos = jnp.arange(end)[None, :]
        mask = s_pos < t_pos
        log_not = jnp.where(mask, jax.nn.log_sigmoid(-z), 0.0)
        later = lax.cumsum(log_not, axis=3, reverse=True) - log_not
        w = jnp.where(mask, jnp.exp(jax.nn.log_sigmoid(z) + later), 0.0)
        outs.append(jnp.einsum('bhts,bhsd->bhtd', w.astype(vb.dtype), vb))
    return jnp.concatenate(outs, axis=2)


def spatial_gating(u, v, v_gain, w_s, b_s):
    B, S, _ = u.shape
    u = jax.nn.gelu(u)
    v = rmsnorm(jax.nn.gelu(v), v_gain)
    v = v.reshape(B, S // SG_CHUNK, SG_CHUNK, SG_GROUPS, SG_GROUP_DIM)
    causal = jnp.tril(jnp.ones((SG_CHUNK, SG_CHUNK), dtype=bool))
    w = jnp.where(causal, w_s, jnp.zeros_like(w_s))
    mixed = jnp.einsum('gts,bcsgd->bctgd', w, v) + b_s.T[:, :, None]
    return u * mixed.reshape(B, S, SG_WIDTH)


def gated_linear_attention(q, k, v, log_a):
    B, H, S, dk = q.shape
    dv = v.shape[-1]
    n = S // GLA_CHUNK

    def chunks(t):
        t = t.astype(jnp.float32).reshape(B, H, n, GLA_CHUNK, t.shape[-1])
        return jnp.moveaxis(t, 2, 0)

    qc = chunks(q) * dk ** -0.5
    kc, vc, gc = chunks(k), chunks(v), chunks(log_a)
    causal = jnp.tril(jnp.ones((GLA_CHUNK, GLA_CHUNK), dtype=bool))[:, :, None]

    def step(state, inp):
        qi, ki, vi, gi = inp
        b = jnp.cumsum(gi, axis=2)
        o_inter = jnp.einsum('bhtk,bhkv->bhtv', qi * jnp.exp(b), state)
        diff = b[:, :, :, None, :] - b[:, :, None, :, :]
        decay = jnp.exp(jnp.where(causal, diff, -jnp.inf))
        scores = jnp.einsum('bhtk,bhsk,bhtsk->bhts', qi, ki, decay)
        o_intra = jnp.einsum('bhts,bhsv->bhtv', scores, vi)
        b_end = b[:, :, -1:, :]
        state = (jnp.exp(b_end[:, :, 0, :, None]) * state
                 + jnp.einsum('bhsk,bhsv->bhkv', ki * jnp.exp(b_end - b), vi))
        return state, o_inter + o_intra

    state0 = jnp.zeros((B, H, dk, dv), jnp.float32)
    _, o = lax.scan(step, state0, (qc, kc, vc, gc))
    o = jnp.moveaxis(o, 0, 2).reshape(B, H, S, dv)
    return o.astype(v.dtype)


def hybrid_mixer(h, w_in, sg_v_gain, sg_w_spatial, sg_b_spatial,
                 gla_w_gate, gla_b_gate, gla_out_gain, w_out):
    B, S, _ = h.shape
    proj = h @ w_in
    offsets = np.cumsum(IN_SPLITS)[:-1].tolist()
    sb_q, sb_k, sb_v, sg_u, sg_v, g_q, g_k, g_v, g_o, g_a = jnp.split(proj, offsets, axis=-1)

    def heads(t, n_heads):
        return t.reshape(B, S, n_heads, -1).transpose(0, 2, 1, 3)

    y_sb = stick_breaking_attention(heads(sb_q, SB_HEADS), heads(sb_k, SB_HEADS), heads(sb_v, SB_HEADS))
    y_sb = y_sb.transpose(0, 2, 1, 3).reshape(B, S, SB_WIDTH)

    y_sg = spatial_gating(sg_u, sg_v, sg_v_gain, sg_w_spatial, sg_b_spatial)

    log_a = jax.nn.log_sigmoid((g_a @ gla_w_gate + gla_b_gate).astype(jnp.float32)) / GLA_TAU
    y_gla = gated_linear_attention(heads(g_q, GLA_HEADS), heads(g_k, GLA_HEADS),
                                   heads(g_v, GLA_HEADS), heads(log_a, GLA_HEADS))
    y_gla = y_gla.transpose(0, 2, 1, 3)
    y_gla = rmsnorm(y_gla, gla_out_gain.reshape(GLA_HEADS, GLA_DV)).reshape(B, S, GLA_WIDTH)
    y_gla = y_gla * jax.nn.silu(g_o)

    return jnp.concatenate([y_sb, y_sg, y_gla], axis=-1) @ w_out


def memory_cross_attention(h, mem, mem_gain, w_q, w_kv, w_o):
    B, S, D = h.shape
    m = rmsnorm(mem, mem_gain)
    q = (h @ w_q).reshape(B, S, X_HEADS, X_HEAD_DIM)
    k, v = jnp.split(m @ w_kv, 2, axis=-1)
    k = k.reshape(B, -1, X_HEADS, X_HEAD_DIM)
    v = v.reshape(B, -1, X_HEADS, X_HEAD_DIM)
    s = jnp.einsum('bthd,bmhd->bhtm', q, k).astype(jnp.float32) * X_HEAD_DIM ** -0.5
    p = jax.nn.softmax(s, axis=-1).astype(v.dtype)
    o = jnp.einsum('bhtm,bmhd->bthd', p, v).reshape(B, S, D)
    return o @ w_o


def peer_ffn(h, w_q, sub_keys, expert_u, expert_v):
    B, S, D = h.shape
    tokens = h.reshape(-1, PEER_TOKENS, D)

    def block(xt):
        T = xt.shape[0]
        q = (xt @ w_q).reshape(T, PEER_HEADS, 2, PEER_DQ // 2)
        scores = jnp.einsum('thpd,hpnd->thpn', q, sub_keys).astype(jnp.float32)
        s_top, i_top = lax.top_k(scores, PEER_TOPK)
        cand = s_top[:, :, 0, :, None] + s_top[:, :, 1, None, :]
        cand_idx = i_top[:, :, 0, :, None] * PEER_KEYS + i_top[:, :, 1, None, :]
        c_s, c_i = lax.top_k(cand.reshape(T, PEER_HEADS, -1), PEER_TOPK)
        idx = jnp.take_along_axis(cand_idx.reshape(T, PEER_HEADS, -1), c_i, axis=-1)
        g = jax.nn.softmax(c_s, axis=-1).astype(xt.dtype)
        act = jax.nn.gelu(jnp.einsum('td,thkd->thk', xt, expert_u[idx]))
        return jnp.einsum('thk,thkd->td', g * act, expert_v[idx])

    return lax.map(block, tokens).reshape(B, S, D)


def setup_inputs(seed: int = 0) -> dict:
    key = jax.random.key(seed)
    ks = jax.random.split(key, 22)
    L, D = DEPTH, D_MODEL

    def nrm(k, shape, scale):
        return jax.random.normal(k, shape, jnp.float32) * scale

    def gain(k, shape):
        return 1.0 + 0.05 * jax.random.normal(k, shape, jnp.float32)

    return {
        'x': nrm(ks[0], (BATCH, SEQ, D), 1.0),
        'mem': nrm(ks[1], (BATCH, N_MEM, D), 1.0),
        'norm_mix': gain(ks[2], (L, D)),
        'w_in': nrm(ks[3], (L, D, IN_WIDTH), D ** -0.5),
        'sg_v_gain': gain(ks[4], (L, SG_WIDTH)),
        'sg_w_spatial': nrm(ks[5], (L, SG_GROUPS, SG_CHUNK, SG_CHUNK), SG_CHUNK ** -0.5),
        'sg_b_spatial': gain(ks[6], (L, SG_GROUPS, SG_CHUNK)),
        'gla_w_gate': nrm(ks[7], (L, GLA_GATE_RANK, GLA_KEY_WIDTH), GLA_GATE_RANK ** -0.5),
        'gla_b_gate': gain(ks[8], (L, GLA_KEY_WIDTH)),
        'gla_out_gain': gain(ks[9], (L, GLA_WIDTH)),
        'w_out': nrm(ks[10], (L, MIX_WIDTH, D), MIX_WIDTH ** -0.5),
        'norm_mem': gain(ks[11], (L, D)),
        'mem_gain': gain(ks[12], (L, D)),
        'w_cq': nrm(ks[13], (L, D, D), D ** -0.5),
        'w_ckv': nrm(ks[14], (L, D, 2 * D), D ** -0.5),
        'w_co': nrm(ks[15], (L, D, D), D ** -0.5),
        'norm_ffn': gain(ks[16], (L, D)),
        'peer_w_q': nrm(ks[17], (L, D, PEER_HEADS * PEER_DQ), D ** -0.5),
        'peer_sub_keys': nrm(ks[18], (L, PEER_HEADS, 2, PEER_KEYS, PEER_DQ // 2), (PEER_DQ // 2) ** -0.5),
        'peer_u': nrm(ks[19], (L, PEER_N, D), D ** -0.5),
        'peer_v': nrm(ks[20], (L, PEER_N, D), (PEER_HEADS * PEER_TOPK) ** -0.5),
        'final_gain': gain(ks[21], (D,)),
    }


def reference(x, mem, norm_mix, w_in, sg_v_gain, sg_w_spatial, sg_b_spatial,
              gla_w_gate, gla_b_gate, gla_out_gain, w_out, norm_mem, mem_gain,
              w_cq, w_ckv, w_co, norm_ffn, peer_w_q, peer_sub_keys, peer_u, peer_v,
              final_gain):
    for l in range(DEPTH):
        h = rmsnorm(x, norm_mix[l])
        x = x + hybrid_mixer(h, w_in[l], sg_v_gain[l], sg_w_spatial[l], sg_b_spatial[l],
                             gla_w_gate[l], gla_b_gate[l], gla_out_gain[l], w_out[l])
        h = rmsnorm(x, norm_mem[l])
        x = x + memory_cross_attention(h, mem, mem_gain[l], w_cq[l], w_ckv[l], w_co[l])
        h = rmsnorm(x, norm_ffn[l])
        x = x + peer_ffn(h, peer_w_q[l], peer_sub_keys[l], peer_u[l], peer_v[l])
    return rmsnorm(x, final_gain)
```

```cpp
#include <hip/hip_runtime.h>
#include <hip/hip_cooperative_groups.h>
#include <cstdio>
#include <cstdint>
#include <cmath>
namespace cg = cooperative_groups;

#ifndef PHMASK
#define PHMASK 0xFFFF
#endif
#define EN(n) (((PHMASK) >> (n)) & 1)
#ifndef PROBE_REP_K
#define PROBE_REP_K (-2)
#endif
#ifndef MK_ONE_LAUNCH
#define MK_ONE_LAUNCH 1
#endif

#define LAS __attribute__((address_space(3)))
typedef unsigned short bf16_t;
typedef short bf16x8 __attribute__((ext_vector_type(8)));
typedef short s16x4 __attribute__((ext_vector_type(4)));
typedef short v4i16_t __attribute__((ext_vector_type(4)));
typedef float f32x4 __attribute__((ext_vector_type(4)));
typedef float f32x2 __attribute__((ext_vector_type(2)));
typedef float f32x16 __attribute__((ext_vector_type(16)));
typedef unsigned u32x4 __attribute__((ext_vector_type(4)));
typedef unsigned u32x2 __attribute__((ext_vector_type(2)));
typedef __bf16 bf16x2_t __attribute__((ext_vector_type(2)));
#define DI __device__ __forceinline__
#define MFMA32(a, b, c) __builtin_amdgcn_mfma_f32_32x32x16_bf16((a), (b), (c), 0, 0, 0)

constexpr int BATCH = 16, SEQ = 2048, DM = 1024, MTOK = BATCH * SEQ, DEPTH = 2;
constexpr int NMEM = 256, MMEM = BATCH * NMEM;
constexpr int INW = 2832, LDP = 2944, NPROJ = 3072;
constexpr int C_SBQ = 0, C_SBK = 512, C_SBV = 1024, C_SGU = 1536, C_SGV = 1792, C_GQ = 2048, C_GK = 2176, C_GV = 2304, C_GO = 2560, C_GA = 2816;
constexpr float EPS = 1e-6f;
constexpr float LOG2E = 1.4426950408889634f;

constexpr size_t MiB = 1u << 20;
constexpr size_t WS_CTL = 0;
constexpr size_t WS_SUBK = 1 * MiB;
constexpr size_t WS_WSP = WS_SUBK + 512 * 1024;
constexpr size_t WS_RSTDM = WS_WSP + 256 * 1024;
constexpr size_t WS_SS = 2 * MiB;
constexpr size_t WS_W = 8 * MiB;
constexpr size_t W_IN = 0, W_OUT = 6 * MiB, W_CQ = 8 * MiB, W_CKV = 10 * MiB, W_CO = 14 * MiB, W_PQ = 16 * MiB, W_LAYER = 18 * MiB;
constexpr size_t WS_MEMB = 44 * MiB;
constexpr size_t WS_KMEM = 52 * MiB;
constexpr size_t WS_TAB = 84 * MiB;
constexpr size_t WS_XB = 148 * MiB;
constexpr size_t WS_YCAT = 212 * MiB;
constexpr size_t WS_PROJ = 276 * MiB;
constexpr size_t WS_GKV = 460 * MiB;
constexpr size_t WS_GD = 468 * MiB;
constexpr size_t WS_END = 469 * MiB;

DI unsigned cvtpk(float lo, float hi) { f32x2 v = {lo, hi}; bf16x2_t b = __builtin_convertvector(v, bf16x2_t); return __builtin_bit_cast(unsigned, b); }
DI bf16_t cvt1(float v) { return (bf16_t)(cvtpk(v, 0.f) & 0xffffu); }
DI float bf2f(unsigned short b) { return __uint_as_float((unsigned)b << 16); }
DI float bflo(unsigned w) { return __uint_as_float(w << 16); }
DI float bfhi(unsigned w) { return __uint_as_float(w & 0xffff0000u); }
DI int crow(int r, int hi) { return (r & 3) + 8 * (r >> 2) + 4 * hi; }
DI float fexp2(float x) { return __builtin_amdgcn_exp2f(x); }
DI float flog2(float x) { return __builtin_amdgcn_logf(x); }
DI float frcp(float x) { return __builtin_amdgcn_rcpf(x); }
DI float gelu_tanh(float x) { const float y2 = x * (1.5957691216057308f + 0.0713548162726009f * x * x); return x * frcp(1.f + fexp2(-y2 * LOG2E)); }
DI float silu(float x) { return x * frcp(1.f + fexp2(-x * LOG2E)); }
DI float wave_sum(float v) {
#pragma unroll
    for (int o = 1; o < 64; o <<= 1) v += __shfl_xor(v, o);
    return v;
}
DI s16x4 vtr(LAS const char* p) { return __builtin_bit_cast(s16x4, __builtin_amdgcn_ds_read_tr16_b64_v4i16((LAS v4i16_t*)p)); }
DI bf16x8 cat8(s16x4 lo, s16x4 hi) { return __builtin_shufflevector(lo, hi, 0, 1, 2, 3, 4, 5, 6, 7); }
DI bf16x8 pack8(float a0, float a1, float a2, float a3, float a4, float a5, float a6, float a7) {
    u32x4 p; p[0] = cvtpk(a0, a1); p[1] = cvtpk(a2, a3); p[2] = cvtpk(a4, a5); p[3] = cvtpk(a6, a7); return __builtin_bit_cast(bf16x8, p);
}
#define LDS_WAIT() asm volatile("s_waitcnt lgkmcnt(0)" ::: "memory")
#define LDS_SYNC() do { asm volatile("s_waitcnt lgkmcnt(0)" ::: "memory"); __builtin_amdgcn_s_barrier(); asm volatile("" ::: "memory"); } while (0)
#define WG_SYNC() do { asm volatile("s_waitcnt vmcnt(0) lgkmcnt(0)" ::: "memory"); __builtin_amdgcn_s_barrier(); asm volatile("" ::: "memory"); } while (0)

namespace pg8 {
constexpr int BM = 256, BK = 64, HALF = 128, HTB = HALF * BK * 2, STAGE_BYTES = 8 * HTB, NXCD = 8, WGM = 8;
__host__ __device__ __forceinline__ int lds_byte(int r, int c) { const int st = (r >> 4) * 2 + (c >> 5), rr = r & 15, cc = c & 31, ob = rr * 64 + cc * 2; return st * 1024 + (ob ^ (((ob >> 9) & 1) << 5)); }
__host__ __device__ __forceinline__ void stage_rc(int b, int& R, int& C) { const int st = b / 1024, sb = b % 1024, swz = sb ^ (((sb >> 9) & 1) << 5); R = (st >> 1) * 16 + swz / 64; C = (st & 1) * 32 + (swz % 64) / 2; }
__host__ __device__ __forceinline__ int perm32(int rho) { const int n = rho >> 4, i = rho & 15; return 8 * (i >> 2) + 4 * n + (i & 3); }

struct Unit { int pm, pn; size_t aoff, boff; };
struct Gemm { const bf16_t* A; const bf16_t* Bt; int lda, ldb, K; };

struct StaticOrder {
    int nM, nN, nwg, G, c, lda, ldb;
    __device__ void init(int M, int N, int G_, int c_, int lda_, int ldb_) { nM = M / BM; nN = N / BM; nwg = nM * nN; G = G_; c = c_; lda = lda_; ldb = ldb_; }
    __device__ bool next(int i, Unit& u) const {
        const long L = (long)i * G + c; if (L >= nwg) return false;
        int wgid = (int)L; { const int q = nwg / NXCD, r = nwg % NXCD, xcd = wgid % NXCD, off = wgid / NXCD; wgid = (xcd < r ? xcd * (q + 1) : r * (q + 1) + (xcd - r) * q) + off; }
        const int nig = WGM * nN, gid = wgid / nig, fm = gid * WGM, gsz = (nM - fm) < WGM ? (nM - fm) : WGM;
        u.pm = fm + ((wgid % nig) % gsz); u.pn = (wgid % nig) / gsz;
        u.aoff = (size_t)u.pm * BM * lda; u.boff = (size_t)u.pn * BM * ldb; return true;
    }
};
struct XOrder {
    int G, c, mode;
    __device__ bool next(int i, Unit& u) const {
        const int L = i * G + c; if (L >= 512) return false;
        u.pm = L >> 2; u.pn = L & 3; const int b = u.pm >> 3;
        u.aoff = (size_t)u.pm * 256 * 1024 + u.pn * 256;
        u.boff = mode == 0 ? (size_t)b * 256 * 1024 + u.pn * 256 : (size_t)(b * 4 + u.pn) * 256 * 256;
        return true;
    }
};

struct XOrder2 {
    StaticOrder S; int mode;
    __device__ bool next(int i, Unit& u) const {
        if (!S.next(i, u)) return false; const int b = u.pm >> 3;
        u.aoff = (size_t)u.pm * 256 * 1024 + u.pn * 256;
        u.boff = mode == 0 ? (size_t)b * 256 * 1024 + u.pn * 256 : (size_t)(b * 4 + u.pn) * 256 * 256;
        return true;
    }
};

DI float row_rstd_from_ss(const float* ss, int row, int fq) {
    const f32x4 v = *(const f32x4*)(ss + (size_t)row * 16 + 4 * fq);
    float s = (v[0] + v[1]) + (v[2] + v[3]); s += __shfl_xor(s, 16); s += __shfl_xor(s, 32);
    return 1.0f / sqrtf(s * (1.0f / 1024.0f) + EPS);
}
struct EpiBf16 {
    static constexpr bool PERM = true;
    bf16_t* O; int ldc; const float* ss; float cscale; int ncols;
    DI void operator()(f32x4 (&acc)[2][2][4][2], const Unit& u, int wr, int wc, int fr, int fq) const {
        const int row0 = u.pm * BM + wr * 64 + fr, col0 = u.pn * BM + wc * 32 + 8 * fq;
#pragma unroll
        for (int ai = 0; ai < 2; ++ai)
#pragma unroll
            for (int m = 0; m < 4; ++m) {
                const int row = row0 + ai * HALF + m * 16;
                float rs = cscale; if (ss) rs *= row_rstd_from_ss(ss, row, fq);
                bf16_t* rowp = O + (size_t)row * ldc + col0;
#pragma unroll
                for (int bj = 0; bj < 2; ++bj) if (col0 + bj * HALF < ncols) {
                    const f32x4 v0 = acc[ai][bj][m][0] * rs, v1 = acc[ai][bj][m][1] * rs;
                    u32x4 w; w.x = cvtpk(v0[0], v0[1]); w.y = cvtpk(v0[2], v0[3]); w.z = cvtpk(v1[0], v1[1]); w.w = cvtpk(v1[2], v1[3]);
                    *(u32x4*)(rowp + bj * HALF) = w; }
            }
    }
};
struct EpiKV {
    static constexpr bool PERM = true;
    bf16_t* Kd; bf16_t* VT; const float* rvec;
    DI void operator()(f32x4 (&acc)[2][2][4][2], const Unit& u, int wr, int wc, int fr, int fq) const {
        const int row0 = u.pm * BM + wr * 64 + fr;
#pragma unroll
        for (int ai = 0; ai < 2; ++ai)
#pragma unroll
            for (int m = 0; m < 4; ++m) {
                const int row = row0 + ai * HALF + m * 16; const float rs = rvec[row];
#pragma unroll
                for (int bj = 0; bj < 2; ++bj) {
                    const f32x4 v0 = acc[ai][bj][m][0] * rs, v1 = acc[ai][bj][m][1] * rs;
                    const unsigned w0 = cvtpk(v0[0], v0[1]), w1 = cvtpk(v0[2], v0[3]), w2 = cvtpk(v1[0], v1[1]), w3 = cvtpk(v1[2], v1[3]);
                    if (u.pn < 4) {
                        u32x4 w; w.x = w0; w.y = w1; w.z = w2; w.w = w3;
                        *(u32x4*)(Kd + (size_t)row * 1024 + u.pn * BM + bj * HALF + wc * 32 + 8 * fq) = w;
                    } else {
                        const int key = row & 255, dv0 = bj * HALF + wc * 32 + 8 * fq;
                        bf16_t* p = VT + ((size_t)(u.pm * 4 + (u.pn - 4)) * 256 + dv0) * 256 + key;
                        p[0 * 256] = (bf16_t)w0; p[1 * 256] = (bf16_t)(w0 >> 16); p[2 * 256] = (bf16_t)w1; p[3 * 256] = (bf16_t)(w1 >> 16);
                        p[4 * 256] = (bf16_t)w2; p[5 * 256] = (bf16_t)(w2 >> 16); p[6 * 256] = (bf16_t)w3; p[7 * 256] = (bf16_t)(w3 >> 16);
                    }
                }
            }
    }
};
struct EpiResid {
    static constexpr bool PERM = true;
    bf16_t* XB; float* ss;
    DI void operator()(f32x4 (&acc)[2][2][4][2], const Unit& u, int wr, int wc, int fr, int fq) const {
        const int row0 = u.pm * BM + wr * 64 + fr, col0 = u.pn * BM + wc * 32 + 8 * fq;
#pragma unroll
        for (int ai = 0; ai < 2; ++ai)
#pragma unroll
            for (int m = 0; m < 4; ++m) {
                const int row = row0 + ai * HALF + m * 16; float s = 0.f;
#pragma unroll
                for (int bj = 0; bj < 2; ++bj) {
                    const size_t off = (size_t)row * 1024 + col0 + bj * HALF;
                    const u32x4 o = *(const u32x4*)(XB + off); const f32x4 a0 = acc[ai][bj][m][0], a1 = acc[ai][bj][m][1];
                    u32x4 w; w.x = cvtpk(bflo(o.x) + a0[0], bfhi(o.x) + a0[1]); w.y = cvtpk(bflo(o.y) + a0[2], bfhi(o.y) + a0[3]);
                    w.z = cvtpk(bflo(o.z) + a1[0], bfhi(o.z) + a1[1]); w.w = cvtpk(bflo(o.w) + a1[2], bfhi(o.w) + a1[3]);
                    *(u32x4*)(XB + off) = w;
#pragma unroll
                    for (int q = 0; q < 4; ++q) { const float x0 = bflo(w[q]), x1 = bfhi(w[q]); s += x0 * x0 + x1 * x1; }
                }
                s += __shfl_xor(s, 16); s += __shfl_xor(s, 32);
                if (fq == 0) ss[(size_t)row * 16 + u.pn * 4 + wc] = s;
            }
    }
};
struct EpiSoftmax {
    static constexpr bool PERM = true;
    bf16_t* P; LAS float* xm; LAS float* xs;
    DI void operator()(f32x4 (&acc)[2][2][4][2], const Unit& u, int wr, int wc, int fr, int fq) const {
#pragma unroll
        for (int ai = 0; ai < 2; ++ai)
#pragma unroll
            for (int m = 0; m < 4; ++m) {
                float v = -INFINITY;
#pragma unroll
                for (int bj = 0; bj < 2; ++bj)
#pragma unroll
                    for (int n = 0; n < 2; ++n) { const f32x4 x = acc[ai][bj][m][n]; v = fmaxf(v, fmaxf(fmaxf(x[0], x[1]), fmaxf(x[2], x[3]))); }
                v = fmaxf(v, __shfl_xor(v, 16)); v = fmaxf(v, __shfl_xor(v, 32));
                if (fq == 0) xm[(ai * HALF + wr * 64 + m * 16 + fr) * 4 + wc] = v;
            }
        LDS_WAIT(); __builtin_amdgcn_s_barrier(); asm volatile("" ::: "memory");
#pragma unroll
        for (int ai = 0; ai < 2; ++ai)
#pragma unroll
            for (int m = 0; m < 4; ++m) {
                const f32x4 q = *(LAS const f32x4*)(xm + (ai * HALF + wr * 64 + m * 16 + fr) * 4);
                const float g = fmaxf(fmaxf(q[0], q[1]), fmaxf(q[2], q[3])); float s = 0.f;
#pragma unroll
                for (int bj = 0; bj < 2; ++bj)
#pragma unroll
                    for (int n = 0; n < 2; ++n) { f32x4 x = acc[ai][bj][m][n]; x[0] = fexp2(x[0] - g); x[1] = fexp2(x[1] - g); x[2] = fexp2(x[2] - g); x[3] = fexp2(x[3] - g); acc[ai][bj][m][n] = x; s += (x[0] + x[1]) + (x[2] + x[3]); }
                s += __shfl_xor(s, 16); s += __shfl_xor(s, 32);
                if (fq == 0) xs[(ai * HALF + wr * 64 + m * 16 + fr) * 4 + wc] = s;
            }
        LDS_WAIT(); __builtin_amdgcn_s_barrier(); asm volatile("" ::: "memory");
        const int row0 = u.pm * BM + wr * 64 + fr, col0 = u.pn * BM + wc * 32 + 8 * fq;
#pragma unroll
        for (int ai = 0; ai < 2; ++ai)
#pragma unroll
            for (int m = 0; m < 4; ++m) {
                const f32x4 q = *(LAS const f32x4*)(xs + (ai * HALF + wr * 64 + m * 16 + fr) * 4);
                const float inv = 1.0f / ((q[0] + q[1]) + (q[2] + q[3]));
                bf16_t* rowp = P + (size_t)(row0 + ai * HALF + m * 16) * 1024 + col0;
#pragma unroll
                for (int bj = 0; bj < 2; ++bj) {
                    const f32x4 v0 = acc[ai][bj][m][0] * inv, v1 = acc[ai][bj][m][1] * inv;
                    u32x4 w; w.x = cvtpk(v0[0], v0[1]); w.y = cvtpk(v0[2], v0[3]); w.z = cvtpk(v1[0], v1[1]); w.w = cvtpk(v1[2], v1[3]);
                    *(u32x4*)(rowp + bj * HALF) = w; }
            }
    }
};

template <class Epi, class Sched, bool ALIGN_EPI>
__device__ __forceinline__ void gemm_phase(LAS unsigned char* lds, const Gemm g, const Sched& S, const Epi& E) {
    int tid = threadIdx.x; asm volatile("" : "+v"(tid));
    const int wid = __builtin_amdgcn_readfirstlane(tid >> 6), lane = tid & 63, wr = wid >> 2, wc = wid & 3, fr = lane & 15, fq = lane >> 4;
    const int K = g.K, nt = K / BK;
    unsigned voffA[2], voffB[2];
#pragma unroll
    for (int i = 0; i < 2; ++i) { int R, C; stage_rc(tid * 16 + i * 8192, R, C); const int Rb = Epi::PERM ? ((R & ~31) + perm32(R & 31)) : R;
        voffA[i] = (unsigned)(R * g.lda + C) * 2u; voffB[i] = (unsigned)(Rb * g.ldb + C) * 2u; }
    const size_t kstep = (size_t)(BK * 2);
    const size_t hstepA = (size_t)HALF * g.lda * 2, hstepB = (size_t)HALF * g.ldb * 2;
    const unsigned ldsw = (unsigned)wid * 1024u;
    const int aoff = lds_byte(wr * 64 + fr, fq * 8), boff = lds_byte(wc * 32 + fr, fq * 8);
#define PG8_SA(b, h) (((b) * 2 + (h)) * HTB)
#define PG8_SB(b, h) ((4 + (b) * 2 + (h)) * HTB)
#define PG8_STAGE(bufoff, gbase, voff) do { _Pragma("unroll") for (int _i = 0; _i < 2; ++_i) \
        __builtin_amdgcn_global_load_lds((const unsigned*)((const char*)(gbase) + (voff)[_i]), (LAS unsigned*)(lds + (bufoff) + ldsw + _i * 8192), 16, 0, 0); } while (0)
#define PG8_LDA(dst, b, h) do { _Pragma("unroll") for (int m = 0; m < 4; ++m) _Pragma("unroll") for (int k = 0; k < 2; ++k) dst[m][k] = *(const LAS bf16x8*)(lds + PG8_SA(b, h) + aoff + m * 2048 + k * 1024); } while (0)
#define PG8_LDB(dst, b, h) do { _Pragma("unroll") for (int n = 0; n < 2; ++n) _Pragma("unroll") for (int k = 0; k < 2; ++k) dst[n][k] = *(const LAS bf16x8*)(lds + PG8_SB(b, h) + boff + n * 2048 + k * 1024); } while (0)
#define PG8_MMA(ai, bj, At, Bt) do { __builtin_amdgcn_s_setprio(1); _Pragma("unroll") for (int m = 0; m < 4; ++m) _Pragma("unroll") for (int n = 0; n < 2; ++n) _Pragma("unroll") for (int k = 0; k < 2; ++k) \
        acc[ai][bj][m][n] = __builtin_amdgcn_mfma_f32_16x16x32_bf16(Bt[n][k], At[m][k], acc[ai][bj][m][n], 0, 0, 0); __builtin_amdgcn_s_setprio(0); } while (0)
#define PG8_WAIT_V(n) asm volatile("s_waitcnt vmcnt(" #n ")" ::: "memory")
#define PG8_WAIT_L(n) asm volatile("s_waitcnt lgkmcnt(" #n ")" ::: "memory")
#define PG8_BAR __builtin_amdgcn_s_barrier()
#define PG8_SCHED __builtin_amdgcn_sched_barrier(0)
    Unit cur, nxt; int ui = 0;
    if (!S.next(0, cur)) return;
    f32x4 acc[2][2][4][2];
#pragma unroll
    for (int a = 0; a < 2; ++a)
#pragma unroll
        for (int b = 0; b < 2; ++b)
#pragma unroll
            for (int m = 0; m < 4; ++m)
#pragma unroll
                for (int n = 0; n < 2; ++n) acc[a][b][m][n] = (f32x4){0.f, 0.f, 0.f, 0.f};
    bf16x8 At[4][2], B0[2][2], B1[2][2];
    const char* cA = (const char*)g.A + cur.aoff * 2; const char* cB = (const char*)g.Bt + cur.boff * 2;
    PG8_STAGE(PG8_SB(0, 0), cB, voffB); PG8_STAGE(PG8_SB(0, 1), cB + hstepB, voffB); PG8_STAGE(PG8_SA(0, 0), cA, voffA); PG8_STAGE(PG8_SA(0, 1), cA + hstepA, voffA);
    if (wr == 1) PG8_BAR;
    PG8_WAIT_V(2); PG8_BAR;
    PG8_STAGE(PG8_SB(1, 0), cB + kstep, voffB); PG8_STAGE(PG8_SA(1, 0), cA + kstep, voffA); PG8_STAGE(PG8_SB(1, 1), cB + hstepB + kstep, voffB);
    PG8_WAIT_V(6); PG8_BAR;
    for (;;) {
        const bool has_next = S.next(ui + 1, nxt);
        const char* nA = has_next ? (const char*)g.A + nxt.aoff * 2 : cA; const char* nB = has_next ? (const char*)g.Bt + nxt.boff * 2 : cB;
#pragma unroll 1
        for (int t = 0; t < nt; t += 2) {
            const bool last = (t == nt - 2);
            const char* a1 = cA + (size_t)(t + 1) * kstep;
            const char* a2 = last ? nA : cA + (size_t)(t + 2) * kstep; const char* b2 = last ? nB : cB + (size_t)(t + 2) * kstep;
            const char* a3 = a2 + kstep; const char* b3 = b2 + kstep;
            PG8_LDB(B0, 0, 0); PG8_LDB(B1, 0, 1); PG8_SCHED; PG8_LDA(At, 0, 0); PG8_STAGE(PG8_SA(1, 1), a1 + hstepA, voffA);
            PG8_WAIT_V(8); PG8_WAIT_L(0); PG8_BAR; PG8_MMA(0, 0, At, B0); PG8_MMA(0, 1, At, B1); PG8_BAR; PG8_SCHED;
            PG8_LDA(At, 0, 1); PG8_STAGE(PG8_SB(0, 0), b2, voffB); PG8_STAGE(PG8_SB(0, 1), b2 + hstepB, voffB); PG8_STAGE(PG8_SA(0, 0), a2, voffA);
            PG8_WAIT_V(8); PG8_WAIT_L(0); PG8_BAR; PG8_MMA(1, 0, At, B0); PG8_MMA(1, 1, At, B1); PG8_BAR; PG8_SCHED;
            PG8_LDB(B0, 1, 0); PG8_LDB(B1, 1, 1); PG8_SCHED; PG8_LDA(At, 1, 0); PG8_STAGE(PG8_SA(0, 1), a2 + hstepA, voffA);
            PG8_WAIT_V(8); PG8_WAIT_L(0); PG8_BAR; PG8_MMA(0, 0, At, B0); PG8_MMA(0, 1, At, B1); PG8_BAR; PG8_SCHED;
            PG8_LDA(At, 1, 1); PG8_STAGE(PG8_SB(1, 0), b3, voffB); PG8_STAGE(PG8_SB(1, 1), b3 + hstepB, voffB); PG8_STAGE(PG8_SA(1, 0), a3, voffA);
            PG8_WAIT_V(8); PG8_WAIT_L(0); PG8_BAR; PG8_MMA(1, 0, At, B0); PG8_MMA(1, 1, At, B1); PG8_BAR; PG8_SCHED;
        }
        if constexpr (ALIGN_EPI) { if (wr == 0) PG8_BAR; }
        E(acc, cur, wr, wc, fr, fq);
        if (!has_next) break;
#pragma unroll
        for (int a = 0; a < 2; ++a)
#pragma unroll
            for (int b = 0; b < 2; ++b)
#pragma unroll
                for (int m = 0; m < 4; ++m)
#pragma unroll
                    for (int n = 0; n < 2; ++n) acc[a][b][m][n] = (f32x4){0.f, 0.f, 0.f, 0.f};
        cur = nxt; cA = nA; cB = nB; ++ui;
        if constexpr (ALIGN_EPI) { if (wr == 1) PG8_BAR; }
    }
    PG8_WAIT_V(0);
    if constexpr (!ALIGN_EPI) { if (wr == 0) PG8_BAR; }
    PG8_BAR;
#undef PG8_SA
#undef PG8_SB
#undef PG8_STAGE
#undef PG8_LDA
#undef PG8_LDB
#undef PG8_MMA
#undef PG8_WAIT_V
#undef PG8_WAIT_L
#undef PG8_BAR
#undef PG8_SCHED
}
}

constexpr int NWAVES = 8, NTHR = 512, GRID = 256;
constexpr int RING_BYTES = 131072, XCH_OFF = RING_BYTES, LDS_BYTES = 147456;
struct Args { const float* in[22]; float* out; unsigned char* ws; int ph_lo, ph_hi; };
enum { I_X = 0, I_MEM, I_NORM_MIX, I_W_IN, I_SG_VG, I_SG_W, I_SG_B, I_GLA_WG, I_GLA_BG, I_GLA_OG, I_W_OUT, I_NORM_MEM, I_MEM_GAIN, I_W_CQ, I_W_CKV, I_W_CO, I_NORM_FFN, I_PEER_WQ, I_PEER_SK, I_PEER_U, I_PEER_V, I_FINAL_G };

struct Frame {
    LAS unsigned char* lds; int tid, lane, wave, bx, gw; static constexpr int G = GRID, NGW = GRID * NWAVES;
    float* X; unsigned char* ws;
};
#define INP(i) (args.in[(i)])

#define XB_TMO      128
#define XB_XCNT(j)  (256  + 64 * (j))
#define XB_XSUB(j)  (1280 + 64 * (j))
#define XB_XGEN(j)  (2304 + 64 * (j))
#define XB_TOP      3328
#define XB_TOPGEN   3392
#define XCD_BAR_WORDS 3456
#define XB_SPIN_CAP (1u << 22)
DI unsigned xb_ld(unsigned* p)              { return __hip_atomic_load(p, __ATOMIC_RELAXED, __HIP_MEMORY_SCOPE_AGENT); }
DI unsigned xb_add(unsigned* p, unsigned v) { return __hip_atomic_fetch_add(p, v, __ATOMIC_RELAXED, __HIP_MEMORY_SCOPE_AGENT); }
DI unsigned xb_xcc_id() { return (unsigned)__builtin_amdgcn_s_getreg((3 << 11) | 20) & 0xFu; }
#define XB_SPIN(cond, bar) do { unsigned _sp = 0; while (cond) { __builtin_amdgcn_s_sleep(1); \
    if ((++_sp & 255u) == 0u) { if (xb_ld(&(bar)[XB_TMO])) break; if (_sp > XB_SPIN_CAP) { atomicAdd(&(bar)[XB_TMO], 1u); break; } } } } while (0)
struct XcdBarrier { unsigned* bar; unsigned x; volatile LAS unsigned* st; };
DI XcdBarrier xcd_barrier_post(unsigned* bar, volatile LAS unsigned* st) {
    XcdBarrier b; b.bar = bar; b.x = xb_xcc_id(); b.st = st;
    if (threadIdx.x == 0) (void)xb_add(&bar[XB_XCNT(b.x)], 1u);
    return b;
}
DI void xcd_barrier_complete(unsigned* bar, unsigned x, unsigned& nloc, unsigned& nx) {
    const unsigned G = gridDim.x * gridDim.y * gridDim.z;
    unsigned sum, cnt, mine, sp = 0u;
    for (;;) {
        sum = 0u; cnt = 0u; mine = 0u;
#pragma unroll
        for (unsigned j = 0; j < 16; ++j) { const unsigned c = xb_ld(&bar[XB_XCNT(j)]); sum += c; cnt += (c > 0u) ? 1u : 0u; mine = (j == x) ? c : mine; }
        if (sum == G) break;
        __builtin_amdgcn_s_sleep(1);
        if ((++sp & 255u) == 0u) { if (xb_ld(&bar[XB_TMO])) break; if (sp > XB_SPIN_CAP) { atomicAdd(&bar[XB_TMO], 1u); break; } }
    }
    nloc = mine > 0u ? mine : 1u; nx = cnt > 0u ? cnt : 1u;
}
DI void xcd_barrier(const XcdBarrier& b) {
    asm volatile("s_waitcnt vmcnt(0)" ::: "memory");
    __syncthreads();
    if (threadIdx.x == 0) {
        unsigned* bar = b.bar;
        __builtin_amdgcn_s_waitcnt(0);
        unsigned nloc = b.st[0], nx = b.st[1];
        if (nloc == 0u) { xcd_barrier_complete(bar, b.x, nloc, nx); b.st[0] = nloc; b.st[1] = nx; }
        const unsigned old = xb_add(&bar[XB_XSUB(b.x)], 1u);
        const unsigned gen = old / nloc;
        if (old + 1u == (gen + 1u) * nloc) {
            __builtin_amdgcn_fence(__ATOMIC_RELEASE, "agent");
            asm volatile("s_waitcnt vmcnt(0)" ::: "memory");
            const unsigned og = xb_add(&bar[XB_TOP], 1u);
            const unsigned tg = og / nx;
            if (og + 1u == (tg + 1u) * nx) xb_add(&bar[XB_TOPGEN], 1u);
            else XB_SPIN(xb_ld(&bar[XB_TOPGEN]) == tg, bar);
            __builtin_amdgcn_fence(__ATOMIC_ACQUIRE, "agent");
            xb_add(&bar[XB_XGEN(b.x)], 1u);
            asm volatile("s_waitcnt vmcnt(0)" ::: "memory");
        } else {
            XB_SPIN(xb_ld(&bar[XB_XGEN(b.x)]) == gen, bar);
            __builtin_amdgcn_fence(__ATOMIC_ACQUIRE, "agent");
            asm volatile("s_waitcnt vmcnt(0)" ::: "memory");
        }
    }
    __syncthreads();
}

DI void p0_transpose_item(const float* W, int ldw, int N, int K, const float* gain, bf16_t* WT, LAS float* scr, int item, int lane) {
    const int nblk = N / 32, kb = item / nblk, nb = item % nblk, k0 = 64 * kb, n0 = 32 * nb;
#pragma unroll 8
    for (int i = 0; i < 32; ++i) { const int kk = 2 * i + (lane >> 5); float w = W[(size_t)(k0 + kk) * ldw + n0 + (lane & 31)]; if (gain) w *= gain[k0 + kk]; scr[kk * 33 + (lane & 31)] = w; }
    LDS_WAIT(); asm volatile("" ::: "memory");
    const int c = lane & 7;
#pragma unroll
    for (int j = 0; j < 4; ++j) { const int n = (lane >> 3) + 8 * j; const LAS float* s = scr + (8 * c) * 33 + n;
        u32x4 o; o.x = cvtpk(s[0 * 33], s[1 * 33]); o.y = cvtpk(s[2 * 33], s[3 * 33]); o.z = cvtpk(s[4 * 33], s[5 * 33]); o.w = cvtpk(s[6 * 33], s[7 * 33]);
        *(u32x4*)(WT + (size_t)(n0 + n) * K + k0 + 8 * c) = o; }
    LDS_WAIT(); asm volatile("" ::: "memory");
}
DI unsigned fp4x8(const f32x4 a, const f32x4 b, float inv) {
    unsigned w = 0;
    w = __builtin_amdgcn_cvt_scalef32_pk_fp4_f32(w, a[0] * inv, a[1] * inv, 1.0f, 0); w = __builtin_amdgcn_cvt_scalef32_pk_fp4_f32(w, a[2] * inv, a[3] * inv, 1.0f, 1);
    w = __builtin_amdgcn_cvt_scalef32_pk_fp4_f32(w, b[0] * inv, b[1] * inv, 1.0f, 2); w = __builtin_amdgcn_cvt_scalef32_pk_fp4_f32(w, b[2] * inv, b[3] * inv, 1.0f, 3);
    return w;
}
DI float wave_max(float v) {
#pragma unroll
    for (int o = 1; o < 64; o <<= 1) v = fmaxf(v, __shfl_xor(v, o));
    return v;
}
DI void convert_tables(const Frame& F, const Args& args, int l, int wv, int nwv) {
    const float* gn = INP(I_NORM_FFN) + l * 1024 + 16 * F.lane;
    f32x4 g[4];
#pragma unroll
    for (int q = 0; q < 4; ++q) g[q] = *(const f32x4*)(gn + 4 * q);
    for (int r0 = wv; r0 < 2 * 16384; r0 += 4 * nwv) {
        f32x4 v[4][4];
#pragma unroll
        for (int j = 0; j < 4; ++j) { const int r = min(r0 + j * nwv, 2 * 16384 - 1), isv = r >= 16384, e = r & 16383;
            const float* src = (isv ? INP(I_PEER_V) : INP(I_PEER_U)) + ((size_t)l * 16384 + e) * 1024 + 16 * F.lane;
#pragma unroll
            for (int q = 0; q < 4; ++q) v[j][q] = *(const f32x4*)(src + 4 * q); }
#pragma unroll
        for (int j = 0; j < 4; ++j) { const int r = r0 + j * nwv, isv = r >= 16384, e = r & 16383; float am = 0.f;
            if (r < 2 * 16384) {
#pragma unroll
            for (int q = 0; q < 4; ++q) { if (!isv) v[j][q] = v[j][q] * g[q];
                am = fmaxf(am, fmaxf(fmaxf(fabsf(v[j][q][0]), fabsf(v[j][q][1])), fmaxf(fabsf(v[j][q][2]), fabsf(v[j][q][3])))); }
            am = wave_max(am);
            const float sc = bf2f(cvt1(am > 0.f ? am * (1.0f / 6.0f) : 1.0f)), inv = 1.0f / sc;
            u32x2 w; w.x = fp4x8(v[j][0], v[j][1], inv); w.y = fp4x8(v[j][2], v[j][3], inv);
            *(u32x2*)(F.ws + WS_TAB + (size_t)l * 16 * MiB + (size_t)isv * 8 * MiB + (size_t)e * 512 + 8 * F.lane) = w;
            if (F.lane == 0) ((bf16_t*)(F.ws + WS_TAB + 32 * MiB))[((size_t)l * 16384 + e) * 2 + isv] = cvt1(sc); } }
    }
}
struct TDesc { const float* W; const float* gain; bf16_t* WT; int ldw, nblk; };
DI TDesc tdesc(const Frame& F, const Args& args, int l, int t) {
    TDesc D; D.gain = nullptr; D.ldw = 1024; D.nblk = 32; size_t woff;
    switch (t) {
    case 0: D.W = INP(I_W_IN) + (size_t)l * 1024 * INW; D.ldw = INW; D.nblk = 88; D.gain = INP(I_NORM_MIX) + l * 1024; woff = W_IN; break;
    case 1: D.W = INP(I_W_OUT) + (size_t)l * 1024 * 1024; woff = W_OUT; break;
    case 2: D.W = INP(I_W_CQ) + (size_t)l * 1024 * 1024; D.gain = INP(I_NORM_MEM) + l * 1024; woff = W_CQ; break;
    case 3: D.W = INP(I_W_CKV) + (size_t)l * 1024 * 2048; D.ldw = 2048; D.nblk = 64; D.gain = INP(I_MEM_GAIN) + l * 1024; woff = W_CKV; break;
    case 4: D.W = INP(I_W_CO) + (size_t)l * 1024 * 1024; woff = W_CO; break;
    default: D.W = INP(I_PEER_WQ) + (size_t)l * 1024 * 1024; D.gain = INP(I_NORM_FFN) + l * 1024; woff = W_PQ; break;
    }
    D.WT = (bf16_t*)(F.ws + WS_W + l * W_LAYER + woff); return D;
}
DI void titem_load(const TDesc& D, int item, int lane, float (&v)[32]) {
    const int kb = item / D.nblk, nb = item % D.nblk, k0 = 64 * kb, n0 = 32 * nb;
#pragma unroll
    for (int i = 0; i < 32; ++i) { const int kk = 2 * i + (lane >> 5); float w = D.W[(size_t)(k0 + kk) * D.ldw + n0 + (lane & 31)]; if (D.gain) w *= D.gain[k0 + kk]; v[i] = w; }
}
DI void titem_store(const TDesc& D, int item, int lane, LAS float* scr, const float (&v)[32]) {
    const int kb = item / D.nblk, nb = item % D.nblk, k0 = 64 * kb, n0 = 32 * nb;
#pragma unroll
    for (int i = 0; i < 32; ++i) scr[(2 * i + (lane >> 5)) * 33 + (lane & 31)] = v[i];
    LDS_WAIT(); asm volatile("" ::: "memory");
    const int c = lane & 7;
#pragma unroll
    for (int j = 0; j < 4; ++j) { const int n = (lane >> 3) + 8 * j; const LAS float* s = scr + (8 * c) * 33 + n;
        u32x4 o; o.x = cvtpk(s[0 * 33], s[1 * 33]); o.y = cvtpk(s[2 * 33], s[3 * 33]); o.z = cvtpk(s[4 * 33], s[5 * 33]); o.w = cvtpk(s[6 * 33], s[7 * 33]);
        *(u32x4*)(D.WT + (size_t)(n0 + n) * 1024 + k0 + 8 * c) = o; }
    LDS_WAIT(); asm volatile("" ::: "memory");
}
DI int tl_index(int part, int e) {
    if (part == 0) return e < 1408 ? e : e < 2432 ? 2432 + (e - 1408) : 4480 + 2432 + (e - 2432);
    return e < 1024 ? 1408 + e : e < 2048 ? 3456 + (e - 1024) : e < 4480 ? 4480 + (e - 2048) : 4480 + 3456 + (e - 4480);
}
DI void transpose_list(const Frame& F, const Args& args, LAS float* scr, int wv, int nwv, int part) {
    constexpr int NIT_L = 16 * 88 + 4 * 16 * 32 + 16 * 64;
    const int NIT = part == 0 ? 3456 : 5504;
    float va[32], vb[32]; TDesc Da{}, Db{}; int la = 0, lb = 0;
#define TI_DECODE(e_, D_, loc_) do { const int it_ = tl_index(part, (e_)); const int l_ = it_ / NIT_L; int r_ = it_ % NIT_L; int t_; \
        if (r_ < 1408) t_ = 0; else if (r_ < 1920) { t_ = 1; r_ -= 1408; } else if (r_ < 2432) { t_ = 2; r_ -= 1920; } else if (r_ < 3456) { t_ = 3; r_ -= 2432; } else if (r_ < 3968) { t_ = 4; r_ -= 3456; } else { t_ = 5; r_ -= 3968; } \
        D_ = tdesc(F, args, l_, t_); loc_ = r_; } while (0)
    int it = wv;
    if (it < NIT) { TI_DECODE(it, Da, la); titem_load(Da, la, F.lane, va); }
    for (;;) {
        int itn = it + nwv;
        if (itn < NIT) { TI_DECODE(itn, Db, lb); titem_load(Db, lb, F.lane, vb); }
        if (it < NIT) titem_store(Da, la, F.lane, scr, va);
        it = itn; if (it >= NIT) break;
        itn = it + nwv;
        if (itn < NIT) { TI_DECODE(itn, Da, la); titem_load(Da, la, F.lane, va); }
        titem_store(Db, lb, F.lane, scr, vb);
        it = itn; if (it >= NIT) break;
    }
#undef TI_DECODE
}
DI void p0_prologue(const Frame& F, const Args& args) {
    LAS float* scr = (LAS float*)(F.lds + F.wave * 16384);
    transpose_list(F, args, scr, F.gw, F.NGW, 0);
    const int gt = F.bx * NTHR + F.tid, nthr = F.G * NTHR;
    for (int i = gt; i < DEPTH * 256 * 1024; i += nthr) {
        const int l = i / (256 * 1024), r = i % (256 * 1024), j = r >> 10, k = r & 1023;
        bf16_t* Wi = (bf16_t*)(F.ws + WS_W + l * W_LAYER) + W_IN / 2;
        float v = 0.f;
        if (j < 128) {
            const float* wi = INP(I_W_IN) + (size_t)l * 1024 * INW + (size_t)k * INW + 2816; const float* wg = INP(I_GLA_WG) + l * 16 * 128 + j;
#pragma unroll
            for (int q4 = 0; q4 < 4; ++q4) { const f32x4 w4 = *(const f32x4*)(wi + 4 * q4);
#pragma unroll
                for (int e = 0; e < 4; ++e) v += w4[e] * wg[(4 * q4 + e) * 128]; }
            v *= INP(I_NORM_MIX)[l * 1024 + k];
        }
        Wi[(size_t)(2816 + j) * 1024 + k] = cvt1(v);
    }
    { bf16_t* WSP = (bf16_t*)(F.ws + WS_WSP); const float* sw = INP(I_SG_W);
      for (int i = gt; i < DEPTH * 4 * 128 * 128; i += nthr) { const int s = i & 127, t = (i >> 7) & 127; WSP[i] = cvt1(s <= t ? sw[i] : 0.f); }
      bf16_t* SK = (bf16_t*)(F.ws + WS_SUBK); const float* sk = INP(I_PEER_SK);
      for (int i = gt; i < DEPTH * 8 * 2 * 128 * 64; i += nthr) SK[i] = cvt1(sk[i]); }
    { float* SS = (float*)(F.ws + WS_SS); bf16_t* XB = (bf16_t*)(F.ws + WS_XB); const float* x = INP(I_X);
      for (int m0 = F.gw; m0 < MTOK; m0 += 4 * F.NGW) {
          f32x4 v[4][4];
#pragma unroll
          for (int i = 0; i < 4; ++i) { const f32x4* xr = (const f32x4*)(x + (size_t)(m0 + i * F.NGW) * 1024) + F.lane;
#pragma unroll
              for (int j = 0; j < 4; ++j) v[i][j] = xr[64 * j]; }
#pragma unroll
          for (int i = 0; i < 4; ++i) { const int m = m0 + i * F.NGW; float s = 0.f; u32x2 w[4];
#pragma unroll
              for (int j = 0; j < 4; ++j) { w[j].x = cvtpk(v[i][j][0], v[i][j][1]); w[j].y = cvtpk(v[i][j][2], v[i][j][3]);
                  s += (bflo(w[j].x) * bflo(w[j].x) + bfhi(w[j].x) * bfhi(w[j].x)) + (bflo(w[j].y) * bflo(w[j].y) + bfhi(w[j].y) * bfhi(w[j].y)); }
              s = wave_sum(s);
              u32x2* xb = (u32x2*)(XB + (size_t)m * 1024) + F.lane;
#pragma unroll
              for (int j = 0; j < 4; ++j) xb[64 * j] = w[j];
              if (F.lane < 16) SS[(size_t)m * 16 + F.lane] = F.lane == 0 ? s : 0.f; }
      }
      bf16_t* MB = (bf16_t*)(F.ws + WS_MEMB); float* RM = (float*)(F.ws + WS_RSTDM); const float* mem = INP(I_MEM);
      for (int m = F.gw; m < MMEM; m += F.NGW) {
          const f32x4* xr = (const f32x4*)(mem + (size_t)m * 1024) + F.lane; f32x4 v[4]; float s = 0.f;
#pragma unroll
          for (int j = 0; j < 4; ++j) { v[j] = xr[64 * j]; s += (v[j][0] * v[j][0] + v[j][1] * v[j][1]) + (v[j][2] * v[j][2] + v[j][3] * v[j][3]); }
          s = wave_sum(s);
          u32x2* xb = (u32x2*)(MB + (size_t)m * 1024) + F.lane;
#pragma unroll
          for (int j = 0; j < 4; ++j) { u32x2 w; w.x = cvtpk(v[j][0], v[j][1]); w.y = cvtpk(v[j][2], v[j][3]); xb[64 * j] = w; }
          if (F.lane == 0) RM[m] = 1.0f / sqrtf(s * (1.0f / 1024.0f) + EPS);
      } }
}

constexpr int SBV_PITCH = 192;
DI void sb_unit2(const bf16_t* PROJ, bf16_t* YCAT, int b, int h, int qp, LAS char* vl, int lane) {
    const int q = lane & 31, hh = lane >> 5;
    const size_t rowbase = (size_t)b * SEQ; const int qa = 2 * qp, qb = qa + 1;
    bf16x8 qfA[4], qfB[4];
    { const bf16_t* qrow = PROJ + (rowbase + qa * 32 + q) * LDP + C_SBQ + h * 64 + hh * 8;
#pragma unroll
      for (int s = 0; s < 4; ++s) { qfA[s] = *(const bf16x8*)(qrow + 16 * s); qfB[s] = *(const bf16x8*)(qrow + 32 * LDP + 16 * s); } }
    f32x16 oA0, oA1, oB0, oB1;
#pragma unroll
    for (int r = 0; r < 16; ++r) { oA0[r] = 0.f; oA1[r] = 0.f; oB0[r] = 0.f; oB1[r] = 0.f; }
    float RA = 0.f, RB = 0.f;
    const float zs = 0.125f * LOG2E;
    const int i16 = lane & 15, tq = i16 >> 2, tp = i16 & 3, blk = (lane >> 4) & 1;
    bf16x8 kf[4]; u32x4 vr[4];
#define SB_LOAD_TILE(kt_, kf, vr) do { const bf16_t* krow_ = PROJ + (rowbase + (kt_) * 32 + q) * LDP + C_SBK + h * 64 + hh * 8; \
        _Pragma("unroll") for (int s_ = 0; s_ < 4; ++s_) kf[s_] = *(const bf16x8*)(krow_ + 16 * s_); \
        _Pragma("unroll") for (int i_ = 0; i_ < 4; ++i_) { const int c_ = lane + 64 * i_, row_ = c_ >> 3, ch_ = c_ & 7; vr[i_] = *(const u32x4*)(PROJ + (rowbase + (kt_) * 32 + row_) * LDP + C_SBV + h * 64 + ch_ * 8); } } while (0)
#define SB_MATH(Z, DIAG, R, O0, O1) { \
        float L[16]; \
        _Pragma("unroll") for (int r = 0; r < 16; ++r) { \
            const float zl = Z[r] * zs; float l2 = flog2(1.f + fexp2(zl)); l2 = zl > 60.f ? zl : l2; \
            const bool valid = !(DIAG) || (crow(r, hh) < q); \
            L[r] = valid ? l2 : 0.f; Z[r] = valid ? zl : -INFINITY; } \
        float G[4], Go[4]; \
        _Pragma("unroll") for (int g = 0; g < 4; ++g) { G[g] = (L[4 * g] + L[4 * g + 1]) + (L[4 * g + 2] + L[4 * g + 3]); Go[g] = __shfl_xor(G[g], 32); } \
        float base[4]; float run = 0.f; \
        _Pragma("unroll") for (int g = 3; g >= 0; --g) { base[g] = run + (hh == 0 ? Go[g] : 0.f); run += G[g] + Go[g]; } \
        float P[16]; \
        _Pragma("unroll") for (int g = 0; g < 4; ++g) { \
            const float c3 = R + base[g], c2 = c3 + L[4 * g + 3], c1 = c2 + L[4 * g + 2], c0 = c1 + L[4 * g + 1]; \
            P[4 * g + 3] = fexp2(Z[4 * g + 3] - L[4 * g + 3] - c3); P[4 * g + 2] = fexp2(Z[4 * g + 2] - L[4 * g + 2] - c2); \
            P[4 * g + 1] = fexp2(Z[4 * g + 1] - L[4 * g + 1] - c1); P[4 * g + 0] = fexp2(Z[4 * g + 0] - L[4 * g + 0] - c0); } \
        R += run; \
        const bf16x8 p0 = pack8(P[0], P[1], P[2], P[3], P[4], P[5], P[6], P[7]), p1 = pack8(P[8], P[9], P[10], P[11], P[12], P[13], P[14], P[15]); \
        _Pragma("unroll") for (int s = 0; s < 2; ++s) { \
            const LAS char* vb = vl + (16 * s + 4 * hh + tq) * SBV_PITCH + blk * 32 + tp * 8; \
            const bf16x8 a0 = cat8(vtr(vb), vtr(vb + 8 * SBV_PITCH)), a1 = cat8(vtr(vb + 64), vtr(vb + 8 * SBV_PITCH + 64)); \
            O0 = MFMA32(a0, s == 0 ? p0 : p1, O0); O1 = MFMA32(a1, s == 0 ? p0 : p1, O1); } }
#define SB_ZERO(Z) _Pragma("unroll") for (int r = 0; r < 16; ++r) Z[r] = 0.f;
#define SB_VTOLDS(VR) _Pragma("unroll") for (int i = 0; i < 4; ++i) { const int c = lane + 64 * i, row = c >> 3, ch = c & 7; *(LAS u32x4*)(vl + row * SBV_PITCH + ch * 16) = VR[i]; }
    SB_LOAD_TILE(qb, kf, vr);
    {
        f32x16 zB; SB_ZERO(zB)
#pragma unroll
        for (int s = 0; s < 4; ++s) zB = MFMA32(kf[s], qfB[s], zB);
        SB_VTOLDS(vr)
        SB_LOAD_TILE(qa, kf, vr);
        SB_MATH(zB, true, RB, oB0, oB1)
    }
#define SB_STEP2(kt) { \
        f32x16 zA, zB; SB_ZERO(zA) SB_ZERO(zB) \
        _Pragma("unroll") for (int s = 0; s < 4; ++s) { zA = MFMA32(kf[s], qfA[s], zA); zB = MFMA32(kf[s], qfB[s], zB); } \
        SB_VTOLDS(vr) \
        if (kt > 0) SB_LOAD_TILE(kt - 1, kf, vr); \
        SB_MATH(zA, (kt == qa), RA, oA0, oA1) \
        SB_MATH(zB, false, RB, oB0, oB1) \
        if (__all(RA > 57.7f && RB > 57.7f)) break;            \
    }
    for (int kt = qa; kt >= 0; --kt) SB_STEP2(kt)
#undef SB_STEP2
#undef SB_VTOLDS
#undef SB_ZERO
#undef SB_MATH
#undef SB_LOAD_TILE
    bf16_t* orow = YCAT + (rowbase + qa * 32 + q) * 1024 + h * 64 + 4 * hh;
#pragma unroll
    for (int g = 0; g < 4; ++g) {
        u32x2 w0; w0.x = cvtpk(oA0[4 * g], oA0[4 * g + 1]); w0.y = cvtpk(oA0[4 * g + 2], oA0[4 * g + 3]); *(u32x2*)(orow + 8 * g) = w0;
        u32x2 w1; w1.x = cvtpk(oA1[4 * g], oA1[4 * g + 1]); w1.y = cvtpk(oA1[4 * g + 2], oA1[4 * g + 3]); *(u32x2*)(orow + 32 + 8 * g) = w1;
        u32x2 w2; w2.x = cvtpk(oB0[4 * g], oB0[4 * g + 1]); w2.y = cvtpk(oB0[4 * g + 2], oB0[4 * g + 3]); *(u32x2*)(orow + 32 * 1024 + 8 * g) = w2;
        u32x2 w3; w3.x = cvtpk(oB1[4 * g], oB1[4 * g + 1]); w3.y = cvtpk(oB1[4 * g + 2], oB1[4 * g + 3]); *(u32x2*)(orow + 32 * 1024 + 32 + 8 * g) = w3;
    }
}

constexpr int SGV_PITCH = 576;
DI void sgu_unit(const Frame& F, const Args& args, int l, int b, int c, const bf16_t* PROJ, bf16_t* YCAT) {
    const size_t m0 = (size_t)b * SEQ + c * 128;
    LAS char* Vn = (LAS char*)F.lds;
    {
      const int t = F.tid >> 2, part = F.tid & 3; const bf16_t* vrow = PROJ + (m0 + t) * LDP + C_SGV + part * 64; const float* gn = INP(I_SG_VG) + l * 256 + part * 64;
      float gv[64]; float s = 0.f;
#pragma unroll
      for (int i = 0; i < 8; ++i) { const u32x4 w = *(const u32x4*)(vrow + 8 * i);
#pragma unroll
          for (int j = 0; j < 4; ++j) { const float a = gelu_tanh(bflo(w[j])), bb = gelu_tanh(bfhi(w[j])); gv[8 * i + 2 * j] = a; gv[8 * i + 2 * j + 1] = bb; s += a * a + bb * bb; } }
      s += __shfl_xor(s, 1); s += __shfl_xor(s, 2);
      const float rstd = 1.0f / sqrtf(s * (1.0f / 256.0f) + EPS);
#pragma unroll
      for (int i = 0; i < 8; ++i) { const f32x4 g0 = *(const f32x4*)(gn + 8 * i), g1 = *(const f32x4*)(gn + 8 * i + 4);
          u32x4 w; w.x = cvtpk(gv[8 * i] * rstd * g0[0], gv[8 * i + 1] * rstd * g0[1]); w.y = cvtpk(gv[8 * i + 2] * rstd * g0[2], gv[8 * i + 3] * rstd * g0[3]);
          w.z = cvtpk(gv[8 * i + 4] * rstd * g1[0], gv[8 * i + 5] * rstd * g1[1]); w.w = cvtpk(gv[8 * i + 6] * rstd * g1[2], gv[8 * i + 7] * rstd * g1[3]);
          *(LAS u32x4*)(Vn + t * SGV_PITCH + (part * 64 + 8 * i) * 2) = w; } }
    WG_SYNC();
    {
      const int g = F.wave >> 1, db = F.wave & 1, lane = F.lane, r32 = lane & 31, hh = lane >> 5;
      const int i16 = lane & 15, tq = i16 >> 2, tp = i16 & 3, blk = (lane >> 4) & 1;
      const bf16_t* Wg = (const bf16_t*)(F.ws + WS_WSP) + ((size_t)(l * 4 + g) * 128) * 128;
      const float* bias = INP(I_SG_B) + (l * 4 + g) * 128;
      const int ch0 = g * 64 + db * 32 + 4 * hh;
      for (int tb = 0; tb < 4; ++tb) {
          const int t = tb * 32 + r32;
          u32x2 uw[4];
#pragma unroll
          for (int gi = 0; gi < 4; ++gi) uw[gi] = *(const u32x2*)(PROJ + (m0 + t) * LDP + C_SGU + ch0 + 8 * gi);
          const float bt = bias[t];
          f32x16 acc;
#pragma unroll
          for (int r = 0; r < 16; ++r) acc[r] = 0.f;
          for (int sb = 0; sb <= tb; ++sb) {
#pragma unroll
              for (int ks = 0; ks < 2; ++ks) {
                  const bf16x8 wf = *(const bf16x8*)(Wg + (size_t)t * 128 + sb * 32 + 16 * ks + 8 * hh);
                  const LAS char* vb = Vn + (sb * 32 + 16 * ks + 8 * hh + tq) * SGV_PITCH + (g * 64 + db * 32 + blk * 16) * 2 + tp * 8;
                  const bf16x8 vf = cat8(vtr(vb), vtr(vb + 4 * SGV_PITCH));
                  acc = MFMA32(vf, wf, acc);
              }
          }
          bf16_t* yo = YCAT + (m0 + t) * 1024 + 512 + ch0;
#pragma unroll
          for (int gi = 0; gi < 4; ++gi) {
              const float y0 = gelu_tanh(bflo(uw[gi].x)) * (acc[4 * gi] + bt), y1 = gelu_tanh(bfhi(uw[gi].x)) * (acc[4 * gi + 1] + bt);
              const float y2 = gelu_tanh(bflo(uw[gi].y)) * (acc[4 * gi + 2] + bt), y3 = gelu_tanh(bfhi(uw[gi].y)) * (acc[4 * gi + 3] + bt);
              u32x2 wv; wv.x = cvtpk(y0, y1); wv.y = cvtpk(y2, y3); *(u32x2*)(yo + 8 * gi) = wv;
          }
      } }
    WG_SYNC();
}

constexpr int GQ_PITCH = 80, GV_PITCH = 192, GS_PITCH = 80;
constexpr int GL_QT = 0, GL_KT = GL_QT + 128 * GQ_PITCH, GL_VV = GL_KT + 128 * GQ_PITCH, GL_ST = GL_VV + 128 * GV_PITCH, GL_SEG = GL_ST + 64 * GS_PITCH,
              GL_D = GL_SEG + 16 * 32 * 4, GL_SSQ = GL_D + 32 * 4, GL_END = GL_SSQ + 128 * 2 * 4;
DI void gla_chain(const Frame& F, const Args& args, int l, int b, int h, const bf16_t* PROJ, bf16_t* YCAT) {
    LAS char* L = (LAS char*)F.lds;
    LAS float* SEG = (LAS float*)(L + GL_SEG); LAS float* Dd = (LAS float*)(L + GL_D); LAS float* SSQ = (LAS float*)(L + GL_SSQ);
    const int tid = F.tid, lane = F.lane, w = F.wave, r32 = lane & 31, hh = lane >> 5;
    const int i16 = lane & 15, tq = i16 >> 2, tp = i16 & 3, blk = (lane >> 4) & 1;
    for (int i = tid; i < 64 * GS_PITCH / 4; i += NTHR) ((LAS unsigned*)(L + GL_ST))[i] = 0u;
    f32x16 st;
#pragma unroll
    for (int r = 0; r < 16; ++r) st[r] = 0.f;
    const int j = tid & 31, seg = tid >> 5;
    const float bg = INP(I_GLA_BG)[l * 128 + h * 32 + j];
    const int tb = w & 3, dh = w >> 2;
    float ga[8], kr[8], qr[8]; u32x4 vv[2];
#define GC_LOAD(c_) do { const size_t m0_ = (size_t)b * SEQ + (c_) * 128; \
        _Pragma("unroll") for (int i_ = 0; i_ < 8; ++i_) { const bf16_t* p_ = PROJ + (m0_ + seg * 8 + i_) * LDP + h * 32 + j; ga[i_] = bf2f(p_[C_GA]); kr[i_] = bf2f(p_[C_GK]); qr[i_] = bf2f(p_[C_GQ]); } \
        _Pragma("unroll") for (int i_ = 0; i_ < 2; ++i_) { const int cc_ = tid + 512 * i_, row_ = cc_ >> 3, ch_ = cc_ & 7; vv[i_] = *(const u32x4*)(PROJ + (m0_ + row_) * LDP + C_GV + h * 64 + ch_ * 8); } } while (0)
    GC_LOAD(0);
    LDS_SYNC();
#pragma unroll 1
    for (int c = 0; c < 16; ++c) {
        const size_t m0 = (size_t)b * SEQ + c * 128;
        float bc[8]; float run = 0.f;
#pragma unroll
        for (int i = 0; i < 8; ++i) {
            const float g = ga[i] + bg;
            const float sp = fmaxf(-g, 0.f) + flog2(1.f + fexp2(-fabsf(g) * LOG2E)) * 0.6931471805599453f;
            run += -sp * (1.0f / 16.0f); bc[i] = run;
        }
        SEG[seg * 32 + j] = run;
#pragma unroll
        for (int i = 0; i < 2; ++i) { const int cc = tid + 512 * i, row = cc >> 3, ch = cc & 7; *(LAS u32x4*)(L + GL_VV + row * GV_PITCH + ch * 16) = vv[i]; }
        LDS_SYNC();
        float pre = 0.f;
#pragma unroll
        for (int s2 = 0; s2 < 15; ++s2) { const float v_ = SEG[s2 * 32 + j]; pre += s2 < seg ? v_ : 0.f; }
#pragma unroll
        for (int i = 0; i < 8; ++i) {
            const int t = seg * 8 + i; const float bb = pre + bc[i];
            *(LAS bf16_t*)(L + GL_QT + t * GQ_PITCH + j * 2) = cvt1(qr[i] * 0.17677669529663687f * fexp2(bb * LOG2E));
            *(LAS bf16_t*)(L + GL_KT + t * GQ_PITCH + j * 2) = cvt1(kr[i] * fexp2(-bb * LOG2E));
            if (t == 127) Dd[j] = fexp2(bb * LOG2E);
        }
        if (c < 15) GC_LOAD(c + 1);
        u32x2 gov[4];
        { const bf16_t* go = PROJ + (m0 + tb * 32 + r32) * LDP + C_GO + h * 64 + dh * 32 + 4 * hh;
#pragma unroll
          for (int g = 0; g < 4; ++g) gov[g] = *(const u32x2*)(go + 8 * g); }
        LDS_SYNC();
        f32x16 o;
#pragma unroll
        for (int r = 0; r < 16; ++r) o[r] = 0.f;
        bf16x8 qf[2];
#pragma unroll
        for (int ks = 0; ks < 2; ++ks) qf[ks] = *(LAS const bf16x8*)(L + GL_QT + (tb * 32 + r32) * GQ_PITCH + (16 * ks + 8 * hh) * 2);
        for (int sb = 0; sb <= tb; ++sb) {
            f32x16 sT;
#pragma unroll
            for (int r = 0; r < 16; ++r) sT[r] = 0.f;
#pragma unroll
            for (int ks = 0; ks < 2; ++ks) { const bf16x8 kf = *(LAS const bf16x8*)(L + GL_KT + (sb * 32 + r32) * GQ_PITCH + (16 * ks + 8 * hh) * 2); sT = MFMA32(kf, qf[ks], sT); }
            if (sb == tb) {
#pragma unroll
                for (int r = 0; r < 16; ++r) if (crow(r, hh) > r32) sT[r] = 0.f;
            }
            const bf16x8 p0 = pack8(sT[0], sT[1], sT[2], sT[3], sT[4], sT[5], sT[6], sT[7]), p1 = pack8(sT[8], sT[9], sT[10], sT[11], sT[12], sT[13], sT[14], sT[15]);
#pragma unroll
            for (int s = 0; s < 2; ++s) {
                const LAS char* vb = L + GL_VV + (sb * 32 + 16 * s + 4 * hh + tq) * GV_PITCH + (dh * 32 + blk * 16) * 2 + tp * 8;
                const bf16x8 a = cat8(vtr(vb), vtr(vb + 8 * GV_PITCH));
                o = MFMA32(a, s == 0 ? p0 : p1, o);
            }
        }
#pragma unroll
        for (int ks = 0; ks < 2; ++ks) {
            const bf16x8 a = *(LAS const bf16x8*)(L + GL_ST + (dh * 32 + r32) * GS_PITCH + (16 * ks + 8 * hh) * 2);
            o = MFMA32(a, qf[ks], o);
        }
        if (tb == 0) {
#pragma unroll
            for (int ks = 0; ks < 8; ++ks) {
                const LAS char* kb = L + GL_KT + (16 * ks + 8 * hh + tq) * GQ_PITCH + (blk * 16) * 2 + tp * 8;
                const bf16x8 a = cat8(vtr(kb), vtr(kb + 4 * GQ_PITCH));
                const LAS char* vb = L + GL_VV + (16 * ks + 8 * hh + tq) * GV_PITCH + (dh * 32 + blk * 16) * 2 + tp * 8;
                const bf16x8 bfr = cat8(vtr(vb), vtr(vb + 4 * GV_PITCH));
                st = MFMA32(a, bfr, st);
            }
#pragma unroll
            for (int r = 0; r < 16; ++r) st[r] *= Dd[crow(r, hh)];
        }
        float ssq = 0.f;
#pragma unroll
        for (int r = 0; r < 16; ++r) ssq += o[r] * o[r];
        ssq += __shfl_xor(ssq, 32);
        if (hh == 0) SSQ[(tb * 32 + r32) * 2 + dh] = ssq;
        LDS_SYNC();
        {
            const int t = tb * 32 + r32; const float tot = SSQ[t * 2] + SSQ[t * 2 + 1]; const float rstd = 1.0f / sqrtf(tot * (1.0f / 64.0f) + EPS);
            const float* gn = INP(I_GLA_OG) + l * 256 + h * 64 + dh * 32 + 4 * hh;
            bf16_t* yo = YCAT + (m0 + t) * 1024 + 768 + h * 64 + dh * 32 + 4 * hh;
#pragma unroll
            for (int g = 0; g < 4; ++g) {
                const u32x2 gw = gov[g]; const f32x4 gg = *(const f32x4*)(gn + 8 * g);
                const float y0 = o[4 * g] * rstd * gg[0] * silu(bflo(gw.x)), y1 = o[4 * g + 1] * rstd * gg[1] * silu(bfhi(gw.x));
                const float y2 = o[4 * g + 2] * rstd * gg[2] * silu(bflo(gw.y)), y3 = o[4 * g + 3] * rstd * gg[3] * silu(bfhi(gw.y));
                u32x2 wv; wv.x = cvtpk(y0, y1); wv.y = cvtpk(y2, y3); *(u32x2*)(yo + 8 * g) = wv;
            }
        }
        if (tb == 0) {
#pragma unroll
            for (int g = 0; g < 4; ++g) { u32x2 wv; wv.x = cvtpk(st[4 * g], st[4 * g + 1]); wv.y = cvtpk(st[4 * g + 2], st[4 * g + 3]);
                *(LAS u32x2*)(L + GL_ST + (dh * 32 + r32) * GS_PITCH + (8 * g + 4 * hh) * 2) = wv; }
        }
        LDS_SYNC();
    }
#undef GC_LOAD
}

constexpr int XA_PITCH = 528;
template <int PITCH, int I0, int N> DI void xattn_load(const bf16_t* src, int tid, u32x4 (&v)[N]) {
    const bf16_t* p = src + (size_t)(tid >> 5) * PITCH + (tid & 31) * 8;
#pragma unroll
    for (int i = 0; i < N; ++i) v[i] = *(const u32x4*)(p + (size_t)(I0 + i) * 16 * PITCH);
}
template <int I0, int N> DI void xattn_store(LAS char* img, int tid, const u32x4 (&v)[N]) {
    LAS char* d = img + (tid >> 5) * XA_PITCH + (tid & 31) * 16;
#pragma unroll
    for (int i = 0; i < N; ++i) *(LAS u32x4*)(d + (I0 + i) * 16 * XA_PITCH) = v[i];
}
DI void xattn_unit(const Frame& F, const bf16_t* CQ, const bf16_t* Kl, const bf16_t* VTl, bf16_t* O, int pm, int h) {
    LAS char* img = (LAS char*)F.lds;
    const int lane = F.lane, r32 = lane & 31, hh = lane >> 5, b = pm >> 3;
    const size_t tok = (size_t)pm * 256 + F.wave * 32 + r32;
    { u32x4 sk[16]; xattn_load<1024, 0, 16>(Kl + (size_t)b * 256 * 1024 + h * 256, F.tid, sk); xattn_store<0, 16>(img, F.tid, sk); }
    const bf16_t* qrow = CQ + tok * 1024 + h * 256 + 8 * hh;
    bf16x8 qn = *(const bf16x8*)qrow;
    LDS_SYNC();
    u32x4 sv0[8]; xattn_load<256, 0, 8>(VTl + (size_t)(b * 4 + h) * 256 * 256, F.tid, sv0);
    f32x16 acc[8];
#pragma unroll
    for (int kb = 0; kb < 8; ++kb)
#pragma unroll
        for (int r = 0; r < 16; ++r) acc[kb][r] = 0.f;
#pragma unroll 1
    for (int ks = 0; ks < 16; ++ks) {
        const bf16x8 q = qn;
        qn = *(const bf16x8*)(qrow + 16 * (ks < 15 ? ks + 1 : ks));
        const LAS char* kp = img + r32 * XA_PITCH + (16 * ks + 8 * hh) * 2;
#pragma unroll
        for (int kb = 0; kb < 8; ++kb) acc[kb] = MFMA32(*(LAS const bf16x8*)(kp + kb * 32 * XA_PITCH), q, acc[kb]);
    }
    float mx = -INFINITY;
#pragma unroll
    for (int kb = 0; kb < 8; ++kb)
#pragma unroll
        for (int r = 0; r < 16; ++r) mx = fmaxf(mx, acc[kb][r]);
    mx = fmaxf(mx, __shfl_xor(mx, 32));
    float sum = 0.f;
#pragma unroll
    for (int kb = 0; kb < 8; ++kb)
#pragma unroll
        for (int r = 0; r < 16; ++r) { const float p = fexp2(acc[kb][r] - mx); acc[kb][r] = p; sum += p; }
    sum += __shfl_xor(sum, 32);
    const float inv = 1.0f / sum;
    bf16x8 pf[8][2];
#pragma unroll
    for (int kb = 0; kb < 8; ++kb) {
        pf[kb][0] = pack8(acc[kb][0], acc[kb][1], acc[kb][2], acc[kb][3], acc[kb][4], acc[kb][5], acc[kb][6], acc[kb][7]);
        pf[kb][1] = pack8(acc[kb][8], acc[kb][9], acc[kb][10], acc[kb][11], acc[kb][12], acc[kb][13], acc[kb][14], acc[kb][15]);
    }
    LDS_SYNC();
    { u32x4 sv1[8]; xattn_load<256, 8, 8>(VTl + (size_t)(b * 4 + h) * 256 * 256, F.tid, sv1); xattn_store<0, 8>(img, F.tid, sv0); xattn_store<8, 8>(img, F.tid, sv1); }
    LDS_SYNC();
    bf16_t* orow = O + tok * 1024 + h * 256 + 4 * hh;
#pragma unroll 1
    for (int db = 0; db < 8; ++db) {
        f32x16 o;
#pragma unroll
        for (int r = 0; r < 16; ++r) o[r] = 0.f;
#pragma unroll
        for (int kb = 0; kb < 8; ++kb)
#pragma unroll
            for (int s2 = 0; s2 < 2; ++s2) {
                const LAS char* vp = img + (db * 32 + r32) * XA_PITCH + (32 * kb + 16 * s2 + 4 * hh) * 2;
                const bf16x8 vf = cat8(*(LAS const s16x4*)vp, *(LAS const s16x4*)(vp + 16));
                o = MFMA32(vf, pf[kb][s2], o);
            }
#pragma unroll
        for (int g = 0; g < 4; ++g) { u32x2 w; w.x = cvtpk(o[4 * g] * inv, o[4 * g + 1] * inv); w.y = cvtpk(o[4 * g + 2] * inv, o[4 * g + 3] * inv); *(u32x2*)(orow + 32 * db + 8 * g) = w; }
    }
    LDS_SYNC();
}

DI unsigned key_pack(float v, unsigned tag, unsigned mask) { const unsigned b = __float_as_uint(v); const unsigned mono = b ^ ((unsigned)((int)b >> 31) | 0x80000000u); return (mono & ~mask) | tag; }
DI float key_val(unsigned k, unsigned mask) { const unsigned mono = k & ~mask; const unsigned b = (mono & 0x80000000u) ? (mono ^ 0x80000000u) : ~mono; return __uint_as_float(b); }
#define CE(a, b) do { const unsigned _h = (a) > (b) ? (a) : (b); const unsigned _l = (a) > (b) ? (b) : (a); (a) = _h; (b) = _l; } while (0)
#define SORT16_DESC(v) do { CE(v[0], v[1]); CE(v[2], v[3]); CE(v[0], v[2]); CE(v[1], v[3]); CE(v[1], v[2]); CE(v[4], v[5]); CE(v[6], v[7]); CE(v[4], v[6]); CE(v[5], v[7]); CE(v[5], v[6]); CE(v[0], v[4]); CE(v[2], v[6]); CE(v[2], v[4]); CE(v[1], v[5]); CE(v[3], v[7]); CE(v[3], v[5]); CE(v[1], v[2]); CE(v[3], v[4]); CE(v[5], v[6]); CE(v[8], v[9]); CE(v[10], v[11]); CE(v[8], v[10]); CE(v[9], v[11]); CE(v[9], v[10]); CE(v[12], v[13]); CE(v[14], v[15]); CE(v[12], v[14]); CE(v[13], v[15]); CE(v[13], v[14]); CE(v[8], v[12]); CE(v[10], v[14]); CE(v[10], v[12]); CE(v[9], v[13]); CE(v[11], v[15]); CE(v[11], v[13]); CE(v[9], v[10]); CE(v[11], v[12]); CE(v[13], v[14]); CE(v[0], v[8]); CE(v[4], v[12]); CE(v[4], v[8]); CE(v[2], v[10]); CE(v[6], v[14]); CE(v[6], v[10]); CE(v[2], v[4]); CE(v[6], v[8]); CE(v[10], v[12]); CE(v[1], v[9]); CE(v[5], v[13]); CE(v[5], v[9]); CE(v[3], v[11]); CE(v[7], v[15]); CE(v[7], v[11]); CE(v[3], v[5]); CE(v[7], v[9]); CE(v[11], v[13]); CE(v[1], v[2]); CE(v[3], v[4]); CE(v[5], v[6]); CE(v[7], v[8]); CE(v[9], v[10]); CE(v[11], v[12]); CE(v[13], v[14]); } while (0)
#define BITONIC16_DESC(v) do { CE(v[0], v[8]); CE(v[1], v[9]); CE(v[2], v[10]); CE(v[3], v[11]); CE(v[4], v[12]); CE(v[5], v[13]); CE(v[6], v[14]); CE(v[7], v[15]); CE(v[0], v[4]); CE(v[1], v[5]); CE(v[2], v[6]); CE(v[3], v[7]); CE(v[8], v[12]); CE(v[9], v[13]); CE(v[10], v[14]); CE(v[11], v[15]); CE(v[0], v[2]); CE(v[1], v[3]); CE(v[4], v[6]); CE(v[5], v[7]); CE(v[8], v[10]); CE(v[9], v[11]); CE(v[12], v[14]); CE(v[13], v[15]); CE(v[0], v[1]); CE(v[2], v[3]); CE(v[4], v[5]); CE(v[6], v[7]); CE(v[8], v[9]); CE(v[10], v[11]); CE(v[12], v[13]); CE(v[14], v[15]); } while (0)
#define MERGE_TOP16(T, v) do { _Pragma("unroll") for (int _i = 0; _i < 16; ++_i) T[_i] = T[_i] > v[15 - _i] ? T[_i] : v[15 - _i]; BITONIC16_T(T); } while (0)
DI void bitonic16(unsigned (&v)[16]) { BITONIC16_DESC(v); }
#define BITONIC16_T(T) bitonic16(T)
constexpr float RT_BIAS = 64.0f;
DI void route_level1(const bf16_t* PQ, const bf16_t* SK  , int tile, int h, int lane, unsigned (&tpk)[2][16]) {
    const int r32 = lane & 31, hh = lane >> 5; const size_t m = (size_t)tile * 32 + r32;
    bf16x8 qfa[2][4];
#pragma unroll
    for (int p = 0; p < 2; ++p)
#pragma unroll
        for (int ks = 0; ks < 4; ++ks) qfa[p][ks] = *(const bf16x8*)(PQ + m * 1024 + h * 128 + p * 64 + 16 * ks + 8 * hh);
    bf16x8 an[4];
#define RT_LOADA(p_, nb_) do { const bf16_t* skp_ = SK + ((size_t)(h * 2 + (p_)) * 128) * 64; _Pragma("unroll") for (int ks_ = 0; ks_ < 4; ++ks_) an[ks_] = *(const bf16x8*)(skp_ + (size_t)((nb_) * 32 + r32) * 64 + 16 * ks_ + 8 * hh); } while (0)
    RT_LOADA(0, 0);
#pragma unroll
    for (int p = 0; p < 2; ++p) {
        unsigned T[16];
#pragma unroll
        for (int i = 0; i < 16; ++i) T[i] = 0u;
#pragma unroll 1
        for (int nb = 0; nb < 4; ++nb) {
            bf16x8 a[4];
#pragma unroll
            for (int ks = 0; ks < 4; ++ks) a[ks] = an[ks];
            if (nb < 3) RT_LOADA(p, nb + 1); else if (p == 0) RT_LOADA(1, 0);
            f32x16 acc;
#pragma unroll
            for (int r = 0; r < 16; ++r) acc[r] = RT_BIAS;
#pragma unroll
            for (int ks = 0; ks < 4; ++ks) acc = MFMA32(a[ks], qfa[p][ks], acc);
            unsigned v[16];
            const unsigned tb_ = (unsigned)(nb * 32 + 4 * hh);
#pragma unroll
            for (int r = 0; r < 16; ++r) v[r] = (__float_as_uint(fmaxf(acc[r], 0.f)) & ~127u) | (tb_ + (unsigned)crow(r, 0));
            SORT16_DESC(v);
            MERGE_TOP16(T, v);
        }
        unsigned pv[16];
#pragma unroll
        for (int i = 0; i < 16; ++i) pv[i] = (unsigned)__shfl_xor((int)T[i], 32);
        MERGE_TOP16(T, pv);
#pragma unroll
        for (int i = 0; i < 16; ++i) tpk[p][i] = T[i];
    }
#undef RT_LOADA
}
DI void route_level2(const unsigned (&tpk)[2][16], size_t m, int h, int lane, int* IDX, float* Gw, unsigned* SCL, const LAS unsigned* SCT  , LAS char* scr  ) {
    { u32x4 w0, w1, w2, w3;
#pragma unroll
      for (int q = 0; q < 4; ++q) {
          w0[q] = (tpk[0][4 * q] & 127u) | ((tpk[0][4 * q + 1] & 127u) << 8) | ((tpk[0][4 * q + 2] & 127u) << 16) | ((tpk[0][4 * q + 3] & 127u) << 24);
          w1[q] = (tpk[1][4 * q] & 127u) | ((tpk[1][4 * q + 1] & 127u) << 8) | ((tpk[1][4 * q + 2] & 127u) << 16) | ((tpk[1][4 * q + 3] & 127u) << 24); }
      (void)w2; (void)w3;
      *(LAS u32x4*)(scr + lane * 48) = w0; *(LAS u32x4*)(scr + lane * 48 + 16) = w1; }
    float av[16], bv[16];
#pragma unroll
    for (int i = 0; i < 16; ++i) { av[i] = __uint_as_float(tpk[0][i] & ~127u); bv[i] = __uint_as_float(tpk[1][i] & ~127u); }
    unsigned cv[16];
#pragma unroll
    for (int i = 0; i < 16; ++i) cv[i] = 0u;
#pragma unroll
    for (int i = 0; i < 16; ++i)
#pragma unroll
        for (int jj = 0; jj < 16; ++jj) if ((i + 1) * (jj + 1) <= 16) {
            unsigned x = (__float_as_uint(av[i] + bv[jj]) & ~255u) | (unsigned)(i * 16 + jj);
#pragma unroll
            for (int pos = (i + 1) * (jj + 1) - 1; pos < 16; ++pos) CE(cv[pos], x);
        }
    const float cmax = __uint_as_float(cv[0] & ~255u);
    float e[16]; float sum = 0.f;
#pragma unroll
    for (int k = 0; k < 16; ++k) { e[k] = fexp2((__uint_as_float(cv[k] & ~255u) - cmax) * LOG2E); sum += e[k]; }
    const float inv = 1.0f / sum;
    int id[16];
#pragma unroll
    for (int k = 0; k < 16; ++k) {
        const unsigned ij = cv[k] & 255u;
        const unsigned n0 = *(LAS const unsigned char*)(scr + lane * 48 + (ij >> 4)), n1 = *(LAS const unsigned char*)(scr + lane * 48 + 16 + (ij & 15u));
        id[k] = (int)(n0 * 128u + n1);
    }
    { int* ip = IDX + m * 128 + h * 16;
#pragma unroll
      for (int k = 0; k < 16; k += 4) *(int4*)(ip + k) = make_int4(id[k], id[k + 1], id[k + 2], id[k + 3]);
      unsigned* sp = SCL + m * 128 + h * 16;
#pragma unroll
      for (int k = 0; k < 16; k += 4) { u32x4 w;
#pragma unroll
          for (int q = 0; q < 4; ++q) w[q] = SCT[id[k + q]];
          *(u32x4*)(sp + k) = w; }
      float* gp = Gw + m * 128 + h * 16;
#pragma unroll
      for (int k = 0; k < 16; k += 4) *(f32x4*)(gp + k) = (f32x4){e[k] * inv, e[k + 1] * inv, e[k + 2] * inv, e[k + 3] * inv}; }
}
DI void route_pair(const bf16_t* PQ, const bf16_t* SK, int* IDX, float* Gw, unsigned* SCL, const LAS unsigned* SCT, int tileA, int h, int lane, LAS char* scr) {
    unsigned tA[2][16], tB[2][16];
    route_level1(PQ, SK, tileA, h, lane, tA);
    route_level1(PQ, SK, tileA + 1, h, lane, tB);
    const bool hi = lane >= 32;
#pragma unroll
    for (int p = 0; p < 2; ++p)
#pragma unroll
        for (int i = 0; i < 16; ++i) tA[p][i] = hi ? tB[p][i] : tA[p][i];
    route_level2(tA, (size_t)(tileA + (hi ? 1 : 0)) * 32 + (lane & 31), h, lane, IDX, Gw, SCL, SCT, scr);
}

#define FP4PAIR(w, bsel) __builtin_amdgcn_cvt_scalef32_pk_f32_fp4((w), 1.0f, (bsel))
typedef __bf16 bf16p_t __attribute__((ext_vector_type(2)));
#define FP4BF(w, bsel) __builtin_amdgcn_cvt_scalef32_pk_bf16_fp4((w), 1.0f, (bsel))
#define DOT2(accf, xw, ub) accf = __builtin_amdgcn_fdot2_f32_bf16(__builtin_bit_cast(bf16p_t, (xw)), (ub), accf, false)
typedef int v8i_t __attribute__((ext_vector_type(8)));
typedef short s16x2_t __attribute__((ext_vector_type(2)));
DI f32x4 mfma_x4u4(const u32x4 a, const u32x4 b, const f32x4 c) {
    const v8i_t aa = {(int)a.x, (int)a.y, (int)a.z, (int)a.w, 0, 0, 0, 0}, bb = {(int)b.x, (int)b.y, (int)b.z, (int)b.w, 0, 0, 0, 0};
    return __builtin_amdgcn_mfma_scale_f32_16x16x128_f8f6f4(aa, bb, c, 4, 4, 0, 0x7F7F7F7F, 0, 0x7F7F7F7F);
}
DI void peer_wave(const Frame& F, const Args& args, bool last, const unsigned char* Ub, const unsigned char* Vb, const unsigned* SCL, const int* IDX, const float* Gw, bf16_t* XB, float* SS) {
    const int lane = F.lane, j16 = lane & 15, kb = lane >> 4;
    LAS unsigned char* xs = F.lds + F.wave * 1536;
    LAS unsigned char* zr = F.lds + NWAVES * 1536;
    { unsigned zz; asm volatile("v_mov_b32 %0, 0" : "=v"(zz)); *(LAS u32x4*)(zr + 16 * lane) = (u32x4){zz, zz, zz, zz}; }
    const LAS unsigned char* xrd = j16 < 3 ? xs + 512 * j16 + 16 * kb : zr;
    constexpr int UPITCH = 528;
    LAS unsigned char* stg = F.lds + 16384 + F.wave * (16 * UPITCH);
    LAS unsigned char* stw = stg + (lane >> 5) * UPITCH + 16 * (lane & 31);
    const LAS unsigned char* strd = stg + j16 * UPITCH + 16 * kb;
    u32x2 A[16], B[16];
    u32x4 UA[8], UB[8], UC[8];
#define PW_ISSUE(buf, tab, idv, sub) do { _Pragma("unroll") for (int i_ = 0; i_ < 16; ++i_) { const int e_ = __builtin_amdgcn_readlane(idv, (sub) * 16 + i_); buf[i_] = *(const u32x2*)((tab) + (size_t)e_ * 512 + 8 * lane); } } while (0)
#define PU_ISSUE(buf, idv, sub) do { _Pragma("unroll") for (int i_ = 0; i_ < 8; ++i_) { const int e_ = __shfl(idv, (sub) * 16 + 2 * i_ + (lane >> 5)); \
            buf[i_] = *(const u32x4*)(Ub + (size_t)e_ * 512 + 16 * (lane & 31)); } } while (0)
#define PU_DOTS(buf, sub, dreg) do { f32x4 c_ = {0.f, 0.f, 0.f, 0.f}; asm volatile("" ::: "memory"); \
        _Pragma("unroll") for (int i_ = 0; i_ < 8; ++i_) *(LAS u32x4*)(stw + i_ * (2 * UPITCH)) = buf[i_];        \
        _Pragma("unroll") for (int s_ = 0; s_ < 8; ++s_) { const u32x4 xq_ = *(const LAS u32x4*)(xrd + 64 * s_), bq_ = *(const LAS u32x4*)(strd + 64 * s_); c_ = mfma_x4u4(xq_, bq_, c_); } \
        const float dv_ = __shfl(fmaf(c_[2], xs3, fmaf(c_[1], xs2, c_[0] * xs1)), j16); if (kb == (sub)) dreg = dv_; } while (0)
#define PW_ACCUM(buf, cv, sub) do { _Pragma("unroll") for (int i_ = 0; i_ < 16; ++i_) { \
            const float cf_ = __builtin_bit_cast(float, __builtin_amdgcn_readlane(__builtin_bit_cast(int, cv), (sub) * 16 + i_)); const f32x2 cf2_ = {cf_, cf_}; \
            _Pragma("unroll") for (int q_ = 0; q_ < 2; ++q_) { acc[4 * q_] += cf2_ * FP4PAIR(buf[i_][q_], 0); acc[4 * q_ + 1] += cf2_ * FP4PAIR(buf[i_][q_], 1); acc[4 * q_ + 2] += cf2_ * FP4PAIR(buf[i_][q_], 2); acc[4 * q_ + 3] += cf2_ * FP4PAIR(buf[i_][q_], 3); } } } while (0)
    int m = F.gw;
    u32x4 xa = *(const u32x4*)(XB + (size_t)m * 1024 + 16 * lane), xb = *(const u32x4*)(XB + (size_t)m * 1024 + 16 * lane + 8);
    int id0 = IDX[(size_t)m * 128 + lane], id1 = IDX[(size_t)m * 128 + 64 + lane];
    float g0 = Gw[(size_t)m * 128 + lane], g1 = Gw[(size_t)m * 128 + 64 + lane];
    unsigned sc0 = SCL[(size_t)m * 128 + lane], sc1 = SCL[(size_t)m * 128 + 64 + lane];
    float ssl = lane < 16 ? SS[(size_t)m * 16 + lane] : 0.f;
    PU_ISSUE(UA, id0, 0);
#pragma unroll 1
    for (; m < MTOK; m += F.NGW) {
        unsigned xp[8];
#pragma unroll
        for (int i = 0; i < 4; ++i) { xp[i] = xa[i]; xp[4 + i] = xb[i]; }
        PU_ISSUE(UB, id0, 1); PU_ISSUE(UC, id0, 2);
        float xs1, xs2, xs3;
        {
          float xr_[16]; float am = 0.f;
#pragma unroll
          for (int i = 0; i < 8; ++i) { xr_[2 * i] = bflo(xp[i]); xr_[2 * i + 1] = bfhi(xp[i]); am = fmaxf(am, fmaxf(fabsf(xr_[2 * i]), fabsf(xr_[2 * i + 1]))); }
          am = wave_max(am);
          int eb = (int)((__builtin_bit_cast(unsigned, am) >> 23) & 0xFFu); eb = eb < 40 ? 40 : eb;
          xs1 = __builtin_bit_cast(float, (unsigned)(eb - 1) << 23); xs2 = xs1 * 0.25f; xs3 = xs1 * 0.03125f;
#pragma unroll
          for (int t = 0; t < 3; ++t) {
              const float sc_ = t == 0 ? xs1 : t == 1 ? xs2 : xs3;
              u32x2 w;
#pragma unroll
              for (int hw = 0; hw < 2; ++hw) {
                  unsigned ww = 0;
                  ww = __builtin_amdgcn_cvt_scalef32_pk_fp4_f32(ww, xr_[8 * hw + 0], xr_[8 * hw + 1], sc_, 0); ww = __builtin_amdgcn_cvt_scalef32_pk_fp4_f32(ww, xr_[8 * hw + 2], xr_[8 * hw + 3], sc_, 1);
                  ww = __builtin_amdgcn_cvt_scalef32_pk_fp4_f32(ww, xr_[8 * hw + 4], xr_[8 * hw + 5], sc_, 2); ww = __builtin_amdgcn_cvt_scalef32_pk_fp4_f32(ww, xr_[8 * hw + 6], xr_[8 * hw + 7], sc_, 3);
                  w[hw] = ww;
                  if (t < 2) {
                      const f32x2 q0 = __builtin_amdgcn_cvt_scalef32_pk_f32_fp4(ww, sc_, 0), q1 = __builtin_amdgcn_cvt_scalef32_pk_f32_fp4(ww, sc_, 1), q2 = __builtin_amdgcn_cvt_scalef32_pk_f32_fp4(ww, sc_, 2), q3 = __builtin_amdgcn_cvt_scalef32_pk_f32_fp4(ww, sc_, 3);
                      xr_[8 * hw + 0] -= q0.x; xr_[8 * hw + 1] -= q0.y; xr_[8 * hw + 2] -= q1.x; xr_[8 * hw + 3] -= q1.y; xr_[8 * hw + 4] -= q2.x; xr_[8 * hw + 5] -= q2.y; xr_[8 * hw + 6] -= q3.x; xr_[8 * hw + 7] -= q3.y;
                  }
              }
              *(LAS u32x2*)(xs + 512 * t + 8 * lane) = w;
          }
        }
        const float rstd = 1.0f / sqrtf(wave_sum(ssl) * (1.0f / 1024.0f) + EPS);
        float d0 = 0.f, d1 = 0.f;
        PU_DOTS(UA, 0, d0); PU_ISSUE(UA, id0, 3);
        PU_DOTS(UB, 1, d0); PU_ISSUE(UB, id1, 0);
        PU_DOTS(UC, 2, d0); PU_ISSUE(UC, id1, 1);
        PU_DOTS(UA, 3, d0); PU_ISSUE(UA, id1, 2);
        PU_DOTS(UB, 0, d1); PU_ISSUE(UB, id1, 3);
        PU_DOTS(UC, 1, d1); PW_ISSUE(A, Vb, id0, 0);
        PU_DOTS(UA, 2, d1);
        PU_DOTS(UB, 3, d1);
        const float c0 = g0 * gelu_tanh(d0 * (bflo(sc0) * rstd)) * bfhi(sc0), c1 = g1 * gelu_tanh(d1 * (bflo(sc1) * rstd)) * bfhi(sc1);
        const int mn = m + F.NGW < MTOK ? m + F.NGW : m;
        const u32x4 nxa = *(const u32x4*)(XB + (size_t)mn * 1024 + 16 * lane), nxb = *(const u32x4*)(XB + (size_t)mn * 1024 + 16 * lane + 8);
        const int nid0 = IDX[(size_t)mn * 128 + lane], nid1 = IDX[(size_t)mn * 128 + 64 + lane];
        const float ng0 = Gw[(size_t)mn * 128 + lane], ng1 = Gw[(size_t)mn * 128 + 64 + lane];
        const unsigned nsc0 = SCL[(size_t)mn * 128 + lane], nsc1 = SCL[(size_t)mn * 128 + 64 + lane];
        const float nssl = lane < 16 ? SS[(size_t)mn * 16 + lane] : 0.f;
        f32x2 acc[8];
#pragma unroll
        for (int q = 0; q < 8; ++q) acc[q] = (f32x2){0.f, 0.f};
        PW_ISSUE(B, Vb, id0, 1); PW_ACCUM(A, c0, 0);
        PW_ISSUE(A, Vb, id0, 2); PW_ACCUM(B, c0, 1);
        PW_ISSUE(B, Vb, id0, 3); PW_ACCUM(A, c0, 2);
        PW_ISSUE(A, Vb, id1, 0); PW_ACCUM(B, c0, 3);
        PW_ISSUE(B, Vb, id1, 1); PW_ACCUM(A, c1, 0);
        PW_ISSUE(A, Vb, id1, 2); PW_ACCUM(B, c1, 1);
        PW_ISSUE(B, Vb, id1, 3); PW_ACCUM(A, c1, 2);
        PU_ISSUE(UA, nid0, 0); PW_ACCUM(B, c1, 3);
        float xo[16]; float s = 0.f;
#pragma unroll
        for (int q = 0; q < 8; ++q) { xo[2 * q] = bflo(xp[q]) + acc[q].x; xo[2 * q + 1] = bfhi(xp[q]) + acc[q].y; }
        if (!last) {
            u32x4 w0, w1;
#pragma unroll
            for (int q = 0; q < 4; ++q) { w0[q] = cvtpk(xo[2 * q], xo[2 * q + 1]); w1[q] = cvtpk(xo[8 + 2 * q], xo[8 + 2 * q + 1]);
                s += (bflo(w0[q]) * bflo(w0[q]) + bfhi(w0[q]) * bfhi(w0[q])) + (bflo(w1[q]) * bflo(w1[q]) + bfhi(w1[q]) * bfhi(w1[q])); }
            s = wave_sum(s);
            *(u32x4*)(XB + (size_t)m * 1024 + 16 * lane) = w0; *(u32x4*)(XB + (size_t)m * 1024 + 16 * lane + 8) = w1;
            if (lane < 16) SS[(size_t)m * 16 + lane] = lane == 0 ? s : 0.f;
        } else {
#pragma unroll
            for (int q = 0; q < 16; ++q) s += xo[q] * xo[q];
            s = wave_sum(s);
            const float rf = 1.0f / sqrtf(s * (1.0f / 1024.0f) + EPS); const float* fg = INP(I_FINAL_G) + 16 * lane; float* xr = F.X + (size_t)m * 1024 + 16 * lane;
#pragma unroll
            for (int q = 0; q < 4; ++q) { const f32x4 gq = *(const f32x4*)(fg + 4 * q); *(f32x4*)(xr + 4 * q) = (f32x4){xo[4 * q], xo[4 * q + 1], xo[4 * q + 2], xo[4 * q + 3]} * rf * gq; }
        }
        xa = nxa; xb = nxb; id0 = nid0; id1 = nid1; g0 = ng0; g1 = ng1; sc0 = nsc0; sc1 = nsc1; ssl = nssl;
    }
#undef PW_ISSUE
#undef PU_ISSUE
#undef PU_DOTS
#undef PW_ACCUM
}

constexpr int PPL = 7;
constexpr int NPHASE = 1 + DEPTH * PPL;
__global__ void __launch_bounds__(NTHR, 2) trunk_fwd(Args args) {
    extern __shared__ __attribute__((aligned(16))) unsigned char lds_raw[];
    Frame F;
    F.lds = (LAS unsigned char*)lds_raw;
    F.tid = threadIdx.x; F.lane = F.tid & 63; F.wave = __builtin_amdgcn_readfirstlane(F.tid >> 6);
    F.bx = blockIdx.x; F.gw = F.bx * NWAVES + F.wave;
    F.X = args.out; F.ws = args.ws;
    const int lo = args.ph_lo, hi = args.ph_hi;
#if MK_ONE_LAUNCH
    volatile LAS unsigned* bst = (volatile LAS unsigned*)(F.lds + LDS_BYTES - 64);
    if (F.tid < 16) bst[F.tid] = 0u;
    __syncthreads();
    if (F.tid < 64) ((unsigned*)(args.ws + WS_CTL))[F.bx * 64 + F.tid] = 0u;
    cg::this_grid().sync();
    const XcdBarrier gbar = xcd_barrier_post((unsigned*)(args.ws + WS_CTL) + 4096, bst);
#endif
#define REFRESH() int t_ = threadIdx.x; asm volatile("" : "+v"(t_)); F.tid = t_; F.lane = t_ & 63; F.wave = __builtin_amdgcn_readfirstlane(t_ >> 6); \
    F.gw = F.bx * NWAVES + F.wave; size_t z_ = 0; asm volatile("" : "+s"(z_)); unsigned char* ws = args.ws + z_; F.ws = ws; \
    bf16_t* XB = (bf16_t*)(ws + WS_XB); float* SS = (float*)(ws + WS_SS); bf16_t* YC = (bf16_t*)(ws + WS_YCAT); bf16_t* PROJ = (bf16_t*)(ws + WS_PROJ); \
    bf16_t* CQ = PROJ; bf16_t* PP = (bf16_t*)(ws + WS_PROJ + 64 * MiB); int* IDX = (int*)(ws + WS_PROJ + 64 * MiB); float* GW = (float*)(ws + WS_PROJ + 80 * MiB); \
    bf16_t* Wl = (bf16_t*)(ws + WS_W + l * W_LAYER); bf16_t* Kl = (bf16_t*)(ws + WS_KMEM + (size_t)l * 16 * MiB); bf16_t* VTl = Kl + (size_t)4096 * 1024; \
    (void)XB; (void)SS; (void)YC; (void)PROJ; (void)CQ; (void)PP; (void)IDX; (void)GW; (void)Wl; (void)Kl; (void)VTl;
#pragma unroll 1
    for (int ph = lo; ph < hi; ++ph) {
        const int l = ph == 0 ? 0 : (ph - 1) / PPL, k = ph == 0 ? -1 : (ph - 1) % PPL;
        for (int rep = 0; rep < ((k == PROBE_REP_K) ? 2 : 1); ++rep) {
        if (rep) { WG_SYNC(); xcd_barrier(gbar); }
        switch (k) {
        case -1: if (EN(0)) { REFRESH(); p0_prologue(F, args); } break;
        case 0: case 3: case 5: if (EN(1)) {
            REFRESH();
            if (k == 0 && l == 0) {
#pragma unroll 1
                for (int l2 = 0; l2 < DEPTH; ++l2) {
                    bf16_t* W2 = (bf16_t*)(ws + WS_W + l2 * W_LAYER); bf16_t* K2 = (bf16_t*)(ws + WS_KMEM + (size_t)l2 * 16 * MiB);
                    pg8::Gemm g{(const bf16_t*)(ws + WS_MEMB), W2 + W_CKV / 2, 1024, 1024, 1024}; pg8::StaticOrder S; S.init(MMEM, 2048, F.G, (F.bx + 128 * l2) % F.G, 1024, 1024);
                    pg8::EpiKV E{K2, K2 + (size_t)4096 * 1024, (const float*)(ws + WS_RSTDM)};
                    pg8::gemm_phase<pg8::EpiKV, pg8::StaticOrder, true>(F.lds, g, S, E);
                }
            }
            const bf16_t* Bt = Wl + (k == 0 ? W_IN : k == 3 ? W_CQ : W_PQ) / 2; const int N = k == 0 ? NPROJ : 1024, ldc = k == 0 ? LDP : 1024;
            pg8::Gemm g{XB, Bt, 1024, 1024, 1024}; pg8::StaticOrder S; S.init(MTOK, N, F.G, F.bx, 1024, 1024);
            pg8::EpiBf16 E{k == 0 ? PROJ : CQ, ldc, SS, k == 3 ? 0.0625f * LOG2E : 1.0f, ldc};
            pg8::gemm_phase<pg8::EpiBf16, pg8::StaticOrder, true>(F.lds, g, S, E);
            if (k == 3) {
                pg8::Unit u;
                for (int i = 0; S.next(i, u); ++i) xattn_unit(F, CQ, Kl, VTl, YC, u.pm, u.pn);
            } else if (k == 5) {
                const bf16_t* SK = (const bf16_t*)(ws + WS_SUBK) + (size_t)l * 8 * 2 * 128 * 64;
                LAS unsigned* SCT = (LAS unsigned*)(F.lds + 65536);
                { const u32x4* src = (const u32x4*)(ws + WS_TAB + 32 * MiB + (size_t)l * 65536);
                  for (int i = F.tid; i < 4096; i += NTHR) *(LAS u32x4*)((LAS char*)SCT + 16 * i) = src[i];
                  LDS_SYNC(); }
                LAS char* scr = (LAS char*)F.lds + F.wave * 8192;
                pg8::Unit u;
                for (int i = 0; S.next(i, u); ++i)
                    route_pair(CQ, SK, IDX, GW, (unsigned*)(ws + WS_PROJ + 96 * MiB), SCT, u.pm * 8 + 2 * (F.wave & 3), 2 * u.pn + (F.wave >> 2), F.lane, scr);
            }
        } break;
        case 1: {
            REFRESH();
            if (F.bx < 64) { if (EN(2)) gla_chain(F, args, l, F.bx >> 2, F.bx & 3, PROJ, YC); }
            else {
                if (l == 0) {
                    const int wv = (F.bx - 64) * NWAVES + F.wave, nwv = (F.G - 64) * NWAVES;
                    transpose_list(F, args, (LAS float*)(F.lds + F.wave * 16384), wv, nwv, 1);
                    convert_tables(F, args, 0, wv, nwv); convert_tables(F, args, 1, wv, nwv);
                    WG_SYNC();
                }
                if (EN(3)) { for (int u = F.bx - 64; u < 256; u += F.G - 64) sgu_unit(F, args, l, u >> 4, u & 15, PROJ, YC); }
            }
            if (EN(4)) { LAS char* vl = (LAS char*)F.lds + F.wave * 8192; unsigned* ctr = (unsigned*)(ws + WS_CTL) + 15360 + 64 * l;
                for (;;) { int u0 = 0; if (F.lane == 0) u0 = (int)atomicAdd(ctr, 2u); u0 = __builtin_amdgcn_readfirstlane(u0); if (u0 >= BATCH * 8 * 32) break;
                    for (int u = u0; u < u0 + 2; ++u) sb_unit2(PROJ, YC, u >> 8, (u >> 5) & 7, u & 31, vl, F.lane); } }
        } break;
        case 2: case 4: if (EN(5)) {
            REFRESH();
            pg8::Gemm g{YC, Wl + (k == 2 ? W_OUT : W_CO) / 2, 1024, 1024, 1024}; pg8::StaticOrder S; S.init(MTOK, 1024, F.G, F.bx, 1024, 1024);
            pg8::EpiResid E{XB, SS};
            pg8::gemm_phase<pg8::EpiResid, pg8::StaticOrder, true>(F.lds, g, S, E);
        } break;
        default: if (EN(12)) {
            REFRESH();
            const unsigned char* Ub = ws + WS_TAB + (size_t)l * 16 * MiB; const unsigned char* Vb = Ub + 8 * MiB;
            peer_wave(F, args, l == DEPTH - 1, Ub, Vb, (const unsigned*)(ws + WS_PROJ + 96 * MiB), IDX, GW, XB, SS);
        } break;
        }
        }
        WG_SYNC();
#if MK_ONE_LAUNCH
        if (ph + 1 < hi) xcd_barrier(gbar);
#endif
    }
#undef REFRESH
}

extern "C" void kernel_launch(void* const* d_in, const int* in_sizes, int n_in, void* d_out, int out_size, void* d_ws, size_t ws_size, hipStream_t stream) {
    static int grid = 0;
    if (grid == 0) {
        if (n_in != 22 || out_size != MTOK * DM || ws_size < WS_END) { fprintf(stderr, "kernel_launch: unexpected problem (n_in %d out %d ws %zu)\n", n_in, out_size, ws_size); grid = -1; return; }
        int dev = 0, cus = 0, per_cu = 0;
        if (hipGetDevice(&dev) != hipSuccess || hipDeviceGetAttribute(&cus, hipDeviceAttributeMultiprocessorCount, dev) != hipSuccess) { grid = -1; return; }
        if (hipFuncSetAttribute((const void*)trunk_fwd, hipFuncAttributeMaxDynamicSharedMemorySize, LDS_BYTES) != hipSuccess) { fprintf(stderr, "kernel_launch: hipFuncSetAttribute failed\n"); grid = -1; return; }
        if (hipOccupancyMaxActiveBlocksPerMultiprocessor(&per_cu, (const void*)trunk_fwd, NTHR, LDS_BYTES) != hipSuccess || per_cu < 1) { fprintf(stderr, "kernel_launch: occupancy query says %d\n", per_cu); (void)hipGetLastError(); grid = -1; return; }
        if (cus * per_cu < GRID) { fprintf(stderr, "kernel_launch: built for a %d-workgroup resident grid, this device holds %d\n", GRID, cus * per_cu); grid = -1; return; }
        grid = GRID;
    }
    if (grid < 0) return;
    Args a{};
    for (int i = 0; i < 22; ++i) a.in[i] = (const float*)d_in[i];
    a.out = (float*)d_out; a.ws = (unsigned char*)d_ws;
#if MK_ONE_LAUNCH
    a.ph_lo = 0; a.ph_hi = NPHASE;
    void* kargs[] = {&a};
    hipError_t e = hipLaunchCooperativeKernel((const void*)trunk_fwd, dim3(grid), dim3(NTHR), kargs, LDS_BYTES, stream);
    if (e != hipSuccess) fprintf(stderr, "cooperative launch failed: %s (grid %d)\n", hipGetErrorString(e), grid);
#else
    for (int p = 0; p < NPHASE; ++p) { a.ph_lo = p; a.ph_hi = p + 1; hipLaunchKernelGGL(trunk_fwd, dim3(grid), dim3(NTHR), LDS_BYTES, stream, a); }
#endif
}
```

```cpp
#include <hip/hip_runtime.h>
#include <hip/hip_cooperative_groups.h>
#include <cstdio>
#include <cstdint>
#include <cmath>
namespace cg = cooperative_groups;

#ifndef PHMASK
#define PHMASK 0xFFFF
#endif
#define EN(n) (((PHMASK) >> (n)) & 1)
#ifndef PROBE_REP_K
#define PROBE_REP_K (-2)
#endif
#ifndef MK_ONE_LAUNCH
#define MK_ONE_LAUNCH 1
#endif

#define LAS __attribute__((address_space(3)))
typedef unsigned short bf16_t;
typedef short bf16x8 __attribute__((ext_vector_type(8)));
typedef short s16x4 __attribute__((ext_vector_type(4)));
typedef short v4i16_t __attribute__((ext_vector_type(4)));
typedef float f32x4 __attribute__((ext_vector_type(4)));
typedef float f32x2 __attribute__((ext_vector_type(2)));
typedef float f32x16 __attribute__((ext_vector_type(16)));
typedef unsigned u32x4 __attribute__((ext_vector_type(4)));
typedef unsigned u32x2 __attribute__((ext_vector_type(2)));
typedef __bf16 bf16x2_t __attribute__((ext_vector_type(2)));
#define DI __device__ __forceinline__
#define MFMA32(a, b, c) __builtin_amdgcn_mfma_f32_32x32x16_bf16((a), (b), (c), 0, 0, 0)

constexpr int BATCH = 16, SEQ = 2048, DM = 1024, MTOK = BATCH * SEQ, DEPTH = 2;
constexpr int NMEM = 256, MMEM = BATCH * NMEM;
constexpr int INW = 2832, LDP = 2944, NPROJ = 3072;
constexpr int C_SBQ = 0, C_SBK = 512, C_SBV = 1024, C_SGU = 1536, C_SGV = 1792, C_GQ = 2048, C_GK = 2176, C_GV = 2304, C_GO = 2560, C_GA = 2816;
constexpr float EPS = 1e-6f;
constexpr float LOG2E = 1.4426950408889634f;

constexpr size_t MiB = 1u << 20;
constexpr size_t WS_CTL = 0;
constexpr size_t WS_SUBK = 1 * MiB;
constexpr size_t WS_WSP = WS_SUBK + 512 * 1024;
constexpr size_t WS_RSTDM = WS_WSP + 256 * 1024;
constexpr size_t WS_SS = 2 * MiB;
constexpr size_t WS_W = 8 * MiB;
constexpr size_t W_IN = 0, W_OUT = 6 * MiB, W_CQ = 8 * MiB, W_CKV = 10 * MiB, W_CO = 14 * MiB, W_PQ = 16 * MiB, W_LAYER = 18 * MiB;
constexpr size_t WS_MEMB = 44 * MiB;
constexpr size_t WS_KMEM = 52 * MiB;
constexpr size_t WS_TAB = 84 * MiB;
constexpr size_t WS_XB = 148 * MiB;
constexpr size_t WS_YCAT = 212 * MiB;
constexpr size_t WS_PROJ = 276 * MiB;
constexpr size_t WS_GKV = 460 * MiB;
constexpr size_t WS_GD = 468 * MiB;
constexpr size_t WS_END = 469 * MiB;

DI unsigned cvtpk(float lo, float hi) { f32x2 v = {lo, hi}; bf16x2_t b = __builtin_convertvector(v, bf16x2_t); return __builtin_bit_cast(unsigned, b); }
DI bf16_t cvt1(float v) { return (bf16_t)(cvtpk(v, 0.f) & 0xffffu); }
DI float bf2f(unsigned short b) { return __uint_as_float((unsigned)b << 16); }
DI float bflo(unsigned w) { return __uint_as_float(w << 16); }
DI float bfhi(unsigned w) { return __uint_as_float(w & 0xffff0000u); }
DI int crow(int r, int hi) { return (r & 3) + 8 * (r >> 2) + 4 * hi; }
DI float fexp2(float x) { return __builtin_amdgcn_exp2f(x); }
DI float flog2(float x) { return __builtin_amdgcn_logf(x); }
DI float frcp(float x) { return __builtin_amdgcn_rcpf(x); }
DI float gelu_tanh(float x) { const float y2 = x * (1.5957691216057308f + 0.0713548162726009f * x * x); return x * frcp(1.f + fexp2(-y2 * LOG2E)); }
DI float silu(float x) { return x * frcp(1.f + fexp2(-x * LOG2E)); }
DI float wave_sum(float v) {
#pragma unroll
    for (int o = 1; o < 64; o <<= 1) v += __shfl_xor(v, o);
    return v;
}
DI s16x4 vtr(LAS const char* p) { return __builtin_bit_cast(s16x4, __builtin_amdgcn_ds_read_tr16_b64_v4i16((LAS v4i16_t*)p)); }
DI bf16x8 cat8(s16x4 lo, s16x4 hi) { return __builtin_shufflevector(lo, hi, 0, 1, 2, 3, 4, 5, 6, 7); }
DI bf16x8 pack8(float a0, float a1, float a2, float a3, float a4, float a5, float a6, float a7) {
    u32x4 p; p[0] = cvtpk(a0, a1); p[1] = cvtpk(a2, a3); p[2] = cvtpk(a4, a5); p[3] = cvtpk(a6, a7); return __builtin_bit_cast(bf16x8, p);
}
#define LDS_WAIT() asm volatile("s_waitcnt lgkmcnt(0)" ::: "memory")
#define LDS_SYNC() do { asm volatile("s_waitcnt lgkmcnt(0)" ::: "memory"); __builtin_amdgcn_s_barrier(); asm volatile("" ::: "memory"); } while (0)
#define WG_SYNC() do { asm volatile("s_waitcnt vmcnt(0) lgkmcnt(0)" ::: "memory"); __builtin_amdgcn_s_barrier(); asm volatile("" ::: "memory"); } while (0)

namespace pg8 {
constexpr int BM = 256, BK = 64, HALF = 128, HTB = HALF * BK * 2, STAGE_BYTES = 8 * HTB, NXCD = 8, WGM = 8;
__host__ __device__ __forceinline__ int lds_byte(int r, int c) { const int st = (r >> 4) * 2 + (c >> 5), rr = r & 15, cc = c & 31, ob = rr * 64 + cc * 2; return st * 1024 + (ob ^ (((ob >> 9) & 1) << 5)); }
__host__ __device__ __forceinline__ void stage_rc(int b, int& R, int& C) { const int st = b / 1024, sb = b % 1024, swz = sb ^ (((sb >> 9) & 1) << 5); R = (st >> 1) * 16 + swz / 64; C = (st & 1) * 32 + (swz % 64) / 2; }
__host__ __device__ __forceinline__ int perm32(int rho) { const int n = rho >> 4, i = rho & 15; return 8 * (i >> 2) + 4 * n + (i & 3); }

struct Unit { int pm, pn; size_t aoff, boff; };
struct Gemm { const bf16_t* A; const bf16_t* Bt; int lda, ldb, K; };

struct StaticOrder {
    int nM, nN, nwg, G, c, lda, ldb;
    __device__ void init(int M, int N, int G_, int c_, int lda_, int ldb_) { nM = M / BM; nN = N / BM; nwg = nM * nN; G = G_; c = c_; lda = lda_; ldb = ldb_; }
    __device__ bool next(int i, Unit& u) const {
        const long L = (long)i * G + c; if (L >= nwg) return false;
        int wgid = (int)L; { const int q = nwg / NXCD, r = nwg % NXCD, xcd = wgid % NXCD, off = wgid / NXCD; wgid = (xcd < r ? xcd * (q + 1) : r * (q + 1) + (xcd - r) * q) + off; }
        const int nig = WGM * nN, gid = wgid / nig, fm = gid * WGM, gsz = (nM - fm) < WGM ? (nM - fm) : WGM;
        u.pm = fm + ((wgid % nig) % gsz); u.pn = (wgid % nig) / gsz;
        u.aoff = (size_t)u.pm * BM * lda; u.boff = (size_t)u.pn * BM * ldb; return true;
    }
};
struct XOrder {
    int G, c, mode;
    __device__ bool next(int i, Unit& u) const {
        const int L = i * G + c; if (L >= 512) return false;
        u.pm = L >> 2; u.pn = L & 3; const int b = u.pm >> 3;
        u.aoff = (size_t)u.pm * 256 * 1024 + u.pn * 256;
        u.boff = mode == 0 ? (size_t)b * 256 * 1024 + u.pn * 256 : (size_t)(b * 4 + u.pn) * 256 * 256;
        return true;
    }
};

struct XOrder2 {
    StaticOrder S; int mode;
    __device__ bool next(int i, Unit& u) const {
        if (!S.next(i, u)) return false; const int b = u.pm >> 3;
        u.aoff = (size_t)u.pm * 256 * 1024 + u.pn * 256;
        u.boff = mode == 0 ? (size_t)b * 256 * 1024 + u.pn * 256 : (size_t)(b * 4 + u.pn) * 256 * 256;
        return true;
    }
};

DI float row_rstd_from_ss(const float* ss, int row, int fq) {
    const f32x4 v = *(const f32x4*)(ss + (size_t)row * 16 + 4 * fq);
    float s = (v[0] + v[1]) + (v[2] + v[3]); s += __shfl_xor(s, 16); s += __shfl_xor(s, 32);
    return 1.0f / sqrtf(s * (1.0f / 1024.0f) + EPS);
}
struct EpiBf16 {
    static constexpr bool PERM = true;
    bf16_t* O; int ldc; const float* ss; float cscale; int ncols;
    DI void operator()(f32x4 (&acc)[2][2][4][2], const Unit& u, int wr, int wc, int fr, int fq) const {
        const int row0 = u.pm * BM + wr * 64 + fr, col0 = u.pn * BM + wc * 32 + 8 * fq;
#pragma unroll
        for (int ai = 0; ai < 2; ++ai)
#pragma unroll
            for (int m = 0; m < 4; ++m) {
                const int row = row0 + ai * HALF + m * 16;
                float rs = cscale; if (ss) rs *= row_rstd_from_ss(ss, row, fq);
                bf16_t* rowp = O + (size_t)row * ldc + col0;
#pragma unroll
                for (int bj = 0; bj < 2; ++bj) if (col0 + bj * HALF < ncols) {
                    const f32x4 v0 = acc[ai][bj][m][0] * rs, v1 = acc[ai][bj][m][1] * rs;
                    u32x4 w; w.x = cvtpk(v0[0], v0[1]); w.y = cvtpk(v0[2], v0[3]); w.z = cvtpk(v1[0], v1[1]); w.w = cvtpk(v1[2], v1[3]);
                    *(u32x4*)(rowp + bj * HALF) = w; }
            }
    }
};
struct EpiKV {
    static constexpr bool PERM = true;
    bf16_t* Kd; bf16_t* VT; const float* rvec;
    DI void operator()(f32x4 (&acc)[2][2][4][2], const Unit& u, int wr, int wc, int fr, int fq) const {
        const int row0 = u.pm * BM + wr * 64 + fr;
#pragma unroll
        for (int ai = 0; ai < 2; ++ai)
#pragma unroll
            for (int m = 0; m < 4; ++m) {
                const int row = row0 + ai * HALF + m * 16; const float rs = rvec[row];
#pragma unroll
                for (int bj = 0; bj < 2; ++bj) {
                    const f32x4 v0 = acc[ai][bj][m][0] * rs, v1 = acc[ai][bj][m][1] * rs;
                    const unsigned w0 = cvtpk(v0[0], v0[1]), w1 = cvtpk(v0[2], v0[3]), w2 = cvtpk(v1[0], v1[1]), w3 = cvtpk(v1[2], v1[3]);
                    if (u.pn < 4) {
                        u32x4 w; w.x = w0; w.y = w1; w.z = w2; w.w = w3;
                        *(u32x4*)(Kd + (size_t)row * 1024 + u.pn * BM + bj * HALF + wc * 32 + 8 * fq) = w;
                    } else {
                        const int key = row & 255, dv0 = bj * HALF + wc * 32 + 8 * fq;
                        bf16_t* p = VT + ((size_t)(u.pm * 4 + (u.pn - 4)) * 256 + dv0) * 256 + key;
                        p[0 * 256] = (bf16_t)w0; p[1 * 256] = (bf16_t)(w0 >> 16); p[2 * 256] = (bf16_t)w1; p[3 * 256] = (bf16_t)(w1 >> 16);
                        p[4 * 256] = (bf16_t)w2; p[5 * 256] = (bf16_t)(w2 >> 16); p[6 * 256] = (bf16_t)w3; p[7 * 256] = (bf16_t)(w3 >> 16);
                    }
                }
            }
    }
};
struct EpiResid {
    static constexpr bool PERM = true;
    bf16_t* XB; float* ss;
    DI void operator()(f32x4 (&acc)[2][2][4][2], const Unit& u, int wr, int wc, int fr, int fq) const {
        const int row0 = u.pm * BM + wr * 64 + fr, col0 = u.pn * BM + wc * 32 + 8 * fq;
#pragma unroll
        for (int ai = 0; ai < 2; ++ai)
#pragma unroll
            for (int m = 0; m < 4; ++m) {
                const int row = row0 + ai * HALF + m * 16; float s = 0.f;
#pragma unroll
                for (int bj = 0; bj < 2; ++bj) {
                    const size_t off = (size_t)row * 1024 + col0 + bj * HALF;
                    const u32x4 o = *(const u32x4*)(XB + off); const f32x4 a0 = acc[ai][bj][m][0], a1 = acc[ai][bj][m][1];
                    u32x4 w; w.x = cvtpk(bflo(o.x) + a0[0], bfhi(o.x) + a0[1]); w.y = cvtpk(bflo(o.y) + a0[2], bfhi(o.y) + a0[3]);
                    w.z = cvtpk(bflo(o.z) + a1[0], bfhi(o.z) + a1[1]); w.w = cvtpk(bflo(o.w) + a1[2], bfhi(o.w) + a1[3]);
                    *(u32x4*)(XB + off) = w;
#pragma unroll
                    for (int q = 0; q < 4; ++q) { const float x0 = bflo(w[q]), x1 = bfhi(w[q]); s += x0 * x0 + x1 * x1; }
                }
                s += __shfl_xor(s, 16); s += __shfl_xor(s, 32);
                if (fq == 0) ss[(size_t)row * 16 + u.pn * 4 + wc] = s;
            }
    }
};
struct EpiSoftmax {
    static constexpr bool PERM = true;
    bf16_t* P; LAS float* xm; LAS float* xs;
    DI void operator()(f32x4 (&acc)[2][2][4][2], const Unit& u, int wr, int wc, int fr, int fq) const {
#pragma unroll
        for (int ai = 0; ai < 2; ++ai)
#pragma unroll
            for (int m = 0; m < 4; ++m) {
                float v = -INFINITY;
#pragma unroll
                for (int bj = 0; bj < 2; ++bj)
#pragma unroll
                    for (int n = 0; n < 2; ++n) { const f32x4 x = acc[ai][bj][m][n]; v = fmaxf(v, fmaxf(fmaxf(x[0], x[1]), fmaxf(x[2], x[3]))); }
                v = fmaxf(v, __shfl_xor(v, 16)); v = fmaxf(v, __shfl_xor(v, 32));
                if (fq == 0) xm[(ai * HALF + wr * 64 + m * 16 + fr) * 4 + wc] = v;
            }
        LDS_WAIT(); __builtin_amdgcn_s_barrier(); asm volatile("" ::: "memory");
#pragma unroll
        for (int ai = 0; ai < 2; ++ai)
#pragma unroll
            for (int m = 0; m < 4; ++m) {
                const f32x4 q = *(LAS const f32x4*)(xm + (ai * HALF + wr * 64 + m * 16 + fr) * 4);
                const float g = fmaxf(fmaxf(q[0], q[1]), fmaxf(q[2], q[3])); float s = 0.f;
#pragma unroll
                for (int bj = 0; bj < 2; ++bj)
#pragma unroll
                    for (int n = 0; n < 2; ++n) { f32x4 x = acc[ai][bj][m][n]; x[0] = fexp2(x[0] - g); x[1] = fexp2(x[1] - g); x[2] = fexp2(x[2] - g); x[3] = fexp2(x[3] - g); acc[ai][bj][m][n] = x; s += (x[0] + x[1]) + (x[2] + x[3]); }
                s += __shfl_xor(s, 16); s += __shfl_xor(s, 32);
                if (fq == 0) xs[(ai * HALF + wr * 64 + m * 16 + fr) * 4 + wc] = s;
            }
        LDS_WAIT(); __builtin_amdgcn_s_barrier(); asm volatile("" ::: "memory");
        const int row0 = u.pm * BM + wr * 64 + fr, col0 = u.pn * BM + wc * 32 + 8 * fq;
#pragma unroll
        for (int ai = 0; ai < 2; ++ai)
#pragma unroll
            for (int m = 0; m < 4; ++m) {
                const f32x4 q = *(LAS const f32x4*)(xs + (ai * HALF + wr * 64 + m * 16 + fr) * 4);
                const float inv = 1.0f / ((q[0] + q[1]) + (q[2] + q[3]));
                bf16_t* rowp = P + (size_t)(row0 + ai * HALF + m * 16) * 1024 + col0;
#pragma unroll
                for (int bj = 0; bj < 2; ++bj) {
                    const f32x4 v0 = acc[ai][bj][m][0] * inv, v1 = acc[ai][bj][m][1] * inv;
                    u32x4 w; w.x = cvtpk(v0[0], v0[1]); w.y = cvtpk(v0[2], v0[3]); w.z = cvtpk(v1[0], v1[1]); w.w = cvtpk(v1[2], v1[3]);
                    *(u32x4*)(rowp + bj * HALF) = w; }
            }
    }
};

template <class Epi, class Sched, bool ALIGN_EPI>
__device__ __forceinline__ void gemm_phase(LAS unsigned char* lds, const Gemm g, const Sched& S, const Epi& E) {
    int tid = threadIdx.x; asm volatile("" : "+v"(tid));
    const int wid = __builtin_amdgcn_readfirstlane(tid >> 6), lane = tid & 63, wr = wid >> 2, wc = wid & 3, fr = lane & 15, fq = lane >> 4;
    const int K = g.K, nt = K / BK;
    unsigned voffA[2], voffB[2];
#pragma unroll
    for (int i = 0; i < 2; ++i) { int R, C; stage_rc(tid * 16 + i * 8192, R, C); const int Rb = Epi::PERM ? ((R & ~31) + perm32(R & 31)) : R;
        voffA[i] = (unsigned)(R * g.lda + C) * 2u; voffB[i] = (unsigned)(Rb * g.ldb + C) * 2u; }
    const size_t kstep = (size_t)(BK * 2);
    const size_t hstepA = (size_t)HALF * g.lda * 2, hstepB = (size_t)HALF * g.ldb * 2;
    const unsigned ldsw = (unsigned)wid * 1024u;
    const int aoff = lds_byte(wr * 64 + fr, fq * 8), boff = lds_byte(wc * 32 + fr, fq * 8);
#define PG8_SA(b, h) (((b) * 2 + (h)) * HTB)
#define PG8_SB(b, h) ((4 + (b) * 2 + (h)) * HTB)
#define PG8_STAGE(bufoff, gbase, voff) do { _Pragma("unroll") for (int _i = 0; _i < 2; ++_i) \
        __builtin_amdgcn_global_load_lds((const unsigned*)((const char*)(gbase) + (voff)[_i]), (LAS unsigned*)(lds + (bufoff) + ldsw + _i * 8192), 16, 0, 0); } while (0)
#define PG8_LDA(dst, b, h) do { _Pragma("unroll") for (int m = 0; m < 4; ++m) _Pragma("unroll") for (int k = 0; k < 2; ++k) dst[m][k] = *(const LAS bf16x8*)(lds + PG8_SA(b, h) + aoff + m * 2048 + k * 1024); } while (0)
#define PG8_LDB(dst, b, h) do { _Pragma("unroll") for (int n = 0; n < 2; ++n) _Pragma("unroll") for (int k = 0; k < 2; ++k) dst[n][k] = *(const LAS bf16x8*)(lds + PG8_SB(b, h) + boff + n * 2048 + k * 1024); } while (0)
#define PG8_MMA(ai, bj, At, Bt) do { __builtin_amdgcn_s_setprio(1); _Pragma("unroll") for (int m = 0; m < 4; ++m) _Pragma("unroll") for (int n = 0; n < 2; ++n) _Pragma("unroll") for (int k = 0; k < 2; ++k) \
        acc[ai][bj][m][n] = __builtin_amdgcn_mfma_f32_16x16x32_bf16(Bt[n][k], At[m][k], acc[ai][bj][m][n], 0, 0, 0); __builtin_amdgcn_s_setprio(0); } while (0)
#define PG8_WAIT_V(n) asm volatile("s_waitcnt vmcnt(" #n ")" ::: "memory")
#define PG8_WAIT_L(n) asm volatile("s_waitcnt lgkmcnt(" #n ")" ::: "memory")
#define PG8_BAR __builtin_amdgcn_s_barrier()
#define PG8_SCHED __builtin_amdgcn_sched_barrier(0)
    Unit cur, nxt; int ui = 0;
    if (!S.next(0, cur)) return;
    f32x4 acc[2][2][4][2];
#pragma unroll
    for (int a = 0; a < 2; ++a)
#pragma unroll
        for (int b = 0; b < 2; ++b)
#pragma unroll
            for (int m = 0; m < 4; ++m)
#pragma unroll
                for (int n = 0; n < 2; ++n) acc[a][b][m][n] = (f32x4){0.f, 0.f, 0.f, 0.f};
    bf16x8 At[4][2], B0[2][2], B1[2][2];
    const char* cA = (const char*)g.A + cur.aoff * 2; const char* cB = (const char*)g.Bt + cur.boff * 2;
    PG8_STAGE(PG8_SB(0, 0), cB, voffB); PG8_STAGE(PG8_SB(0, 1), cB + hstepB, voffB); PG8_STAGE(PG8_SA(0, 0), cA, voffA); PG8_STAGE(PG8_SA(0, 1), cA + hstepA, voffA);
    if (wr == 1) PG8_BAR;
    PG8_WAIT_V(2); PG8_BAR;
    PG8_STAGE(PG8_SB(1, 0), cB + kstep, voffB); PG8_STAGE(PG8_SA(1, 0), cA + kstep, voffA); PG8_STAGE(PG8_SB(1, 1), cB + hstepB + kstep, voffB);
    PG8_WAIT_V(6); PG8_BAR;
    for (;;) {
        const bool has_next = S.next(ui + 1, nxt);
        const char* nA = has_next ? (const char*)g.A + nxt.aoff * 2 : cA; const char* nB = has_next ? (const char*)g.Bt + nxt.boff * 2 : cB;
#pragma unroll 1
        for (int t = 0; t < nt; t += 2) {
            const bool last = (t == nt - 2);
            const char* a1 = cA + (size_t)(t + 1) * kstep;
            const char* a2 = last ? nA : cA + (size_t)(t + 2) * kstep; const char* b2 = last ? nB : cB + (size_t)(t + 2) * kstep;
            const char* a3 = a2 + kstep; const char* b3 = b2 + kstep;
            PG8_LDB(B0, 0, 0); PG8_LDB(B1, 0, 1); PG8_SCHED; PG8_LDA(At, 0, 0); PG8_STAGE(PG8_SA(1, 1), a1 + hstepA, voffA);
            PG8_WAIT_V(8); PG8_WAIT_L(0); PG8_BAR; PG8_MMA(0, 0, At, B0); PG8_MMA(0, 1, At, B1); PG8_BAR; PG8_SCHED;
            PG8_LDA(At, 0, 1); PG8_STAGE(PG8_SB(0, 0), b2, voffB); PG8_STAGE(PG8_SB(0, 1), b2 + hstepB, voffB); PG8_STAGE(PG8_SA(0, 0), a2, voffA);
            PG8_WAIT_V(8); PG8_WAIT_L(0); PG8_BAR; PG8_MMA(1, 0, At, B0); PG8_MMA(1, 1, At, B1); PG8_BAR; PG8_SCHED;
            PG8_LDB(B0, 1, 0); PG8_LDB(B1, 1, 1); PG8_SCHED; PG8_LDA(At, 1, 0); PG8_STAGE(PG8_SA(0, 1), a2 + hstepA, voffA);
            PG8_WAIT_V(8); PG8_WAIT_L(0); PG8_BAR; PG8_MMA(0, 0, At, B0); PG8_MMA(0, 1, At, B1); PG8_BAR; PG8_SCHED;
            PG8_LDA(At, 1, 1); PG8_STAGE(PG8_SB(1, 0), b3, voffB); PG8_STAGE(PG8_SB(1, 1), b3 + hstepB, voffB); PG8_STAGE(PG8_SA(1, 0), a3, voffA);
            PG8_WAIT_V(8); PG8_WAIT_L(0); PG8_BAR; PG8_MMA(1, 0, At, B0); PG8_MMA(1, 1, At, B1); PG8_BAR; PG8_SCHED;
        }
        if constexpr (ALIGN_EPI) { if (wr == 0) PG8_BAR; }
        E(acc, cur, wr, wc, fr, fq);
        if (!has_next) break;
#pragma unroll
        for (int a = 0; a < 2; ++a)
#pragma unroll
            for (int b = 0; b < 2; ++b)
#pragma unroll
                for (int m = 0; m < 4; ++m)
#pragma unroll
                    for (int n = 0; n < 2; ++n) acc[a][b][m][n] = (f32x4){0.f, 0.f, 0.f, 0.f};
        cur = nxt; cA = nA; cB = nB; ++ui;
        if constexpr (ALIGN_EPI) { if (wr == 1) PG8_BAR; }
    }
    PG8_WAIT_V(0);
    if constexpr (!ALIGN_EPI) { if (wr == 0) PG8_BAR; }
    PG8_BAR;
#undef PG8_SA
#undef PG8_SB
#undef PG8_STAGE
#undef PG8_LDA
#undef PG8_LDB
#undef PG8_MMA
#undef PG8_WAIT_V
#undef PG8_WAIT_L
#undef PG8_BAR
#undef PG8_SCHED
}
}

constexpr int NWAVES = 8, NTHR = 512, GRID = 256;
constexpr int RING_BYTES = 131072, XCH_OFF = RING_BYTES, LDS_BYTES = 147456;
struct Args { const float* in[22]; float* out; unsigned char* ws; int ph_lo, ph_hi; };
enum { I_X = 0, I_MEM, I_NORM_MIX, I_W_IN, I_SG_VG, I_SG_W, I_SG_B, I_GLA_WG, I_GLA_BG, I_GLA_OG, I_W_OUT, I_NORM_MEM, I_MEM_GAIN, I_W_CQ, I_W_CKV, I_W_CO, I_NORM_FFN, I_PEER_WQ, I_PEER_SK, I_PEER_U, I_PEER_V, I_FINAL_G };

struct Frame {
    LAS unsigned char* lds; int tid, lane, wave, bx, gw; static constexpr int G = GRID, NGW = GRID * NWAVES;
    float* X; unsigned char* ws;
};
#define INP(i) (args.in[(i)])

#define XB_TMO      128
#define XB_XCNT(j)  (256  + 64 * (j))
#define XB_XSUB(j)  (1280 + 64 * (j))
#define XB_XGEN(j)  (2304 + 64 * (j))
#define XB_TOP      3328
#define XB_TOPGEN   3392
#define XCD_BAR_WORDS 3456
#define XB_SPIN_CAP (1u << 22)
DI unsigned xb_ld(unsigned* p)              { return __hip_atomic_load(p, __ATOMIC_RELAXED, __HIP_MEMORY_SCOPE_AGENT); }
DI unsigned xb_add(unsigned* p, unsigned v) { return __hip_atomic_fetch_add(p, v, __ATOMIC_RELAXED, __HIP_MEMORY_SCOPE_AGENT); }
DI unsigned xb_xcc_id() { return (unsigned)__builtin_amdgcn_s_getreg((3 << 11) | 20) & 0xFu; }
#define XB_SPIN(cond, bar) do { unsigned _sp = 0; while (cond) { __builtin_amdgcn_s_sleep(1); \
    if ((++_sp & 255u) == 0u) { if (xb_ld(&(bar)[XB_TMO])) break; if (_sp > XB_SPIN_CAP) { atomicAdd(&(bar)[XB_TMO], 1u); break; } } } } while (0)
struct XcdBarrier { unsigned* bar; unsigned x; volatile LAS unsigned* st; };
DI XcdBarrier xcd_barrier_post(unsigned* bar, volatile LAS unsigned* st) {
    XcdBarrier b; b.bar = bar; b.x = xb_xcc_id(); b.st = st;
    if (threadIdx.x == 0) (void)xb_add(&bar[XB_XCNT(b.x)], 1u);
    return b;
}
DI void xcd_barrier_complete(unsigned* bar, unsigned x, unsigned& nloc, unsigned& nx) {
    const unsigned G = gridDim.x * gridDim.y * gridDim.z;
    unsigned sum, cnt, mine, sp = 0u;
    for (;;) {
        sum = 0u; cnt = 0u; mine = 0u;
#pragma unroll
        for (unsigned j = 0; j < 16; ++j) { const unsigned c = xb_ld(&bar[XB_XCNT(j)]); sum += c; cnt += (c > 0u) ? 1u : 0u; mine = (j == x) ? c : mine; }
        if (sum == G) break;
        __builtin_amdgcn_s_sleep(1);
        if ((++sp & 255u) == 0u) { if (xb_ld(&bar[XB_TMO])) break; if (sp > XB_SPIN_CAP) { atomicAdd(&bar[XB_TMO], 1u); break; } }
    }
    nloc = mine > 0u ? mine : 1u; nx = cnt > 0u ? cnt : 1u;
}
DI void xcd_barrier(const XcdBarrier& b) {
    asm volatile("s_waitcnt vmcnt(0)" ::: "memory");
    __syncthreads();
    if (threadIdx.x == 0) {
        unsigned* bar = b.bar;
        __builtin_amdgcn_s_waitcnt(0);
        unsigned nloc = b.st[0], nx = b.st[1];
        if (nloc == 0u) { xcd_barrier_complete(bar, b.x, nloc, nx); b.st[0] = nloc; b.st[1] = nx; }
        const unsigned old = xb_add(&bar[XB_XSUB(b.x)], 1u);
        const unsigned gen = old / nloc;
        if (old + 1u == (gen + 1u) * nloc) {
            __builtin_amdgcn_fence(__ATOMIC_RELEASE, "agent");
            asm volatile("s_waitcnt vmcnt(0)" ::: "memory");
            const unsigned og = xb_add(&bar[XB_TOP], 1u);
            const unsigned tg = og / nx;
            if (og + 1u == (tg + 1u) * nx) xb_add(&bar[XB_TOPGEN], 1u);
            else XB_SPIN(xb_ld(&bar[XB_TOPGEN]) == tg, bar);
            __builtin_amdgcn_fence(__ATOMIC_ACQUIRE, "agent");
            xb_add(&bar[XB_XGEN(b.x)], 1u);
            asm volatile("s_waitcnt vmcnt(0)" ::: "memory");
        } else {
            XB_SPIN(xb_ld(&bar[XB_XGEN(b.x)]) == gen, bar);
            __builtin_amdgcn_fence(__ATOMIC_ACQUIRE, "agent");
            asm volatile("s_waitcnt vmcnt(0)" ::: "memory");
        }
    }
    __syncthreads();
}

DI void p0_transpose_item(const float* W, int ldw, int N, int K, const float* gain, bf16_t* WT, LAS float* scr, int item, int lane) {
    const int nblk = N / 32, kb = item / nblk, nb = item % nblk, k0 = 64 * kb, n0 = 32 * nb;
#pragma unroll 8
    for (int i = 0; i < 32; ++i) { const int kk = 2 * i + (lane >> 5); float w = W[(size_t)(k0 + kk) * ldw + n0 + (lane & 31)]; if (gain) w *= gain[k0 + kk]; scr[kk * 33 + (lane & 31)] = w; }
    LDS_WAIT(); asm volatile("" ::: "memory");
    const int c = lane & 7;
#pragma unroll
    for (int j = 0; j < 4; ++j) { const int n = (lane >> 3) + 8 * j; const LAS float* s = scr + (8 * c) * 33 + n;
        u32x4 o; o.x = cvtpk(s[0 * 33], s[1 * 33]); o.y = cvtpk(s[2 * 33], s[3 * 33]); o.z = cvtpk(s[4 * 33], s[5 * 33]); o.w = cvtpk(s[6 * 33], s[7 * 33]);
        *(u32x4*)(WT + (size_t)(n0 + n) * K + k0 + 8 * c) = o; }
    LDS_WAIT(); asm volatile("" ::: "memory");
}
DI unsigned fp4x8(const f32x4 a, const f32x4 b, float inv) {
    unsigned w = 0;
    w = __builtin_amdgcn_cvt_scalef32_pk_fp4_f32(w, a[0] * inv, a[1] * inv, 1.0f, 0); w = __builtin_amdgcn_cvt_scalef32_pk_fp4_f32(w, a[2] * inv, a[3] * inv, 1.0f, 1);
    w = __builtin_amdgcn_cvt_scalef32_pk_fp4_f32(w, b[0] * inv, b[1] * inv, 1.0f, 2); w = __builtin_amdgcn_cvt_scalef32_pk_fp4_f32(w, b[2] * inv, b[3] * inv, 1.0f, 3);
    return w;
}
DI float wave_max(float v) {
#pragma unroll
    for (int o = 1; o < 64; o <<= 1) v = fmaxf(v, __shfl_xor(v, o));
    return v;
}
DI void convert_tables(const Frame& F, const Args& args, int l, int wv, int nwv) {
    const float* gn = INP(I_NORM_FFN) + l * 1024 + 16 * F.lane;
    f32x4 g[4];
#pragma unroll
    for (int q = 0; q < 4; ++q) g[q] = *(const f32x4*)(gn + 4 * q);
    for (int r0 = wv; r0 < 2 * 16384; r0 += 4 * nwv) {
        f32x4 v[4][4];
#pragma unroll
        for (int j = 0; j < 4; ++j) { const int r = min(r0 + j * nwv, 2 * 16384 - 1), isv = r >= 16384, e = r & 16383;
            const float* src = (isv ? INP(I_PEER_V) : INP(I_PEER_U)) + ((size_t)l * 16384 + e) * 1024 + 16 * F.lane;
#pragma unroll
            for (int q = 0; q < 4; ++q) v[j][q] = *(const f32x4*)(src + 4 * q); }
#pragma unroll
        for (int j = 0; j < 4; ++j) { const int r = r0 + j * nwv, isv = r >= 16384, e = r & 16383; float am = 0.f;
            if (r < 2 * 16384) {
#pragma unroll
            for (int q = 0; q < 4; ++q) { if (!isv) v[j][q] = v[j][q] * g[q];
                am = fmaxf(am, fmaxf(fmaxf(fabsf(v[j][q][0]), fabsf(v[j][q][1])), fmaxf(fabsf(v[j][q][2]), fabsf(v[j][q][3])))); }
            am = wave_max(am);
            const float sc = bf2f(cvt1(am > 0.f ? am * (1.0f / 6.0f) : 1.0f)), inv = 1.0f / sc;
            u32x2 w; w.x = fp4x8(v[j][0], v[j][1], inv); w.y = fp4x8(v[j][2], v[j][3], inv);
            *(u32x2*)(F.ws + WS_TAB + (size_t)l * 16 * MiB + (size_t)isv * 8 * MiB + (size_t)e * 512 + 8 * F.lane) = w;
            if (F.lane == 0) ((bf16_t*)(F.ws + WS_TAB + 32 * MiB))[((size_t)l * 16384 + e) * 2 + isv] = cvt1(sc); } }
    }
}
struct TDesc { const float* W; const float* gain; bf16_t* WT; int ldw, nblk; };
DI TDesc tdesc(const Frame& F, const Args& args, int l, int t) {
    TDesc D; D.gain = nullptr; D.ldw = 1024; D.nblk = 32; size_t woff;
    switch (t) {
    case 0: D.W = INP(I_W_IN) + (size_t)l * 1024 * INW; D.ldw = INW; D.nblk = 88; D.gain = INP(I_NORM_MIX) + l * 1024; woff = W_IN; break;
    case 1: D.W = INP(I_W_OUT) + (size_t)l * 1024 * 1024; woff = W_OUT; break;
    case 2: D.W = INP(I_W_CQ) + (size_t)l * 1024 * 1024; D.gain = INP(I_NORM_MEM) + l * 1024; woff = W_CQ; break;
    case 3: D.W = INP(I_W_CKV) + (size_t)l * 1024 * 2048; D.ldw = 2048; D.nblk = 64; D.gain = INP(I_MEM_GAIN) + l * 1024; woff = W_CKV; break;
    case 4: D.W = INP(I_W_CO) + (size_t)l * 1024 * 1024; woff = W_CO; break;
    default: D.W = INP(I_PEER_WQ) + (size_t)l * 1024 * 1024; D.gain = INP(I_NORM_FFN) + l * 1024; woff = W_PQ; break;
    }
    D.WT = (bf16_t*)(F.ws + WS_W + l * W_LAYER + woff); return D;
}
DI void titem_load(const TDesc& D, int item, int lane, float (&v)[32]) {
    const int kb = item / D.nblk, nb = item % D.nblk, k0 = 64 * kb, n0 = 32 * nb;
#pragma unroll
    for (int i = 0; i < 32; ++i) { const int kk = 2 * i + (lane >> 5); float w = D.W[(size_t)(k0 + kk) * D.ldw + n0 + (lane & 31)]; if (D.gain) w *= D.gain[k0 + kk]; v[i] = w; }
}
DI void titem_store(const TDesc& D, int item, int lane, LAS float* scr, const float (&v)[32]) {
    const int kb = item / D.nblk, nb = item % D.nblk, k0 = 64 * kb, n0 = 32 * nb;
#pragma unroll
    for (int i = 0; i < 32; ++i) scr[(2 * i + (lane >> 5)) * 33 + (lane & 31)] = v[i];
    LDS_WAIT(); asm volatile("" ::: "memory");
    const int c = lane & 7;
#pragma unroll
    for (int j = 0; j < 4; ++j) { const int n = (lane >> 3) + 8 * j; const LAS float* s = scr + (8 * c) * 33 + n;
        u32x4 o; o.x = cvtpk(s[0 * 33], s[1 * 33]); o.y = cvtpk(s[2 * 33], s[3 * 33]); o.z = cvtpk(s[4 * 33], s[5 * 33]); o.w = cvtpk(s[6 * 33], s[7 * 33]);
        *(u32x4*)(D.WT + (size_t)(n0 + n) * 1024 + k0 + 8 * c) = o; }
    LDS_WAIT(); asm volatile("" ::: "memory");
}
DI int tl_index(int part, int e) {
    if (part == 0) return e < 1408 ? e : e < 2432 ? 2432 + (e - 1408) : 4480 + 2432 + (e - 2432);
    return e < 1024 ? 1408 + e : e < 2048 ? 3456 + (e - 1024) : e < 4480 ? 4480 + (e - 2048) : 4480 + 3456 + (e - 4480);
}
DI void transpose_list(const Frame& F, const Args& args, LAS float* scr, int wv, int nwv, int part) {
    constexpr int NIT_L = 16 * 88 + 4 * 16 * 32 + 16 * 64;
    const int NIT = part == 0 ? 3456 : 5504;
    float va[32], vb[32]; TDesc Da{}, Db{}; int la = 0, lb = 0;
#define TI_DECODE(e_, D_, loc_) do { const int it_ = tl_index(part, (e_)); const int l_ = it_ / NIT_L; int r_ = it_ % NIT_L; int t_; \
        if (r_ < 1408) t_ = 0; else if (r_ < 1920) { t_ = 1; r_ -= 1408; } else if (r_ < 2432) { t_ = 2; r_ -= 1920; } else if (r_ < 3456) { t_ = 3; r_ -= 2432; } else if (r_ < 3968) { t_ = 4; r_ -= 3456; } else { t_ = 5; r_ -= 3968; } \
        D_ = tdesc(F, args, l_, t_); loc_ = r_; } while (0)
    int it = wv;
    if (it < NIT) { TI_DECODE(it, Da, la); titem_load(Da, la, F.lane, va); }
    for (;;) {
        int itn = it + nwv;
        if (itn < NIT) { TI_DECODE(itn, Db, lb); titem_load(Db, lb, F.lane, vb); }
        if (it < NIT) titem_store(Da, la, F.lane, scr, va);
        it = itn; if (it >= NIT) break;
        itn = it + nwv;
        if (itn < NIT) { TI_DECODE(itn, Da, la); titem_load(Da, la, F.lane, va); }
        titem_store(Db, lb, F.lane, scr, vb);
        it = itn; if (it >= NIT) break;
    }
#undef TI_DECODE
}
DI void p0_prologue(const Frame& F, const Args& args) {
    LAS float* scr = (LAS float*)(F.lds + F.wave * 16384);
    transpose_list(F, args, scr, F.gw, F.NGW, 0);
    const int gt = F.bx * NTHR + F.tid, nthr = F.G * NTHR;
    for (int i = gt; i < DEPTH * 256 * 1024; i += nthr) {
        const int l = i / (256 * 1024), r = i % (256 * 1024), j = r >> 10, k = r & 1023;
        bf16_t* Wi = (bf16_t*)(F.ws + WS_W + l * W_LAYER) + W_IN / 2;
        float v = 0.f;
        if (j < 128) {
            const float* wi = INP(I_W_IN) + (size_t)l * 1024 * INW + (size_t)k * INW + 2816; const float* wg = INP(I_GLA_WG) + l * 16 * 128 + j;
#pragma unroll
            for (int q4 = 0; q4 < 4; ++q4) { const f32x4 w4 = *(const f32x4*)(wi + 4 * q4);
#pragma unroll
                for (int e = 0; e < 4; ++e) v += w4[e] * wg[(4 * q4 + e) * 128]; }
            v *= INP(I_NORM_MIX)[l * 1024 + k];
        }
        Wi[(size_t)(2816 + j) * 1024 + k] = cvt1(v);
    }
    { bf16_t* WSP = (bf16_t*)(F.ws + WS_WSP); const float* sw = INP(I_SG_W);
      for (int i = gt; i < DEPTH * 4 * 128 * 128; i += nthr) { const int s = i & 127, t = (i >> 7) & 127; WSP[i] = cvt1(s <= t ? sw[i] : 0.f); }
      bf16_t* SK = (bf16_t*)(F.ws + WS_SUBK); const float* sk = INP(I_PEER_SK);
      for (int i = gt; i < DEPTH * 8 * 2 * 128 * 64; i += nthr) SK[i] = cvt1(sk[i]); }
    { float* SS = (float*)(F.ws + WS_SS); bf16_t* XB = (bf16_t*)(F.ws + WS_XB); const float* x = INP(I_X);
      for (int m0 = F.gw; m0 < MTOK; m0 += 4 * F.NGW) {
          f32x4 v[4][4];
#pragma unroll
          for (int i = 0; i < 4; ++i) { const f32x4* xr = (const f32x4*)(x + (size_t)(m0 + i * F.NGW) * 1024) + F.lane;
#pragma unroll
              for (int j = 0; j < 4; ++j) v[i][j] = xr[64 * j]; }
#pragma unroll
          for (int i = 0; i < 4; ++i) { const int m = m0 + i * F.NGW; float s = 0.f; u32x2 w[4];
#pragma unroll
              for (int j = 0; j < 4; ++j) { w[j].x = cvtpk(v[i][j][0], v[i][j][1]); w[j].y = cvtpk(v[i][j][2], v[i][j][3]);
                  s += (bflo(w[j].x) * bflo(w[j].x) + bfhi(w[j].x) * bfhi(w[j].x)) + (bflo(w[j].y) * bflo(w[j].y) + bfhi(w[j].y) * bfhi(w[j].y)); }
              s = wave_sum(s);
              u32x2* xb = (u32x2*)(XB + (size_t)m * 1024) + F.lane;
#pragma unroll
              for (int j = 0; j < 4; ++j) xb[64 * j] = w[j];
              if (F.lane < 16) SS[(size_t)m * 16 + F.lane] = F.lane == 0 ? s : 0.f; }
      }
      bf16_t* MB = (bf16_t*)(F.ws + WS_MEMB); float* RM = (float*)(F.ws + WS_RSTDM); const float* mem = INP(I_MEM);
      for (int m = F.gw; m < MMEM; m += F.NGW) {
          const f32x4* xr = (const f32x4*)(mem + (size_t)m * 1024) + F.lane; f32x4 v[4]; float s = 0.f;
#pragma unroll
          for (int j = 0; j < 4; ++j) { v[j] = xr[64 * j]; s += (v[j][0] * v[j][0] + v[j][1] * v[j][1]) + (v[j][2] * v[j][2] + v[j][3] * v[j][3]); }
          s = wave_sum(s);
          u32x2* xb = (u32x2*)(MB + (size_t)m * 1024) + F.lane;
#pragma unroll
          for (int j = 0; j < 4; ++j) { u32x2 w; w.x = cvtpk(v[j][0], v[j][1]); w.y = cvtpk(v[j][2], v[j][3]); xb[64 * j] = w; }
          if (F.lane == 0) RM[m] = 1.0f / sqrtf(s * (1.0f / 1024.0f) + EPS);
      } }
}

constexpr int SBV_PITCH = 192;
DI void sb_unit2(const bf16_t* PROJ, bf16_t* YCAT, int b, int h, int qp, LAS char* vl, int lane) {
    const int q = lane & 31, hh = lane >> 5;
    const size_t rowbase = (size_t)b * SEQ; const int qa = 2 * qp, qb = qa + 1;
    bf16x8 qfA[4], qfB[4];
    { const bf16_t* qrow = PROJ + (rowbase + qa * 32 + q) * LDP + C_SBQ + h * 64 + hh * 8;
#pragma unroll
      for (int s = 0; s < 4; ++s) { qfA[s] = *(const bf16x8*)(qrow + 16 * s); qfB[s] = *(const bf16x8*)(qrow + 32 * LDP + 16 * s); } }
    f32x16 oA0, oA1, oB0, oB1;
#pragma unroll
    for (int r = 0; r < 16; ++r) { oA0[r] = 0.f; oA1[r] = 0.f; oB0[r] = 0.f; oB1[r] = 0.f; }
    float RA = 0.f, RB = 0.f;
    const float zs = 0.125f * LOG2E;
    const int i16 = lane & 15, tq = i16 >> 2, tp = i16 & 3, blk = (lane >> 4) & 1;
    bf16x8 kf[4]; u32x4 vr[4];
#define SB_LOAD_TILE(kt_, kf, vr) do { const bf16_t* krow_ = PROJ + (rowbase + (kt_) * 32 + q) * LDP + C_SBK + h * 64 + hh * 8; \
        _Pragma("unroll") for (int s_ = 0; s_ < 4; ++s_) kf[s_] = *(const bf16x8*)(krow_ + 16 * s_); \
        _Pragma("unroll") for (int i_ = 0; i_ < 4; ++i_) { const int c_ = lane + 64 * i_, row_ = c_ >> 3, ch_ = c_ & 7; vr[i_] = *(const u32x4*)(PROJ + (rowbase + (kt_) * 32 + row_) * LDP + C_SBV + h * 64 + ch_ * 8); } } while (0)
#define SB_MATH(Z, DIAG, R, O0, O1) { \
        float L[16]; \
        _Pragma("unroll") for (int r = 0; r < 16; ++r) { \
            const float zl = Z[r] * zs; float l2 = flog2(1.f + fexp2(zl)); l2 = zl > 60.f ? zl : l2; \
            const bool valid = !(DIAG) || (crow(r, hh) < q); \
            L[r] = valid ? l2 : 0.f; Z[r] = valid ? zl : -INFINITY; } \
        float G[4], Go[4]; \
        _Pragma("unroll") for (int g = 0; g < 4; ++g) { G[g] = (L[4 * g] + L[4 * g + 1]) + (L[4 * g + 2] + L[4 * g + 3]); Go[g] = __shfl_xor(G[g], 32); } \
        float base[4]; float run = 0.f; \
        _Pragma("unroll") for (int g = 3; g >= 0; --g) { base[g] = run + (hh == 0 ? Go[g] : 0.f); run += G[g] + Go[g]; } \
        float P[16]; \
        _Pragma("unroll") for (int g = 0; g < 4; ++g) { \
            const float c3 = R + base[g], c2 = c3 + L[4 * g + 3], c1 = c2 + L[4 * g + 2], c0 = c1 + L[4 * g + 1]; \
            P[4 * g + 3] = fexp2(Z[4 * g + 3] - L[4 * g + 3] - c3); P[4 * g + 2] = fexp2(Z[4 * g + 2] - L[4 * g + 2] - c2); \
            P[4 * g + 1] = fexp2(Z[4 * g + 1] - L[4 * g + 1] - c1); P[4 * g + 0] = fexp2(Z[4 * g + 0] - L[4 * g + 0] - c0); } \
        R += run; \
        const bf16x8 p0 = pack8(P[0], P[1], P[2], P[3], P[4], P[5], P[6], P[7]), p1 = pack8(P[8], P[9], P[10], P[11], P[12], P[13], P[14], P[15]); \
        _Pragma("unroll") for (int s = 0; s < 2; ++s) { \
            const LAS char* vb = vl + (16 * s + 4 * hh + tq) * SBV_PITCH + blk * 32 + tp * 8; \
            const bf16x8 a0 = cat8(vtr(vb), vtr(vb + 8 * SBV_PITCH)), a1 = cat8(vtr(vb + 64), vtr(vb + 8 * SBV_PITCH + 64)); \
            O0 = MFMA32(a0, s == 0 ? p0 : p1, O0); O1 = MFMA32(a1, s == 0 ? p0 : p1, O1); } }
#define SB_ZERO(Z) _Pragma("unroll") for (int r = 0; r < 16; ++r) Z[r] = 0.f;
#define SB_VTOLDS(VR) _Pragma("unroll") for (int i = 0; i < 4; ++i) { const int c = lane + 64 * i, row = c >> 3, ch = c & 7; *(LAS u32x4*)(vl + row * SBV_PITCH + ch * 16) = VR[i]; }
    SB_LOAD_TILE(qb, kf, vr);
    {
        f32x16 zB; SB_ZERO(zB)
#pragma unroll
        for (int s = 0; s < 4; ++s) zB = MFMA32(kf[s], qfB[s], zB);
        SB_VTOLDS(vr)
        SB_LOAD_TILE(qa, kf, vr);
        SB_MATH(zB, true, RB, oB0, oB1)
    }
#define SB_STEP2(kt) { \
        f32x16 zA, zB; SB_ZERO(zA) SB_ZERO(zB) \
        _Pragma("unroll") for (int s = 0; s < 4; ++s) { zA = MFMA32(kf[s], qfA[s], zA); zB = MFMA32(kf[s], qfB[s], zB); } \
        SB_VTOLDS(vr) \
        if (kt > 0) SB_LOAD_TILE(kt - 1, kf, vr); \
        SB_MATH(zA, (kt == qa), RA, oA0, oA1) \
        SB_MATH(zB, false, RB, oB0, oB1) \
        if (__all(RA > 57.7f && RB > 57.7f)) break;            \
    }
    for (int kt = qa; kt >= 0; --kt) SB_STEP2(kt)
#undef SB_STEP2
#undef SB_VTOLDS
#undef SB_ZERO
#undef SB_MATH
#undef SB_LOAD_TILE
    bf16_t* orow = YCAT + (rowbase + qa * 32 + q) * 1024 + h * 64 + 4 * hh;
#pragma unroll
    for (int g = 0; g < 4; ++g) {
        u32x2 w0; w0.x = cvtpk(oA0[4 * g], oA0[4 * g + 1]); w0.y = cvtpk(oA0[4 * g + 2], oA0[4 * g + 3]); *(u32x2*)(orow + 8 * g) = w0;
        u32x2 w1; w1.x = cvtpk(oA1[4 * g], oA1[4 * g + 1]); w1.y = cvtpk(oA1[4 * g + 2], oA1[4 * g + 3]); *(u32x2*)(orow + 32 + 8 * g) = w1;
        u32x2 w2; w2.x = cvtpk(oB0[4 * g], oB0[4 * g + 1]); w2.y = cvtpk(oB0[4 * g + 2], oB0[4 * g + 3]); *(u32x2*)(orow + 32 * 1024 + 8 * g) = w2;
        u32x2 w3; w3.x = cvtpk(oB1[4 * g], oB1[4 * g + 1]); w3.y = cvtpk(oB1[4 * g + 2], oB1[4 * g + 3]); *(u32x2*)(orow + 32 * 1024 + 32 + 8 * g) = w3;
    }
}

constexpr int SGV_PITCH = 576;
DI void sgu_unit(const Frame& F, const Args& args, int l, int b, int c, const bf16_t* PROJ, bf16_t* YCAT) {
    const size_t m0 = (size_t)b * SEQ + c * 128;
    LAS char* Vn = (LAS char*)F.lds;
    {
      const int t = F.tid >> 2, part = F.tid & 3; const bf16_t* vrow = PROJ + (m0 + t) * LDP + C_SGV + part * 64; const float* gn = INP(I_SG_VG) + l * 256 + part * 64;
      float gv[64]; float s = 0.f;
#pragma unroll
      for (int i = 0; i < 8; ++i) { const u32x4 w = *(const u32x4*)(vrow + 8 * i);
#pragma unroll
          for (int j = 0; j < 4; ++j) { const float a = gelu_tanh(bflo(w[j])), bb = gelu_tanh(bfhi(w[j])); gv[8 * i + 2 * j] = a; gv[8 * i + 2 * j + 1] = bb; s += a * a + bb * bb; } }
      s += __shfl_xor(s, 1); s += __shfl_xor(s, 2);
      const float rstd = 1.0f / sqrtf(s * (1.0f / 256.0f) + EPS);
#pragma unroll
      for (int i = 0; i < 8; ++i) { const f32x4 g0 = *(const f32x4*)(gn + 8 * i), g1 = *(const f32x4*)(gn + 8 * i + 4);
          u32x4 w; w.x = cvtpk(gv[8 * i] * rstd * g0[0], gv[8 * i + 1] * rstd * g0[1]); w.y = cvtpk(gv[8 * i + 2] * rstd * g0[2], gv[8 * i + 3] * rstd * g0[3]);
          w.z = cvtpk(gv[8 * i + 4] * rstd * g1[0], gv[8 * i + 5] * rstd * g1[1]); w.w = cvtpk(gv[8 * i + 6] * rstd * g1[2], gv[8 * i + 7] * rstd * g1[3]);
          *(LAS u32x4*)(Vn + t * SGV_PITCH + (part * 64 + 8 * i) * 2) = w; } }
    WG_SYNC();
    {
      const int g = F.wave >> 1, db = F.wave & 1, lane = F.lane, r32 = lane & 31, hh = lane >> 5;
      const int i16 = lane & 15, tq = i16 >> 2, tp = i16 & 3, blk = (lane >> 4) & 1;
      const bf16_t* Wg = (const bf16_t*)(F.ws + WS_WSP) + ((size_t)(l * 4 + g) * 128) * 128;
      const float* bias = INP(I_SG_B) + (l * 4 + g) * 128;
      const int ch0 = g * 64 + db * 32 + 4 * hh;
      for (int tb = 0; tb < 4; ++tb) {
          const int t = tb * 32 + r32;
          u32x2 uw[4];
#pragma unroll
          for (int gi = 0; gi < 4; ++gi) uw[gi] = *(const u32x2*)(PROJ + (m0 + t) * LDP + C_SGU + ch0 + 8 * gi);
          const float bt = bias[t];
          f32x16 acc;
#pragma unroll
          for (int r = 0; r < 16; ++r) acc[r] = 0.f;
          for (int sb = 0; sb <= tb; ++sb) {
#pragma unroll
              for (int ks = 0; ks < 2; ++ks) {
                  const bf16x8 wf = *(const bf16x8*)(Wg + (size_t)t * 128 + sb * 32 + 16 * ks + 8 * hh);
                  const LAS char* vb = Vn + (sb * 32 + 16 * ks + 8 * hh + tq) * SGV_PITCH + (g * 64 + db * 32 + blk * 16) * 2 + tp * 8;
                  const bf16x8 vf = cat8(vtr(vb), vtr(vb + 4 * SGV_PITCH));
                  acc = MFMA32(vf, wf, acc);
              }
          }
          bf16_t* yo = YCAT + (m0 + t) * 1024 + 512 + ch0;
#pragma unroll
          for (int gi = 0; gi < 4; ++gi) {
              const float y0 = gelu_tanh(bflo(uw[gi].x)) * (acc[4 * gi] + bt), y1 = gelu_tanh(bfhi(uw[gi].x)) * (acc[4 * gi + 1] + bt);
              const float y2 = gelu_tanh(bflo(uw[gi].y)) * (acc[4 * gi + 2] + bt), y3 = gelu_tanh(bfhi(uw[gi].y)) * (acc[4 * gi + 3] + bt);
              u32x2 wv; wv.x = cvtpk(y0, y1); wv.y = cvtpk(y2, y3); *(u32x2*)(yo + 8 * gi) = wv;
          }
      } }
    WG_SYNC();
}

constexpr int GQ_PITCH = 80, GV_PITCH = 192, GS_PITCH = 80;
constexpr int GL_QT = 0, GL_KT = GL_QT + 128 * GQ_PITCH, GL_VV = GL_KT + 128 * GQ_PITCH, GL_ST = GL_VV + 128 * GV_PITCH, GL_SEG = GL_ST + 64 * GS_PITCH,
              GL_D = GL_SEG + 16 * 32 * 4, GL_SSQ = GL_D + 32 * 4, GL_END = GL_SSQ + 128 * 2 * 4;
DI void gla_chain(const Frame& F, const Args& args, int l, int b, int h, const bf16_t* PROJ, bf16_t* YCAT) {
    LAS char* L = (LAS char*)F.lds;
    LAS float* SEG = (LAS float*)(L + GL_SEG); LAS float* Dd = (LAS float*)(L + GL_D); LAS float* SSQ = (LAS float*)(L + GL_SSQ);
    const int tid = F.tid, lane = F.lane, w = F.wave, r32 = lane & 31, hh = lane >> 5;
    const int i16 = lane & 15, tq = i16 >> 2, tp = i16 & 3, blk = (lane >> 4) & 1;
    for (int i = tid; i < 64 * GS_PITCH / 4; i += NTHR) ((LAS unsigned*)(L + GL_ST))[i] = 0u;
    f32x16 st;
#pragma unroll
    for (int r = 0; r < 16; ++r) st[r] = 0.f;
    const int j = tid & 31, seg = tid >> 5;
    const float bg = INP(I_GLA_BG)[l * 128 + h * 32 + j];
    const int tb = w & 3, dh = w >> 2;
    float ga[8], kr[8], qr[8]; u32x4 vv[2];
#define GC_LOAD(c_) do { const size_t m0_ = (size_t)b * SEQ + (c_) * 128; \
        _Pragma("unroll") for (int i_ = 0; i_ < 8; ++i_) { const bf16_t* p_ = PROJ + (m0_ + seg * 8 + i_) * LDP + h * 32 + j; ga[i_] = bf2f(p_[C_GA]); kr[i_] = bf2f(p_[C_GK]); qr[i_] = bf2f(p_[C_GQ]); } \
        _Pragma("unroll") for (int i_ = 0; i_ < 2; ++i_) { const int cc_ = tid + 512 * i_, row_ = cc_ >> 3, ch_ = cc_ & 7; vv[i_] = *(const u32x4*)(PROJ + (m0_ + row_) * LDP + C_GV + h * 64 + ch_ * 8); } } while (0)
    GC_LOAD(0);
    LDS_SYNC();
#pragma unroll 1
    for (int c = 0; c < 16; ++c) {
        const size_t m0 = (size_t)b * SEQ + c * 128;
        float bc[8]; float run = 0.f;
#pragma unroll
        for (int i = 0; i < 8; ++i) {
            const float g = ga[i] + bg;
            const float sp = fmaxf(-g, 0.f) + flog2(1.f + fexp2(-fabsf(g) * LOG2E)) * 0.6931471805599453f;
            run += -sp * (1.0f / 16.0f); bc[i] = run;
        }
        SEG[seg * 32 + j] = run;
#pragma unroll
        for (int i = 0; i < 2; ++i) { const int cc = tid + 512 * i, row = cc >> 3, ch = cc & 7; *(LAS u32x4*)(L + GL_VV + row * GV_PITCH + ch * 16) = vv[i]; }
        LDS_SYNC();
        float pre = 0.f;
#pragma unroll
        for (int s2 = 0; s2 < 15; ++s2) { const float v_ = SEG[s2 * 32 + j]; pre += s2 < seg ? v_ : 0.f; }
#pragma unroll
        for (int i = 0; i < 8; ++i) {
            const int t = seg * 8 + i; const float bb = pre + bc[i];
            *(LAS bf16_t*)(L + GL_QT + t * GQ_PITCH + j * 2) = cvt1(qr[i] * 0.17677669529663687f * fexp2(bb * LOG2E));
            *(LAS bf16_t*)(L + GL_KT + t * GQ_PITCH + j * 2) = cvt1(kr[i] * fexp2(-bb * LOG2E));
            if (t == 127) Dd[j] = fexp2(bb * LOG2E);
        }
        if (c < 15) GC_LOAD(c + 1);
        u32x2 gov[4];
        { const bf16_t* go = PROJ + (m0 + tb * 32 + r32) * LDP + C_GO + h * 64 + dh * 32 + 4 * hh;
#pragma unroll
          for (int g = 0; g < 4; ++g) gov[g] = *(const u32x2*)(go + 8 * g); }
        LDS_SYNC();
        f32x16 o;
#pragma unroll
        for (int r = 0; r < 16; ++r) o[r] = 0.f;
        bf16x8 qf[2];
#pragma unroll
        for (int ks = 0; ks < 2; ++ks) qf[ks] = *(LAS const bf16x8*)(L + GL_QT + (tb * 32 + r32) * GQ_PITCH + (16 * ks + 8 * hh) * 2);
        for (int sb = 0; sb <= tb; ++sb) {
            f32x16 sT;
#pragma unroll
            for (int r = 0; r < 16; ++r) sT[r] = 0.f;
#pragma unroll
            for (int ks = 0; ks < 2; ++ks) { const bf16x8 kf = *(LAS const bf16x8*)(L + GL_KT + (sb * 32 + r32) * GQ_PITCH + (16 * ks + 8 * hh) * 2); sT = MFMA32(kf, qf[ks], sT); }
            if (sb == tb) {
#pragma unroll
                for (int r = 0; r < 16; ++r) if (crow(r, hh) > r32) sT[r] = 0.f;
            }
            const bf16x8 p0 = pack8(sT[0], sT[1], sT[2], sT[3], sT[4], sT[5], sT[6], sT[7]), p1 = pack8(sT[8], sT[9], sT[10], sT[11], sT[12], sT[13], sT[14], sT[15]);
#pragma unroll
            for (int s = 0; s < 2; ++s) {
                const LAS char* vb = L + GL_VV + (sb * 32 + 16 * s + 4 * hh + tq) * GV_PITCH + (dh * 32 + blk * 16) * 2 + tp * 8;
                const bf16x8 a = cat8(vtr(vb), vtr(vb + 8 * GV_PITCH));
                o = MFMA32(a, s == 0 ? p0 : p1, o);
            }
        }
#pragma unroll
        for (int ks = 0; ks < 2; ++ks) {
            const bf16x8 a = *(LAS const bf16x8*)(L + GL_ST + (dh * 32 + r32) * GS_PITCH + (16 * ks + 8 * hh) * 2);
            o = MFMA32(a, qf[ks], o);
        }
        if (tb == 0) {
#pragma unroll
            for (int ks = 0; ks < 8; ++ks) {
                const LAS char* kb = L + GL_KT + (16 * ks + 8 * hh + tq) * GQ_PITCH + (blk * 16) * 2 + tp * 8;
                const bf16x8 a = cat8(vtr(kb), vtr(kb + 4 * GQ_PITCH));
                const LAS char* vb = L + GL_VV + (16 * ks + 8 * hh + tq) * GV_PITCH + (dh * 32 + blk * 16) * 2 + tp * 8;
                const bf16x8 bfr = cat8(vtr(vb), vtr(vb + 4 * GV_PITCH));
                st = MFMA32(a, bfr, st);
            }
#pragma unroll
            for (int r = 0; r < 16; ++r) st[r] *= Dd[crow(r, hh)];
        }
        float ssq = 0.f;
#pragma unroll
        for (int r = 0; r < 16; ++r) ssq += o[r] * o[r];
        ssq += __shfl_xor(ssq, 32);
        if (hh == 0) SSQ[(tb * 32 + r32) * 2 + dh] = ssq;
        LDS_SYNC();
        {
            const int t = tb * 32 + r32; const float tot = SSQ[t * 2] + SSQ[t * 2 + 1]; const float rstd = 1.0f / sqrtf(tot * (1.0f / 64.0f) + EPS);
            const float* gn = INP(I_GLA_OG) + l * 256 + h * 64 + dh * 32 + 4 * hh;
            bf16_t* yo = YCAT + (m0 + t) * 1024 + 768 + h * 64 + dh * 32 + 4 * hh;
#pragma unroll
            for (int g = 0; g < 4; ++g) {
                const u32x2 gw = gov[g]; const f32x4 gg = *(const f32x4*)(gn + 8 * g);
                const float y0 = o[4 * g] * rstd * gg[0] * silu(bflo(gw.x)), y1 = o[4 * g + 1] * rstd * gg[1] * silu(bfhi(gw.x));
                const float y2 = o[4 * g + 2] * rstd * gg[2] * silu(bflo(gw.y)), y3 = o[4 * g + 3] * rstd * gg[3] * silu(bfhi(gw.y));
                u32x2 wv; wv.x = cvtpk(y0, y1); wv.y = cvtpk(y2, y3); *(u32x2*)(yo + 8 * g) = wv;
            }
        }
        if (tb == 0) {
#pragma unroll
            for (int g = 0; g < 4; ++g) { u32x2 wv; wv.x = cvtpk(st[4 * g], st[4 * g + 1]); wv.y = cvtpk(st[4 * g + 2], st[4 * g + 3]);
                *(LAS u32x2*)(L + GL_ST + (dh * 32 + r32) * GS_PITCH + (8 * g + 4 * hh) * 2) = wv; }
        }
        LDS_SYNC();
    }
#undef GC_LOAD
}

constexpr int XA_PITCH = 528;
template <int PITCH, int I0, int N> DI void xattn_load(const bf16_t* src, int tid, u32x4 (&v)[N]) {
    const bf16_t* p = src + (size_t)(tid >> 5) * PITCH + (tid & 31) * 8;
#pragma unroll
    for (int i = 0; i < N; ++i) v[i] = *(const u32x4*)(p + (size_t)(I0 + i) * 16 * PITCH);
}
template <int I0, int N> DI void xattn_store(LAS char* img, int tid, const u32x4 (&v)[N]) {
    LAS char* d = img + (tid >> 5) * XA_PITCH + (tid & 31) * 16;
#pragma unroll
    for (int i = 0; i < N; ++i) *(LAS u32x4*)(d + (I0 + i) * 16 * XA_PITCH) = v[i];
}
DI void xattn_unit(const Frame& F, const bf16_t* CQ, const bf16_t* Kl, const bf16_t* VTl, bf16_t* O, int pm, int h) {
    LAS char* img = (LAS char*)F.lds;
    const int lane = F.lane, r32 = lane & 31, hh = lane >> 5, b = pm >> 3;
    const size_t tok = (size_t)pm * 256 + F.wave * 32 + r32;
    { u32x4 sk[16]; xattn_load<1024, 0, 16>(Kl + (size_t)b * 256 * 1024 + h * 256, F.tid, sk); xattn_store<0, 16>(img, F.tid, sk); }
    const bf16_t* qrow = CQ + tok * 1024 + h * 256 + 8 * hh;
    bf16x8 qn = *(const bf16x8*)qrow;
    LDS_SYNC();
    u32x4 sv0[8]; xattn_load<256, 0, 8>(VTl + (size_t)(b * 4 + h) * 256 * 256, F.tid, sv0);
    f32x16 acc[8];
#pragma unroll
    for (int kb = 0; kb < 8; ++kb)
#pragma unroll
        for (int r = 0; r < 16; ++r) acc[kb][r] = 0.f;
#pragma unroll 1
    for (int ks = 0; ks < 16; ++ks) {
        const bf16x8 q = qn;
        qn = *(const bf16x8*)(qrow + 16 * (ks < 15 ? ks + 1 : ks));
        const LAS char* kp = img + r32 * XA_PITCH + (16 * ks + 8 * hh) * 2;
#pragma unroll
        for (int kb = 0; kb < 8; ++kb) acc[kb] = MFMA32(*(LAS const bf16x8*)(kp + kb * 32 * XA_PITCH), q, acc[kb]);
    }
    float mx = -INFINITY;
#pragma unroll
    for (int kb = 0; kb < 8; ++kb)
#pragma unroll
        for (int r = 0; r < 16; ++r) mx = fmaxf(mx, acc[kb][r]);
    mx = fmaxf(mx, __shfl_xor(mx, 32));
    float sum = 0.f;
#pragma unroll
    for (int kb = 0; kb < 8; ++kb)
#pragma unroll
        for (int r = 0; r < 16; ++r) { const float p = fexp2(acc[kb][r] - mx); acc[kb][r] = p; sum += p; }
    sum += __shfl_xor(sum, 32);
    const float inv = 1.0f / sum;
    bf16x8 pf[8][2];
#pragma unroll
    for (int kb = 0; kb < 8; ++kb) {
        pf[kb][0] = pack8(acc[kb][0], acc[kb][1], acc[kb][2], acc[kb][3], acc[kb][4], acc[kb][5], acc[kb][6], acc[kb][7]);
        pf[kb][1] = pack8(acc[kb][8], acc[kb][9], acc[kb][10], acc[kb][11], acc[kb][12], acc[kb][13], acc[kb][14], acc[kb][15]);
    }
    LDS_SYNC();
    { u32x4 sv1[8]; xattn_load<256, 8, 8>(VTl + (size_t)(b * 4 + h) * 256 * 256, F.tid, sv1); xattn_store<0, 8>(img, F.tid, sv0); xattn_store<8, 8>(img, F.tid, sv1); }
    LDS_SYNC();
    bf16_t* orow = O + tok * 1024 + h * 256 + 4 * hh;
#pragma unroll 1
    for (int db = 0; db < 8; ++db) {
        f32x16 o;
#pragma unroll
        for (int r = 0; r < 16; ++r) o[r] = 0.f;
#pragma unroll
        for (int kb = 0; kb < 8; ++kb)
#pragma unroll
            for (int s2 = 0; s2 < 2; ++s2) {
                const LAS char* vp = img + (db * 32 + r32) * XA_PITCH + (32 * kb + 16 * s2 + 4 * hh) * 2;
                const bf16x8 vf = cat8(*(LAS const s16x4*)vp, *(LAS const s16x4*)(vp + 16));
                o = MFMA32(vf, pf[kb][s2], o);
            }
#pragma unroll
        for (int g = 0; g < 4; ++g) { u32x2 w; w.x = cvtpk(o[4 * g] * inv, o[4 * g + 1] * inv); w.y = cvtpk(o[4 * g + 2] * inv, o[4 * g + 3] * inv); *(u32x2*)(orow + 32 * db + 8 * g) = w; }
    }
    LDS_SYNC();
}

DI unsigned key_pack(float v, unsigned tag, unsigned mask) { const unsigned b = __float_as_uint(v); const unsigned mono = b ^ ((unsigned)((int)b >> 31) | 0x80000000u); return (mono & ~mask) | tag; }
DI float key_val(unsigned k, unsigned mask) { const unsigned mono = k & ~mask; const unsigned b = (mono & 0x80000000u) ? (mono ^ 0x80000000u) : ~mono; return __uint_as_float(b); }
#define CE(a, b) do { const unsigned _h = (a) > (b) ? (a) : (b); const unsigned _l = (a) > (b) ? (b) : (a); (a) = _h; (b) = _l; } while (0)
#define SORT16_DESC(v) do { CE(v[0], v[1]); CE(v[2], v[3]); CE(v[0], v[2]); CE(v[1], v[3]); CE(v[1], v[2]); CE(v[4], v[5]); CE(v[6], v[7]); CE(v[4], v[6]); CE(v[5], v[7]); CE(v[5], v[6]); CE(v[0], v[4]); CE(v[2], v[6]); CE(v[2], v[4]); CE(v[1], v[5]); CE(v[3], v[7]); CE(v[3], v[5]); CE(v[1], v[2]); CE(v[3], v[4]); CE(v[5], v[6]); CE(v[8], v[9]); CE(v[10], v[11]); CE(v[8], v[10]); CE(v[9], v[11]); CE(v[9], v[10]); CE(v[12], v[13]); CE(v[14], v[15]); CE(v[12], v[14]); CE(v[13], v[15]); CE(v[13], v[14]); CE(v[8], v[12]); CE(v[10], v[14]); CE(v[10], v[12]); CE(v[9], v[13]); CE(v[11], v[15]); CE(v[11], v[13]); CE(v[9], v[10]); CE(v[11], v[12]); CE(v[13], v[14]); CE(v[0], v[8]); CE(v[4], v[12]); CE(v[4], v[8]); CE(v[2], v[10]); CE(v[6], v[14]); CE(v[6], v[10]); CE(v[2], v[4]); CE(v[6], v[8]); CE(v[10], v[12]); CE(v[1], v[9]); CE(v[5], v[13]); CE(v[5], v[9]); CE(v[3], v[11]); CE(v[7], v[15]); CE(v[7], v[11]); CE(v[3], v[5]); CE(v[7], v[9]); CE(v[11], v[13]); CE(v[1], v[2]); CE(v[3], v[4]); CE(v[5], v[6]); CE(v[7], v[8]); CE(v[9], v[10]); CE(v[11], v[12]); CE(v[13], v[14]); } while (0)
#define BITONIC16_DESC(v) do { CE(v[0], v[8]); CE(v[1], v[9]); CE(v[2], v[10]); CE(v[3], v[11]); CE(v[4], v[12]); CE(v[5], v[13]); CE(v[6], v[14]); CE(v[7], v[15]); CE(v[0], v[4]); CE(v[1], v[5]); CE(v[2], v[6]); CE(v[3], v[7]); CE(v[8], v[12]); CE(v[9], v[13]); CE(v[10], v[14]); CE(v[11], v[15]); CE(v[0], v[2]); CE(v[1], v[3]); CE(v[4], v[6]); CE(v[5], v[7]); CE(v[8], v[10]); CE(v[9], v[11]); CE(v[12], v[14]); CE(v[13], v[15]); CE(v[0], v[1]); CE(v[2], v[3]); CE(v[4], v[5]); CE(v[6], v[7]); CE(v[8], v[9]); CE(v[10], v[11]); CE(v[12], v[13]); CE(v[14], v[15]); } while (0)
#define MERGE_TOP16(T, v) do { _Pragma("unroll") for (int _i = 0; _i < 16; ++_i) T[_i] = T[_i] > v[15 - _i] ? T[_i] : v[15 - _i]; BITONIC16_T(T); } while (0)
DI void bitonic16(unsigned (&v)[16]) { BITONIC16_DESC(v); }
#define BITONIC16_T(T) bitonic16(T)
DI void route_level1(const bf16_t* PQ, const bf16_t* SK  , int tile, int h, int lane, unsigned (&tpk)[2][16]) {
    const int r32 = lane & 31, hh = lane >> 5; const size_t m = (size_t)tile * 32 + r32;
    bf16x8 qfa[2][4];
#pragma unroll
    for (int p = 0; p < 2; ++p)
#pragma unroll
        for (int ks = 0; ks < 4; ++ks) qfa[p][ks] = *(const bf16x8*)(PQ + m * 1024 + h * 128 + p * 64 + 16 * ks + 8 * hh);
    bf16x8 an[4];
#define RT_LOADA(p_, nb_) do { const bf16_t* skp_ = SK + ((size_t)(h * 2 + (p_)) * 128) * 64; _Pragma("unroll") for (int ks_ = 0; ks_ < 4; ++ks_) an[ks_] = *(const bf16x8*)(skp_ + (size_t)((nb_) * 32 + r32) * 64 + 16 * ks_ + 8 * hh); } while (0)
    RT_LOADA(0, 0);
#pragma unroll
    for (int p = 0; p < 2; ++p) {
        unsigned T[16];
#pragma unroll
        for (int i = 0; i < 16; ++i) T[i] = 0u;
#pragma unroll 1
        for (int nb = 0; nb < 4; ++nb) {
            bf16x8 a[4];
#pragma unroll
            for (int ks = 0; ks < 4; ++ks) a[ks] = an[ks];
            if (nb < 3) RT_LOADA(p, nb + 1); else if (p == 0) RT_LOADA(1, 0);
            f32x16 acc;
#pragma unroll
            for (int r = 0; r < 16; ++r) acc[r] = 0.f;
#pragma unroll
            for (int ks = 0; ks < 4; ++ks) acc = MFMA32(a[ks], qfa[p][ks], acc);
            unsigned v[16];
#pragma unroll
            for (int r = 0; r < 16; ++r) v[r] = key_pack(acc[r], (unsigned)(nb * 32 + crow(r, hh)), 127u);
            SORT16_DESC(v);
            MERGE_TOP16(T, v);
        }
        unsigned pv[16];
#pragma unroll
        for (int i = 0; i < 16; ++i) pv[i] = (unsigned)__shfl_xor((int)T[i], 32);
        MERGE_TOP16(T, pv);
#pragma unroll
        for (int i = 0; i < 16; ++i) tpk[p][i] = T[i];
    }
#undef RT_LOADA
}
DI void route_level2(const unsigned (&tpk)[2][16], size_t m, int h, int lane, int* IDX, float* Gw, unsigned* SCL, const LAS unsigned* SCT  , LAS char* scr  ) {
    { u32x4 w0, w1, w2, w3;
#pragma unroll
      for (int q = 0; q < 4; ++q) {
          w0[q] = (tpk[0][4 * q] & 127u) | ((tpk[0][4 * q + 1] & 127u) << 8) | ((tpk[0][4 * q + 2] & 127u) << 16) | ((tpk[0][4 * q + 3] & 127u) << 24);
          w1[q] = (tpk[1][4 * q] & 127u) | ((tpk[1][4 * q + 1] & 127u) << 8) | ((tpk[1][4 * q + 2] & 127u) << 16) | ((tpk[1][4 * q + 3] & 127u) << 24); }
      (void)w2; (void)w3;
      *(LAS u32x4*)(scr + lane * 48) = w0; *(LAS u32x4*)(scr + lane * 48 + 16) = w1; }
    float av[16], bv[16];
#pragma unroll
    for (int i = 0; i < 16; ++i) { av[i] = key_val(tpk[0][i], 127u); bv[i] = key_val(tpk[1][i], 127u); }
    unsigned cv[16];
#pragma unroll
    for (int i = 0; i < 16; ++i) cv[i] = 0u;
#pragma unroll
    for (int i = 0; i < 16; ++i)
#pragma unroll
        for (int jj = 0; jj < 16; ++jj) if ((i + 1) * (jj + 1) <= 16) {
            unsigned x = key_pack(av[i] + bv[jj], (unsigned)(i * 16 + jj), 255u);
#pragma unroll
            for (int pos = (i + 1) * (jj + 1) - 1; pos < 16; ++pos) CE(cv[pos], x);
        }
    const float cmax = key_val(cv[0], 255u);
    float e[16]; float sum = 0.f;
#pragma unroll
    for (int k = 0; k < 16; ++k) { e[k] = fexp2((key_val(cv[k], 255u) - cmax) * LOG2E); sum += e[k]; }
    const float inv = 1.0f / sum;
    int id[16];
#pragma unroll
    for (int k = 0; k < 16; ++k) {
        const unsigned ij = cv[k] & 255u;
        const unsigned n0 = *(LAS const unsigned char*)(scr + lane * 48 + (ij >> 4)), n1 = *(LAS const unsigned char*)(scr + lane * 48 + 16 + (ij & 15u));
        id[k] = (int)(n0 * 128u + n1);
    }
    { int* ip = IDX + m * 128 + h * 16;
#pragma unroll
      for (int k = 0; k < 16; k += 4) *(int4*)(ip + k) = make_int4(id[k], id[k + 1], id[k + 2], id[k + 3]);
      unsigned* sp = SCL + m * 128 + h * 16;
#pragma unroll
      for (int k = 0; k < 16; k += 4) { u32x4 w;
#pragma unroll
          for (int q = 0; q < 4; ++q) w[q] = SCT[id[k + q]];
          *(u32x4*)(sp + k) = w; }
      float* gp = Gw + m * 128 + h * 16;
#pragma unroll
      for (int k = 0; k < 16; k += 4) *(f32x4*)(gp + k) = (f32x4){e[k] * inv, e[k + 1] * inv, e[k + 2] * inv, e[k + 3] * inv}; }
}
DI void route_pair(const bf16_t* PQ, const bf16_t* SK, int* IDX, float* Gw, unsigned* SCL, const LAS unsigned* SCT, int tileA, int h, int lane, LAS char* scr) {
    unsigned tA[2][16], tB[2][16];
    route_level1(PQ, SK, tileA, h, lane, tA);
    route_level1(PQ, SK, tileA + 1, h, lane, tB);
    const bool hi = lane >= 32;
#pragma unroll
    for (int p = 0; p < 2; ++p)
#pragma unroll
        for (int i = 0; i < 16; ++i) tA[p][i] = hi ? tB[p][i] : tA[p][i];
    route_level2(tA, (size_t)(tileA + (hi ? 1 : 0)) * 32 + (lane & 31), h, lane, IDX, Gw, SCL, SCT, scr);
}

#define FP4PAIR(w, bsel) __builtin_amdgcn_cvt_scalef32_pk_f32_fp4((w), 1.0f, (bsel))
typedef __bf16 bf16p_t __attribute__((ext_vector_type(2)));
#define FP4BF(w, bsel) __builtin_amdgcn_cvt_scalef32_pk_bf16_fp4((w), 1.0f, (bsel))
#define DOT2(accf, xw, ub) accf = __builtin_amdgcn_fdot2_f32_bf16(__builtin_bit_cast(bf16p_t, (xw)), (ub), accf, false)
typedef int v8i_t __attribute__((ext_vector_type(8)));
typedef short s16x2_t __attribute__((ext_vector_type(2)));
DI f32x4 mfma_x4u4(const u32x4 a, const u32x4 b, const f32x4 c) {
    const v8i_t aa = {(int)a.x, (int)a.y, (int)a.z, (int)a.w, 0, 0, 0, 0}, bb = {(int)b.x, (int)b.y, (int)b.z, (int)b.w, 0, 0, 0, 0};
    return __builtin_amdgcn_mfma_scale_f32_16x16x128_f8f6f4(aa, bb, c, 4, 4, 0, 0x7F7F7F7F, 0, 0x7F7F7F7F);
}
DI void peer_wave(const Frame& F, const Args& args, bool last, const unsigned char* Ub, const unsigned char* Vb, const unsigned* SCL, const int* IDX, const float* Gw, bf16_t* XB, float* SS) {
    const int lane = F.lane, j16 = lane & 15, kb = lane >> 4;
    LAS unsigned char* xs = F.lds + F.wave * 1536;
    LAS unsigned char* zr = F.lds + NWAVES * 1536;
    { unsigned zz; asm volatile("v_mov_b32 %0, 0" : "=v"(zz)); *(LAS u32x4*)(zr + 16 * lane) = (u32x4){zz, zz, zz, zz}; }
    const LAS unsigned char* xrd = j16 < 3 ? xs + 512 * j16 + 16 * kb : zr;
    constexpr int UPITCH = 528;
    LAS unsigned char* stg = F.lds + 78848 + F.wave * (16 * UPITCH);
    LAS unsigned char* stw = stg + (lane >> 5) * UPITCH + 16 * (lane & 31);
    const LAS unsigned char* strd = stg + j16 * UPITCH + 16 * kb;
    u32x2 A[16], B[16];
    u32x4 UA[8], UB[8];
#define PW_ISSUE(buf, tab, idv, sub) do { _Pragma("unroll") for (int i_ = 0; i_ < 16; ++i_) { const int e_ = __builtin_amdgcn_readlane(idv, (sub) * 16 + i_); buf[i_] = *(const u32x2*)((tab) + (size_t)e_ * 512 + 8 * lane); } } while (0)
#define PU_ISSUE(buf, idv, sub) do { _Pragma("unroll") for (int i_ = 0; i_ < 8; ++i_) { const int e_ = __shfl(idv, (sub) * 16 + 2 * i_ + (lane >> 5)); \
            buf[i_] = *(const u32x4*)(Ub + (size_t)e_ * 512 + 16 * (lane & 31)); } } while (0)
#define PU_DOTS(buf, sub, dreg) do { f32x4 c_ = {0.f, 0.f, 0.f, 0.f}; asm volatile("" ::: "memory"); \
        _Pragma("unroll") for (int i_ = 0; i_ < 8; ++i_) *(LAS u32x4*)(stw + i_ * (2 * UPITCH)) = buf[i_];        \
        _Pragma("unroll") for (int s_ = 0; s_ < 8; ++s_) { const u32x4 xq_ = *(const LAS u32x4*)(xrd + 64 * s_), bq_ = *(const LAS u32x4*)(strd + 64 * s_); c_ = mfma_x4u4(xq_, bq_, c_); } \
        const float dv_ = __shfl(fmaf(c_[2], xs3, fmaf(c_[1], xs2, c_[0] * xs1)), j16); if (kb == (sub)) dreg = dv_; } while (0)
#define PW_ACCUM(buf, cv, sub) do { _Pragma("unroll") for (int i_ = 0; i_ < 16; ++i_) { \
            const float cf_ = __builtin_bit_cast(float, __builtin_amdgcn_readlane(__builtin_bit_cast(int, cv), (sub) * 16 + i_)); const f32x2 cf2_ = {cf_, cf_}; \
            _Pragma("unroll") for (int q_ = 0; q_ < 2; ++q_) { acc[4 * q_] += cf2_ * FP4PAIR(buf[i_][q_], 0); acc[4 * q_ + 1] += cf2_ * FP4PAIR(buf[i_][q_], 1); acc[4 * q_ + 2] += cf2_ * FP4PAIR(buf[i_][q_], 2); acc[4 * q_ + 3] += cf2_ * FP4PAIR(buf[i_][q_], 3); } } } while (0)
    LAS float* cs = (LAS float*)(F.lds + 13312 + F.wave * 8192);
    {
    int m = F.gw;
    u32x4 xa = *(const u32x4*)(XB + (size_t)m * 1024 + 16 * lane), xb = *(const u32x4*)(XB + (size_t)m * 1024 + 16 * lane + 8);
    int id0 = IDX[(size_t)m * 128 + lane], id1 = IDX[(size_t)m * 128 + 64 + lane];
    float g0 = Gw[(size_t)m * 128 + lane], g1 = Gw[(size_t)m * 128 + 64 + lane];
    unsigned sc0 = SCL[(size_t)m * 128 + lane], sc1 = SCL[(size_t)m * 128 + 64 + lane];
    float ssl = lane < 16 ? SS[(size_t)m * 16 + lane] : 0.f;
    PU_ISSUE(UA, id0, 0);
    int it = 0;
#pragma unroll 1
    for (; m < MTOK; m += F.NGW, ++it) {
        unsigned xp[8];
#pragma unroll
        for (int i = 0; i < 4; ++i) { xp[i] = xa[i]; xp[4 + i] = xb[i]; }
        PU_ISSUE(UB, id0, 1);
        const int mn = m + F.NGW < MTOK ? m + F.NGW : m;
        const u32x4 nxa = *(const u32x4*)(XB + (size_t)mn * 1024 + 16 * lane), nxb = *(const u32x4*)(XB + (size_t)mn * 1024 + 16 * lane + 8);
        const int nid0 = IDX[(size_t)mn * 128 + lane], nid1 = IDX[(size_t)mn * 128 + 64 + lane];
        const float ng0 = Gw[(size_t)mn * 128 + lane], ng1 = Gw[(size_t)mn * 128 + 64 + lane];
        const unsigned nsc0 = SCL[(size_t)mn * 128 + lane], nsc1 = SCL[(size_t)mn * 128 + 64 + lane];
        const float nssl = lane < 16 ? SS[(size_t)mn * 16 + lane] : 0.f;
        float xs1, xs2, xs3;
        {
          float xr_[16]; float am = 0.f;
#pragma unroll
          for (int i = 0; i < 8; ++i) { xr_[2 * i] = bflo(xp[i]); xr_[2 * i + 1] = bfhi(xp[i]); am = fmaxf(am, fmaxf(fabsf(xr_[2 * i]), fabsf(xr_[2 * i + 1]))); }
          am = wave_max(am);
          int eb = (int)((__builtin_bit_cast(unsigned, am) >> 23) & 0xFFu); eb = eb < 40 ? 40 : eb;
          xs1 = __builtin_bit_cast(float, (unsigned)(eb - 1) << 23); xs2 = xs1 * 0.25f; xs3 = xs1 * 0.03125f;
#pragma unroll
          for (int t = 0; t < 3; ++t) {
              const float sc_ = t == 0 ? xs1 : t == 1 ? xs2 : xs3;
              u32x2 w;
#pragma unroll
              for (int hw = 0; hw < 2; ++hw) {
                  unsigned ww = 0;
                  ww = __builtin_amdgcn_cvt_scalef32_pk_fp4_f32(ww, xr_[8 * hw + 0], xr_[8 * hw + 1], sc_, 0); ww = __builtin_amdgcn_cvt_scalef32_pk_fp4_f32(ww, xr_[8 * hw + 2], xr_[8 * hw + 3], sc_, 1);
                  ww = __builtin_amdgcn_cvt_scalef32_pk_fp4_f32(ww, xr_[8 * hw + 4], xr_[8 * hw + 5], sc_, 2); ww = __builtin_amdgcn_cvt_scalef32_pk_fp4_f32(ww, xr_[8 * hw + 6], xr_[8 * hw + 7], sc_, 3);
                  w[hw] = ww;
                  if (t < 2) {
                      const f32x2 q0 = __builtin_amdgcn_cvt_scalef32_pk_f32_fp4(ww, sc_, 0), q1 = __builtin_amdgcn_cvt_scalef32_pk_f32_fp4(ww, sc_, 1), q2 = __builtin_amdgcn_cvt_scalef32_pk_f32_fp4(ww, sc_, 2), q3 = __builtin_amdgcn_cvt_scalef32_pk_f32_fp4(ww, sc_, 3);
                      xr_[8 * hw + 0] -= q0.x; xr_[8 * hw + 1] -= q0.y; xr_[8 * hw + 2] -= q1.x; xr_[8 * hw + 3] -= q1.y; xr_[8 * hw + 4] -= q2.x; xr_[8 * hw + 5] -= q2.y; xr_[8 * hw + 6] -= q3.x; xr_[8 * hw + 7] -= q3.y;
                  }
              }
              *(LAS u32x2*)(xs + 512 * t + 8 * lane) = w;
          }
        }
        const float rstd = 1.0f / sqrtf(wave_sum(ssl) * (1.0f / 1024.0f) + EPS);
        float d0 = 0.f, d1 = 0.f;
        PU_DOTS(UA, 0, d0); PU_ISSUE(UA, id0, 2);
        PU_DOTS(UB, 1, d0); PU_ISSUE(UB, id0, 3);
        PU_DOTS(UA, 2, d0); PU_ISSUE(UA, id1, 0);
        PU_DOTS(UB, 3, d0); PU_ISSUE(UB, id1, 1);
        PU_DOTS(UA, 0, d1); PU_ISSUE(UA, id1, 2);
        PU_DOTS(UB, 1, d1); PU_ISSUE(UB, id1, 3);
        PU_DOTS(UA, 2, d1); PU_ISSUE(UA, nid0, 0);
        PU_DOTS(UB, 3, d1);
        const float c0 = g0 * gelu_tanh(d0 * (bflo(sc0) * rstd)) * bfhi(sc0), c1 = g1 * gelu_tanh(d1 * (bflo(sc1) * rstd)) * bfhi(sc1);
        cs[it * 128 + lane] = c0; cs[it * 128 + 64 + lane] = c1;
        xa = nxa; xb = nxb; id0 = nid0; id1 = nid1; g0 = ng0; g1 = ng1; sc0 = nsc0; sc1 = nsc1; ssl = nssl;
    }
    }
    {
    int m = F.gw;
    u32x4 xa = *(const u32x4*)(XB + (size_t)m * 1024 + 16 * lane), xb = *(const u32x4*)(XB + (size_t)m * 1024 + 16 * lane + 8);
    int id0 = IDX[(size_t)m * 128 + lane], id1 = IDX[(size_t)m * 128 + 64 + lane];
    PW_ISSUE(A, Vb, id0, 0);
    int it = 0;
#pragma unroll 1
    for (; m < MTOK; m += F.NGW, ++it) {
        unsigned xp[8];
#pragma unroll
        for (int i = 0; i < 4; ++i) { xp[i] = xa[i]; xp[4 + i] = xb[i]; }
        const float c0 = cs[it * 128 + lane], c1 = cs[it * 128 + 64 + lane];
        const int mn = m + F.NGW < MTOK ? m + F.NGW : m;
        const u32x4 nxa = *(const u32x4*)(XB + (size_t)mn * 1024 + 16 * lane), nxb = *(const u32x4*)(XB + (size_t)mn * 1024 + 16 * lane + 8);
        const int nid0 = IDX[(size_t)mn * 128 + lane], nid1 = IDX[(size_t)mn * 128 + 64 + lane];
        f32x2 acc[8];
#pragma unroll
        for (int q = 0; q < 8; ++q) acc[q] = (f32x2){0.f, 0.f};
        PW_ISSUE(B, Vb, id0, 1); PW_ACCUM(A, c0, 0);
        PW_ISSUE(A, Vb, id0, 2); PW_ACCUM(B, c0, 1);
        PW_ISSUE(B, Vb, id0, 3); PW_ACCUM(A, c0, 2);
        PW_ISSUE(A, Vb, id1, 0); PW_ACCUM(B, c0, 3);
        PW_ISSUE(B, Vb, id1, 1); PW_ACCUM(A, c1, 0);
        PW_ISSUE(A, Vb, id1, 2); PW_ACCUM(B, c1, 1);
        PW_ISSUE(B, Vb, id1, 3); PW_ACCUM(A, c1, 2);
        PW_ISSUE(A, Vb, nid0, 0); PW_ACCUM(B, c1, 3);
        float xo[16]; float s = 0.f;
#pragma unroll
        for (int q = 0; q < 8; ++q) { xo[2 * q] = bflo(xp[q]) + acc[q].x; xo[2 * q + 1] = bfhi(xp[q]) + acc[q].y; }
        if (!last) {
            u32x4 w0, w1;
#pragma unroll
            for (int q = 0; q < 4; ++q) { w0[q] = cvtpk(xo[2 * q], xo[2 * q + 1]); w1[q] = cvtpk(xo[8 + 2 * q], xo[8 + 2 * q + 1]);
                s += (bflo(w0[q]) * bflo(w0[q]) + bfhi(w0[q]) * bfhi(w0[q])) + (bflo(w1[q]) * bflo(w1[q]) + bfhi(w1[q]) * bfhi(w1[q])); }
            s = wave_sum(s);
            *(u32x4*)(XB + (size_t)m * 1024 + 16 * lane) = w0; *(u32x4*)(XB + (size_t)m * 1024 + 16 * lane + 8) = w1;
            if (lane < 16) SS[(size_t)m * 16 + lane] = lane == 0 ? s : 0.f;
        } else {
#pragma unroll
            for (int q = 0; q < 16; ++q) s += xo[q] * xo[q];
            s = wave_sum(s);
            const float rf = 1.0f / sqrtf(s * (1.0f / 1024.0f) + EPS); const float* fg = INP(I_FINAL_G) + 16 * lane; float* xr = F.X + (size_t)m * 1024 + 16 * lane;
#pragma unroll
            for (int q = 0; q < 4; ++q) { const f32x4 gq = *(const f32x4*)(fg + 4 * q); *(f32x4*)(xr + 4 * q) = (f32x4){xo[4 * q], xo[4 * q + 1], xo[4 * q + 2], xo[4 * q + 3]} * rf * gq; }
        }
        xa = nxa; xb = nxb; id0 = nid0; id1 = nid1;
    }
    }
#undef PW_ISSUE
#undef PU_ISSUE
#undef PU_DOTS
#undef PW_ACCUM
}

constexpr int PPL = 7;
constexpr int NPHASE = 1 + DEPTH * PPL;
__global__ void __launch_bounds__(NTHR, 2) trunk_fwd(Args args) {
    extern __shared__ __attribute__((aligned(16))) unsigned char lds_raw[];
    Frame F;
    F.lds = (LAS unsigned char*)lds_raw;
    F.tid = threadIdx.x; F.lane = F.tid & 63; F.wave = __builtin_amdgcn_readfirstlane(F.tid >> 6);
    F.bx = blockIdx.x; F.gw = F.bx * NWAVES + F.wave;
    F.X = args.out; F.ws = args.ws;
    const int lo = args.ph_lo, hi = args.ph_hi;
#if MK_ONE_LAUNCH
    volatile LAS unsigned* bst = (volatile LAS unsigned*)(F.lds + LDS_BYTES - 64);
    if (F.tid < 16) bst[F.tid] = 0u;
    __syncthreads();
    const XcdBarrier gbar = xcd_barrier_post((unsigned*)(args.ws + WS_CTL) + 4096, bst);
    cg::this_grid().sync();
#endif
#define REFRESH() int t_ = threadIdx.x; asm volatile("" : "+v"(t_)); F.tid = t_; F.lane = t_ & 63; F.wave = __builtin_amdgcn_readfirstlane(t_ >> 6); \
    F.gw = F.bx * NWAVES + F.wave; size_t z_ = 0; asm volatile("" : "+s"(z_)); unsigned char* ws = args.ws + z_; F.ws = ws; \
    bf16_t* XB = (bf16_t*)(ws + WS_XB); float* SS = (float*)(ws + WS_SS); bf16_t* YC = (bf16_t*)(ws + WS_YCAT); bf16_t* PROJ = (bf16_t*)(ws + WS_PROJ); \
    bf16_t* CQ = PROJ; bf16_t* PP = (bf16_t*)(ws + WS_PROJ + 64 * MiB); int* IDX = (int*)(ws + WS_PROJ + 64 * MiB); float* GW = (float*)(ws + WS_PROJ + 80 * MiB); \
    bf16_t* Wl = (bf16_t*)(ws + WS_W + l * W_LAYER); bf16_t* Kl = (bf16_t*)(ws + WS_KMEM + (size_t)l * 16 * MiB); bf16_t* VTl = Kl + (size_t)4096 * 1024; \
    (void)XB; (void)SS; (void)YC; (void)PROJ; (void)CQ; (void)PP; (void)IDX; (void)GW; (void)Wl; (void)Kl; (void)VTl;
#pragma unroll 1
    for (int ph = lo; ph < hi; ++ph) {
        const int l = ph == 0 ? 0 : (ph - 1) / PPL, k = ph == 0 ? -1 : (ph - 1) % PPL;
        for (int rep = 0; rep < ((k == PROBE_REP_K) ? 2 : 1); ++rep) {
        if (rep) { WG_SYNC(); xcd_barrier(gbar); }
        switch (k) {
        case -1: if (EN(0)) { REFRESH(); p0_prologue(F, args); } break;
        case 0: case 3: case 5: if (EN(1)) {
            REFRESH();
            if (k == 0 && l == 0) {
#pragma unroll 1
                for (int l2 = 0; l2 < DEPTH; ++l2) {
                    bf16_t* W2 = (bf16_t*)(ws + WS_W + l2 * W_LAYER); bf16_t* K2 = (bf16_t*)(ws + WS_KMEM + (size_t)l2 * 16 * MiB);
                    pg8::Gemm g{(const bf16_t*)(ws + WS_MEMB), W2 + W_CKV / 2, 1024, 1024, 1024}; pg8::StaticOrder S; S.init(MMEM, 2048, F.G, (F.bx + 128 * l2) % F.G, 1024, 1024);
                    pg8::EpiKV E{K2, K2 + (size_t)4096 * 1024, (const float*)(ws + WS_RSTDM)};
                    pg8::gemm_phase<pg8::EpiKV, pg8::StaticOrder, true>(F.lds, g, S, E);
                }
            }
            const bf16_t* Bt = Wl + (k == 0 ? W_IN : k == 3 ? W_CQ : W_PQ) / 2; const int N = k == 0 ? NPROJ : 1024, ldc = k == 0 ? LDP : 1024;
            pg8::Gemm g{XB, Bt, 1024, 1024, 1024}; pg8::StaticOrder S; S.init(MTOK, N, F.G, F.bx, 1024, 1024);
            pg8::EpiBf16 E{k == 0 ? PROJ : CQ, ldc, SS, k == 3 ? 0.0625f * LOG2E : 1.0f, ldc};
            pg8::gemm_phase<pg8::EpiBf16, pg8::StaticOrder, true>(F.lds, g, S, E);
            if (k == 3) {
                pg8::Unit u;
                for (int i = 0; S.next(i, u); ++i) xattn_unit(F, CQ, Kl, VTl, YC, u.pm, u.pn);
            } else if (k == 5) {
                const bf16_t* SK = (const bf16_t*)(ws + WS_SUBK) + (size_t)l * 8 * 2 * 128 * 64;
                LAS unsigned* SCT = (LAS unsigned*)(F.lds + 65536);
                { const u32x4* src = (const u32x4*)(ws + WS_TAB + 32 * MiB + (size_t)l * 65536);
                  for (int i = F.tid; i < 4096; i += NTHR) *(LAS u32x4*)((LAS char*)SCT + 16 * i) = src[i];
                  LDS_SYNC(); }
                LAS char* scr = (LAS char*)F.lds + F.wave * 8192;
                pg8::Unit u;
                for (int i = 0; S.next(i, u); ++i)
                    route_pair(CQ, SK, IDX, GW, (unsigned*)(ws + WS_PROJ + 96 * MiB), SCT, u.pm * 8 + 2 * (F.wave & 3), 2 * u.pn + (F.wave >> 2), F.lane, scr);
            }
        } break;
        case 1: {
            REFRESH();
            if (F.bx < 64) { if (EN(2)) gla_chain(F, args, l, F.bx >> 2, F.bx & 3, PROJ, YC); }
            else {
                if (l == 0) {
                    const int wv = (F.bx - 64) * NWAVES + F.wave, nwv = (F.G - 64) * NWAVES;
                    transpose_list(F, args, (LAS float*)(F.lds + F.wave * 16384), wv, nwv, 1);
                    convert_tables(F, args, 0, wv, nwv); convert_tables(F, args, 1, wv, nwv);
                    WG_SYNC();
                }
                if (EN(3)) { for (int u = F.bx - 64; u < 256; u += F.G - 64) sgu_unit(F, args, l, u >> 4, u & 15, PROJ, YC); }
            }
            if (EN(4)) { LAS char* vl = (LAS char*)F.lds + F.wave * 8192; unsigned* ctr = (unsigned*)(ws + WS_CTL) + 15360 + 64 * l;
                for (;;) { int u0 = 0; if (F.lane == 0) u0 = (int)atomicAdd(ctr, 2u); u0 = __builtin_amdgcn_readfirstlane(u0); if (u0 >= BATCH * 8 * 32) break;
                    for (int u = u0; u < u0 + 2; ++u) sb_unit2(PROJ, YC, u >> 8, (u >> 5) & 7, u & 31, vl, F.lane); } }
        } break;
        case 2: case 4: if (EN(5)) {
            REFRESH();
            pg8::Gemm g{YC, Wl + (k == 2 ? W_OUT : W_CO) / 2, 1024, 1024, 1024}; pg8::StaticOrder S; S.init(MTOK, 1024, F.G, F.bx, 1024, 1024);
            pg8::EpiResid E{XB, SS};
            pg8::gemm_phase<pg8::EpiResid, pg8::StaticOrder, true>(F.lds, g, S, E);
        } break;
        default: if (EN(12)) {
            REFRESH();
            const unsigned char* Ub = ws + WS_TAB + (size_t)l * 16 * MiB; const unsigned char* Vb = Ub + 8 * MiB;
            peer_wave(F, args, l == DEPTH - 1, Ub, Vb, (const unsigned*)(ws + WS_PROJ + 96 * MiB), IDX, GW, XB, SS);
        } break;
        }
        }
        WG_SYNC();
#if MK_ONE_LAUNCH
        if (ph + 1 < hi) xcd_barrier(gbar);
#endif
    }
#undef REFRESH
}

extern "C" void kernel_launch(void* const* d_in, const int* in_sizes, int n_in, void* d_out, int out_size, void* d_ws, size_t ws_size, hipStream_t stream) {
    static int grid = 0;
    if (grid == 0) {
        if (n_in != 22 || out_size != MTOK * DM || ws_size < WS_END) { fprintf(stderr, "kernel_launch: unexpected problem (n_in %d out %d ws %zu)\n", n_in, out_size, ws_size); grid = -1; return; }
        int dev = 0, cus = 0, per_cu = 0;
        if (hipGetDevice(&dev) != hipSuccess || hipDeviceGetAttribute(&cus, hipDeviceAttributeMultiprocessorCount, dev) != hipSuccess) { grid = -1; return; }
        if (hipFuncSetAttribute((const void*)trunk_fwd, hipFuncAttributeMaxDynamicSharedMemorySize, LDS_BYTES) != hipSuccess) { fprintf(stderr, "kernel_launch: hipFuncSetAttribute failed\n"); grid = -1; return; }
        if (hipOccupancyMaxActiveBlocksPerMultiprocessor(&per_cu, (const void*)trunk_fwd, NTHR, LDS_BYTES) != hipSuccess || per_cu < 1) { fprintf(stderr, "kernel_launch: occupancy query says %d\n", per_cu); (void)hipGetLastError(); grid = -1; return; }
        if (cus * per_cu < GRID) { fprintf(stderr, "kernel_launch: built for a %d-workgroup resident grid, this device holds %d\n", GRID, cus * per_cu); grid = -1; return; }
        grid = GRID;
    }
    if (grid < 0) return;
    Args a{};
    for (int i = 0; i < 22; ++i) a.in[i] = (const float*)d_in[i];
    a.out = (float*)d_out; a.ws = (unsigned char*)d_ws;
#if MK_ONE_LAUNCH
    if (hipMemsetAsync((char*)d_ws + WS_CTL, 0, 65536, stream) != hipSuccess) { fprintf(stderr, "kernel_launch: memset of the control words failed\n"); return; }
    a.ph_lo = 0; a.ph_hi = NPHASE;
    void* kargs[] = {&a};
    hipError_t e = hipLaunchCooperativeKernel((const void*)trunk_fwd, dim3(grid), dim3(NTHR), kargs, LDS_BYTES, stream);
    if (e != hipSuccess) fprintf(stderr, "cooperative launch failed: %s (grid %d)\n", hipGetErrorString(e), grid);
#else
    for (int p = 0; p < NPHASE; ++p) { a.ph_lo = p; a.ph_hi = p + 1; hipLaunchKernelGGL(trunk_fwd, dim3(grid), dim3(NTHR), LDS_BYTES, stream, a); }
#endif
}
```

```cpp
#include <hip/hip_runtime.h>
#include <hip/hip_cooperative_groups.h>
#include <cstdio>
#include <cstdint>
#include <cmath>
namespace cg = cooperative_groups;

#ifndef PHMASK
#define PHMASK 0xFFFF
#endif
#define EN(n) (((PHMASK) >> (n)) & 1)
#ifndef PROBE_REP_K
#define PROBE_REP_K (-2)
#endif
#ifndef MK_ONE_LAUNCH
#define MK_ONE_LAUNCH 1
#endif

#define LAS __attribute__((address_space(3)))
typedef unsigned short bf16_t;
typedef short bf16x8 __attribute__((ext_vector_type(8)));
typedef short s16x4 __attribute__((ext_vector_type(4)));
typedef short v4i16_t __attribute__((ext_vector_type(4)));
typedef float f32x4 __attribute__((ext_vector_type(4)));
typedef float f32x2 __attribute__((ext_vector_type(2)));
typedef float f32x16 __attribute__((ext_vector_type(16)));
typedef unsigned u32x4 __attribute__((ext_vector_type(4)));
typedef unsigned u32x2 __attribute__((ext_vector_type(2)));
typedef __bf16 bf16x2_t __attribute__((ext_vector_type(2)));
#define DI __device__ __forceinline__
#define MFMA32(a, b, c) __builtin_amdgcn_mfma_f32_32x32x16_bf16((a), (b), (c), 0, 0, 0)

constexpr int BATCH = 16, SEQ = 2048, DM = 1024, MTOK = BATCH * SEQ, DEPTH = 2;
constexpr int NMEM = 256, MMEM = BATCH * NMEM;
constexpr int INW = 2832, LDP = 2944, NPROJ = 3072;
constexpr int C_SBQ = 0, C_SBK = 512, C_SBV = 1024, C_SGU = 1536, C_SGV = 1792, C_GQ = 2048, C_GK = 2176, C_GV = 2304, C_GO = 2560, C_GA = 2816;
constexpr float EPS = 1e-6f;
constexpr float LOG2E = 1.4426950408889634f;

constexpr size_t MiB = 1u << 20;
constexpr size_t WS_CTL = 0;
constexpr size_t WS_SUBK = 1 * MiB;
constexpr size_t WS_WSP = WS_SUBK + 512 * 1024;
constexpr size_t WS_RSTDM = WS_WSP + 256 * 1024;
constexpr size_t WS_SS = 2 * MiB;
constexpr size_t WS_W = 8 * MiB;
constexpr size_t W_IN = 0, W_OUT = 6 * MiB, W_CQ = 8 * MiB, W_CKV = 10 * MiB, W_CO = 14 * MiB, W_PQ = 16 * MiB, W_LAYER = 18 * MiB;
constexpr size_t WS_MEMB = 44 * MiB;
constexpr size_t WS_KMEM = 52 * MiB;
constexpr size_t WS_TAB = 84 * MiB;
constexpr size_t WS_XB = 148 * MiB;
constexpr size_t WS_YCAT = 212 * MiB;
constexpr size_t WS_PROJ = 276 * MiB;
constexpr size_t WS_GKV = 460 * MiB;
constexpr size_t WS_GD = 468 * MiB;
constexpr size_t WS_END = 469 * MiB;

DI unsigned cvtpk(float lo, float hi) { f32x2 v = {lo, hi}; bf16x2_t b = __builtin_convertvector(v, bf16x2_t); return __builtin_bit_cast(unsigned, b); }
DI bf16_t cvt1(float v) { return (bf16_t)(cvtpk(v, 0.f) & 0xffffu); }
DI float bf2f(unsigned short b) { return __uint_as_float((unsigned)b << 16); }
DI float bflo(unsigned w) { return __uint_as_float(w << 16); }
DI float bfhi(unsigned w) { return __uint_as_float(w & 0xffff0000u); }
DI int crow(int r, int hi) { return (r & 3) + 8 * (r >> 2) + 4 * hi; }
DI float fexp2(float x) { return __builtin_amdgcn_exp2f(x); }
DI float flog2(float x) { return __builtin_amdgcn_logf(x); }
DI float frcp(float x) { return __builtin_amdgcn_rcpf(x); }
DI float gelu_tanh(float x) { const float y2 = x * (1.5957691216057308f + 0.0713548162726009f * x * x); return x * frcp(1.f + fexp2(-y2 * LOG2E)); }
DI float silu(float x) { return x * frcp(1.f + fexp2(-x * LOG2E)); }
DI float wave_sum(float v) {
#pragma unroll
    for (int o = 1; o < 64; o <<= 1) v += __shfl_xor(v, o);
    return v;
}
DI s16x4 vtr(LAS const char* p) { return __builtin_bit_cast(s16x4, __builtin_amdgcn_ds_read_tr16_b64_v4i16((LAS v4i16_t*)p)); }
DI bf16x8 cat8(s16x4 lo, s16x4 hi) { return __builtin_shufflevector(lo, hi, 0, 1, 2, 3, 4, 5, 6, 7); }
DI bf16x8 pack8(float a0, float a1, float a2, float a3, float a4, float a5, float a6, float a7) {
    u32x4 p; p[0] = cvtpk(a0, a1); p[1] = cvtpk(a2, a3); p[2] = cvtpk(a4, a5); p[3] = cvtpk(a6, a7); return __builtin_bit_cast(bf16x8, p);
}
#define LDS_WAIT() asm volatile("s_waitcnt lgkmcnt(0)" ::: "memory")
#define LDS_SYNC() do { asm volatile("s_waitcnt lgkmcnt(0)" ::: "memory"); __builtin_amdgcn_s_barrier(); asm volatile("" ::: "memory"); } while (0)
#define WG_SYNC() do { asm volatile("s_waitcnt vmcnt(0) lgkmcnt(0)" ::: "memory"); __builtin_amdgcn_s_barrier(); asm volatile("" ::: "memory"); } while (0)

namespace pg8 {
constexpr int BM = 256, BK = 64, HALF = 128, HTB = HALF * BK * 2, STAGE_BYTES = 8 * HTB, NXCD = 8, WGM = 8;
__host__ __device__ __forceinline__ int lds_byte(int r, int c) { const int st = (r >> 4) * 2 + (c >> 5), rr = r & 15, cc = c & 31, ob = rr * 64 + cc * 2; return st * 1024 + (ob ^ (((ob >> 9) & 1) << 5)); }
__host__ __device__ __forceinline__ void stage_rc(int b, int& R, int& C) { const int st = b / 1024, sb = b % 1024, swz = sb ^ (((sb >> 9) & 1) << 5); R = (st >> 1) * 16 + swz / 64; C = (st & 1) * 32 + (swz % 64) / 2; }
__host__ __device__ __forceinline__ int perm32(int rho) { const int n = rho >> 4, i = rho & 15; return 8 * (i >> 2) + 4 * n + (i & 3); }

struct Unit { int pm, pn; size_t aoff, boff; };
struct Gemm { const bf16_t* A; const bf16_t* Bt; int lda, ldb, K; };

struct StaticOrder {
    int nM, nN, nwg, G, c, lda, ldb;
    __device__ void init(int M, int N, int G_, int c_, int lda_, int ldb_) { nM = M / BM; nN = N / BM; nwg = nM * nN; G = G_; c = c_; lda = lda_; ldb = ldb_; }
    __device__ bool next(int i, Unit& u) const {
        const long L = (long)i * G + c; if (L >= nwg) return false;
        int wgid = (int)L; { const int q = nwg / NXCD, r = nwg % NXCD, xcd = wgid % NXCD, off = wgid / NXCD; wgid = (xcd < r ? xcd * (q + 1) : r * (q + 1) + (xcd - r) * q) + off; }
        const int nig = WGM * nN, gid = wgid / nig, fm = gid * WGM, gsz = (nM - fm) < WGM ? (nM - fm) : WGM;
        u.pm = fm + ((wgid % nig) % gsz); u.pn = (wgid % nig) / gsz;
        u.aoff = (size_t)u.pm * BM * lda; u.boff = (size_t)u.pn * BM * ldb; return true;
    }
};
struct XOrder {
    int G, c, mode;
    __device__ bool next(int i, Unit& u) const {
        const int L = i * G + c; if (L >= 512) return false;
        u.pm = L >> 2; u.pn = L & 3; const int b = u.pm >> 3;
        u.aoff = (size_t)u.pm * 256 * 1024 + u.pn * 256;
        u.boff = mode == 0 ? (size_t)b * 256 * 1024 + u.pn * 256 : (size_t)(b * 4 + u.pn) * 256 * 256;
        return true;
    }
};

struct XOrder2 {
    StaticOrder S; int mode;
    __device__ bool next(int i, Unit& u) const {
        if (!S.next(i, u)) return false; const int b = u.pm >> 3;
        u.aoff = (size_t)u.pm * 256 * 1024 + u.pn * 256;
        u.boff = mode == 0 ? (size_t)b * 256 * 1024 + u.pn * 256 : (size_t)(b * 4 + u.pn) * 256 * 256;
        return true;
    }
};

DI float row_rstd_from_ss(const float* ss, int row, int fq) {
    const f32x4 v = *(const f32x4*)(ss + (size_t)row * 16 + 4 * fq);
    float s = (v[0] + v[1]) + (v[2] + v[3]); s += __shfl_xor(s, 16); s += __shfl_xor(s, 32);
    return 1.0f / sqrtf(s * (1.0f / 1024.0f) + EPS);
}
struct EpiBf16 {
    static constexpr bool PERM = true;
    bf16_t* O; int ldc; const float* ss; float cscale; int ncols;
    DI void operator()(f32x4 (&acc)[2][2][4][2], const Unit& u, int wr, int wc, int fr, int fq) const {
        const int row0 = u.pm * BM + wr * 64 + fr, col0 = u.pn * BM + wc * 32 + 8 * fq;
#pragma unroll
        for (int ai = 0; ai < 2; ++ai)
#pragma unroll
            for (int m = 0; m < 4; ++m) {
                const int row = row0 + ai * HALF + m * 16;
                float rs = cscale; if (ss) rs *= row_rstd_from_ss(ss, row, fq);
                bf16_t* rowp = O + (size_t)row * ldc + col0;
#pragma unroll
                for (int bj = 0; bj < 2; ++bj) if (col0 + bj * HALF < ncols) {
                    const f32x4 v0 = acc[ai][bj][m][0] * rs, v1 = acc[ai][bj][m][1] * rs;
                    u32x4 w; w.x = cvtpk(v0[0], v0[1]); w.y = cvtpk(v0[2], v0[3]); w.z = cvtpk(v1[0], v1[1]); w.w = cvtpk(v1[2], v1[3]);
                    *(u32x4*)(rowp + bj * HALF) = w; }
            }
    }
};
struct EpiKV {
    static constexpr bool PERM = true;
    bf16_t* Kd; bf16_t* VT; const float* rvec;
    DI void operator()(f32x4 (&acc)[2][2][4][2], const Unit& u, int wr, int wc, int fr, int fq) const {
        const int row0 = u.pm * BM + wr * 64 + fr;
#pragma unroll
        for (int ai = 0; ai < 2; ++ai)
#pragma unroll
            for (int m = 0; m < 4; ++m) {
                const int row = row0 + ai * HALF + m * 16; const float rs = rvec[row];
#pragma unroll
                for (int bj = 0; bj < 2; ++bj) {
                    const f32x4 v0 = acc[ai][bj][m][0] * rs, v1 = acc[ai][bj][m][1] * rs;
                    const unsigned w0 = cvtpk(v0[0], v0[1]), w1 = cvtpk(v0[2], v0[3]), w2 = cvtpk(v1[0], v1[1]), w3 = cvtpk(v1[2], v1[3]);
                    if (u.pn < 4) {
                        u32x4 w; w.x = w0; w.y = w1; w.z = w2; w.w = w3;
                        *(u32x4*)(Kd + (size_t)row * 1024 + u.pn * BM + bj * HALF + wc * 32 + 8 * fq) = w;
                    } else {
                        const int key = row & 255, dv0 = bj * HALF + wc * 32 + 8 * fq;
                        bf16_t* p = VT + ((size_t)(u.pm * 4 + (u.pn - 4)) * 256 + dv0) * 256 + key;
                        p[0 * 256] = (bf16_t)w0; p[1 * 256] = (bf16_t)(w0 >> 16); p[2 * 256] = (bf16_t)w1; p[3 * 256] = (bf16_t)(w1 >> 16);
                        p[4 * 256] = (bf16_t)w2; p[5 * 256] = (bf16_t)(w2 >> 16); p[6 * 256] = (bf16_t)w3; p[7 * 256] = (bf16_t)(w3 >> 16);
                    }
                }
            }
    }
};
struct EpiResid {
    static constexpr bool PERM = true;
    bf16_t* XB; float* ss;
    DI void operator()(f32x4 (&acc)[2][2][4][2], const Unit& u, int wr, int wc, int fr, int fq) const {
        const int row0 = u.pm * BM + wr * 64 + fr, col0 = u.pn * BM + wc * 32 + 8 * fq;
#pragma unroll
        for (int ai = 0; ai < 2; ++ai)
#pragma unroll
            for (int m = 0; m < 4; ++m) {
                const int row = row0 + ai * HALF + m * 16; float s = 0.f;
#pragma unroll
                for (int bj = 0; bj < 2; ++bj) {
                    const size_t off = (size_t)row * 1024 + col0 + bj * HALF;
                    const u32x4 o = *(const u32x4*)(XB + off); const f32x4 a0 = acc[ai][bj][m][0], a1 = acc[ai][bj][m][1];
                    u32x4 w; w.x = cvtpk(bflo(o.x) + a0[0], bfhi(o.x) + a0[1]); w.y = cvtpk(bflo(o.y) + a0[2], bfhi(o.y) + a0[3]);
                    w.z = cvtpk(bflo(o.z) + a1[0], bfhi(o.z) + a1[1]); w.w = cvtpk(bflo(o.w) + a1[2], bfhi(o.w) + a1[3]);
                    *(u32x4*)(XB + off) = w;
#pragma unroll
                    for (int q = 0; q < 4; ++q) { const float x0 = bflo(w[q]), x1 = bfhi(w[q]); s += x0 * x0 + x1 * x1; }
                }
                s += __shfl_xor(s, 16); s += __shfl_xor(s, 32);
                if (fq == 0) ss[(size_t)row * 16 + u.pn * 4 + wc] = s;
            }
    }
};
struct EpiSoftmax {
    static constexpr bool PERM = true;
    bf16_t* P; LAS float* xm; LAS float* xs;
    DI void operator()(f32x4 (&acc)[2][2][4][2], const Unit& u, int wr, int wc, int fr, int fq) const {
#pragma unroll
        for (int ai = 0; ai < 2; ++ai)
#pragma unroll
            for (int m = 0; m < 4; ++m) {
                float v = -INFINITY;
#pragma unroll
                for (int bj = 0; bj < 2; ++bj)
#pragma unroll
                    for (int n = 0; n < 2; ++n) { const f32x4 x = acc[ai][bj][m][n]; v = fmaxf(v, fmaxf(fmaxf(x[0], x[1]), fmaxf(x[2], x[3]))); }
                v = fmaxf(v, __shfl_xor(v, 16)); v = fmaxf(v, __shfl_xor(v, 32));
                if (fq == 0) xm[(ai * HALF + wr * 64 + m * 16 + fr) * 4 + wc] = v;
            }
        LDS_WAIT(); __builtin_amdgcn_s_barrier(); asm volatile("" ::: "memory");
#pragma unroll
        for (int ai = 0; ai < 2; ++ai)
#pragma unroll
            for (int m = 0; m < 4; ++m) {
                const f32x4 q = *(LAS const f32x4*)(xm + (ai * HALF + wr * 64 + m * 16 + fr) * 4);
                const float g = fmaxf(fmaxf(q[0], q[1]), fmaxf(q[2], q[3])); float s = 0.f;
#pragma unroll
                for (int bj = 0; bj < 2; ++bj)
#pragma unroll
                    for (int n = 0; n < 2; ++n) { f32x4 x = acc[ai][bj][m][n]; x[0] = fexp2(x[0] - g); x[1] = fexp2(x[1] - g); x[2] = fexp2(x[2] - g); x[3] = fexp2(x[3] - g); acc[ai][bj][m][n] = x; s += (x[0] + x[1]) + (x[2] + x[3]); }
                s += __shfl_xor(s, 16); s += __shfl_xor(s, 32);
                if (fq == 0) xs[(ai * HALF + wr * 64 + m * 16 + fr) * 4 + wc] = s;
            }
        LDS_WAIT(); __builtin_amdgcn_s_barrier(); asm volatile("" ::: "memory");
        const int row0 = u.pm * BM + wr * 64 + fr, col0 = u.pn * BM + wc * 32 + 8 * fq;
#pragma unroll
        for (int ai = 0; ai < 2; ++ai)
#pragma unroll
            for (int m = 0; m < 4; ++m) {
                const f32x4 q = *(LAS const f32x4*)(xs + (ai * HALF + wr * 64 + m * 16 + fr) * 4);
                const float inv = 1.0f / ((q[0] + q[1]) + (q[2] + q[3]));
                bf16_t* rowp = P + (size_t)(row0 + ai * HALF + m * 16) * 1024 + col0;
#pragma unroll
                for (int bj = 0; bj < 2; ++bj) {
                    const f32x4 v0 = acc[ai][bj][m][0] * inv, v1 = acc[ai][bj][m][1] * inv;
                    u32x4 w; w.x = cvtpk(v0[0], v0[1]); w.y = cvtpk(v0[2], v0[3]); w.z = cvtpk(v1[0], v1[1]); w.w = cvtpk(v1[2], v1[3]);
                    *(u32x4*)(rowp + bj * HALF) = w; }
            }
    }
};

template <class Epi, class Sched, bool ALIGN_EPI>
__device__ __forceinline__ void gemm_phase(LAS unsigned char* lds, const Gemm g, const Sched& S, const Epi& E) {
    int tid = threadIdx.x; asm volatile("" : "+v"(tid));
    const int wid = __builtin_amdgcn_readfirstlane(tid >> 6), lane = tid & 63, wr = wid >> 2, wc = wid & 3, fr = lane & 15, fq = lane >> 4;
    const int K = g.K, nt = K / BK;
    unsigned voffA[2], voffB[2];
#pragma unroll
    for (int i = 0; i < 2; ++i) { int R, C; stage_rc(tid * 16 + i * 8192, R, C); const int Rb = Epi::PERM ? ((R & ~31) + perm32(R & 31)) : R;
        voffA[i] = (unsigned)(R * g.lda + C) * 2u; voffB[i] = (unsigned)(Rb * g.ldb + C) * 2u; }
    const size_t kstep = (size_t)(BK * 2);
    const size_t hstepA = (size_t)HALF * g.lda * 2, hstepB = (size_t)HALF * g.ldb * 2;
    const unsigned ldsw = (unsigned)wid * 1024u;
    const int aoff = lds_byte(wr * 64 + fr, fq * 8), boff = lds_byte(wc * 32 + fr, fq * 8);
#define PG8_SA(b, h) (((b) * 2 + (h)) * HTB)
#define PG8_SB(b, h) ((4 + (b) * 2 + (h)) * HTB)
#define PG8_STAGE(bufoff, gbase, voff) do { _Pragma("unroll") for (int _i = 0; _i < 2; ++_i) \
        __builtin_amdgcn_global_load_lds((const unsigned*)((const char*)(gbase) + (voff)[_i]), (LAS unsigned*)(lds + (bufoff) + ldsw + _i * 8192), 16, 0, 0); } while (0)
#define PG8_LDA(dst, b, h) do { _Pragma("unroll") for (int m = 0; m < 4; ++m) _Pragma("unroll") for (int k = 0; k < 2; ++k) dst[m][k] = *(const LAS bf16x8*)(lds + PG8_SA(b, h) + aoff + m * 2048 + k * 1024); } while (0)
#define PG8_LDB(dst, b, h) do { _Pragma("unroll") for (int n = 0; n < 2; ++n) _Pragma("unroll") for (int k = 0; k < 2; ++k) dst[n][k] = *(const LAS bf16x8*)(lds + PG8_SB(b, h) + boff + n * 2048 + k * 1024); } while (0)
#define PG8_MMA(ai, bj, At, Bt) do { __builtin_amdgcn_s_setprio(1); _Pragma("unroll") for (int m = 0; m < 4; ++m) _Pragma("unroll") for (int n = 0; n < 2; ++n) _Pragma("unroll") for (int k = 0; k < 2; ++k) \
        acc[ai][bj][m][n] = __builtin_amdgcn_mfma_f32_16x16x32_bf16(Bt[n][k], At[m][k], acc[ai][bj][m][n], 0, 0, 0); __builtin_amdgcn_s_setprio(0); } while (0)
#define PG8_WAIT_V(n) asm volatile("s_waitcnt vmcnt(" #n ")" ::: "memory")
#define PG8_WAIT_L(n) asm volatile("s_waitcnt lgkmcnt(" #n ")" ::: "memory")
#define PG8_BAR __builtin_amdgcn_s_barrier()
#define PG8_SCHED __builtin_amdgcn_sched_barrier(0)
    Unit cur, nxt; int ui = 0;
    if (!S.next(0, cur)) return;
    f32x4 acc[2][2][4][2];
#pragma unroll
    for (int a = 0; a < 2; ++a)
#pragma unroll
        for (int b = 0; b < 2; ++b)
#pragma unroll
            for (int m = 0; m < 4; ++m)
#pragma unroll
                for (int n = 0; n < 2; ++n) acc[a][b][m][n] = (f32x4){0.f, 0.f, 0.f, 0.f};
    bf16x8 At[4][2], B0[2][2], B1[2][2];
    const char* cA = (const char*)g.A + cur.aoff * 2; const char* cB = (const char*)g.Bt + cur.boff * 2;
    PG8_STAGE(PG8_SB(0, 0), cB, voffB); PG8_STAGE(PG8_SB(0, 1), cB + hstepB, voffB); PG8_STAGE(PG8_SA(0, 0), cA, voffA); PG8_STAGE(PG8_SA(0, 1), cA + hstepA, voffA);
    if (wr == 1) PG8_BAR;
    PG8_WAIT_V(2); PG8_BAR;
    PG8_STAGE(PG8_SB(1, 0), cB + kstep, voffB); PG8_STAGE(PG8_SA(1, 0), cA + kstep, voffA); PG8_STAGE(PG8_SB(1, 1), cB + hstepB + kstep, voffB);
    PG8_WAIT_V(6); PG8_BAR;
    for (;;) {
        const bool has_next = S.next(ui + 1, nxt);
        const char* nA = has_next ? (const char*)g.A + nxt.aoff * 2 : cA; const char* nB = has_next ? (const char*)g.Bt + nxt.boff * 2 : cB;
#pragma unroll 1
        for (int t = 0; t < nt; t += 2) {
            const bool last = (t == nt - 2);
            const char* a1 = cA + (size_t)(t + 1) * kstep;
            const char* a2 = last ? nA : cA + (size_t)(t + 2) * kstep; const char* b2 = last ? nB : cB + (size_t)(t + 2) * kstep;
            const char* a3 = a2 + kstep; const char* b3 = b2 + kstep;
            PG8_LDB(B0, 0, 0); PG8_LDB(B1, 0, 1); PG8_SCHED; PG8_LDA(At, 0, 0); PG8_STAGE(PG8_SA(1, 1), a1 + hstepA, voffA);
            PG8_WAIT_V(8); PG8_WAIT_L(0); PG8_BAR; PG8_MMA(0, 0, At, B0); PG8_MMA(0, 1, At, B1); PG8_BAR; PG8_SCHED;
            PG8_LDA(At, 0, 1); PG8_STAGE(PG8_SB(0, 0), b2, voffB); PG8_STAGE(PG8_SB(0, 1), b2 + hstepB, voffB); PG8_STAGE(PG8_SA(0, 0), a2, voffA);
            PG8_WAIT_V(8); PG8_WAIT_L(0); PG8_BAR; PG8_MMA(1, 0, At, B0); PG8_MMA(1, 1, At, B1); PG8_BAR; PG8_SCHED;
            PG8_LDB(B0, 1, 0); PG8_LDB(B1, 1, 1); PG8_SCHED; PG8_LDA(At, 1, 0); PG8_STAGE(PG8_SA(0, 1), a2 + hstepA, voffA);
            PG8_WAIT_V(8); PG8_WAIT_L(0); PG8_BAR; PG8_MMA(0, 0, At, B0); PG8_MMA(0, 1, At, B1); PG8_BAR; PG8_SCHED;
            PG8_LDA(At, 1, 1); PG8_STAGE(PG8_SB(1, 0), b3, voffB); PG8_STAGE(PG8_SB(1, 1), b3 + hstepB, voffB); PG8_STAGE(PG8_SA(1, 0), a3, voffA);
            PG8_WAIT_V(8); PG8_WAIT_L(0); PG8_BAR; PG8_MMA(1, 0, At, B0); PG8_MMA(1, 1, At, B1); PG8_BAR; PG8_SCHED;
        }
        if constexpr (ALIGN_EPI) { if (wr == 0) PG8_BAR; }
        E(acc, cur, wr, wc, fr, fq);
        if (!has_next) break;
#pragma unroll
        for (int a = 0; a < 2; ++a)
#pragma unroll
            for (int b = 0; b < 2; ++b)
#pragma unroll
                for (int m = 0; m < 4; ++m)
#pragma unroll
                    for (int n = 0; n < 2; ++n) acc[a][b][m][n] = (f32x4){0.f, 0.f, 0.f, 0.f};
        cur = nxt; cA = nA; cB = nB; ++ui;
        if constexpr (ALIGN_EPI) { if (wr == 1) PG8_BAR; }
    }
    PG8_WAIT_V(0);
    if constexpr (!ALIGN_EPI) { if (wr == 0) PG8_BAR; }
    PG8_BAR;
#undef PG8_SA
#undef PG8_SB
#undef PG8_STAGE
#undef PG8_LDA
#undef PG8_LDB
#undef PG8_MMA
#undef PG8_WAIT_V
#undef PG8_WAIT_L
#undef PG8_BAR
#undef PG8_SCHED
}
}

constexpr int NWAVES = 8, NTHR = 512, GRID = 256;
constexpr int RING_BYTES = 131072, XCH_OFF = RING_BYTES, LDS_BYTES = 147456;
struct Args { const float* in[22]; float* out; unsigned char* ws; int ph_lo, ph_hi; };
enum { I_X = 0, I_MEM, I_NORM_MIX, I_W_IN, I_SG_VG, I_SG_W, I_SG_B, I_GLA_WG, I_GLA_BG, I_GLA_OG, I_W_OUT, I_NORM_MEM, I_MEM_GAIN, I_W_CQ, I_W_CKV, I_W_CO, I_NORM_FFN, I_PEER_WQ, I_PEER_SK, I_PEER_U, I_PEER_V, I_FINAL_G };

struct Frame {
    LAS unsigned char* lds; int tid, lane, wave, bx, gw; static constexpr int G = GRID, NGW = GRID * NWAVES;
    float* X; unsigned char* ws;
};
#define INP(i) (args.in[(i)])

#define XB_TMO      128
#define XB_XCNT(j)  (256  + 64 * (j))
#define XB_XSUB(j)  (1280 + 64 * (j))
#define XB_XGEN(j)  (2304 + 64 * (j))
#define XB_TOP      3328
#define XB_TOPGEN   3392
#define XCD_BAR_WORDS 3456
#define XB_SPIN_CAP (1u << 22)
DI unsigned xb_ld(unsigned* p)              { return __hip_atomic_load(p, __ATOMIC_RELAXED, __HIP_MEMORY_SCOPE_AGENT); }
DI unsigned xb_add(unsigned* p, unsigned v) { return __hip_atomic_fetch_add(p, v, __ATOMIC_RELAXED, __HIP_MEMORY_SCOPE_AGENT); }
DI unsigned xb_xcc_id() { return (unsigned)__builtin_amdgcn_s_getreg((3 << 11) | 20) & 0xFu; }
#define XB_SPIN(cond, bar) do { unsigned _sp = 0; while (cond) { __builtin_amdgcn_s_sleep(1); \
    if ((++_sp & 255u) == 0u) { if (xb_ld(&(bar)[XB_TMO])) break; if (_sp > XB_SPIN_CAP) { atomicAdd(&(bar)[XB_TMO], 1u); break; } } } } while (0)
struct XcdBarrier { unsigned* bar; unsigned x; volatile LAS unsigned* st; };
DI XcdBarrier xcd_barrier_post(unsigned* bar, volatile LAS unsigned* st) {
    XcdBarrier b; b.bar = bar; b.x = xb_xcc_id(); b.st = st;
    if (threadIdx.x == 0) (void)xb_add(&bar[XB_XCNT(b.x)], 1u);
    return b;
}
DI void xcd_barrier_complete(unsigned* bar, unsigned x, unsigned& nloc, unsigned& nx) {
    const unsigned G = gridDim.x * gridDim.y * gridDim.z;
    unsigned sum, cnt, mine, sp = 0u;
    for (;;) {
        sum = 0u; cnt = 0u; mine = 0u;
#pragma unroll
        for (unsigned j = 0; j < 16; ++j) { const unsigned c = xb_ld(&bar[XB_XCNT(j)]); sum += c; cnt += (c > 0u) ? 1u : 0u; mine = (j == x) ? c : mine; }
        if (sum == G) break;
        __builtin_amdgcn_s_sleep(1);
        if ((++sp & 255u) == 0u) { if (xb_ld(&bar[XB_TMO])) break; if (sp > XB_SPIN_CAP) { atomicAdd(&bar[XB_TMO], 1u); break; } }
    }
    nloc = mine > 0u ? mine : 1u; nx = cnt > 0u ? cnt : 1u;
}
DI void xcd_barrier(const XcdBarrier& b) {
    asm volatile("s_waitcnt vmcnt(0)" ::: "memory");
    __syncthreads();
    if (threadIdx.x == 0) {
        unsigned* bar = b.bar;
        __builtin_amdgcn_s_waitcnt(0);
        unsigned nloc = b.st[0], nx = b.st[1];
        if (nloc == 0u) { xcd_barrier_complete(bar, b.x, nloc, nx); b.st[0] = nloc; b.st[1] = nx; }
        const unsigned old = xb_add(&bar[XB_XSUB(b.x)], 1u);
        const unsigned gen = old / nloc;
        if (old + 1u == (gen + 1u) * nloc) {
            __builtin_amdgcn_fence(__ATOMIC_RELEASE, "agent");
            asm volatile("s_waitcnt vmcnt(0)" ::: "memory");
            const unsigned og = xb_add(&bar[XB_TOP], 1u);
            const unsigned tg = og / nx;
            if (og + 1u == (tg + 1u) * nx) xb_add(&bar[XB_TOPGEN], 1u);
            else XB_SPIN(xb_ld(&bar[XB_TOPGEN]) == tg, bar);
            __builtin_amdgcn_fence(__ATOMIC_ACQUIRE, "agent");
            xb_add(&bar[XB_XGEN(b.x)], 1u);
            asm volatile("s_waitcnt vmcnt(0)" ::: "memory");
        } else {
            XB_SPIN(xb_ld(&bar[XB_XGEN(b.x)]) == gen, bar);
            __builtin_amdgcn_fence(__ATOMIC_ACQUIRE, "agent");
            asm volatile("s_waitcnt vmcnt(0)" ::: "memory");
        }
    }
    __syncthreads();
}

DI void p0_transpose_item(const float* W, int ldw, int N, int K, const float* gain, bf16_t* WT, LAS float* scr, int item, int lane) {
    const int nblk = N / 32, kb = item / nblk, nb = item % nblk, k0 = 64 * kb, n0 = 32 * nb;
#pragma unroll 8
    for (int i = 0; i < 32; ++i) { const int kk = 2 * i + (lane >> 5); float w = W[(size_t)(k0 + kk) * ldw + n0 + (lane & 31)]; if (gain) w *= gain[k0 + kk]; scr[kk * 33 + (lane & 31)] = w; }
    LDS_WAIT(); asm volatile("" ::: "memory");
    const int c = lane & 7;
#pragma unroll
    for (int j = 0; j < 4; ++j) { const int n = (lane >> 3) + 8 * j; const LAS float* s = scr + (8 * c) * 33 + n;
        u32x4 o; o.x = cvtpk(s[0 * 33], s[1 * 33]); o.y = cvtpk(s[2 * 33], s[3 * 33]); o.z = cvtpk(s[4 * 33], s[5 * 33]); o.w = cvtpk(s[6 * 33], s[7 * 33]);
        *(u32x4*)(WT + (size_t)(n0 + n) * K + k0 + 8 * c) = o; }
    LDS_WAIT(); asm volatile("" ::: "memory");
}
DI unsigned fp4x8(const f32x4 a, const f32x4 b, float inv) {
    unsigned w = 0;
    w = __builtin_amdgcn_cvt_scalef32_pk_fp4_f32(w, a[0] * inv, a[1] * inv, 1.0f, 0); w = __builtin_amdgcn_cvt_scalef32_pk_fp4_f32(w, a[2] * inv, a[3] * inv, 1.0f, 1);
    w = __builtin_amdgcn_cvt_scalef32_pk_fp4_f32(w, b[0] * inv, b[1] * inv, 1.0f, 2); w = __builtin_amdgcn_cvt_scalef32_pk_fp4_f32(w, b[2] * inv, b[3] * inv, 1.0f, 3);
    return w;
}
DI float wave_max(float v) {
#pragma unroll
    for (int o = 1; o < 64; o <<= 1) v = fmaxf(v, __shfl_xor(v, o));
    return v;
}
DI void convert_tables(const Frame& F, const Args& args, int l, int wv, int nwv) {
    const float* gn = INP(I_NORM_FFN) + l * 1024 + 16 * F.lane;
    f32x4 g[4];
#pragma unroll
    for (int q = 0; q < 4; ++q) g[q] = *(const f32x4*)(gn + 4 * q);
    for (int r0 = wv; r0 < 2 * 16384; r0 += 4 * nwv) {
        f32x4 v[4][4];
#pragma unroll
        for (int j = 0; j < 4; ++j) { const int r = min(r0 + j * nwv, 2 * 16384 - 1), isv = r >= 16384, e = r & 16383;
            const float* src = (isv ? INP(I_PEER_V) : INP(I_PEER_U)) + ((size_t)l * 16384 + e) * 1024 + 16 * F.lane;
#pragma unroll
            for (int q = 0; q < 4; ++q) v[j][q] = *(const f32x4*)(src + 4 * q); }
#pragma unroll
        for (int j = 0; j < 4; ++j) { const int r = r0 + j * nwv, isv = r >= 16384, e = r & 16383; float am = 0.f;
            if (r < 2 * 16384) {
#pragma unroll
            for (int q = 0; q < 4; ++q) { if (!isv) v[j][q] = v[j][q] * g[q];
                am = fmaxf(am, fmaxf(fmaxf(fabsf(v[j][q][0]), fabsf(v[j][q][1])), fmaxf(fabsf(v[j][q][2]), fabsf(v[j][q][3])))); }
            am = wave_max(am);
            const float sc = bf2f(cvt1(am > 0.f ? am * (1.0f / 6.0f) : 1.0f)), inv = 1.0f / sc;
            u32x2 w; w.x = fp4x8(v[j][0], v[j][1], inv); w.y = fp4x8(v[j][2], v[j][3], inv);
            *(u32x2*)(F.ws + WS_TAB + (size_t)l * 16 * MiB + (size_t)isv * 8 * MiB + (size_t)e * 512 + 8 * F.lane) = w;
            if (F.lane == 0) ((bf16_t*)(F.ws + WS_TAB + 32 * MiB))[((size_t)l * 16384 + e) * 2 + isv] = cvt1(sc); } }
    }
}
struct TDesc { const float* W; const float* gain; bf16_t* WT; int ldw, nblk; };
DI TDesc tdesc(const Frame& F, const Args& args, int l, int t) {
    TDesc D; D.gain = nullptr; D.ldw = 1024; D.nblk = 32; size_t woff;
    switch (t) {
    case 0: D.W = INP(I_W_IN) + (size_t)l * 1024 * INW; D.ldw = INW; D.nblk = 88; D.gain = INP(I_NORM_MIX) + l * 1024; woff = W_IN; break;
    case 1: D.W = INP(I_W_OUT) + (size_t)l * 1024 * 1024; woff = W_OUT; break;
    case 2: D.W = INP(I_W_CQ) + (size_t)l * 1024 * 1024; D.gain = INP(I_NORM_MEM) + l * 1024; woff = W_CQ; break;
    case 3: D.W = INP(I_W_CKV) + (size_t)l * 1024 * 2048; D.ldw = 2048; D.nblk = 64; D.gain = INP(I_MEM_GAIN) + l * 1024; woff = W_CKV; break;
    case 4: D.W = INP(I_W_CO) + (size_t)l * 1024 * 1024; woff = W_CO; break;
    default: D.W = INP(I_PEER_WQ) + (size_t)l * 1024 * 1024; D.gain = INP(I_NORM_FFN) + l * 1024; woff = W_PQ; break;
    }
    D.WT = (bf16_t*)(F.ws + WS_W + l * W_LAYER + woff); return D;
}
DI void titem_load(const TDesc& D, int item, int lane, float (&v)[32]) {
    const int kb = item / D.nblk, nb = item % D.nblk, k0 = 64 * kb, n0 = 32 * nb;
#pragma unroll
    for (int i = 0; i < 32; ++i) { const int kk = 2 * i + (lane >> 5); float w = D.W[(size_t)(k0 + kk) * D.ldw + n0 + (lane & 31)]; if (D.gain) w *= D.gain[k0 + kk]; v[i] = w; }
}
DI void titem_store(const TDesc& D, int item, int lane, LAS float* scr, const float (&v)[32]) {
    const int kb = item / D.nblk, nb = item % D.nblk, k0 = 64 * kb, n0 = 32 * nb;
#pragma unroll
    for (int i = 0; i < 32; ++i) scr[(2 * i + (lane >> 5)) * 33 + (lane & 31)] = v[i];
    LDS_WAIT(); asm volatile("" ::: "memory");
    const int c = lane & 7;
#pragma unroll
    for (int j = 0; j < 4; ++j) { const int n = (lane >> 3) + 8 * j; const LAS float* s = scr + (8 * c) * 33 + n;
        u32x4 o; o.x = cvtpk(s[0 * 33], s[1 * 33]); o.y = cvtpk(s[2 * 33], s[3 * 33]); o.z = cvtpk(s[4 * 33], s[5 * 33]); o.w = cvtpk(s[6 * 33], s[7 * 33]);
        *(u32x4*)(D.WT + (size_t)(n0 + n) * 1024 + k0 + 8 * c) = o; }
    LDS_WAIT(); asm volatile("" ::: "memory");
}
DI int tl_index(int part, int e) {
    if (part == 0) return e < 1408 ? e : e < 2432 ? 2432 + (e - 1408) : 4480 + 2432 + (e - 2432);
    return e < 1024 ? 1408 + e : e < 2048 ? 3456 + (e - 1024) : e < 4480 ? 4480 + (e - 2048) : 4480 + 3456 + (e - 4480);
}
DI void transpose_list(const Frame& F, const Args& args, LAS float* scr, int wv, int nwv, int part) {
    constexpr int NIT_L = 16 * 88 + 4 * 16 * 32 + 16 * 64;
    const int NIT = part == 0 ? 3456 : 5504;
    float va[32], vb[32]; TDesc Da{}, Db{}; int la = 0, lb = 0;
#define TI_DECODE(e_, D_, loc_) do { const int it_ = tl_index(part, (e_)); const int l_ = it_ / NIT_L; int r_ = it_ % NIT_L; int t_; \
        if (r_ < 1408) t_ = 0; else if (r_ < 1920) { t_ = 1; r_ -= 1408; } else if (r_ < 2432) { t_ = 2; r_ -= 1920; } else if (r_ < 3456) { t_ = 3; r_ -= 2432; } else if (r_ < 3968) { t_ = 4; r_ -= 3456; } else { t_ = 5; r_ -= 3968; } \
        D_ = tdesc(F, args, l_, t_); loc_ = r_; } while (0)
    int it = wv;
    if (it < NIT) { TI_DECODE(it, Da, la); titem_load(Da, la, F.lane, va); }
    for (;;) {
        int itn = it + nwv;
        if (itn < NIT) { TI_DECODE(itn, Db, lb); titem_load(Db, lb, F.lane, vb); }
        if (it < NIT) titem_store(Da, la, F.lane, scr, va);
        it = itn; if (it >= NIT) break;
        itn = it + nwv;
        if (itn < NIT) { TI_DECODE(itn, Da, la); titem_load(Da, la, F.lane, va); }
        titem_store(Db, lb, F.lane, scr, vb);
        it = itn; if (it >= NIT) break;
    }
#undef TI_DECODE
}
DI void p0_prologue(const Frame& F, const Args& args) {
    LAS float* scr = (LAS float*)(F.lds + F.wave * 16384);
    transpose_list(F, args, scr, F.gw, F.NGW, 0);
    const int gt = F.bx * NTHR + F.tid, nthr = F.G * NTHR;
    for (int i = gt; i < DEPTH * 256 * 1024; i += nthr) {
        const int l = i / (256 * 1024), r = i % (256 * 1024), j = r >> 10, k = r & 1023;
        bf16_t* Wi = (bf16_t*)(F.ws + WS_W + l * W_LAYER) + W_IN / 2;
        float v = 0.f;
        if (j < 128) {
            const float* wi = INP(I_W_IN) + (size_t)l * 1024 * INW + (size_t)k * INW + 2816; const float* wg = INP(I_GLA_WG) + l * 16 * 128 + j;
#pragma unroll
            for (int q4 = 0; q4 < 4; ++q4) { const f32x4 w4 = *(const f32x4*)(wi + 4 * q4);
#pragma unroll
                for (int e = 0; e < 4; ++e) v += w4[e] * wg[(4 * q4 + e) * 128]; }
            v *= INP(I_NORM_MIX)[l * 1024 + k];
        }
        Wi[(size_t)(2816 + j) * 1024 + k] = cvt1(v);
    }
    { bf16_t* WSP = (bf16_t*)(F.ws + WS_WSP); const float* sw = INP(I_SG_W);
      for (int i = gt; i < DEPTH * 4 * 128 * 128; i += nthr) { const int s = i & 127, t = (i >> 7) & 127; WSP[i] = cvt1(s <= t ? sw[i] : 0.f); }
      bf16_t* SK = (bf16_t*)(F.ws + WS_SUBK); const float* sk = INP(I_PEER_SK);
      for (int i = gt; i < DEPTH * 8 * 2 * 128 * 64; i += nthr) SK[i] = cvt1(sk[i]); }
    { float* SS = (float*)(F.ws + WS_SS); bf16_t* XB = (bf16_t*)(F.ws + WS_XB); const float* x = INP(I_X);
      for (int m0 = F.gw; m0 < MTOK; m0 += 4 * F.NGW) {
          f32x4 v[4][4];
#pragma unroll
          for (int i = 0; i < 4; ++i) { const f32x4* xr = (const f32x4*)(x + (size_t)(m0 + i * F.NGW) * 1024) + F.lane;
#pragma unroll
              for (int j = 0; j < 4; ++j) v[i][j] = xr[64 * j]; }
#pragma unroll
          for (int i = 0; i < 4; ++i) { const int m = m0 + i * F.NGW; float s = 0.f; u32x2 w[4];
#pragma unroll
              for (int j = 0; j < 4; ++j) { w[j].x = cvtpk(v[i][j][0], v[i][j][1]); w[j].y = cvtpk(v[i][j][2], v[i][j][3]);
                  s += (bflo(w[j].x) * bflo(w[j].x) + bfhi(w[j].x) * bfhi(w[j].x)) + (bflo(w[j].y) * bflo(w[j].y) + bfhi(w[j].y) * bfhi(w[j].y)); }
              s = wave_sum(s);
              u32x2* xb = (u32x2*)(XB + (size_t)m * 1024) + F.lane;
#pragma unroll
              for (int j = 0; j < 4; ++j) xb[64 * j] = w[j];
              if (F.lane < 16) SS[(size_t)m * 16 + F.lane] = F.lane == 0 ? s : 0.f; }
      }
      bf16_t* MB = (bf16_t*)(F.ws + WS_MEMB); float* RM = (float*)(F.ws + WS_RSTDM); const float* mem = INP(I_MEM);
      for (int m = F.gw; m < MMEM; m += F.NGW) {
          const f32x4* xr = (const f32x4*)(mem + (size_t)m * 1024) + F.lane; f32x4 v[4]; float s = 0.f;
#pragma unroll
          for (int j = 0; j < 4; ++j) { v[j] = xr[64 * j]; s += (v[j][0] * v[j][0] + v[j][1] * v[j][1]) + (v[j][2] * v[j][2] + v[j][3] * v[j][3]); }
          s = wave_sum(s);
          u32x2* xb = (u32x2*)(MB + (size_t)m * 1024) + F.lane;
#pragma unroll
          for (int j = 0; j < 4; ++j) { u32x2 w; w.x = cvtpk(v[j][0], v[j][1]); w.y = cvtpk(v[j][2], v[j][3]); xb[64 * j] = w; }
          if (F.lane == 0) RM[m] = 1.0f / sqrtf(s * (1.0f / 1024.0f) + EPS);
      } }
}

constexpr int SBV_PITCH = 192;
DI void sb_unit2(const bf16_t* PROJ, bf16_t* YCAT, int b, int h, int qp, LAS char* vl, int lane) {
    const int q = lane & 31, hh = lane >> 5;
    const size_t rowbase = (size_t)b * SEQ; const int qa = 2 * qp, qb = qa + 1;
    bf16x8 qfA[4], qfB[4];
    { const bf16_t* qrow = PROJ + (rowbase + qa * 32 + q) * LDP + C_SBQ + h * 64 + hh * 8;
#pragma unroll
      for (int s = 0; s < 4; ++s) { qfA[s] = *(const bf16x8*)(qrow + 16 * s); qfB[s] = *(const bf16x8*)(qrow + 32 * LDP + 16 * s); } }
    f32x16 oA0, oA1, oB0, oB1;
#pragma unroll
    for (int r = 0; r < 16; ++r) { oA0[r] = 0.f; oA1[r] = 0.f; oB0[r] = 0.f; oB1[r] = 0.f; }
    float RA = 0.f, RB = 0.f;
    const float zs = 0.125f * LOG2E;
    const int i16 = lane & 15, tq = i16 >> 2, tp = i16 & 3, blk = (lane >> 4) & 1;
    bf16x8 kf[4]; u32x4 vr[4];
#define SB_LOAD_TILE(kt_, kf, vr) do { const bf16_t* krow_ = PROJ + (rowbase + (kt_) * 32 + q) * LDP + C_SBK + h * 64 + hh * 8; \
        _Pragma("unroll") for (int s_ = 0; s_ < 4; ++s_) kf[s_] = *(const bf16x8*)(krow_ + 16 * s_); \
        _Pragma("unroll") for (int i_ = 0; i_ < 4; ++i_) { const int c_ = lane + 64 * i_, row_ = c_ >> 3, ch_ = c_ & 7; vr[i_] = *(const u32x4*)(PROJ + (rowbase + (kt_) * 32 + row_) * LDP + C_SBV + h * 64 + ch_ * 8); } } while (0)
#define SB_MATH(Z, DIAG, R, O0, O1) { \
        float L[16]; \
        _Pragma("unroll") for (int r = 0; r < 16; ++r) { \
            const float zl = Z[r] * zs; float l2 = flog2(1.f + fexp2(zl)); l2 = zl > 60.f ? zl : l2; \
            const bool valid = !(DIAG) || (crow(r, hh) < q); \
            L[r] = valid ? l2 : 0.f; Z[r] = valid ? zl : -INFINITY; } \
        float G[4], Go[4]; \
        _Pragma("unroll") for (int g = 0; g < 4; ++g) { G[g] = (L[4 * g] + L[4 * g + 1]) + (L[4 * g + 2] + L[4 * g + 3]); Go[g] = __shfl_xor(G[g], 32); } \
        float base[4]; float run = 0.f; \
        _Pragma("unroll") for (int g = 3; g >= 0; --g) { base[g] = run + (hh == 0 ? Go[g] : 0.f); run += G[g] + Go[g]; } \
        float P[16]; \
        _Pragma("unroll") for (int g = 0; g < 4; ++g) { \
            const float c3 = R + base[g], c2 = c3 + L[4 * g + 3], c1 = c2 + L[4 * g + 2], c0 = c1 + L[4 * g + 1]; \
            P[4 * g + 3] = fexp2(Z[4 * g + 3] - L[4 * g + 3] - c3); P[4 * g + 2] = fexp2(Z[4 * g + 2] - L[4 * g + 2] - c2); \
            P[4 * g + 1] = fexp2(Z[4 * g + 1] - L[4 * g + 1] - c1); P[4 * g + 0] = fexp2(Z[4 * g + 0] - L[4 * g + 0] - c0); } \
        R += run; \
        const bf16x8 p0 = pack8(P[0], P[1], P[2], P[3], P[4], P[5], P[6], P[7]), p1 = pack8(P[8], P[9], P[10], P[11], P[12], P[13], P[14], P[15]); \
        _Pragma("unroll") for (int s = 0; s < 2; ++s) { \
            const LAS char* vb = vl + (16 * s + 4 * hh + tq) * SBV_PITCH + blk * 32 + tp * 8; \
            const bf16x8 a0 = cat8(vtr(vb), vtr(vb + 8 * SBV_PITCH)), a1 = cat8(vtr(vb + 64), vtr(vb + 8 * SBV_PITCH + 64)); \
            O0 = MFMA32(a0, s == 0 ? p0 : p1, O0); O1 = MFMA32(a1, s == 0 ? p0 : p1, O1); } }
#define SB_ZERO(Z) _Pragma("unroll") for (int r = 0; r < 16; ++r) Z[r] = 0.f;
#define SB_VTOLDS(VR) _Pragma("unroll") for (int i = 0; i < 4; ++i) { const int c = lane + 64 * i, row = c >> 3, ch = c & 7; *(LAS u32x4*)(vl + row * SBV_PITCH + ch * 16) = VR[i]; }
    SB_LOAD_TILE(qb, kf, vr);
    {
        f32x16 zB; SB_ZERO(zB)
#pragma unroll
        for (int s = 0; s < 4; ++s) zB = MFMA32(kf[s], qfB[s], zB);
        SB_VTOLDS(vr)
        SB_LOAD_TILE(qa, kf, vr);
        SB_MATH(zB, true, RB, oB0, oB1)
    }
#define SB_STEP2(kt) { \
        f32x16 zA, zB; SB_ZERO(zA) SB_ZERO(zB) \
        _Pragma("unroll") for (int s = 0; s < 4; ++s) { zA = MFMA32(kf[s], qfA[s], zA); zB = MFMA32(kf[s], qfB[s], zB); } \
        SB_VTOLDS(vr) \
        if (kt > 0) SB_LOAD_TILE(kt - 1, kf, vr); \
        SB_MATH(zA, (kt == qa), RA, oA0, oA1) \
        SB_MATH(zB, false, RB, oB0, oB1) \
        if (__all(RA > 57.7f && RB > 57.7f)) break;            \
    }
    for (int kt = qa; kt >= 0; --kt) SB_STEP2(kt)
#undef SB_STEP2
#undef SB_VTOLDS
#undef SB_ZERO
#undef SB_MATH
#undef SB_LOAD_TILE
    bf16_t* orow = YCAT + (rowbase + qa * 32 + q) * 1024 + h * 64 + 4 * hh;
#pragma unroll
    for (int g = 0; g < 4; ++g) {
        u32x2 w0; w0.x = cvtpk(oA0[4 * g], oA0[4 * g + 1]); w0.y = cvtpk(oA0[4 * g + 2], oA0[4 * g + 3]); *(u32x2*)(orow + 8 * g) = w0;
        u32x2 w1; w1.x = cvtpk(oA1[4 * g], oA1[4 * g + 1]); w1.y = cvtpk(oA1[4 * g + 2], oA1[4 * g + 3]); *(u32x2*)(orow + 32 + 8 * g) = w1;
        u32x2 w2; w2.x = cvtpk(oB0[4 * g], oB0[4 * g + 1]); w2.y = cvtpk(oB0[4 * g + 2], oB0[4 * g + 3]); *(u32x2*)(orow + 32 * 1024 + 8 * g) = w2;
        u32x2 w3; w3.x = cvtpk(oB1[4 * g], oB1[4 * g + 1]); w3.y = cvtpk(oB1[4 * g + 2], oB1[4 * g + 3]); *(u32x2*)(orow + 32 * 1024 + 32 + 8 * g) = w3;
    }
}

constexpr int SGV_PITCH = 576;
DI void sgu_unit(const Frame& F, const Args& args, int l, int b, int c, const bf16_t* PROJ, bf16_t* YCAT) {
    const size_t m0 = (size_t)b * SEQ + c * 128;
    LAS char* Vn = (LAS char*)F.lds;
    {
      const int t = F.tid >> 2, part = F.tid & 3; const bf16_t* vrow = PROJ + (m0 + t) * LDP + C_SGV + part * 64; const float* gn = INP(I_SG_VG) + l * 256 + part * 64;
      float gv[64]; float s = 0.f;
#pragma unroll
      for (int i = 0; i < 8; ++i) { const u32x4 w = *(const u32x4*)(vrow + 8 * i);
#pragma unroll
          for (int j = 0; j < 4; ++j) { const float a = gelu_tanh(bflo(w[j])), bb = gelu_tanh(bfhi(w[j])); gv[8 * i + 2 * j] = a; gv[8 * i + 2 * j + 1] = bb; s += a * a + bb * bb; } }
      s += __shfl_xor(s, 1); s += __shfl_xor(s, 2);
      const float rstd = 1.0f / sqrtf(s * (1.0f / 256.0f) + EPS);
#pragma unroll
      for (int i = 0; i < 8; ++i) { const f32x4 g0 = *(const f32x4*)(gn + 8 * i), g1 = *(const f32x4*)(gn + 8 * i + 4);
          u32x4 w; w.x = cvtpk(gv[8 * i] * rstd * g0[0], gv[8 * i + 1] * rstd * g0[1]); w.y = cvtpk(gv[8 * i + 2] * rstd * g0[2], gv[8 * i + 3] * rstd * g0[3]);
          w.z = cvtpk(gv[8 * i + 4] * rstd * g1[0], gv[8 * i + 5] * rstd * g1[1]); w.w = cvtpk(gv[8 * i + 6] * rstd * g1[2], gv[8 * i + 7] * rstd * g1[3]);
          *(LAS u32x4*)(Vn + t * SGV_PITCH + (part * 64 + 8 * i) * 2) = w; } }
    WG_SYNC();
    {
      const int g = F.wave >> 1, db = F.wave & 1, lane = F.lane, r32 = lane & 31, hh = lane >> 5;
      const int i16 = lane & 15, tq = i16 >> 2, tp = i16 & 3, blk = (lane >> 4) & 1;
      const bf16_t* Wg = (const bf16_t*)(F.ws + WS_WSP) + ((size_t)(l * 4 + g) * 128) * 128;
      const float* bias = INP(I_SG_B) + (l * 4 + g) * 128;
      const int ch0 = g * 64 + db * 32 + 4 * hh;
      for (int tb = 0; tb < 4; ++tb) {
          const int t = tb * 32 + r32;
          u32x2 uw[4];
#pragma unroll
          for (int gi = 0; gi < 4; ++gi) uw[gi] = *(const u32x2*)(PROJ + (m0 + t) * LDP + C_SGU + ch0 + 8 * gi);
          const float bt = bias[t];
          f32x16 acc;
#pragma unroll
          for (int r = 0; r < 16; ++r) acc[r] = 0.f;
          for (int sb = 0; sb <= tb; ++sb) {
#pragma unroll
              for (int ks = 0; ks < 2; ++ks) {
                  const bf16x8 wf = *(const bf16x8*)(Wg + (size_t)t * 128 + sb * 32 + 16 * ks + 8 * hh);
                  const LAS char* vb = Vn + (sb * 32 + 16 * ks + 8 * hh + tq) * SGV_PITCH + (g * 64 + db * 32 + blk * 16) * 2 + tp * 8;
                  const bf16x8 vf = cat8(vtr(vb), vtr(vb + 4 * SGV_PITCH));
                  acc = MFMA32(vf, wf, acc);
              }
          }
          bf16_t* yo = YCAT + (m0 + t) * 1024 + 512 + ch0;
#pragma unroll
          for (int gi = 0; gi < 4; ++gi) {
              const float y0 = gelu_tanh(bflo(uw[gi].x)) * (acc[4 * gi] + bt), y1 = gelu_tanh(bfhi(uw[gi].x)) * (acc[4 * gi + 1] + bt);
              const float y2 = gelu_tanh(bflo(uw[gi].y)) * (acc[4 * gi + 2] + bt), y3 = gelu_tanh(bfhi(uw[gi].y)) * (acc[4 * gi + 3] + bt);
              u32x2 wv; wv.x = cvtpk(y0, y1); wv.y = cvtpk(y2, y3); *(u32x2*)(yo + 8 * gi) = wv;
          }
      } }
    WG_SYNC();
}

constexpr int GQ_PITCH = 80, GV_PITCH = 192, GS_PITCH = 80;
constexpr int GL_QT = 0, GL_KT = GL_QT + 128 * GQ_PITCH, GL_VV = GL_KT + 128 * GQ_PITCH, GL_ST = GL_VV + 128 * GV_PITCH, GL_SEG = GL_ST + 64 * GS_PITCH,
              GL_D = GL_SEG + 16 * 32 * 4, GL_SSQ = GL_D + 32 * 4, GL_END = GL_SSQ + 128 * 2 * 4;
DI void gla_chain(const Frame& F, const Args& args, int l, int b, int h, const bf16_t* PROJ, bf16_t* YCAT) {
    LAS char* L = (LAS char*)F.lds;
    LAS float* SEG = (LAS float*)(L + GL_SEG); LAS float* Dd = (LAS float*)(L + GL_D); LAS float* SSQ = (LAS float*)(L + GL_SSQ);
    const int tid = F.tid, lane = F.lane, w = F.wave, r32 = lane & 31, hh = lane >> 5;
    const int i16 = lane & 15, tq = i16 >> 2, tp = i16 & 3, blk = (lane >> 4) & 1;
    for (int i = tid; i < 64 * GS_PITCH / 4; i += NTHR) ((LAS unsigned*)(L + GL_ST))[i] = 0u;
    f32x16 st;
#pragma unroll
    for (int r = 0; r < 16; ++r) st[r] = 0.f;
    const int j = tid & 31, seg = tid >> 5;
    const float bg = INP(I_GLA_BG)[l * 128 + h * 32 + j];
    const int tb = w & 3, dh = w >> 2;
    float ga[8], kr[8], qr[8]; u32x4 vv[2];
#define GC_LOAD(c_) do { const size_t m0_ = (size_t)b * SEQ + (c_) * 128; \
        _Pragma("unroll") for (int i_ = 0; i_ < 8; ++i_) { const bf16_t* p_ = PROJ + (m0_ + seg * 8 + i_) * LDP + h * 32 + j; ga[i_] = bf2f(p_[C_GA]); kr[i_] = bf2f(p_[C_GK]); qr[i_] = bf2f(p_[C_GQ]); } \
        _Pragma("unroll") for (int i_ = 0; i_ < 2; ++i_) { const int cc_ = tid + 512 * i_, row_ = cc_ >> 3, ch_ = cc_ & 7; vv[i_] = *(const u32x4*)(PROJ + (m0_ + row_) * LDP + C_GV + h * 64 + ch_ * 8); } } while (0)
    GC_LOAD(0);
    LDS_SYNC();
#pragma unroll 1
    for (int c = 0; c < 16; ++c) {
        const size_t m0 = (size_t)b * SEQ + c * 128;
        float bc[8]; float run = 0.f;
#pragma unroll
        for (int i = 0; i < 8; ++i) {
            const float g = ga[i] + bg;
            const float sp = fmaxf(-g, 0.f) + flog2(1.f + fexp2(-fabsf(g) * LOG2E)) * 0.6931471805599453f;
            run += -sp * (1.0f / 16.0f); bc[i] = run;
        }
        SEG[seg * 32 + j] = run;
#pragma unroll
        for (int i = 0; i < 2; ++i) { const int cc = tid + 512 * i, row = cc >> 3, ch = cc & 7; *(LAS u32x4*)(L + GL_VV + row * GV_PITCH + ch * 16) = vv[i]; }
        LDS_SYNC();
        float pre = 0.f;
#pragma unroll
        for (int s2 = 0; s2 < 15; ++s2) { const float v_ = SEG[s2 * 32 + j]; pre += s2 < seg ? v_ : 0.f; }
#pragma unroll
        for (int i = 0; i < 8; ++i) {
            const int t = seg * 8 + i; const float bb = pre + bc[i];
            *(LAS bf16_t*)(L + GL_QT + t * GQ_PITCH + j * 2) = cvt1(qr[i] * 0.17677669529663687f * fexp2(bb * LOG2E));
            *(LAS bf16_t*)(L + GL_KT + t * GQ_PITCH + j * 2) = cvt1(kr[i] * fexp2(-bb * LOG2E));
            if (t == 127) Dd[j] = fexp2(bb * LOG2E);
        }
        if (c < 15) GC_LOAD(c + 1);
        u32x2 gov[4];
        { const bf16_t* go = PROJ + (m0 + tb * 32 + r32) * LDP + C_GO + h * 64 + dh * 32 + 4 * hh;
#pragma unroll
          for (int g = 0; g < 4; ++g) gov[g] = *(const u32x2*)(go + 8 * g); }
        LDS_SYNC();
        f32x16 o;
#pragma unroll
        for (int r = 0; r < 16; ++r) o[r] = 0.f;
        bf16x8 qf[2];
#pragma unroll
        for (int ks = 0; ks < 2; ++ks) qf[ks] = *(LAS const bf16x8*)(L + GL_QT + (tb * 32 + r32) * GQ_PITCH + (16 * ks + 8 * hh) * 2);
        for (int sb = 0; sb <= tb; ++sb) {
            f32x16 sT;
#pragma unroll
            for (int r = 0; r < 16; ++r) sT[r] = 0.f;
#pragma unroll
            for (int ks = 0; ks < 2; ++ks) { const bf16x8 kf = *(LAS const bf16x8*)(L + GL_KT + (sb * 32 + r32) * GQ_PITCH + (16 * ks + 8 * hh) * 2); sT = MFMA32(kf, qf[ks], sT); }
            if (sb == tb) {
#pragma unroll
                for (int r = 0; r < 16; ++r) if (crow(r, hh) > r32) sT[r] = 0.f;
            }
            const bf16x8 p0 = pack8(sT[0], sT[1], sT[2], sT[3], sT[4], sT[5], sT[6], sT[7]), p1 = pack8(sT[8], sT[9], sT[10], sT[11], sT[12], sT[13], sT[14], sT[15]);
#pragma unroll
            for (int s = 0; s < 2; ++s) {
                const LAS char* vb = L + GL_VV + (sb * 32 + 16 * s + 4 * hh + tq) * GV_PITCH + (dh * 32 + blk * 16) * 2 + tp * 8;
                const bf16x8 a = cat8(vtr(vb), vtr(vb + 8 * GV_PITCH));
                o = MFMA32(a, s == 0 ? p0 : p1, o);
            }
        }
#pragma unroll
        for (int ks = 0; ks < 2; ++ks) {
            const bf16x8 a = *(LAS const bf16x8*)(L + GL_ST + (dh * 32 + r32) * GS_PITCH + (16 * ks + 8 * hh) * 2);
            o = MFMA32(a, qf[ks], o);
        }
        if (tb == 0) {
#pragma unroll
            for (int ks = 0; ks < 8; ++ks) {
                const LAS char* kb = L + GL_KT + (16 * ks + 8 * hh + tq) * GQ_PITCH + (blk * 16) * 2 + tp * 8;
                const bf16x8 a = cat8(vtr(kb), vtr(kb + 4 * GQ_PITCH));
                const LAS char* vb = L + GL_VV + (16 * ks + 8 * hh + tq) * GV_PITCH + (dh * 32 + blk * 16) * 2 + tp * 8;
                const bf16x8 bfr = cat8(vtr(vb), vtr(vb + 4 * GV_PITCH));
                st = MFMA32(a, bfr, st);
            }
#pragma unroll
            for (int r = 0; r < 16; ++r) st[r] *= Dd[crow(r, hh)];
        }
        float ssq = 0.f;
#pragma unroll
        for (int r = 0; r < 16; ++r) ssq += o[r] * o[r];
        ssq += __shfl_xor(ssq, 32);
        if (hh == 0) SSQ[(tb * 32 + r32) * 2 + dh] = ssq;
        LDS_SYNC();
        {
            const int t = tb * 32 + r32; const float tot = SSQ[t * 2] + SSQ[t * 2 + 1]; const float rstd = 1.0f / sqrtf(tot * (1.0f / 64.0f) + EPS);
            const float* gn = INP(I_GLA_OG) + l * 256 + h * 64 + dh * 32 + 4 * hh;
            bf16_t* yo = YCAT + (m0 + t) * 1024 + 768 + h * 64 + dh * 32 + 4 * hh;
#pragma unroll
            for (int g = 0; g < 4; ++g) {
                const u32x2 gw = gov[g]; const f32x4 gg = *(const f32x4*)(gn + 8 * g);
                const float y0 = o[4 * g] * rstd * gg[0] * silu(bflo(gw.x)), y1 = o[4 * g + 1] * rstd * gg[1] * silu(bfhi(gw.x));
                const float y2 = o[4 * g + 2] * rstd * gg[2] * silu(bflo(gw.y)), y3 = o[4 * g + 3] * rstd * gg[3] * silu(bfhi(gw.y));
                u32x2 wv; wv.x = cvtpk(y0, y1); wv.y = cvtpk(y2, y3); *(u32x2*)(yo + 8 * g) = wv;
            }
        }
        if (tb == 0) {
#pragma unroll
            for (int g = 0; g < 4; ++g) { u32x2 wv; wv.x = cvtpk(st[4 * g], st[4 * g + 1]); wv.y = cvtpk(st[4 * g + 2], st[4 * g + 3]);
                *(LAS u32x2*)(L + GL_ST + (dh * 32 + r32) * GS_PITCH + (8 * g + 4 * hh) * 2) = wv; }
        }
        LDS_SYNC();
    }
#undef GC_LOAD
}

constexpr int XA_PITCH = 528;
template <int PITCH, int I0, int N> DI void xattn_load(const bf16_t* src, int tid, u32x4 (&v)[N]) {
    const bf16_t* p = src + (size_t)(tid >> 5) * PITCH + (tid & 31) * 8;
#pragma unroll
    for (int i = 0; i < N; ++i) v[i] = *(const u32x4*)(p + (size_t)(I0 + i) * 16 * PITCH);
}
template <int I0, int N> DI void xattn_store(LAS char* img, int tid, const u32x4 (&v)[N]) {
    LAS char* d = img + (tid >> 5) * XA_PITCH + (tid & 31) * 16;
#pragma unroll
    for (int i = 0; i < N; ++i) *(LAS u32x4*)(d + (I0 + i) * 16 * XA_PITCH) = v[i];
}
DI void xattn_unit(const Frame& F, const bf16_t* CQ, const bf16_t* Kl, const bf16_t* VTl, bf16_t* O, int pm, int h) {
    LAS char* img = (LAS char*)F.lds;
    const int lane = F.lane, r32 = lane & 31, hh = lane >> 5, b = pm >> 3;
    const size_t tok = (size_t)pm * 256 + F.wave * 32 + r32;
    { u32x4 sk[16]; xattn_load<1024, 0, 16>(Kl + (size_t)b * 256 * 1024 + h * 256, F.tid, sk); xattn_store<0, 16>(img, F.tid, sk); }
    const bf16_t* qrow = CQ + tok * 1024 + h * 256 + 8 * hh;
    bf16x8 qn = *(const bf16x8*)qrow;
    LDS_SYNC();
    u32x4 sv0[8]; xattn_load<256, 0, 8>(VTl + (size_t)(b * 4 + h) * 256 * 256, F.tid, sv0);
    f32x16 acc[8];
#pragma unroll
    for (int kb = 0; kb < 8; ++kb)
#pragma unroll
        for (int r = 0; r < 16; ++r) acc[kb][r] = 0.f;
#pragma unroll 1
    for (int ks = 0; ks < 16; ++ks) {
        const bf16x8 q = qn;
        qn = *(const bf16x8*)(qrow + 16 * (ks < 15 ? ks + 1 : ks));
        const LAS char* kp = img + r32 * XA_PITCH + (16 * ks + 8 * hh) * 2;
#pragma unroll
        for (int kb = 0; kb < 8; ++kb) acc[kb] = MFMA32(*(LAS const bf16x8*)(kp + kb * 32 * XA_PITCH), q, acc[kb]);
    }
    float mx = -INFINITY;
#pragma unroll
    for (int kb = 0; kb < 8; ++kb)
#pragma unroll
        for (int r = 0; r < 16; ++r) mx = fmaxf(mx, acc[kb][r]);
    mx = fmaxf(mx, __shfl_xor(mx, 32));
    float sum = 0.f;
#pragma unroll
    for (int kb = 0; kb < 8; ++kb)
#pragma unroll
        for (int r = 0; r < 16; ++r) { const float p = fexp2(acc[kb][r] - mx); acc[kb][r] = p; sum += p; }
    sum += __shfl_xor(sum, 32);
    const float inv = 1.0f / sum;
    bf16x8 pf[8][2];
#pragma unroll
    for (int kb = 0; kb < 8; ++kb) {
        pf[kb][0] = pack8(acc[kb][0], acc[kb][1], acc[kb][2], acc[kb][3], acc[kb][4], acc[kb][5], acc[kb][6], acc[kb][7]);
        pf[kb][1] = pack8(acc[kb][8], acc[kb][9], acc[kb][10], acc[kb][11], acc[kb][12], acc[kb][13], acc[kb][14], acc[kb][15]);
    }
    LDS_SYNC();
    { u32x4 sv1[8]; xattn_load<256, 8, 8>(VTl + (size_t)(b * 4 + h) * 256 * 256, F.tid, sv1); xattn_store<0, 8>(img, F.tid, sv0); xattn_store<8, 8>(img, F.tid, sv1); }
    LDS_SYNC();
    bf16_t* orow = O + tok * 1024 + h * 256 + 4 * hh;
#pragma unroll 1
    for (int db = 0; db < 8; ++db) {
        f32x16 o;
#pragma unroll
        for (int r = 0; r < 16; ++r) o[r] = 0.f;
#pragma unroll
        for (int kb = 0; kb < 8; ++kb)
#pragma unroll
            for (int s2 = 0; s2 < 2; ++s2) {
                const LAS char* vp = img + (db * 32 + r32) * XA_PITCH + (32 * kb + 16 * s2 + 4 * hh) * 2;
                const bf16x8 vf = cat8(*(LAS const s16x4*)vp, *(LAS const s16x4*)(vp + 16));
                o = MFMA32(vf, pf[kb][s2], o);
            }
#pragma unroll
        for (int g = 0; g < 4; ++g) { u32x2 w; w.x = cvtpk(o[4 * g] * inv, o[4 * g + 1] * inv); w.y = cvtpk(o[4 * g + 2] * inv, o[4 * g + 3] * inv); *(u32x2*)(orow + 32 * db + 8 * g) = w; }
    }
    LDS_SYNC();
}

DI unsigned key_pack(float v, unsigned tag, unsigned mask) { const unsigned b = __float_as_uint(v); const unsigned mono = b ^ ((unsigned)((int)b >> 31) | 0x80000000u); return (mono & ~mask) | tag; }
DI float key_val(unsigned k, unsigned mask) { const unsigned mono = k & ~mask; const unsigned b = (mono & 0x80000000u) ? (mono ^ 0x80000000u) : ~mono; return __uint_as_float(b); }
#define CE(a, b) do { const unsigned _h = (a) > (b) ? (a) : (b); const unsigned _l = (a) > (b) ? (b) : (a); (a) = _h; (b) = _l; } while (0)
#define SORT16_DESC(v) do { CE(v[0], v[1]); CE(v[2], v[3]); CE(v[0], v[2]); CE(v[1], v[3]); CE(v[1], v[2]); CE(v[4], v[5]); CE(v[6], v[7]); CE(v[4], v[6]); CE(v[5], v[7]); CE(v[5], v[6]); CE(v[0], v[4]); CE(v[2], v[6]); CE(v[2], v[4]); CE(v[1], v[5]); CE(v[3], v[7]); CE(v[3], v[5]); CE(v[1], v[2]); CE(v[3], v[4]); CE(v[5], v[6]); CE(v[8], v[9]); CE(v[10], v[11]); CE(v[8], v[10]); CE(v[9], v[11]); CE(v[9], v[10]); CE(v[12], v[13]); CE(v[14], v[15]); CE(v[12], v[14]); CE(v[13], v[15]); CE(v[13], v[14]); CE(v[8], v[12]); CE(v[10], v[14]); CE(v[10], v[12]); CE(v[9], v[13]); CE(v[11], v[15]); CE(v[11], v[13]); CE(v[9], v[10]); CE(v[11], v[12]); CE(v[13], v[14]); CE(v[0], v[8]); CE(v[4], v[12]); CE(v[4], v[8]); CE(v[2], v[10]); CE(v[6], v[14]); CE(v[6], v[10]); CE(v[2], v[4]); CE(v[6], v[8]); CE(v[10], v[12]); CE(v[1], v[9]); CE(v[5], v[13]); CE(v[5], v[9]); CE(v[3], v[11]); CE(v[7], v[15]); CE(v[7], v[11]); CE(v[3], v[5]); CE(v[7], v[9]); CE(v[11], v[13]); CE(v[1], v[2]); CE(v[3], v[4]); CE(v[5], v[6]); CE(v[7], v[8]); CE(v[9], v[10]); CE(v[11], v[12]); CE(v[13], v[14]); } while (0)
#define BITONIC16_DESC(v) do { CE(v[0], v[8]); CE(v[1], v[9]); CE(v[2], v[10]); CE(v[3], v[11]); CE(v[4], v[12]); CE(v[5], v[13]); CE(v[6], v[14]); CE(v[7], v[15]); CE(v[0], v[4]); CE(v[1], v[5]); CE(v[2], v[6]); CE(v[3], v[7]); CE(v[8], v[12]); CE(v[9], v[13]); CE(v[10], v[14]); CE(v[11], v[15]); CE(v[0], v[2]); CE(v[1], v[3]); CE(v[4], v[6]); CE(v[5], v[7]); CE(v[8], v[10]); CE(v[9], v[11]); CE(v[12], v[14]); CE(v[13], v[15]); CE(v[0], v[1]); CE(v[2], v[3]); CE(v[4], v[5]); CE(v[6], v[7]); CE(v[8], v[9]); CE(v[10], v[11]); CE(v[12], v[13]); CE(v[14], v[15]); } while (0)
#define MERGE_TOP16(T, v) do { _Pragma("unroll") for (int _i = 0; _i < 16; ++_i) T[_i] = T[_i] > v[15 - _i] ? T[_i] : v[15 - _i]; BITONIC16_T(T); } while (0)
DI void bitonic16(unsigned (&v)[16]) { BITONIC16_DESC(v); }
#define BITONIC16_T(T) bitonic16(T)
DI void route_level1(const bf16_t* PQ, const bf16_t* SK  , int tile, int h, int lane, unsigned (&tpk)[2][16]) {
    const int r32 = lane & 31, hh = lane >> 5; const size_t m = (size_t)tile * 32 + r32;
    bf16x8 qfa[2][4];
#pragma unroll
    for (int p = 0; p < 2; ++p)
#pragma unroll
        for (int ks = 0; ks < 4; ++ks) qfa[p][ks] = *(const bf16x8*)(PQ + m * 1024 + h * 128 + p * 64 + 16 * ks + 8 * hh);
    bf16x8 an[4];
#define RT_LOADA(p_, nb_) do { const bf16_t* skp_ = SK + ((size_t)(h * 2 + (p_)) * 128) * 64; _Pragma("unroll") for (int ks_ = 0; ks_ < 4; ++ks_) an[ks_] = *(const bf16x8*)(skp_ + (size_t)((nb_) * 32 + r32) * 64 + 16 * ks_ + 8 * hh); } while (0)
    RT_LOADA(0, 0);
#pragma unroll
    for (int p = 0; p < 2; ++p) {
        unsigned T[16];
#pragma unroll
        for (int i = 0; i < 16; ++i) T[i] = 0u;
#pragma unroll 1
        for (int nb = 0; nb < 4; ++nb) {
            bf16x8 a[4];
#pragma unroll
            for (int ks = 0; ks < 4; ++ks) a[ks] = an[ks];
            if (nb < 3) RT_LOADA(p, nb + 1); else if (p == 0) RT_LOADA(1, 0);
            f32x16 acc;
#pragma unroll
            for (int r = 0; r < 16; ++r) acc[r] = 0.f;
#pragma unroll
            for (int ks = 0; ks < 4; ++ks) acc = MFMA32(a[ks], qfa[p][ks], acc);
            unsigned v[16];
#pragma unroll
            for (int r = 0; r < 16; ++r) v[r] = key_pack(acc[r], (unsigned)(nb * 32 + crow(r, hh)), 127u);
            SORT16_DESC(v);
            MERGE_TOP16(T, v);
        }
        unsigned pv[16];
#pragma unroll
        for (int i = 0; i < 16; ++i) pv[i] = (unsigned)__shfl_xor((int)T[i], 32);
        MERGE_TOP16(T, pv);
#pragma unroll
        for (int i = 0; i < 16; ++i) tpk[p][i] = T[i];
    }
#undef RT_LOADA
}
DI void route_level2(const unsigned (&tpk)[2][16], size_t m, int h, int lane, int* IDX, float* Gw, unsigned* SCL, const LAS unsigned* SCT  , LAS char* scr  ) {
    { u32x4 w0, w1, w2, w3;
#pragma unroll
      for (int q = 0; q < 4; ++q) {
          w0[q] = (tpk[0][4 * q] & 127u) | ((tpk[0][4 * q + 1] & 127u) << 8) | ((tpk[0][4 * q + 2] & 127u) << 16) | ((tpk[0][4 * q + 3] & 127u) << 24);
          w1[q] = (tpk[1][4 * q] & 127u) | ((tpk[1][4 * q + 1] & 127u) << 8) | ((tpk[1][4 * q + 2] & 127u) << 16) | ((tpk[1][4 * q + 3] & 127u) << 24); }
      (void)w2; (void)w3;
      *(LAS u32x4*)(scr + lane * 48) = w0; *(LAS u32x4*)(scr + lane * 48 + 16) = w1; }
    float av[16], bv[16];
#pragma unroll
    for (int i = 0; i < 16; ++i) { av[i] = key_val(tpk[0][i], 127u); bv[i] = key_val(tpk[1][i], 127u); }
    unsigned cv[16];
#pragma unroll
    for (int i = 0; i < 16; ++i) cv[i] = 0u;
#pragma unroll
    for (int i = 0; i < 16; ++i)
#pragma unroll
        for (int jj = 0; jj < 16; ++jj) if ((i + 1) * (jj + 1) <= 16) {
            unsigned x = key_pack(av[i] + bv[jj], (unsigned)(i * 16 + jj), 255u);
#pragma unroll
            for (int pos = (i + 1) * (jj + 1) - 1; pos < 16; ++pos) CE(cv[pos], x);
        }
    const float cmax = key_val(cv[0], 255u);
    float e[16]; float sum = 0.f;
#pragma unroll
    for (int k = 0; k < 16; ++k) { e[k] = fexp2((key_val(cv[k], 255u) - cmax) * LOG2E); sum += e[k]; }
    const float inv = 1.0f / sum;
    int id[16];
#pragma unroll
    for (int k = 0; k < 16; ++k) {
        const unsigned ij = cv[k] & 255u;
        const unsigned n0 = *(LAS const unsigned char*)(scr + lane * 48 + (ij >> 4)), n1 = *(LAS const unsigned char*)(scr + lane * 48 + 16 + (ij & 15u));
        id[k] = (int)(n0 * 128u + n1);
    }
    { int* ip = IDX + m * 128 + h * 16;
#pragma unroll
      for (int k = 0; k < 16; k += 4) *(int4*)(ip + k) = make_int4(id[k], id[k + 1], id[k + 2], id[k + 3]);
      unsigned* sp = SCL + m * 128 + h * 16;
#pragma unroll
      for (int k = 0; k < 16; k += 4) { u32x4 w;
#pragma unroll
          for (int q = 0; q < 4; ++q) w[q] = SCT[id[k + q]];
          *(u32x4*)(sp + k) = w; }
      float* gp = Gw + m * 128 + h * 16;
#pragma unroll
      for (int k = 0; k < 16; k += 4) *(f32x4*)(gp + k) = (f32x4){e[k] * inv, e[k + 1] * inv, e[k + 2] * inv, e[k + 3] * inv}; }
}
DI void route_pair(const bf16_t* PQ, const bf16_t* SK, int* IDX, float* Gw, unsigned* SCL, const LAS unsigned* SCT, int tileA, int h, int lane, LAS char* scr) {
    unsigned tA[2][16], tB[2][16];
    route_level1(PQ, SK, tileA, h, lane, tA);
    route_level1(PQ, SK, tileA + 1, h, lane, tB);
    const bool hi = lane >= 32;
#pragma unroll
    for (int p = 0; p < 2; ++p)
#pragma unroll
        for (int i = 0; i < 16; ++i) tA[p][i] = hi ? tB[p][i] : tA[p][i];
    route_level2(tA, (size_t)(tileA + (hi ? 1 : 0)) * 32 + (lane & 31), h, lane, IDX, Gw, SCL, SCT, scr);
}

#define FP4PAIR(w, bsel) __builtin_amdgcn_cvt_scalef32_pk_f32_fp4((w), 1.0f, (bsel))
typedef __bf16 bf16p_t __attribute__((ext_vector_type(2)));
#define FP4BF(w, bsel) __builtin_amdgcn_cvt_scalef32_pk_bf16_fp4((w), 1.0f, (bsel))
#define DOT2(accf, xw, ub) accf = __builtin_amdgcn_fdot2_f32_bf16(__builtin_bit_cast(bf16p_t, (xw)), (ub), accf, false)
typedef int v8i_t __attribute__((ext_vector_type(8)));
typedef short s16x2_t __attribute__((ext_vector_type(2)));
DI f32x4 mfma_x4u4(const u32x4 a, const u32x4 b, const f32x4 c) {
    const v8i_t aa = {(int)a.x, (int)a.y, (int)a.z, (int)a.w, 0, 0, 0, 0}, bb = {(int)b.x, (int)b.y, (int)b.z, (int)b.w, 0, 0, 0, 0};
    return __builtin_amdgcn_mfma_scale_f32_16x16x128_f8f6f4(aa, bb, c, 4, 4, 0, 0x7F7F7F7F, 0, 0x7F7F7F7F);
}
DI void peer_wave(const Frame& F, const Args& args, bool last, const unsigned char* Ub, const unsigned char* Vb, const unsigned* SCL, const int* IDX, const float* Gw, bf16_t* XB, float* SS) {
    const int lane = F.lane, j16 = lane & 15, kb = lane >> 4;
    LAS unsigned char* xs = F.lds + F.wave * 1536;
    LAS unsigned char* zr = F.lds + NWAVES * 1536;
    { unsigned zz; asm volatile("v_mov_b32 %0, 0" : "=v"(zz)); *(LAS u32x4*)(zr + 16 * lane) = (u32x4){zz, zz, zz, zz}; }
    const LAS unsigned char* xrd = j16 < 3 ? xs + 512 * j16 + 16 * kb : zr;
    constexpr int UPITCH = 528;
    LAS unsigned char* stg = F.lds + 78848 + F.wave * (16 * UPITCH);
    LAS unsigned char* stw = stg + (lane >> 5) * UPITCH + 16 * (lane & 31);
    const LAS unsigned char* strd = stg + j16 * UPITCH + 16 * kb;
    u32x2 A[16], B[16];
    u32x4 UA[8], UB[8];
#define PW_ISSUE(buf, tab, idv, sub) do { _Pragma("unroll") for (int i_ = 0; i_ < 16; ++i_) { const int e_ = __builtin_amdgcn_readlane(idv, (sub) * 16 + i_); buf[i_] = *(const u32x2*)((tab) + (size_t)e_ * 512 + 8 * lane); } } while (0)
#define PU_ISSUE(buf, idv, sub) do { _Pragma("unroll") for (int i_ = 0; i_ < 8; ++i_) { const int e_ = __shfl(idv, (sub) * 16 + 2 * i_ + (lane >> 5)); \
            buf[i_] = *(const u32x4*)(Ub + (size_t)e_ * 512 + 16 * (lane & 31)); } } while (0)
#define PU_DOTS(buf, sub, dreg) do { f32x4 c_ = {0.f, 0.f, 0.f, 0.f}; asm volatile("" ::: "memory"); \
        _Pragma("unroll") for (int i_ = 0; i_ < 8; ++i_) *(LAS u32x4*)(stw + i_ * (2 * UPITCH)) = buf[i_];        \
        _Pragma("unroll") for (int s_ = 0; s_ < 8; ++s_) { const u32x4 bq_ = *(const LAS u32x4*)(strd + 64 * s_); c_ = mfma_x4u4(xq[s_], bq_, c_); } \
        const float dv_ = __shfl(fmaf(c_[2], xs3, fmaf(c_[1], xs2, c_[0] * xs1)), j16); if (kb == (sub)) dreg = dv_; } while (0)
#define PW_ACCUM(buf, cv, sub) do { _Pragma("unroll") for (int i_ = 0; i_ < 16; ++i_) { \
            const float cf_ = __builtin_bit_cast(float, __builtin_amdgcn_readlane(__builtin_bit_cast(int, cv), (sub) * 16 + i_)); const f32x2 cf2_ = {cf_, cf_}; \
            _Pragma("unroll") for (int q_ = 0; q_ < 2; ++q_) { acc[4 * q_] += cf2_ * FP4PAIR(buf[i_][q_], 0); acc[4 * q_ + 1] += cf2_ * FP4PAIR(buf[i_][q_], 1); acc[4 * q_ + 2] += cf2_ * FP4PAIR(buf[i_][q_], 2); acc[4 * q_ + 3] += cf2_ * FP4PAIR(buf[i_][q_], 3); } } } while (0)
    LAS float* cs = (LAS float*)(F.lds + 13312 + F.wave * 8192);
    {
    int m = F.gw;
    u32x4 xa = *(const u32x4*)(XB + (size_t)m * 1024 + 16 * lane), xb = *(const u32x4*)(XB + (size_t)m * 1024 + 16 * lane + 8);
    int id0 = IDX[(size_t)m * 128 + lane], id1 = IDX[(size_t)m * 128 + 64 + lane];
    float g0 = Gw[(size_t)m * 128 + lane], g1 = Gw[(size_t)m * 128 + 64 + lane];
    unsigned sc0 = SCL[(size_t)m * 128 + lane], sc1 = SCL[(size_t)m * 128 + 64 + lane];
    float ssl = lane < 16 ? SS[(size_t)m * 16 + lane] : 0.f;
    PU_ISSUE(UA, id0, 0);
    int it = 0;
#pragma unroll 1
    for (; m < MTOK; m += F.NGW, ++it) {
        unsigned xp[8];
#pragma unroll
        for (int i = 0; i < 4; ++i) { xp[i] = xa[i]; xp[4 + i] = xb[i]; }
        PU_ISSUE(UB, id0, 1);
        const int mn = m + F.NGW < MTOK ? m + F.NGW : m;
        const u32x4 nxa = *(const u32x4*)(XB + (size_t)mn * 1024 + 16 * lane), nxb = *(const u32x4*)(XB + (size_t)mn * 1024 + 16 * lane + 8);
        const int nid0 = IDX[(size_t)mn * 128 + lane], nid1 = IDX[(size_t)mn * 128 + 64 + lane];
        const float ng0 = Gw[(size_t)mn * 128 + lane], ng1 = Gw[(size_t)mn * 128 + 64 + lane];
        const unsigned nsc0 = SCL[(size_t)mn * 128 + lane], nsc1 = SCL[(size_t)mn * 128 + 64 + lane];
        const float nssl = lane < 16 ? SS[(size_t)mn * 16 + lane] : 0.f;
        float xs1, xs2, xs3;
        {
          float xr_[16]; float am = 0.f;
#pragma unroll
          for (int i = 0; i < 8; ++i) { xr_[2 * i] = bflo(xp[i]); xr_[2 * i + 1] = bfhi(xp[i]); am = fmaxf(am, fmaxf(fabsf(xr_[2 * i]), fabsf(xr_[2 * i + 1]))); }
          am = wave_max(am);
          int eb = (int)((__builtin_bit_cast(unsigned, am) >> 23) & 0xFFu); eb = eb < 40 ? 40 : eb;
          xs1 = __builtin_bit_cast(float, (unsigned)(eb - 1) << 23); xs2 = xs1 * 0.25f; xs3 = xs1 * 0.03125f;
#pragma unroll
          for (int t = 0; t < 3; ++t) {
              const float sc_ = t == 0 ? xs1 : t == 1 ? xs2 : xs3;
              u32x2 w;
#pragma unroll
              for (int hw = 0; hw < 2; ++hw) {
                  unsigned ww = 0;
                  ww = __builtin_amdgcn_cvt_scalef32_pk_fp4_f32(ww, xr_[8 * hw + 0], xr_[8 * hw + 1], sc_, 0); ww = __builtin_amdgcn_cvt_scalef32_pk_fp4_f32(ww, xr_[8 * hw + 2], xr_[8 * hw + 3], sc_, 1);
                  ww = __builtin_amdgcn_cvt_scalef32_pk_fp4_f32(ww, xr_[8 * hw + 4], xr_[8 * hw + 5], sc_, 2); ww = __builtin_amdgcn_cvt_scalef32_pk_fp4_f32(ww, xr_[8 * hw + 6], xr_[8 * hw + 7], sc_, 3);
                  w[hw] = ww;
                  if (t < 2) {
                      const f32x2 q0 = __builtin_amdgcn_cvt_scalef32_pk_f32_fp4(ww, sc_, 0), q1 = __builtin_amdgcn_cvt_scalef32_pk_f32_fp4(ww, sc_, 1), q2 = __builtin_amdgcn_cvt_scalef32_pk_f32_fp4(ww, sc_, 2), q3 = __builtin_amdgcn_cvt_scalef32_pk_f32_fp4(ww, sc_, 3);
                      xr_[8 * hw + 0] -= q0.x; xr_[8 * hw + 1] -= q0.y; xr_[8 * hw + 2] -= q1.x; xr_[8 * hw + 3] -= q1.y; xr_[8 * hw + 4] -= q2.x; xr_[8 * hw + 5] -= q2.y; xr_[8 * hw + 6] -= q3.x; xr_[8 * hw + 7] -= q3.y;
                  }
              }
              *(LAS u32x2*)(xs + 512 * t + 8 * lane) = w;
          }
        }
        u32x4 xq[8];
#pragma unroll
        for (int s_ = 0; s_ < 8; ++s_) xq[s_] = *(const LAS u32x4*)(xrd + 64 * s_);
        const float rstd = 1.0f / sqrtf(wave_sum(ssl) * (1.0f / 1024.0f) + EPS);
        float d0 = 0.f, d1 = 0.f;
        PU_DOTS(UA, 0, d0); PU_ISSUE(UA, id0, 2);
        PU_DOTS(UB, 1, d0); PU_ISSUE(UB, id0, 3);
        PU_DOTS(UA, 2, d0); PU_ISSUE(UA, id1, 0);
        PU_DOTS(UB, 3, d0); PU_ISSUE(UB, id1, 1);
        PU_DOTS(UA, 0, d1); PU_ISSUE(UA, id1, 2);
        PU_DOTS(UB, 1, d1); PU_ISSUE(UB, id1, 3);
        PU_DOTS(UA, 2, d1); PU_ISSUE(UA, nid0, 0);
        PU_DOTS(UB, 3, d1);
        const float c0 = g0 * gelu_tanh(d0 * (bflo(sc0) * rstd)) * bfhi(sc0), c1 = g1 * gelu_tanh(d1 * (bflo(sc1) * rstd)) * bfhi(sc1);
        cs[it * 128 + lane] = c0; cs[it * 128 + 64 + lane] = c1;
        xa = nxa; xb = nxb; id0 = nid0; id1 = nid1; g0 = ng0; g1 = ng1; sc0 = nsc0; sc1 = nsc1; ssl = nssl;
    }
    }
    {
    int m = F.gw;
    u32x4 xa = *(const u32x4*)(XB + (size_t)m * 1024 + 16 * lane), xb = *(const u32x4*)(XB + (size_t)m * 1024 + 16 * lane + 8);
    int id0 = IDX[(size_t)m * 128 + lane], id1 = IDX[(size_t)m * 128 + 64 + lane];
    PW_ISSUE(A, Vb, id0, 0);
    int it = 0;
#pragma unroll 1
    for (; m < MTOK; m += F.NGW, ++it) {
        unsigned xp[8];
#pragma unroll
        for (int i = 0; i < 4; ++i) { xp[i] = xa[i]; xp[4 + i] = xb[i]; }
        const float c0 = cs[it * 128 + lane], c1 = cs[it * 128 + 64 + lane];
        const int mn = m + F.NGW < MTOK ? m + F.NGW : m;
        const u32x4 nxa = *(const u32x4*)(XB + (size_t)mn * 1024 + 16 * lane), nxb = *(const u32x4*)(XB + (size_t)mn * 1024 + 16 * lane + 8);
        const int nid0 = IDX[(size_t)mn * 128 + lane], nid1 = IDX[(size_t)mn * 128 + 64 + lane];
        f32x2 acc[8];
#pragma unroll
        for (int q = 0; q < 8; ++q) acc[q] = (f32x2){0.f, 0.f};
        PW_ISSUE(B, Vb, id0, 1); PW_ACCUM(A, c0, 0);
        PW_ISSUE(A, Vb, id0, 2); PW_ACCUM(B, c0, 1);
        PW_ISSUE(B, Vb, id0, 3); PW_ACCUM(A, c0, 2);
        PW_ISSUE(A, Vb, id1, 0); PW_ACCUM(B, c0, 3);
        PW_ISSUE(B, Vb, id1, 1); PW_ACCUM(A, c1, 0);
        PW_ISSUE(A, Vb, id1, 2); PW_ACCUM(B, c1, 1);
        PW_ISSUE(B, Vb, id1, 3); PW_ACCUM(A, c1, 2);
        PW_ISSUE(A, Vb, nid0, 0); PW_ACCUM(B, c1, 3);
        float xo[16]; float s = 0.f;
#pragma unroll
        for (int q = 0; q < 8; ++q) { xo[2 * q] = bflo(xp[q]) + acc[q].x; xo[2 * q + 1] = bfhi(xp[q]) + acc[q].y; }
        if (!last) {
            u32x4 w0, w1;
#pragma unroll
            for (int q = 0; q < 4; ++q) { w0[q] = cvtpk(xo[2 * q], xo[2 * q + 1]); w1[q] = cvtpk(xo[8 + 2 * q], xo[8 + 2 * q + 1]);
                s += (bflo(w0[q]) * bflo(w0[q]) + bfhi(w0[q]) * bfhi(w0[q])) + (bflo(w1[q]) * bflo(w1[q]) + bfhi(w1[q]) * bfhi(w1[q])); }
            s = wave_sum(s);
            *(u32x4*)(XB + (size_t)m * 1024 + 16 * lane) = w0; *(u32x4*)(XB + (size_t)m * 1024 + 16 * lane + 8) = w1;
            if (lane < 16) SS[(size_t)m * 16 + lane] = lane == 0 ? s : 0.f;
        } else {
#pragma unroll
            for (int q = 0; q < 16; ++q) s += xo[q] * xo[q];
            s = wave_sum(s);
            const float rf = 1.0f / sqrtf(s * (1.0f / 1024.0f) + EPS); const float* fg = INP(I_FINAL_G) + 16 * lane; float* xr = F.X + (size_t)m * 1024 + 16 * lane;
#pragma unroll
            for (int q = 0; q < 4; ++q) { const f32x4 gq = *(const f32x4*)(fg + 4 * q); *(f32x4*)(xr + 4 * q) = (f32x4){xo[4 * q], xo[4 * q + 1], xo[4 * q + 2], xo[4 * q + 3]} * rf * gq; }
        }
        xa = nxa; xb = nxb; id0 = nid0; id1 = nid1;
    }
    }
#undef PW_ISSUE
#undef PU_ISSUE
#undef PU_DOTS
#undef PW_ACCUM
}

constexpr int PPL = 7;
constexpr int NPHASE = 1 + DEPTH * PPL;
__global__ void __launch_bounds__(NTHR, 2) trunk_fwd(Args args) {
    extern __shared__ __attribute__((aligned(16))) unsigned char lds_raw[];
    Frame F;
    F.lds = (LAS unsigned char*)lds_raw;
    F.tid = threadIdx.x; F.lane = F.tid & 63; F.wave = __builtin_amdgcn_readfirstlane(F.tid >> 6);
    F.bx = blockIdx.x; F.gw = F.bx * NWAVES + F.wave;
    F.X = args.out; F.ws = args.ws;
    const int lo = args.ph_lo, hi = args.ph_hi;
#if MK_ONE_LAUNCH
    volatile LAS unsigned* bst = (volatile LAS unsigned*)(F.lds + LDS_BYTES - 64);
    if (F.tid < 16) bst[F.tid] = 0u;
    __syncthreads();
    const XcdBarrier gbar = xcd_barrier_post((unsigned*)(args.ws + WS_CTL) + 4096, bst);
    cg::this_grid().sync();
#endif
#define REFRESH() int t_ = threadIdx.x; asm volatile("" : "+v"(t_)); F.tid = t_; F.lane = t_ & 63; F.wave = __builtin_amdgcn_readfirstlane(t_ >> 6); \
    F.gw = F.bx * NWAVES + F.wave; size_t z_ = 0; asm volatile("" : "+s"(z_)); unsigned char* ws = args.ws + z_; F.ws = ws; \
    bf16_t* XB = (bf16_t*)(ws + WS_XB); float* SS = (float*)(ws + WS_SS); bf16_t* YC = (bf16_t*)(ws + WS_YCAT); bf16_t* PROJ = (bf16_t*)(ws + WS_PROJ); \
    bf16_t* CQ = PROJ; bf16_t* PP = (bf16_t*)(ws + WS_PROJ + 64 * MiB); int* IDX = (int*)(ws + WS_PROJ + 64 * MiB); float* GW = (float*)(ws + WS_PROJ + 80 * MiB); \
    bf16_t* Wl = (bf16_t*)(ws + WS_W + l * W_LAYER); bf16_t* Kl = (bf16_t*)(ws + WS_KMEM + (size_t)l * 16 * MiB); bf16_t* VTl = Kl + (size_t)4096 * 1024; \
    (void)XB; (void)SS; (void)YC; (void)PROJ; (void)CQ; (void)PP; (void)IDX; (void)GW; (void)Wl; (void)Kl; (void)VTl;
#pragma unroll 1
    for (int ph = lo; ph < hi; ++ph) {
        const int l = ph == 0 ? 0 : (ph - 1) / PPL, k = ph == 0 ? -1 : (ph - 1) % PPL;
        for (int rep = 0; rep < ((k == PROBE_REP_K) ? 2 : 1); ++rep) {
        if (rep) { WG_SYNC(); xcd_barrier(gbar); }
        switch (k) {
        case -1: if (EN(0)) { REFRESH(); p0_prologue(F, args); } break;
        case 0: case 3: case 5: if (EN(1)) {
            REFRESH();
            if (k == 0 && l == 0) {
#pragma unroll 1
                for (int l2 = 0; l2 < DEPTH; ++l2) {
                    bf16_t* W2 = (bf16_t*)(ws + WS_W + l2 * W_LAYER); bf16_t* K2 = (bf16_t*)(ws + WS_KMEM + (size_t)l2 * 16 * MiB);
                    pg8::Gemm g{(const bf16_t*)(ws + WS_MEMB), W2 + W_CKV / 2, 1024, 1024, 1024}; pg8::StaticOrder S; S.init(MMEM, 2048, F.G, (F.bx + 128 * l2) % F.G, 1024, 1024);
                    pg8::EpiKV E{K2, K2 + (size_t)4096 * 1024, (const float*)(ws + WS_RSTDM)};
                    pg8::gemm_phase<pg8::EpiKV, pg8::StaticOrder, true>(F.lds, g, S, E);
                }
            }
            const bf16_t* Bt = Wl + (k == 0 ? W_IN : k == 3 ? W_CQ : W_PQ) / 2; const int N = k == 0 ? NPROJ : 1024, ldc = k == 0 ? LDP : 1024;
            pg8::Gemm g{XB, Bt, 1024, 1024, 1024}; pg8::StaticOrder S; S.init(MTOK, N, F.G, F.bx, 1024, 1024);
            pg8::EpiBf16 E{k == 0 ? PROJ : CQ, ldc, SS, k == 3 ? 0.0625f * LOG2E : 1.0f, ldc};
            pg8::gemm_phase<pg8::EpiBf16, pg8::StaticOrder, true>(F.lds, g, S, E);
            if (k == 3) {
                pg8::Unit u;
                for (int i = 0; S.next(i, u); ++i) xattn_unit(F, CQ, Kl, VTl, YC, u.pm, u.pn);
            } else if (k == 5) {
                const bf16_t* SK = (const bf16_t*)(ws + WS_SUBK) + (size_t)l * 8 * 2 * 128 * 64;
                LAS unsigned* SCT = (LAS unsigned*)(F.lds + 65536);
                { const u32x4* src = (const u32x4*)(ws + WS_TAB + 32 * MiB + (size_t)l * 65536);
                  for (int i = F.tid; i < 4096; i += NTHR) *(LAS u32x4*)((LAS char*)SCT + 16 * i) = src[i];
                  LDS_SYNC(); }
                LAS char* scr = (LAS char*)F.lds + F.wave * 8192;
                pg8::Unit u;
                for (int i = 0; S.next(i, u); ++i)
                    route_pair(CQ, SK, IDX, GW, (unsigned*)(ws + WS_PROJ + 96 * MiB), SCT, u.pm * 8 + 2 * (F.wave & 3), 2 * u.pn + (F.wave >> 2), F.lane, scr);
            }
        } break;
        case 1: {
            REFRESH();
            if (F.bx < 64) { if (EN(2)) gla_chain(F, args, l, F.bx >> 2, F.bx & 3, PROJ, YC); }
            else {
                if (l == 0) {
                    const int wv = (F.bx - 64) * NWAVES + F.wave, nwv = (F.G - 64) * NWAVES;
                    transpose_list(F, args, (LAS float*)(F.lds + F.wave * 16384), wv, nwv, 1);
                    convert_tables(F, args, 0, wv, nwv); convert_tables(F, args, 1, wv, nwv);
                    WG_SYNC();
                }
                if (EN(3)) { for (int u = F.bx - 64; u < 256; u += F.G - 64) sgu_unit(F, args, l, u >> 4, u & 15, PROJ, YC); }
            }
            if (EN(4)) { LAS char* vl = (LAS char*)F.lds + F.wave * 8192; unsigned* ctr = (unsigned*)(ws + WS_CTL) + 15360 + 64 * l;
                for (;;) { int u0 = 0; if (F.lane == 0) u0 = (int)atomicAdd(ctr, 2u); u0 = __builtin_amdgcn_readfirstlane(u0); if (u0 >= BATCH * 8 * 32) break;
                    for (int u = u0; u < u0 + 2; ++u) sb_unit2(PROJ, YC, u >> 8, (u >> 5) & 7, u & 31, vl, F.lane); } }
        } break;
        case 2: case 4: if (EN(5)) {
            REFRESH();
            pg8::Gemm g{YC, Wl + (k == 2 ? W_OUT : W_CO) / 2, 1024, 1024, 1024}; pg8::StaticOrder S; S.init(MTOK, 1024, F.G, F.bx, 1024, 1024);
            pg8::EpiResid E{XB, SS};
            pg8::gemm_phase<pg8::EpiResid, pg8::StaticOrder, true>(F.lds, g, S, E);
        } break;
        default: if (EN(12)) {
            REFRESH();
            const unsigned char* Ub = ws + WS_TAB + (size_t)l * 16 * MiB; const unsigned char* Vb = Ub + 8 * MiB;
            peer_wave(F, args, l == DEPTH - 1, Ub, Vb, (const unsigned*)(ws + WS_PROJ + 96 * MiB), IDX, GW, XB, SS);
        } break;
        }
        }
        WG_SYNC();
#if MK_ONE_LAUNCH
        if (ph + 1 < hi) xcd_barrier(gbar);
#endif
    }
#undef REFRESH
}

extern "C" void kernel_launch(void* const* d_in, const int* in_sizes, int n_in, void* d_out, int out_size, void* d_ws, size_t ws_size, hipStream_t stream) {
    static int grid = 0;
    if (grid == 0) {
        if (n_in != 22 || out_size != MTOK * DM || ws_size < WS_END) { fprintf(stderr, "kernel_launch: unexpected problem (n_in %d out %d ws %zu)\n", n_in, out_size, ws_size); grid = -1; return; }
        int dev = 0, cus = 0, per_cu = 0;
        if (hipGetDevice(&dev) != hipSuccess || hipDeviceGetAttribute(&cus, hipDeviceAttributeMultiprocessorCount, dev) != hipSuccess) { grid = -1; return; }
        if (hipFuncSetAttribute((const void*)trunk_fwd, hipFuncAttributeMaxDynamicSharedMemorySize, LDS_BYTES) != hipSuccess) { fprintf(stderr, "kernel_launch: hipFuncSetAttribute failed\n"); grid = -1; return; }
        if (hipOccupancyMaxActiveBlocksPerMultiprocessor(&per_cu, (const void*)trunk_fwd, NTHR, LDS_BYTES) != hipSuccess || per_cu < 1) { fprintf(stderr, "kernel_launch: occupancy query says %d\n", per_cu); (void)hipGetLastError(); grid = -1; return; }
        if (cus * per_cu < GRID) { fprintf(stderr, "kernel_launch: built for a %d-workgroup resident grid, this device holds %d\n", GRID, cus * per_cu); grid = -1; return; }
        grid = GRID;
    }
    if (grid < 0) return;
    Args a{};
    for (int i = 0; i < 22; ++i) a.in[i] = (const float*)d_in[i];
    a.out = (float*)d_out; a.ws = (unsigned char*)d_ws;
#if MK_ONE_LAUNCH
    if (hipMemsetAsync((char*)d_ws + WS_CTL, 0, 65536, stream) != hipSuccess) { fprintf(stderr, "kernel_launch: memset of the control words failed\n"); return; }
    a.ph_lo = 0; a.ph_hi = NPHASE;
    void* kargs[] = {&a};
    hipError_t e = hipLaunchCooperativeKernel((const void*)trunk_fwd, dim3(grid), dim3(NTHR), kargs, LDS_BYTES, stream);
    if (e != hipSuccess) fprintf(stderr, "cooperative launch failed: %s (grid %d)\n", hipGetErrorString(e), grid);
#else
    for (int p = 0; p < NPHASE; ++p) { a.ph_lo = p; a.ph_hi = p + 1; hipLaunchKernelGGL(trunk_fwd, dim3(grid), dim3(NTHR), LDS_BYTES, stream, a); }
#endif
}
```

```cpp
#include <hip/hip_runtime.h>
#include <hip/hip_cooperative_groups.h>
#include <cstdio>
#include <cstdint>
#include <cmath>
namespace cg = cooperative_groups;

#ifndef PHMASK
#define PHMASK 0xFFFF
#endif
#define EN(n) (((PHMASK) >> (n)) & 1)
#ifndef PROBE_REP_K
#define PROBE_REP_K (-2)
#endif
#ifndef MK_ONE_LAUNCH
#define MK_ONE_LAUNCH 1
#endif

#define LAS __attribute__((address_space(3)))
typedef unsigned short bf16_t;
typedef short bf16x8 __attribute__((ext_vector_type(8)));
typedef short s16x4 __attribute__((ext_vector_type(4)));
typedef short v4i16_t __attribute__((ext_vector_type(4)));
typedef float f32x4 __attribute__((ext_vector_type(4)));
typedef float f32x2 __attribute__((ext_vector_type(2)));
typedef float f32x16 __attribute__((ext_vector_type(16)));
typedef unsigned u32x4 __attribute__((ext_vector_type(4)));
typedef unsigned u32x2 __attribute__((ext_vector_type(2)));
typedef __bf16 bf16x2_t __attribute__((ext_vector_type(2)));
#define DI __device__ __forceinline__
#define MFMA32(a, b, c) __builtin_amdgcn_mfma_f32_32x32x16_bf16((a), (b), (c), 0, 0, 0)

constexpr int BATCH = 16, SEQ = 2048, DM = 1024, MTOK = BATCH * SEQ, DEPTH = 2;
constexpr int NMEM = 256, MMEM = BATCH * NMEM;
constexpr int INW = 2832, LDP = 2944, NPROJ = 3072;
constexpr int C_SBQ = 0, C_SBK = 512, C_SBV = 1024, C_SGU = 1536, C_SGV = 1792, C_GQ = 2048, C_GK = 2176, C_GV = 2304, C_GO = 2560, C_GA = 2816;
constexpr float EPS = 1e-6f;
constexpr float LOG2E = 1.4426950408889634f;

constexpr size_t MiB = 1u << 20;
constexpr size_t WS_CTL = 0;
constexpr size_t WS_SUBK = 1 * MiB;
constexpr size_t WS_WSP = WS_SUBK + 512 * 1024;
constexpr size_t WS_RSTDM = WS_WSP + 256 * 1024;
constexpr size_t WS_SS = 2 * MiB;
constexpr size_t WS_W = 8 * MiB;
constexpr size_t W_IN = 0, W_OUT = 6 * MiB, W_CQ = 8 * MiB, W_CKV = 10 * MiB, W_CO = 14 * MiB, W_PQ = 16 * MiB, W_LAYER = 18 * MiB;
constexpr size_t WS_MEMB = 44 * MiB;
constexpr size_t WS_KMEM = 52 * MiB;
constexpr size_t WS_TAB = 84 * MiB;
constexpr size_t WS_XB = 148 * MiB;
constexpr size_t WS_YCAT = 212 * MiB;
constexpr size_t WS_PROJ = 276 * MiB;
constexpr size_t WS_GKV = 460 * MiB;
constexpr size_t WS_GD = 468 * MiB;
constexpr size_t WS_END = 469 * MiB;

DI unsigned cvtpk(float lo, float hi) { f32x2 v = {lo, hi}; bf16x2_t b = __builtin_convertvector(v, bf16x2_t); return __builtin_bit_cast(unsigned, b); }
DI bf16_t cvt1(float v) { return (bf16_t)(cvtpk(v, 0.f) & 0xffffu); }
DI float bf2f(unsigned short b) { return __uint_as_float((unsigned)b << 16); }
DI float bflo(unsigned w) { return __uint_as_float(w << 16); }
DI float bfhi(unsigned w) { return __uint_as_float(w & 0xffff0000u); }
DI int crow(int r, int hi) { return (r & 3) + 8 * (r >> 2) + 4 * hi; }
DI float fexp2(float x) { return __builtin_amdgcn_exp2f(x); }
DI float flog2(float x) { return __builtin_amdgcn_logf(x); }
DI float frcp(float x) { return __builtin_amdgcn_rcpf(x); }
DI float gelu_tanh(float x) { const float y2 = x * (1.5957691216057308f + 0.0713548162726009f * x * x); return x * frcp(1.f + fexp2(-y2 * LOG2E)); }
DI float silu(float x) { return x * frcp(1.f + fexp2(-x * LOG2E)); }
DI float wave_sum(float v) {
#pragma unroll
    for (int o = 1; o < 64; o <<= 1) v += __shfl_xor(v, o);
    return v;
}
DI s16x4 vtr(LAS const char* p) { return __builtin_bit_cast(s16x4, __builtin_amdgcn_ds_read_tr16_b64_v4i16((LAS v4i16_t*)p)); }
DI bf16x8 cat8(s16x4 lo, s16x4 hi) { return __builtin_shufflevector(lo, hi, 0, 1, 2, 3, 4, 5, 6, 7); }
DI bf16x8 pack8(float a0, float a1, float a2, float a3, float a4, float a5, float a6, float a7) {
    u32x4 p; p[0] = cvtpk(a0, a1); p[1] = cvtpk(a2, a3); p[2] = cvtpk(a4, a5); p[3] = cvtpk(a6, a7); return __builtin_bit_cast(bf16x8, p);
}
#define LDS_WAIT() asm volatile("s_waitcnt lgkmcnt(0)" ::: "memory")
#define LDS_SYNC() do { asm volatile("s_waitcnt lgkmcnt(0)" ::: "memory"); __builtin_amdgcn_s_barrier(); asm volatile("" ::: "memory"); } while (0)
#define WG_SYNC() do { asm volatile("s_waitcnt vmcnt(0) lgkmcnt(0)" ::: "memory"); __builtin_amdgcn_s_barrier(); asm volatile("" ::: "memory"); } while (0)

namespace pg8 {
constexpr int BM = 256, BK = 64, HALF = 128, HTB = HALF * BK * 2, STAGE_BYTES = 8 * HTB, NXCD = 8, WGM = 8;
__host__ __device__ __forceinline__ int lds_byte(int r, int c) { const int st = (r >> 4) * 2 + (c >> 5), rr = r & 15, cc = c & 31, ob = rr * 64 + cc * 2; return st * 1024 + (ob ^ (((ob >> 9) & 1) << 5)); }
__host__ __device__ __forceinline__ void stage_rc(int b, int& R, int& C) { const int st = b / 1024, sb = b % 1024, swz = sb ^ (((sb >> 9) & 1) << 5); R = (st >> 1) * 16 + swz / 64; C = (st & 1) * 32 + (swz % 64) / 2; }
__host__ __device__ __forceinline__ int perm32(int rho) { const int n = rho >> 4, i = rho & 15; return 8 * (i >> 2) + 4 * n + (i & 3); }

struct Unit { int pm, pn; size_t aoff, boff; };
struct Gemm { const bf16_t* A; const bf16_t* Bt; int lda, ldb, K; };

struct StaticOrder {
    int nM, nN, nwg, G, c, lda, ldb;
    __device__ void init(int M, int N, int G_, int c_, int lda_, int ldb_) { nM = M / BM; nN = N / BM; nwg = nM * nN; G = G_; c = c_; lda = lda_; ldb = ldb_; }
    __device__ bool next(int i, Unit& u) const {
        const long L = (long)i * G + c; if (L >= nwg) return false;
        int wgid = (int)L; { const int q = nwg / NXCD, r = nwg % NXCD, xcd = wgid % NXCD, off = wgid / NXCD; wgid = (xcd < r ? xcd * (q + 1) : r * (q + 1) + (xcd - r) * q) + off; }
        const int nig = WGM * nN, gid = wgid / nig, fm = gid * WGM, gsz = (nM - fm) < WGM ? (nM - fm) : WGM;
        u.pm = fm + ((wgid % nig) % gsz); u.pn = (wgid % nig) / gsz;
        u.aoff = (size_t)u.pm * BM * lda; u.boff = (size_t)u.pn * BM * ldb; return true;
    }
};
struct XOrder {
    int G, c, mode;
    __device__ bool next(int i, Unit& u) const {
        const int L = i * G + c; if (L >= 512) return false;
        u.pm = L >> 2; u.pn = L & 3; const int b = u.pm >> 3;
        u.aoff = (size_t)u.pm * 256 * 1024 + u.pn * 256;
        u.boff = mode == 0 ? (size_t)b * 256 * 1024 + u.pn * 256 : (size_t)(b * 4 + u.pn) * 256 * 256;
        return true;
    }
};

struct XOrder2 {
    StaticOrder S; int mode;
    __device__ bool next(int i, Unit& u) const {
        if (!S.next(i, u)) return false; const int b = u.pm >> 3;
        u.aoff = (size_t)u.pm * 256 * 1024 + u.pn * 256;
        u.boff = mode == 0 ? (size_t)b * 256 * 1024 + u.pn * 256 : (size_t)(b * 4 + u.pn) * 256 * 256;
        return true;
    }
};

DI float row_rstd_from_ss(const float* ss, int row, int fq) {
    const f32x4 v = *(const f32x4*)(ss + (size_t)row * 16 + 4 * fq);
    float s = (v[0] + v[1]) + (v[2] + v[3]); s += __shfl_xor(s, 16); s += __shfl_xor(s, 32);
    return 1.0f / sqrtf(s * (1.0f / 1024.0f) + EPS);
}
struct EpiBf16 {
    static constexpr bool PERM = true;
    bf16_t* O; int ldc; const float* ss; float cscale; int ncols;
    DI void operator()(f32x4 (&acc)[2][2][4][2], const Unit& u, int wr, int wc, int fr, int fq) const {
        const int row0 = u.pm * BM + wr * 64 + fr, col0 = u.pn * BM + wc * 32 + 8 * fq;
#pragma unroll
        for (int ai = 0; ai < 2; ++ai)
#pragma unroll
            for (int m = 0; m < 4; ++m) {
                const int row = row0 + ai * HALF + m * 16;
                float rs = cscale; if (ss) rs *= row_rstd_from_ss(ss, row, fq);
                bf16_t* rowp = O + (size_t)row * ldc + col0;
#pragma unroll
                for (int bj = 0; bj < 2; ++bj) if (col0 + bj * HALF < ncols) {
                    const f32x4 v0 = acc[ai][bj][m][0] * rs, v1 = acc[ai][bj][m][1] * rs;
                    u32x4 w; w.x = cvtpk(v0[0], v0[1]); w.y = cvtpk(v0[2], v0[3]); w.z = cvtpk(v1[0], v1[1]); w.w = cvtpk(v1[2], v1[3]);
                    *(u32x4*)(rowp + bj * HALF) = w; }
            }
    }
};
struct EpiKV {
    static constexpr bool PERM = true;
    bf16_t* Kd; bf16_t* VT; const float* rvec;
    DI void operator()(f32x4 (&acc)[2][2][4][2], const Unit& u, int wr, int wc, int fr, int fq) const {
        const int row0 = u.pm * BM + wr * 64 + fr;
#pragma unroll
        for (int ai = 0; ai < 2; ++ai)
#pragma unroll
            for (int m = 0; m < 4; ++m) {
                const int row = row0 + ai * HALF + m * 16; const float rs = rvec[row];
#pragma unroll
                for (int bj = 0; bj < 2; ++bj) {
                    const f32x4 v0 = acc[ai][bj][m][0] * rs, v1 = acc[ai][bj][m][1] * rs;
                    const unsigned w0 = cvtpk(v0[0], v0[1]), w1 = cvtpk(v0[2], v0[3]), w2 = cvtpk(v1[0], v1[1]), w3 = cvtpk(v1[2], v1[3]);
                    if (u.pn < 4) {
                        u32x4 w; w.x = w0; w.y = w1; w.z = w2; w.w = w3;
                        *(u32x4*)(Kd + (size_t)row * 1024 + u.pn * BM + bj * HALF + wc * 32 + 8 * fq) = w;
                    } else {
                        const int key = row & 255, dv0 = bj * HALF + wc * 32 + 8 * fq;
                        bf16_t* p = VT + ((size_t)(u.pm * 4 + (u.pn - 4)) * 256 + dv0) * 256 + key;
                        p[0 * 256] = (bf16_t)w0; p[1 * 256] = (bf16_t)(w0 >> 16); p[2 * 256] = (bf16_t)w1; p[3 * 256] = (bf16_t)(w1 >> 16);
                        p[4 * 256] = (bf16_t)w2; p[5 * 256] = (bf16_t)(w2 >> 16); p[6 * 256] = (bf16_t)w3; p[7 * 256] = (bf16_t)(w3 >> 16);
                    }
                }
            }
    }
};
struct EpiResid {
    static constexpr bool PERM = true;
    bf16_t* XB; float* ss;
    DI void operator()(f32x4 (&acc)[2][2][4][2], const Unit& u, int wr, int wc, int fr, int fq) const {
        const int row0 = u.pm * BM + wr * 64 + fr, col0 = u.pn * BM + wc * 32 + 8 * fq;
#pragma unroll
        for (int ai = 0; ai < 2; ++ai)
#pragma unroll
            for (int m = 0; m < 4; ++m) {
                const int row = row0 + ai * HALF + m * 16; float s = 0.f;
#pragma unroll
                for (int bj = 0; bj < 2; ++bj) {
                    const size_t off = (size_t)row * 1024 + col0 + bj * HALF;
                    const u32x4 o = *(const u32x4*)(XB + off); const f32x4 a0 = acc[ai][bj][m][0], a1 = acc[ai][bj][m][1];
                    u32x4 w; w.x = cvtpk(bflo(o.x) + a0[0], bfhi(o.x) + a0[1]); w.y = cvtpk(bflo(o.y) + a0[2], bfhi(o.y) + a0[3]);
                    w.z = cvtpk(bflo(o.z) + a1[0], bfhi(o.z) + a1[1]); w.w = cvtpk(bflo(o.w) + a1[2], bfhi(o.w) + a1[3]);
                    *(u32x4*)(XB + off) = w;
#pragma unroll
                    for (int q = 0; q < 4; ++q) { const float x0 = bflo(w[q]), x1 = bfhi(w[q]); s += x0 * x0 + x1 * x1; }
                }
                s += __shfl_xor(s, 16); s += __shfl_xor(s, 32);
                if (fq == 0) ss[(size_t)row * 16 + u.pn * 4 + wc] = s;
            }
    }
};
struct EpiSoftmax {
    static constexpr bool PERM = true;
    bf16_t* P; LAS float* xm; LAS float* xs;
    DI void operator()(f32x4 (&acc)[2][2][4][2], const Unit& u, int wr, int wc, int fr, int fq) const {
#pragma unroll
        for (int ai = 0; ai < 2; ++ai)
#pragma unroll
            for (int m = 0; m < 4; ++m) {
                float v = -INFINITY;
#pragma unroll
                for (int bj = 0; bj < 2; ++bj)
#pragma unroll
                    for (int n = 0; n < 2; ++n) { const f32x4 x = acc[ai][bj][m][n]; v = fmaxf(v, fmaxf(fmaxf(x[0], x[1]), fmaxf(x[2], x[3]))); }
                v = fmaxf(v, __shfl_xor(v, 16)); v = fmaxf(v, __shfl_xor(v, 32));
                if (fq == 0) xm[(ai * HALF + wr * 64 + m * 16 + fr) * 4 + wc] = v;
            }
        LDS_WAIT(); __builtin_amdgcn_s_barrier(); asm volatile("" ::: "memory");
#pragma unroll
        for (int ai = 0; ai < 2; ++ai)
#pragma unroll
            for (int m = 0; m < 4; ++m) {
                const f32x4 q = *(LAS const f32x4*)(xm + (ai * HALF + wr * 64 + m * 16 + fr) * 4);
                const float g = fmaxf(fmaxf(q[0], q[1]), fmaxf(q[2], q[3])); float s = 0.f;
#pragma unroll
                for (int bj = 0; bj < 2; ++bj)
#pragma unroll
                    for (int n = 0; n < 2; ++n) { f32x4 x = acc[ai][bj][m][n]; x[0] = fexp2(x[0] - g); x[1] = fexp2(x[1] - g); x[2] = fexp2(x[2] - g); x[3] = fexp2(x[3] - g); acc[ai][bj][m][n] = x; s += (x[0] + x[1]) + (x[2] + x[3]); }
                s += __shfl_xor(s, 16); s += __shfl_xor(s, 32);
                if (fq == 0) xs[(ai * HALF + wr * 64 + m * 16 + fr) * 4 + wc] = s;
            }
        LDS_WAIT(); __builtin_amdgcn_s_barrier(); asm volatile("" ::: "memory");
        const int row0 = u.pm * BM + wr * 64 + fr, col0 = u.pn * BM + wc * 32 + 8 * fq;
#pragma unroll
        for (int ai = 0; ai < 2; ++ai)
#pragma unroll
            for (int m = 0; m < 4; ++m) {
                const f32x4 q = *(LAS const f32x4*)(xs + (ai * HALF + wr * 64 + m * 16 + fr) * 4);
                const float inv = 1.0f / ((q[0] + q[1]) + (q[2] + q[3]));
                bf16_t* rowp = P + (size_t)(row0 + ai * HALF + m * 16) * 1024 + col0;
#pragma unroll
                for (int bj = 0; bj < 2; ++bj) {
                    const f32x4 v0 = acc[ai][bj][m][0] * inv, v1 = acc[ai][bj][m][1] * inv;
                    u32x4 w; w.x = cvtpk(v0[0], v0[1]); w.y = cvtpk(v0[2], v0[3]); w.z = cvtpk(v1[0], v1[1]); w.w = cvtpk(v1[2], v1[3]);
                    *(u32x4*)(rowp + bj * HALF) = w; }
            }
    }
};

template <class Epi, class Sched, bool ALIGN_EPI>
__device__ __forceinline__ void gemm_phase(LAS unsigned char* lds, const Gemm g, const Sched& S, const Epi& E) {
    int tid = threadIdx.x; asm volatile("" : "+v"(tid));
    const int wid = __builtin_amdgcn_readfirstlane(tid >> 6), lane = tid & 63, wr = wid >> 2, wc = wid & 3, fr = lane & 15, fq = lane >> 4;
    const int K = g.K, nt = K / BK;
    unsigned voffA[2], voffB[2];
#pragma unroll
    for (int i = 0; i < 2; ++i) { int R, C; stage_rc(tid * 16 + i * 8192, R, C); const int Rb = Epi::PERM ? ((R & ~31) + perm32(R & 31)) : R;
        voffA[i] = (unsigned)(R * g.lda + C) * 2u; voffB[i] = (unsigned)(Rb * g.ldb + C) * 2u; }
    const size_t kstep = (size_t)(BK * 2);
    const size_t hstepA = (size_t)HALF * g.lda * 2, hstepB = (size_t)HALF * g.ldb * 2;
    const unsigned ldsw = (unsigned)wid * 1024u;
    const int aoff = lds_byte(wr * 64 + fr, fq * 8), boff = lds_byte(wc * 32 + fr, fq * 8);
#define PG8_SA(b, h) (((b) * 2 + (h)) * HTB)
#define PG8_SB(b, h) ((4 + (b) * 2 + (h)) * HTB)
#define PG8_STAGE(bufoff, gbase, voff) do { _Pragma("unroll") for (int _i = 0; _i < 2; ++_i) \
        __builtin_amdgcn_global_load_lds((const unsigned*)((const char*)(gbase) + (voff)[_i]), (LAS unsigned*)(lds + (bufoff) + ldsw + _i * 8192), 16, 0, 0); } while (0)
#define PG8_LDA(dst, b, h) do { _Pragma("unroll") for (int m = 0; m < 4; ++m) _Pragma("unroll") for (int k = 0; k < 2; ++k) dst[m][k] = *(const LAS bf16x8*)(lds + PG8_SA(b, h) + aoff + m * 2048 + k * 1024); } while (0)
#define PG8_LDB(dst, b, h) do { _Pragma("unroll") for (int n = 0; n < 2; ++n) _Pragma("unroll") for (int k = 0; k < 2; ++k) dst[n][k] = *(const LAS bf16x8*)(lds + PG8_SB(b, h) + boff + n * 2048 + k * 1024); } while (0)
#define PG8_MMA(ai, bj, At, Bt) do { __builtin_amdgcn_s_setprio(1); _Pragma("unroll") for (int m = 0; m < 4; ++m) _Pragma("unroll") for (int n = 0; n < 2; ++n) _Pragma("unroll") for (int k = 0; k < 2; ++k) \
        acc[ai][bj][m][n] = __builtin_amdgcn_mfma_f32_16x16x32_bf16(Bt[n][k], At[m][k], acc[ai][bj][m][n], 0, 0, 0); __builtin_amdgcn_s_setprio(0); } while (0)
#define PG8_WAIT_V(n) asm volatile("s_waitcnt vmcnt(" #n ")" ::: "memory")
#define PG8_WAIT_L(n) asm volatile("s_waitcnt lgkmcnt(" #n ")" ::: "memory")
#define PG8_BAR __builtin_amdgcn_s_barrier()
#define PG8_SCHED __builtin_amdgcn_sched_barrier(0)
    Unit cur, nxt; int ui = 0;
    if (!S.next(0, cur)) return;
    f32x4 acc[2][2][4][2];
#pragma unroll
    for (int a = 0; a < 2; ++a)
#pragma unroll
        for (int b = 0; b < 2; ++b)
#pragma unroll
            for (int m = 0; m < 4; ++m)
#pragma unroll
                for (int n = 0; n < 2; ++n) acc[a][b][m][n] = (f32x4){0.f, 0.f, 0.f, 0.f};
    bf16x8 At[4][2], B0[2][2], B1[2][2];
    const char* cA = (const char*)g.A + cur.aoff * 2; const char* cB = (const char*)g.Bt + cur.boff * 2;
    PG8_STAGE(PG8_SB(0, 0), cB, voffB); PG8_STAGE(PG8_SB(0, 1), cB + hstepB, voffB); PG8_STAGE(PG8_SA(0, 0), cA, voffA); PG8_STAGE(PG8_SA(0, 1), cA + hstepA, voffA);
    if (wr == 1) PG8_BAR;
    PG8_WAIT_V(2); PG8_BAR;
    PG8_STAGE(PG8_SB(1, 0), cB + kstep, voffB); PG8_STAGE(PG8_SA(1, 0), cA + kstep, voffA); PG8_STAGE(PG8_SB(1, 1), cB + hstepB + kstep, voffB);
    PG8_WAIT_V(6); PG8_BAR;
    for (;;) {
        const bool has_next = S.next(ui + 1, nxt);
        const char* nA = has_next ? (const char*)g.A + nxt.aoff * 2 : cA; const char* nB = has_next ? (const char*)g.Bt + nxt.boff * 2 : cB;
#pragma unroll 1
        for (int t = 0; t < nt; t += 2) {
            const bool last = (t == nt - 2);
            const char* a1 = cA + (size_t)(t + 1) * kstep;
            const char* a2 = last ? nA : cA + (size_t)(t + 2) * kstep; const char* b2 = last ? nB : cB + (size_t)(t + 2) * kstep;
            const char* a3 = a2 + kstep; const char* b3 = b2 + kstep;
            PG8_LDB(B0, 0, 0); PG8_LDB(B1, 0, 1); PG8_SCHED; PG8_LDA(At, 0, 0); PG8_STAGE(PG8_SA(1, 1), a1 + hstepA, voffA);
            PG8_WAIT_V(8); PG8_WAIT_L(0); PG8_BAR; PG8_MMA(0, 0, At, B0); PG8_MMA(0, 1, At, B1); PG8_BAR; PG8_SCHED;
            PG8_LDA(At, 0, 1); PG8_STAGE(PG8_SB(0, 0), b2, voffB); PG8_STAGE(PG8_SB(0, 1), b2 + hstepB, voffB); PG8_STAGE(PG8_SA(0, 0), a2, voffA);
            PG8_WAIT_V(8); PG8_WAIT_L(0); PG8_BAR; PG8_MMA(1, 0, At, B0); PG8_MMA(1, 1, At, B1); PG8_BAR; PG8_SCHED;
            PG8_LDB(B0, 1, 0); PG8_LDB(B1, 1, 1); PG8_SCHED; PG8_LDA(At, 1, 0); PG8_STAGE(PG8_SA(0, 1), a2 + hstepA, voffA);
            PG8_WAIT_V(8); PG8_WAIT_L(0); PG8_BAR; PG8_MMA(0, 0, At, B0); PG8_MMA(0, 1, At, B1); PG8_BAR; PG8_SCHED;
            PG8_LDA(At, 1, 1); PG8_STAGE(PG8_SB(1, 0), b3, voffB); PG8_STAGE(PG8_SB(1, 1), b3 + hstepB, voffB); PG8_STAGE(PG8_SA(1, 0), a3, voffA);
            PG8_WAIT_V(8); PG8_WAIT_L(0); PG8_BAR; PG8_MMA(1, 0, At, B0); PG8_MMA(1, 1, At, B1); PG8_BAR; PG8_SCHED;
        }
        if constexpr (ALIGN_EPI) { if (wr == 0) PG8_BAR; }
        E(acc, cur, wr, wc, fr, fq);
        if (!has_next) break;
#pragma unroll
        for (int a = 0; a < 2; ++a)
#pragma unroll
            for (int b = 0; b < 2; ++b)
#pragma unroll
                for (int m = 0; m < 4; ++m)
#pragma unroll
                    for (int n = 0; n < 2; ++n) acc[a][b][m][n] = (f32x4){0.f, 0.f, 0.f, 0.f};
        cur = nxt; cA = nA; cB = nB; ++ui;
        if constexpr (ALIGN_EPI) { if (wr == 1) PG8_BAR; }
    }
    PG8_WAIT_V(0);
    if constexpr (!ALIGN_EPI) { if (wr == 0) PG8_BAR; }
    PG8_BAR;
#undef PG8_SA
#undef PG8_SB
#undef PG8_STAGE
#undef PG8_LDA
#undef PG8_LDB
#undef PG8_MMA
#undef PG8_WAIT_V
#undef PG8_WAIT_L
#undef PG8_BAR
#undef PG8_SCHED
}
}

constexpr int NWAVES = 8, NTHR = 512, GRID = 256;
constexpr int RING_BYTES = 131072, XCH_OFF = RING_BYTES, LDS_BYTES = 147456;
struct Args { const float* in[22]; float* out; unsigned char* ws; int ph_lo, ph_hi; };
enum { I_X = 0, I_MEM, I_NORM_MIX, I_W_IN, I_SG_VG, I_SG_W, I_SG_B, I_GLA_WG, I_GLA_BG, I_GLA_OG, I_W_OUT, I_NORM_MEM, I_MEM_GAIN, I_W_CQ, I_W_CKV, I_W_CO, I_NORM_FFN, I_PEER_WQ, I_PEER_SK, I_PEER_U, I_PEER_V, I_FINAL_G };

struct Frame {
    LAS unsigned char* lds; int tid, lane, wave, bx, gw; static constexpr int G = GRID, NGW = GRID * NWAVES;
    float* X; unsigned char* ws;
};
#define INP(i) (args.in[(i)])

#define XB_TMO      128
#define XB_XCNT(j)  (256  + 64 * (j))
#define XB_XSUB(j)  (1280 + 64 * (j))
#define XB_XGEN(j)  (2304 + 64 * (j))
#define XB_TOP      3328
#define XB_TOPGEN   3392
#define XCD_BAR_WORDS 3456
#define XB_SPIN_CAP (1u << 22)
DI unsigned xb_ld(unsigned* p)              { return __hip_atomic_load(p, __ATOMIC_RELAXED, __HIP_MEMORY_SCOPE_AGENT); }
DI unsigned xb_add(unsigned* p, unsigned v) { return __hip_atomic_fetch_add(p, v, __ATOMIC_RELAXED, __HIP_MEMORY_SCOPE_AGENT); }
DI unsigned xb_xcc_id() { return (unsigned)__builtin_amdgcn_s_getreg((3 << 11) | 20) & 0xFu; }
#define XB_SPIN(cond, bar) do { unsigned _sp = 0; while (cond) { __builtin_amdgcn_s_sleep(1); \
    if ((++_sp & 255u) == 0u) { if (xb_ld(&(bar)[XB_TMO])) break; if (_sp > XB_SPIN_CAP) { atomicAdd(&(bar)[XB_TMO], 1u); break; } } } } while (0)
struct XcdBarrier { unsigned* bar; unsigned x; volatile LAS unsigned* st; };
DI XcdBarrier xcd_barrier_post(unsigned* bar, volatile LAS unsigned* st) {
    XcdBarrier b; b.bar = bar; b.x = xb_xcc_id(); b.st = st;
    if (threadIdx.x == 0) (void)xb_add(&bar[XB_XCNT(b.x)], 1u);
    return b;
}
DI void xcd_barrier_complete(unsigned* bar, unsigned x, unsigned& nloc, unsigned& nx) {
    const unsigned G = gridDim.x * gridDim.y * gridDim.z;
    unsigned sum, cnt, mine, sp = 0u;
    for (;;) {
        sum = 0u; cnt = 0u; mine = 0u;
#pragma unroll
        for (unsigned j = 0; j < 16; ++j) { const unsigned c = xb_ld(&bar[XB_XCNT(j)]); sum += c; cnt += (c > 0u) ? 1u : 0u; mine = (j == x) ? c : mine; }
        if (sum == G) break;
        __builtin_amdgcn_s_sleep(1);
        if ((++sp & 255u) == 0u) { if (xb_ld(&bar[XB_TMO])) break; if (sp > XB_SPIN_CAP) { atomicAdd(&bar[XB_TMO], 1u); break; } }
    }
    nloc = mine > 0u ? mine : 1u; nx = cnt > 0u ? cnt : 1u;
}
DI void xcd_barrier(const XcdBarrier& b) {
    asm volatile("s_waitcnt vmcnt(0)" ::: "memory");
    __syncthreads();
    if (threadIdx.x == 0) {
        unsigned* bar = b.bar;
        __builtin_amdgcn_s_waitcnt(0);
        unsigned nloc = b.st[0], nx = b.st[1];
        if (nloc == 0u) { xcd_barrier_complete(bar, b.x, nloc, nx); b.st[0] = nloc; b.st[1] = nx; }
        const unsigned old = xb_add(&bar[XB_XSUB(b.x)], 1u);
        const unsigned gen = old / nloc;
        if (old + 1u == (gen + 1u) * nloc) {
            __builtin_amdgcn_fence(__ATOMIC_RELEASE, "agent");
            asm volatile("s_waitcnt vmcnt(0)" ::: "memory");
            const unsigned og = xb_add(&bar[XB_TOP], 1u);
            const unsigned tg = og / nx;
            if (og + 1u == (tg + 1u) * nx) xb_add(&bar[XB_TOPGEN], 1u);
            else XB_SPIN(xb_ld(&bar[XB_TOPGEN]) == tg, bar);
            __builtin_amdgcn_fence(__ATOMIC_ACQUIRE, "agent");
            xb_add(&bar[XB_XGEN(b.x)], 1u);
            asm volatile("s_waitcnt vmcnt(0)" ::: "memory");
        } else {
            XB_SPIN(xb_ld(&bar[XB_XGEN(b.x)]) == gen, bar);
            __builtin_amdgcn_fence(__ATOMIC_ACQUIRE, "agent");
            asm volatile("s_waitcnt vmcnt(0)" ::: "memory");
        }
    }
    __syncthreads();
}

DI void p0_transpose_item(const float* W, int ldw, int N, int K, const float* gain, bf16_t* WT, LAS float* scr, int item, int lane) {
    const int nblk = N / 32, kb = item / nblk, nb = item % nblk, k0 = 64 * kb, n0 = 32 * nb;
#pragma unroll 8
    for (int i = 0; i < 32; ++i) { const int kk = 2 * i + (lane >> 5); float w = W[(size_t)(k0 + kk) * ldw + n0 + (lane & 31)]; if (gain) w *= gain[k0 + kk]; scr[kk * 33 + (lane & 31)] = w; }
    LDS_WAIT(); asm volatile("" ::: "memory");
    const int c = lane & 7;
#pragma unroll
    for (int j = 0; j < 4; ++j) { const int n = (lane >> 3) + 8 * j; const LAS float* s = scr + (8 * c) * 33 + n;
        u32x4 o; o.x = cvtpk(s[0 * 33], s[1 * 33]); o.y = cvtpk(s[2 * 33], s[3 * 33]); o.z = cvtpk(s[4 * 33], s[5 * 33]); o.w = cvtpk(s[6 * 33], s[7 * 33]);
        *(u32x4*)(WT + (size_t)(n0 + n) * K + k0 + 8 * c) = o; }
    LDS_WAIT(); asm volatile("" ::: "memory");
}
DI unsigned fp4x8(const f32x4 a, const f32x4 b, float inv) {
    unsigned w = 0;
    w = __builtin_amdgcn_cvt_scalef32_pk_fp4_f32(w, a[0] * inv, a[1] * inv, 1.0f, 0); w = __builtin_amdgcn_cvt_scalef32_pk_fp4_f32(w, a[2] * inv, a[3] * inv, 1.0f, 1);
    w = __builtin_amdgcn_cvt_scalef32_pk_fp4_f32(w, b[0] * inv, b[1] * inv, 1.0f, 2); w = __builtin_amdgcn_cvt_scalef32_pk_fp4_f32(w, b[2] * inv, b[3] * inv, 1.0f, 3);
    return w;
}
DI float wave_max(float v) {
#pragma unroll
    for (int o = 1; o < 64; o <<= 1) v = fmaxf(v, __shfl_xor(v, o));
    return v;
}
DI void convert_tables(const Frame& F, const Args& args, int l, int wv, int nwv) {
    const float* gn = INP(I_NORM_FFN) + l * 1024 + 16 * F.lane;
    f32x4 g[4];
#pragma unroll
    for (int q = 0; q < 4; ++q) g[q] = *(const f32x4*)(gn + 4 * q);
    for (int r0 = wv; r0 < 2 * 16384; r0 += 4 * nwv) {
        f32x4 v[4][4];
#pragma unroll
        for (int j = 0; j < 4; ++j) { const int r = min(r0 + j * nwv, 2 * 16384 - 1), isv = r >= 16384, e = r & 16383;
            const float* src = (isv ? INP(I_PEER_V) : INP(I_PEER_U)) + ((size_t)l * 16384 + e) * 1024 + 16 * F.lane;
#pragma unroll
            for (int q = 0; q < 4; ++q) v[j][q] = *(const f32x4*)(src + 4 * q); }
#pragma unroll
        for (int j = 0; j < 4; ++j) { const int r = r0 + j * nwv, isv = r >= 16384, e = r & 16383; float am = 0.f;
            if (r < 2 * 16384) {
#pragma unroll
            for (int q = 0; q < 4; ++q) { if (!isv) v[j][q] = v[j][q] * g[q];
                am = fmaxf(am, fmaxf(fmaxf(fabsf(v[j][q][0]), fabsf(v[j][q][1])), fmaxf(fabsf(v[j][q][2]), fabsf(v[j][q][3])))); }
            am = wave_max(am);
            const float sc = bf2f(cvt1(am > 0.f ? am * (1.0f / 6.0f) : 1.0f)), inv = 1.0f / sc;
            u32x2 w; w.x = fp4x8(v[j][0], v[j][1], inv); w.y = fp4x8(v[j][2], v[j][3], inv);
            *(u32x2*)(F.ws + WS_TAB + (size_t)l * 16 * MiB + (size_t)isv * 8 * MiB + (size_t)e * 512 + 8 * F.lane) = w;
            if (F.lane == 0) ((bf16_t*)(F.ws + WS_TAB + 32 * MiB))[((size_t)l * 16384 + e) * 2 + isv] = cvt1(sc); } }
    }
}
struct TDesc { const float* W; const float* gain; bf16_t* WT; int ldw, nblk; };
DI TDesc tdesc(const Frame& F, const Args& args, int l, int t) {
    TDesc D; D.gain = nullptr; D.ldw = 1024; D.nblk = 32; size_t woff;
    switch (t) {
    case 0: D.W = INP(I_W_IN) + (size_t)l * 1024 * INW; D.ldw = INW; D.nblk = 88; D.gain = INP(I_NORM_MIX) + l * 1024; woff = W_IN; break;
    case 1: D.W = INP(I_W_OUT) + (size_t)l * 1024 * 1024; woff = W_OUT; break;
    case 2: D.W = INP(I_W_CQ) + (size_t)l * 1024 * 1024; D.gain = INP(I_NORM_MEM) + l * 1024; woff = W_CQ; break;
    case 3: D.W = INP(I_W_CKV) + (size_t)l * 1024 * 2048; D.ldw = 2048; D.nblk = 64; D.gain = INP(I_MEM_GAIN) + l * 1024; woff = W_CKV; break;
    case 4: D.W = INP(I_W_CO) + (size_t)l * 1024 * 1024; woff = W_CO; break;
    default: D.W = INP(I_PEER_WQ) + (size_t)l * 1024 * 1024; D.gain = INP(I_NORM_FFN) + l * 1024; woff = W_PQ; break;
    }
    D.WT = (bf16_t*)(F.ws + WS_W + l * W_LAYER + woff); return D;
}
DI void titem_load(const TDesc& D, int item, int lane, float (&v)[32]) {
    const int kb = item / D.nblk, nb = item % D.nblk, k0 = 64 * kb, n0 = 32 * nb;
#pragma unroll
    for (int i = 0; i < 32; ++i) { const int kk = 2 * i + (lane >> 5); float w = D.W[(size_t)(k0 + kk) * D.ldw + n0 + (lane & 31)]; if (D.gain) w *= D.gain[k0 + kk]; v[i] = w; }
}
DI void titem_store(const TDesc& D, int item, int lane, LAS float* scr, const float (&v)[32]) {
    const int kb = item / D.nblk, nb = item % D.nblk, k0 = 64 * kb, n0 = 32 * nb;
#pragma unroll
    for (int i = 0; i < 32; ++i) scr[(2 * i + (lane >> 5)) * 33 + (lane & 31)] = v[i];
    LDS_WAIT(); asm volatile("" ::: "memory");
    const int c = lane & 7;
#pragma unroll
    for (int j = 0; j < 4; ++j) { const int n = (lane >> 3) + 8 * j; const LAS float* s = scr + (8 * c) * 33 + n;
        u32x4 o; o.x = cvtpk(s[0 * 33], s[1 * 33]); o.y = cvtpk(s[2 * 33], s[3 * 33]); o.z = cvtpk(s[4 * 33], s[5 * 33]); o.w = cvtpk(s[6 * 33], s[7 * 33]);
        *(u32x4*)(D.WT + (size_t)(n0 + n) * 1024 + k0 + 8 * c) = o; }
    LDS_WAIT(); asm volatile("" ::: "memory");
}
DI int tl_index(int part, int e) {
    if (part == 0) return e < 1408 ? e : e < 2432 ? 2432 + (e - 1408) : 4480 + 2432 + (e - 2432);
    return e < 1024 ? 1408 + e : e < 2048 ? 3456 + (e - 1024) : e < 4480 ? 4480 + (e - 2048) : 4480 + 3456 + (e - 4480);
}
DI void transpose_list(const Frame& F, const Args& args, LAS float* scr, int wv, int nwv, int part) {
    constexpr int NIT_L = 16 * 88 + 4 * 16 * 32 + 16 * 64;
    const int NIT = part == 0 ? 3456 : 5504;
    float va[32], vb[32]; TDesc Da{}, Db{}; int la = 0, lb = 0;
#define TI_DECODE(e_, D_, loc_) do { const int it_ = tl_index(part, (e_)); const int l_ = it_ / NIT_L; int r_ = it_ % NIT_L; int t_; \
        if (r_ < 1408) t_ = 0; else if (r_ < 1920) { t_ = 1; r_ -= 1408; } else if (r_ < 2432) { t_ = 2; r_ -= 1920; } else if (r_ < 3456) { t_ = 3; r_ -= 2432; } else if (r_ < 3968) { t_ = 4; r_ -= 3456; } else { t_ = 5; r_ -= 3968; } \
        D_ = tdesc(F, args, l_, t_); loc_ = r_; } while (0)
    int it = wv;
    if (it < NIT) { TI_DECODE(it, Da, la); titem_load(Da, la, F.lane, va); }
    for (;;) {
        int itn = it + nwv;
        if (itn < NIT) { TI_DECODE(itn, Db, lb); titem_load(Db, lb, F.lane, vb); }
        if (it < NIT) titem_store(Da, la, F.lane, scr, va);
        it = itn; if (it >= NIT) break;
        itn = it + nwv;
        if (itn < NIT) { TI_DECODE(itn, Da, la); titem_load(Da, la, F.lane, va); }
        titem_store(Db, lb, F.lane, scr, vb);
        it = itn; if (it >= NIT) break;
    }
#undef TI_DECODE
}
DI void p0_prologue(const Frame& F, const Args& args) {
    LAS float* scr = (LAS float*)(F.lds + F.wave * 16384);
    transpose_list(F, args, scr, F.gw, F.NGW, 0);
    const int gt = F.bx * NTHR + F.tid, nthr = F.G * NTHR;
    for (int i = gt; i < DEPTH * 256 * 1024; i += nthr) {
        const int l = i / (256 * 1024), r = i % (256 * 1024), j = r >> 10, k = r & 1023;
        bf16_t* Wi = (bf16_t*)(F.ws + WS_W + l * W_LAYER) + W_IN / 2;
        float v = 0.f;
        if (j < 128) {
            const float* wi = INP(I_W_IN) + (size_t)l * 1024 * INW + (size_t)k * INW + 2816; const float* wg = INP(I_GLA_WG) + l * 16 * 128 + j;
#pragma unroll
            for (int q4 = 0; q4 < 4; ++q4) { const f32x4 w4 = *(const f32x4*)(wi + 4 * q4);
#pragma unroll
                for (int e = 0; e < 4; ++e) v += w4[e] * wg[(4 * q4 + e) * 128]; }
            v *= INP(I_NORM_MIX)[l * 1024 + k];
        }
        Wi[(size_t)(2816 + j) * 1024 + k] = cvt1(v);
    }
    { bf16_t* WSP = (bf16_t*)(F.ws + WS_WSP); const float* sw = INP(I_SG_W);
      for (int i = gt; i < DEPTH * 4 * 128 * 128; i += nthr) { const int s = i & 127, t = (i >> 7) & 127; WSP[i] = cvt1(s <= t ? sw[i] : 0.f); }
      bf16_t* SK = (bf16_t*)(F.ws + WS_SUBK); const float* sk = INP(I_PEER_SK);
      for (int i = gt; i < DEPTH * 8 * 2 * 128 * 64; i += nthr) SK[i] = cvt1(sk[i]); }
    { float* SS = (float*)(F.ws + WS_SS); bf16_t* XB = (bf16_t*)(F.ws + WS_XB); const float* x = INP(I_X);
      for (int m0 = F.gw; m0 < MTOK; m0 += 4 * F.NGW) {
          f32x4 v[4][4];
#pragma unroll
          for (int i = 0; i < 4; ++i) { const f32x4* xr = (const f32x4*)(x + (size_t)(m0 + i * F.NGW) * 1024) + F.lane;
#pragma unroll
              for (int j = 0; j < 4; ++j) v[i][j] = xr[64 * j]; }
#pragma unroll
          for (int i = 0; i < 4; ++i) { const int m = m0 + i * F.NGW; float s = 0.f; u32x2 w[4];
#pragma unroll
              for (int j = 0; j < 4; ++j) { w[j].x = cvtpk(v[i][j][0], v[i][j][1]); w[j].y = cvtpk(v[i][j][2], v[i][j][3]);
                  s += (bflo(w[j].x) * bflo(w[j].x) + bfhi(w[j].x) * bfhi(w[j].x)) + (bflo(w[j].y) * bflo(w[j].y) + bfhi(w[j].y) * bfhi(w[j].y)); }
              s = wave_sum(s);
              u32x2* xb = (u32x2*)(XB + (size_t)m * 1024) + F.lane;
#pragma unroll
              for (int j = 0; j < 4; ++j) xb[64 * j] = w[j];
              if (F.lane < 16) SS[(size_t)m * 16 + F.lane] = F.lane == 0 ? s : 0.f; }
      }
      bf16_t* MB = (bf16_t*)(F.ws + WS_MEMB); float* RM = (float*)(F.ws + WS_RSTDM); const float* mem = INP(I_MEM);
      for (int m = F.gw; m < MMEM; m += F.NGW) {
          const f32x4* xr = (const f32x4*)(mem + (size_t)m * 1024) + F.lane; f32x4 v[4]; float s = 0.f;
#pragma unroll
          for (int j = 0; j < 4; ++j) { v[j] = xr[64 * j]; s += (v[j][0] * v[j][0] + v[j][1] * v[j][1]) + (v[j][2] * v[j][2] + v[j][3] * v[j][3]); }
          s = wave_sum(s);
          u32x2* xb = (u32x2*)(MB + (size_t)m * 1024) + F.lane;
#pragma unroll
          for (int j = 0; j < 4; ++j) { u32x2 w; w.x = cvtpk(v[j][0], v[j][1]); w.y = cvtpk(v[j][2], v[j][3]); xb[64 * j] = w; }
          if (F.lane == 0) RM[m] = 1.0f / sqrtf(s * (1.0f / 1024.0f) + EPS);
      } }
}

constexpr int SBV_PITCH = 192;
DI void sb_unit2(const bf16_t* PROJ, bf16_t* YCAT, int b, int h, int qp, LAS char* vl, int lane) {
    const int q = lane & 31, hh = lane >> 5;
    const size_t rowbase = (size_t)b * SEQ; const int qa = 2 * qp, qb = qa + 1;
    bf16x8 qfA[4], qfB[4];
    { const bf16_t* qrow = PROJ + (rowbase + qa * 32 + q) * LDP + C_SBQ + h * 64 + hh * 8;
#pragma unroll
      for (int s = 0; s < 4; ++s) { qfA[s] = *(const bf16x8*)(qrow + 16 * s); qfB[s] = *(const bf16x8*)(qrow + 32 * LDP + 16 * s); } }
    f32x16 oA0, oA1, oB0, oB1;
#pragma unroll
    for (int r = 0; r < 16; ++r) { oA0[r] = 0.f; oA1[r] = 0.f; oB0[r] = 0.f; oB1[r] = 0.f; }
    float RA = 0.f, RB = 0.f;
    const float zs = 0.125f * LOG2E;
    const int i16 = lane & 15, tq = i16 >> 2, tp = i16 & 3, blk = (lane >> 4) & 1;
    bf16x8 kf[4]; u32x4 vr[4];
#define SB_LOAD_TILE(kt_, kf, vr) do { const bf16_t* krow_ = PROJ + (rowbase + (kt_) * 32 + q) * LDP + C_SBK + h * 64 + hh * 8; \
        _Pragma("unroll") for (int s_ = 0; s_ < 4; ++s_) kf[s_] = *(const bf16x8*)(krow_ + 16 * s_); \
        _Pragma("unroll") for (int i_ = 0; i_ < 4; ++i_) { const int c_ = lane + 64 * i_, row_ = c_ >> 3, ch_ = c_ & 7; vr[i_] = *(const u32x4*)(PROJ + (rowbase + (kt_) * 32 + row_) * LDP + C_SBV + h * 64 + ch_ * 8); } } while (0)
#define SB_MATH(Z, DIAG, R, O0, O1) { \
        float L[16]; \
        _Pragma("unroll") for (int r = 0; r < 16; ++r) { \
            const float zl = Z[r] * zs; float l2 = flog2(1.f + fexp2(zl)); l2 = zl > 60.f ? zl : l2; \
            const bool valid = !(DIAG) || (crow(r, hh) < q); \
            L[r] = valid ? l2 : 0.f; Z[r] = valid ? zl : -INFINITY; } \
        float G[4], Go[4]; \
        _Pragma("unroll") for (int g = 0; g < 4; ++g) { G[g] = (L[4 * g] + L[4 * g + 1]) + (L[4 * g + 2] + L[4 * g + 3]); Go[g] = __shfl_xor(G[g], 32); } \
        float base[4]; float run = 0.f; \
        _Pragma("unroll") for (int g = 3; g >= 0; --g) { base[g] = run + (hh == 0 ? Go[g] : 0.f); run += G[g] + Go[g]; } \
        float P[16]; \
        _Pragma("unroll") for (int g = 0; g < 4; ++g) { \
            const float c3 = R + base[g], c2 = c3 + L[4 * g + 3], c1 = c2 + L[4 * g + 2], c0 = c1 + L[4 * g + 1]; \
            P[4 * g + 3] = fexp2(Z[4 * g + 3] - L[4 * g + 3] - c3); P[4 * g + 2] = fexp2(Z[4 * g + 2] - L[4 * g + 2] - c2); \
            P[4 * g + 1] = fexp2(Z[4 * g + 1] - L[4 * g + 1] - c1); P[4 * g + 0] = fexp2(Z[4 * g + 0] - L[4 * g + 0] - c0); } \
        R += run; \
        const bf16x8 p0 = pack8(P[0], P[1], P[2], P[3], P[4], P[5], P[6], P[7]), p1 = pack8(P[8], P[9], P[10], P[11], P[12], P[13], P[14], P[15]); \
        _Pragma("unroll") for (int s = 0; s < 2; ++s) { \
            const LAS char* vb = vl + (16 * s + 4 * hh + tq) * SBV_PITCH + blk * 32 + tp * 8; \
            const bf16x8 a0 = cat8(vtr(vb), vtr(vb + 8 * SBV_PITCH)), a1 = cat8(vtr(vb + 64), vtr(vb + 8 * SBV_PITCH + 64)); \
            O0 = MFMA32(a0, s == 0 ? p0 : p1, O0); O1 = MFMA32(a1, s == 0 ? p0 : p1, O1); } }
#define SB_ZERO(Z) _Pragma("unroll") for (int r = 0; r < 16; ++r) Z[r] = 0.f;
#define SB_VTOLDS(VR) _Pragma("unroll") for (int i = 0; i < 4; ++i) { const int c = lane + 64 * i, row = c >> 3, ch = c & 7; *(LAS u32x4*)(vl + row * SBV_PITCH + ch * 16) = VR[i]; }
    SB_LOAD_TILE(qb, kf, vr);
    {
        f32x16 zB; SB_ZERO(zB)
#pragma unroll
        for (int s = 0; s < 4; ++s) zB = MFMA32(kf[s], qfB[s], zB);
        SB_VTOLDS(vr)
        SB_LOAD_TILE(qa, kf, vr);
        SB_MATH(zB, true, RB, oB0, oB1)
    }
#define SB_STEP2(kt) { \
        f32x16 zA, zB; SB_ZERO(zA) SB_ZERO(zB) \
        _Pragma("unroll") for (int s = 0; s < 4; ++s) { zA = MFMA32(kf[s], qfA[s], zA); zB = MFMA32(kf[s], qfB[s], zB); } \
        SB_VTOLDS(vr) \
        if (kt > 0) SB_LOAD_TILE(kt - 1, kf, vr); \
        SB_MATH(zA, (kt == qa), RA, oA0, oA1) \
        SB_MATH(zB, false, RB, oB0, oB1) \
        if (__all(RA > 57.7f && RB > 57.7f)) break;            \
    }
    for (int kt = qa; kt >= 0; --kt) SB_STEP2(kt)
#undef SB_STEP2
#undef SB_VTOLDS
#undef SB_ZERO
#undef SB_MATH
#undef SB_LOAD_TILE
    bf16_t* orow = YCAT + (rowbase + qa * 32 + q) * 1024 + h * 64 + 4 * hh;
#pragma unroll
    for (int g = 0; g < 4; ++g) {
        u32x2 w0; w0.x = cvtpk(oA0[4 * g], oA0[4 * g + 1]); w0.y = cvtpk(oA0[4 * g + 2], oA0[4 * g + 3]); *(u32x2*)(orow + 8 * g) = w0;
        u32x2 w1; w1.x = cvtpk(oA1[4 * g], oA1[4 * g + 1]); w1.y = cvtpk(oA1[4 * g + 2], oA1[4 * g + 3]); *(u32x2*)(orow + 32 + 8 * g) = w1;
        u32x2 w2; w2.x = cvtpk(oB0[4 * g], oB0[4 * g + 1]); w2.y = cvtpk(oB0[4 * g + 2], oB0[4 * g + 3]); *(u32x2*)(orow + 32 * 1024 + 8 * g) = w2;
        u32x2 w3; w3.x = cvtpk(oB1[4 * g], oB1[4 * g + 1]); w3.y = cvtpk(oB1[4 * g + 2], oB1[4 * g + 3]); *(u32x2*)(orow + 32 * 1024 + 32 + 8 * g) = w3;
    }
}

constexpr int SGV_PITCH = 576;
DI void sgu_unit(const Frame& F, const Args& args, int l, int b, int c, const bf16_t* PROJ, bf16_t* YCAT) {
    const size_t m0 = (size_t)b * SEQ + c * 128;
    LAS char* Vn = (LAS char*)F.lds;
    {
      const int t = F.tid >> 2, part = F.tid & 3; const bf16_t* vrow = PROJ + (m0 + t) * LDP + C_SGV + part * 64; const float* gn = INP(I_SG_VG) + l * 256 + part * 64;
      float gv[64]; float s = 0.f;
#pragma unroll
      for (int i = 0; i < 8; ++i) { const u32x4 w = *(const u32x4*)(vrow + 8 * i);
#pragma unroll
          for (int j = 0; j < 4; ++j) { const float a = gelu_tanh(bflo(w[j])), bb = gelu_tanh(bfhi(w[j])); gv[8 * i + 2 * j] = a; gv[8 * i + 2 * j + 1] = bb; s += a * a + bb * bb; } }
      s += __shfl_xor(s, 1); s += __shfl_xor(s, 2);
      const float rstd = 1.0f / sqrtf(s * (1.0f / 256.0f) + EPS);
#pragma unroll
      for (int i = 0; i < 8; ++i) { const f32x4 g0 = *(const f32x4*)(gn + 8 * i), g1 = *(const f32x4*)(gn + 8 * i + 4);
          u32x4 w; w.x = cvtpk(gv[8 * i] * rstd * g0[0], gv[8 * i + 1] * rstd * g0[1]); w.y = cvtpk(gv[8 * i + 2] * rstd * g0[2], gv[8 * i + 3] * rstd * g0[3]);
          w.z = cvtpk(gv[8 * i + 4] * rstd * g1[0], gv[8 * i + 5] * rstd * g1[1]); w.w = cvtpk(gv[8 * i + 6] * rstd * g1[2], gv[8 * i + 7] * rstd * g1[3]);
          *(LAS u32x4*)(Vn + t * SGV_PITCH + (part * 64 + 8 * i) * 2) = w; } }
    WG_SYNC();
    {
      const int g = F.wave >> 1, db = F.wave & 1, lane = F.lane, r32 = lane & 31, hh = lane >> 5;
      const int i16 = lane & 15, tq = i16 >> 2, tp = i16 & 3, blk = (lane >> 4) & 1;
      const bf16_t* Wg = (const bf16_t*)(F.ws + WS_WSP) + ((size_t)(l * 4 + g) * 128) * 128;
      const float* bias = INP(I_SG_B) + (l * 4 + g) * 128;
      const int ch0 = g * 64 + db * 32 + 4 * hh;
      for (int tb = 0; tb < 4; ++tb) {
          const int t = tb * 32 + r32;
          u32x2 uw[4];
#pragma unroll
          for (int gi = 0; gi < 4; ++gi) uw[gi] = *(const u32x2*)(PROJ + (m0 + t) * LDP + C_SGU + ch0 + 8 * gi);
          const float bt = bias[t];
          f32x16 acc;
#pragma unroll
          for (int r = 0; r < 16; ++r) acc[r] = 0.f;
          for (int sb = 0; sb <= tb; ++sb) {
#pragma unroll
              for (int ks = 0; ks < 2; ++ks) {
                  const bf16x8 wf = *(const bf16x8*)(Wg + (size_t)t * 128 + sb * 32 + 16 * ks + 8 * hh);
                  const LAS char* vb = Vn + (sb * 32 + 16 * ks + 8 * hh + tq) * SGV_PITCH + (g * 64 + db * 32 + blk * 16) * 2 + tp * 8;
                  const bf16x8 vf = cat8(vtr(vb), vtr(vb + 4 * SGV_PITCH));
                  acc = MFMA32(vf, wf, acc);
              }
          }
          bf16_t* yo = YCAT + (m0 + t) * 1024 + 512 + ch0;
#pragma unroll
          for (int gi = 0; gi < 4; ++gi) {
              const float y0 = gelu_tanh(bflo(uw[gi].x)) * (acc[4 * gi] + bt), y1 = gelu_tanh(bfhi(uw[gi].x)) * (acc[4 * gi + 1] + bt);
              const float y2 = gelu_tanh(bflo(uw[gi].y)) * (acc[4 * gi + 2] + bt), y3 = gelu_tanh(bfhi(uw[gi].y)) * (acc[4 * gi + 3] + bt);
              u32x2 wv; wv.x = cvtpk(y0, y1); wv.y = cvtpk(y2, y3); *(u32x2*)(yo + 8 * gi) = wv;
          }
      } }
    WG_SYNC();
}

constexpr int GQ_PITCH = 80, GV_PITCH = 192, GS_PITCH = 80;
constexpr int GL_QT = 0, GL_KT = GL_QT + 128 * GQ_PITCH, GL_VV = GL_KT + 128 * GQ_PITCH, GL_ST = GL_VV + 128 * GV_PITCH, GL_SEG = GL_ST + 64 * GS_PITCH,
              GL_D = GL_SEG + 16 * 32 * 4, GL_SSQ = GL_D + 32 * 4, GL_END = GL_SSQ + 128 * 2 * 4;
DI void gla_chain(const Frame& F, const Args& args, int l, int b, int h, const bf16_t* PROJ, bf16_t* YCAT) {
    LAS char* L = (LAS char*)F.lds;
    LAS float* SEG = (LAS float*)(L + GL_SEG); LAS float* Dd = (LAS float*)(L + GL_D); LAS float* SSQ = (LAS float*)(L + GL_SSQ);
    const int tid = F.tid, lane = F.lane, w = F.wave, r32 = lane & 31, hh = lane >> 5;
    const int i16 = lane & 15, tq = i16 >> 2, tp = i16 & 3, blk = (lane >> 4) & 1;
    for (int i = tid; i < 64 * GS_PITCH / 4; i += NTHR) ((LAS unsigned*)(L + GL_ST))[i] = 0u;
    f32x16 st;
#pragma unroll
    for (int r = 0; r < 16; ++r) st[r] = 0.f;
    const int j = tid & 31, seg = tid >> 5;
    const float bg = INP(I_GLA_BG)[l * 128 + h * 32 + j];
    const int tb = w & 3, dh = w >> 2;
    float ga[8], kr[8], qr[8]; u32x4 vv[2];
#define GC_LOAD(c_) do { const size_t m0_ = (size_t)b * SEQ + (c_) * 128; \
        _Pragma("unroll") for (int i_ = 0; i_ < 8; ++i_) { const bf16_t* p_ = PROJ + (m0_ + seg * 8 + i_) * LDP + h * 32 + j; ga[i_] = bf2f(p_[C_GA]); kr[i_] = bf2f(p_[C_GK]); qr[i_] = bf2f(p_[C_GQ]); } \
        _Pragma("unroll") for (int i_ = 0; i_ < 2; ++i_) { const int cc_ = tid + 512 * i_, row_ = cc_ >> 3, ch_ = cc_ & 7; vv[i_] = *(const u32x4*)(PROJ + (m0_ + row_) * LDP + C_GV + h * 64 + ch_ * 8); } } while (0)
    GC_LOAD(0);
    LDS_SYNC();
#pragma unroll 1
    for (int c = 0; c < 16; ++c) {
        const size_t m0 = (size_t)b * SEQ + c * 128;
        float bc[8]; float run = 0.f;
#pragma unroll
        for (int i = 0; i < 8; ++i) {
            const float g = ga[i] + bg;
            const float sp = fmaxf(-g, 0.f) + flog2(1.f + fexp2(-fabsf(g) * LOG2E)) * 0.6931471805599453f;
            run += -sp * (1.0f / 16.0f); bc[i] = run;
        }
        SEG[seg * 32 + j] = run;
#pragma unroll
        for (int i = 0; i < 2; ++i) { const int cc = tid + 512 * i, row = cc >> 3, ch = cc & 7; *(LAS u32x4*)(L + GL_VV + row * GV_PITCH + ch * 16) = vv[i]; }
        LDS_SYNC();
        float pre = 0.f;
#pragma unroll
        for (int s2 = 0; s2 < 15; ++s2) { const float v_ = SEG[s2 * 32 + j]; pre += s2 < seg ? v_ : 0.f; }
#pragma unroll
        for (int i = 0; i < 8; ++i) {
            const int t = seg * 8 + i; const float bb = pre + bc[i];
            *(LAS bf16_t*)(L + GL_QT + t * GQ_PITCH + j * 2) = cvt1(qr[i] * 0.17677669529663687f * fexp2(bb * LOG2E));
            *(LAS bf16_t*)(L + GL_KT + t * GQ_PITCH + j * 2) = cvt1(kr[i] * fexp2(-bb * LOG2E));
            if (t == 127) Dd[j] = fexp2(bb * LOG2E);
        }
        if (c < 15) GC_LOAD(c + 1);
        u32x2 gov[4];
        { const bf16_t* go = PROJ + (m0 + tb * 32 + r32) * LDP + C_GO + h * 64 + dh * 32 + 4 * hh;
#pragma unroll
          for (int g = 0; g < 4; ++g) gov[g] = *(const u32x2*)(go + 8 * g); }
        LDS_SYNC();
        f32x16 o;
#pragma unroll
        for (int r = 0; r < 16; ++r) o[r] = 0.f;
        bf16x8 qf[2];
#pragma unroll
        for (int ks = 0; ks < 2; ++ks) qf[ks] = *(LAS const bf16x8*)(L + GL_QT + (tb * 32 + r32) * GQ_PITCH + (16 * ks + 8 * hh) * 2);
        for (int sb = 0; sb <= tb; ++sb) {
            f32x16 sT;
#pragma unroll
            for (int r = 0; r < 16; ++r) sT[r] = 0.f;
#pragma unroll
            for (int ks = 0; ks < 2; ++ks) { const bf16x8 kf = *(LAS const bf16x8*)(L + GL_KT + (sb * 32 + r32) * GQ_PITCH + (16 * ks + 8 * hh) * 2); sT = MFMA32(kf, qf[ks], sT); }
            if (sb == tb) {
#pragma unroll
                for (int r = 0; r < 16; ++r) if (crow(r, hh) > r32) sT[r] = 0.f;
            }
            const bf16x8 p0 = pack8(sT[0], sT[1], sT[2], sT[3], sT[4], sT[5], sT[6], sT[7]), p1 = pack8(sT[8], sT[9], sT[10], sT[11], sT[12], sT[13], sT[14], sT[15]);
#pragma unroll
            for (int s = 0; s < 2; ++s) {
                const LAS char* vb = L + GL_VV + (sb * 32 + 16 * s + 4 * hh + tq) * GV_PITCH + (dh * 32 + blk * 16) * 2 + tp * 8;
                const bf16x8 a = cat8(vtr(vb), vtr(vb + 8 * GV_PITCH));
                o = MFMA32(a, s == 0 ? p0 : p1, o);
            }
        }
#pragma unroll
        for (int ks = 0; ks < 2; ++ks) {
            const bf16x8 a = *(LAS const bf16x8*)(L + GL_ST + (dh * 32 + r32) * GS_PITCH + (16 * ks + 8 * hh) * 2);
            o = MFMA32(a, qf[ks], o);
        }
        if (tb == 0) {
#pragma unroll
            for (int ks = 0; ks < 8; ++ks) {
                const LAS char* kb = L + GL_KT + (16 * ks + 8 * hh + tq) * GQ_PITCH + (blk * 16) * 2 + tp * 8;
                const bf16x8 a = cat8(vtr(kb), vtr(kb + 4 * GQ_PITCH));
                const LAS char* vb = L + GL_VV + (16 * ks + 8 * hh + tq) * GV_PITCH + (dh * 32 + blk * 16) * 2 + tp * 8;
                const bf16x8 bfr = cat8(vtr(vb), vtr(vb + 4 * GV_PITCH));
                st = MFMA32(a, bfr, st);
            }
#pragma unroll
            for (int r = 0; r < 16; ++r) st[r] *= Dd[crow(r, hh)];
        }
        float ssq = 0.f;
#pragma unroll
        for (int r = 0; r < 16; ++r) ssq += o[r] * o[r];
        ssq += __shfl_xor(ssq, 32);
        if (hh == 0) SSQ[(tb * 32 + r32) * 2 + dh] = ssq;
        LDS_SYNC();
        {
            const int t = tb * 32 + r32; const float tot = SSQ[t * 2] + SSQ[t * 2 + 1]; const float rstd = 1.0f / sqrtf(tot * (1.0f / 64.0f) + EPS);
            const float* gn = INP(I_GLA_OG) + l * 256 + h * 64 + dh * 32 + 4 * hh;
            bf16_t* yo = YCAT + (m0 + t) * 1024 + 768 + h * 64 + dh * 32 + 4 * hh;
#pragma unroll
            for (int g = 0; g < 4; ++g) {
                const u32x2 gw = gov[g]; const f32x4 gg = *(const f32x4*)(gn + 8 * g);
                const float y0 = o[4 * g] * rstd * gg[0] * silu(bflo(gw.x)), y1 = o[4 * g + 1] * rstd * gg[1] * silu(bfhi(gw.x));
                const float y2 = o[4 * g + 2] * rstd * gg[2] * silu(bflo(gw.y)), y3 = o[4 * g + 3] * rstd * gg[3] * silu(bfhi(gw.y));
                u32x2 wv; wv.x = cvtpk(y0, y1); wv.y = cvtpk(y2, y3); *(u32x2*)(yo + 8 * g) = wv;
            }
        }
        if (tb == 0) {
#pragma unroll
            for (int g = 0; g < 4; ++g) { u32x2 wv; wv.x = cvtpk(st[4 * g], st[4 * g + 1]); wv.y = cvtpk(st[4 * g + 2], st[4 * g + 3]);
                *(LAS u32x2*)(L + GL_ST + (dh * 32 + r32) * GS_PITCH + (8 * g + 4 * hh) * 2) = wv; }
        }
        LDS_SYNC();
    }
#undef GC_LOAD
}

constexpr int XA_PITCH = 528;
template <int PITCH, int I0, int N> DI void xattn_load(const bf16_t* src, int tid, u32x4 (&v)[N]) {
    const bf16_t* p = src + (size_t)(tid >> 5) * PITCH + (tid & 31) * 8;
#pragma unroll
    for (int i = 0; i < N; ++i) v[i] = *(const u32x4*)(p + (size_t)(I0 + i) * 16 * PITCH);
}
template <int I0, int N> DI void xattn_store(LAS char* img, int tid, const u32x4 (&v)[N]) {
    LAS char* d = img + (tid >> 5) * XA_PITCH + (tid & 31) * 16;
#pragma unroll
    for (int i = 0; i < N; ++i) *(LAS u32x4*)(d + (I0 + i) * 16 * XA_PITCH) = v[i];
}
DI void xattn_unit(const Frame& F, const bf16_t* CQ, const bf16_t* Kl, const bf16_t* VTl, bf16_t* O, int pm, int h) {
    LAS char* img = (LAS char*)F.lds;
    const int lane = F.lane, r32 = lane & 31, hh = lane >> 5, b = pm >> 3;
    const size_t tok = (size_t)pm * 256 + F.wave * 32 + r32;
    { u32x4 sk[16]; xattn_load<1024, 0, 16>(Kl + (size_t)b * 256 * 1024 + h * 256, F.tid, sk); xattn_store<0, 16>(img, F.tid, sk); }
    const bf16_t* qrow = CQ + tok * 1024 + h * 256 + 8 * hh;
    bf16x8 qn = *(const bf16x8*)qrow;
    LDS_SYNC();
    u32x4 sv0[8]; xattn_load<256, 0, 8>(VTl + (size_t)(b * 4 + h) * 256 * 256, F.tid, sv0);
    f32x16 acc[8];
#pragma unroll
    for (int kb = 0; kb < 8; ++kb)
#pragma unroll
        for (int r = 0; r < 16; ++r) acc[kb][r] = 0.f;
#pragma unroll 1
    for (int ks = 0; ks < 16; ++ks) {
        const bf16x8 q = qn;
        qn = *(const bf16x8*)(qrow + 16 * (ks < 15 ? ks + 1 : ks));
        const LAS char* kp = img + r32 * XA_PITCH + (16 * ks + 8 * hh) * 2;
#pragma unroll
        for (int kb = 0; kb < 8; ++kb) acc[kb] = MFMA32(*(LAS const bf16x8*)(kp + kb * 32 * XA_PITCH), q, acc[kb]);
    }
    float mx = -INFINITY;
#pragma unroll
    for (int kb = 0; kb < 8; ++kb)
#pragma unroll
        for (int r = 0; r < 16; ++r) mx = fmaxf(mx, acc[kb][r]);
    mx = fmaxf(mx, __shfl_xor(mx, 32));
    float sum = 0.f;
#pragma unroll
    for (int kb = 0; kb < 8; ++kb)
#pragma unroll
        for (int r = 0; r < 16; ++r) { const float p = fexp2(acc[kb][r] - mx); acc[kb][r] = p; sum += p; }
    sum += __shfl_xor(sum, 32);
    const float inv = 1.0f / sum;
    bf16x8 pf[8][2];
#pragma unroll
    for (int kb = 0; kb < 8; ++kb) {
        pf[kb][0] = pack8(acc[kb][0], acc[kb][1], acc[kb][2], acc[kb][3], acc[kb][4], acc[kb][5], acc[kb][6], acc[kb][7]);
        pf[kb][1] = pack8(acc[kb][8], acc[kb][9], acc[kb][10], acc[kb][11], acc[kb][12], acc[kb][13], acc[kb][14], acc[kb][15]);
    }
    LDS_SYNC();
    { u32x4 sv1[8]; xattn_load<256, 8, 8>(VTl + (size_t)(b * 4 + h) * 256 * 256, F.tid, sv1); xattn_store<0, 8>(img, F.tid, sv0); xattn_store<8, 8>(img, F.tid, sv1); }
    LDS_SYNC();
    bf16_t* orow = O + tok * 1024 + h * 256 + 4 * hh;
#pragma unroll 1
    for (int db = 0; db < 8; ++db) {
        f32x16 o;
#pragma unroll
        for (int r = 0; r < 16; ++r) o[r] = 0.f;
#pragma unroll
        for (int kb = 0; kb < 8; ++kb)
#pragma unroll
            for (int s2 = 0; s2 < 2; ++s2) {
                const LAS char* vp = img + (db * 32 + r32) * XA_PITCH + (32 * kb + 16 * s2 + 4 * hh) * 2;
                const bf16x8 vf = cat8(*(LAS const s16x4*)vp, *(LAS const s16x4*)(vp + 16));
                o = MFMA32(vf, pf[kb][s2], o);
            }
#pragma unroll
        for (int g = 0; g < 4; ++g) { u32x2 w; w.x = cvtpk(o[4 * g] * inv, o[4 * g + 1] * inv); w.y = cvtpk(o[4 * g + 2] * inv, o[4 * g + 3] * inv); *(u32x2*)(orow + 32 * db + 8 * g) = w; }
    }
    LDS_SYNC();
}

DI unsigned key_pack(float v, unsigned tag, unsigned mask) { const unsigned b = __float_as_uint(v); const unsigned mono = b ^ ((unsigned)((int)b >> 31) | 0x80000000u); return (mono & ~mask) | tag; }
DI float key_val(unsigned k, unsigned mask) { const unsigned mono = k & ~mask; const unsigned b = (mono & 0x80000000u) ? (mono ^ 0x80000000u) : ~mono; return __uint_as_float(b); }
#define CE(a, b) do { const unsigned _h = (a) > (b) ? (a) : (b); const unsigned _l = (a) > (b) ? (b) : (a); (a) = _h; (b) = _l; } while (0)
#define SORT16_DESC(v) do { CE(v[0], v[1]); CE(v[2], v[3]); CE(v[0], v[2]); CE(v[1], v[3]); CE(v[1], v[2]); CE(v[4], v[5]); CE(v[6], v[7]); CE(v[4], v[6]); CE(v[5], v[7]); CE(v[5], v[6]); CE(v[0], v[4]); CE(v[2], v[6]); CE(v[2], v[4]); CE(v[1], v[5]); CE(v[3], v[7]); CE(v[3], v[5]); CE(v[1], v[2]); CE(v[3], v[4]); CE(v[5], v[6]); CE(v[8], v[9]); CE(v[10], v[11]); CE(v[8], v[10]); CE(v[9], v[11]); CE(v[9], v[10]); CE(v[12], v[13]); CE(v[14], v[15]); CE(v[12], v[14]); CE(v[13], v[15]); CE(v[13], v[14]); CE(v[8], v[12]); CE(v[10], v[14]); CE(v[10], v[12]); CE(v[9], v[13]); CE(v[11], v[15]); CE(v[11], v[13]); CE(v[9], v[10]); CE(v[11], v[12]); CE(v[13], v[14]); CE(v[0], v[8]); CE(v[4], v[12]); CE(v[4], v[8]); CE(v[2], v[10]); CE(v[6], v[14]); CE(v[6], v[10]); CE(v[2], v[4]); CE(v[6], v[8]); CE(v[10], v[12]); CE(v[1], v[9]); CE(v[5], v[13]); CE(v[5], v[9]); CE(v[3], v[11]); CE(v[7], v[15]); CE(v[7], v[11]); CE(v[3], v[5]); CE(v[7], v[9]); CE(v[11], v[13]); CE(v[1], v[2]); CE(v[3], v[4]); CE(v[5], v[6]); CE(v[7], v[8]); CE(v[9], v[10]); CE(v[11], v[12]); CE(v[13], v[14]); } while (0)
#define BITONIC16_DESC(v) do { CE(v[0], v[8]); CE(v[1], v[9]); CE(v[2], v[10]); CE(v[3], v[11]); CE(v[4], v[12]); CE(v[5], v[13]); CE(v[6], v[14]); CE(v[7], v[15]); CE(v[0], v[4]); CE(v[1], v[5]); CE(v[2], v[6]); CE(v[3], v[7]); CE(v[8], v[12]); CE(v[9], v[13]); CE(v[10], v[14]); CE(v[11], v[15]); CE(v[0], v[2]); CE(v[1], v[3]); CE(v[4], v[6]); CE(v[5], v[7]); CE(v[8], v[10]); CE(v[9], v[11]); CE(v[12], v[14]); CE(v[13], v[15]); CE(v[0], v[1]); CE(v[2], v[3]); CE(v[4], v[5]); CE(v[6], v[7]); CE(v[8], v[9]); CE(v[10], v[11]); CE(v[12], v[13]); CE(v[14], v[15]); } while (0)
#define MERGE_TOP16(T, v) do { _Pragma("unroll") for (int _i = 0; _i < 16; ++_i) T[_i] = T[_i] > v[15 - _i] ? T[_i] : v[15 - _i]; BITONIC16_T(T); } while (0)
DI void bitonic16(unsigned (&v)[16]) { BITONIC16_DESC(v); }
#define BITONIC16_T(T) bitonic16(T)
DI void route_level1(const bf16_t* PQ, const bf16_t* SK  , int tile, int h, int lane, unsigned (&tpk)[2][16]) {
    const int r32 = lane & 31, hh = lane >> 5; const size_t m = (size_t)tile * 32 + r32;
    bf16x8 qfa[2][4];
#pragma unroll
    for (int p = 0; p < 2; ++p)
#pragma unroll
        for (int ks = 0; ks < 4; ++ks) qfa[p][ks] = *(const bf16x8*)(PQ + m * 1024 + h * 128 + p * 64 + 16 * ks + 8 * hh);
    bf16x8 an[4];
#define RT_LOADA(p_, nb_) do { const bf16_t* skp_ = SK + ((size_t)(h * 2 + (p_)) * 128) * 64; _Pragma("unroll") for (int ks_ = 0; ks_ < 4; ++ks_) an[ks_] = *(const bf16x8*)(skp_ + (size_t)((nb_) * 32 + r32) * 64 + 16 * ks_ + 8 * hh); } while (0)
    RT_LOADA(0, 0);
#pragma unroll
    for (int p = 0; p < 2; ++p) {
        unsigned T[16];
#pragma unroll
        for (int i = 0; i < 16; ++i) T[i] = 0u;
#pragma unroll 1
        for (int nb = 0; nb < 4; ++nb) {
            bf16x8 a[4];
#pragma unroll
            for (int ks = 0; ks < 4; ++ks) a[ks] = an[ks];
            if (nb < 3) RT_LOADA(p, nb + 1); else if (p == 0) RT_LOADA(1, 0);
            f32x16 acc;
#pragma unroll
            for (int r = 0; r < 16; ++r) acc[r] = 0.f;
#pragma unroll
            for (int ks = 0; ks < 4; ++ks) acc = MFMA32(a[ks], qfa[p][ks], acc);
            unsigned v[16];
#pragma unroll
            for (int r = 0; r < 16; ++r) v[r] = key_pack(acc[r], (unsigned)(nb * 32 + crow(r, hh)), 127u);
            SORT16_DESC(v);
            MERGE_TOP16(T, v);
        }
        unsigned pv[16];
#pragma unroll
        for (int i = 0; i < 16; ++i) pv[i] = (unsigned)__shfl_xor((int)T[i], 32);
        MERGE_TOP16(T, pv);
#pragma unroll
        for (int i = 0; i < 16; ++i) tpk[p][i] = T[i];
    }
#undef RT_LOADA
}
DI void route_level2(const unsigned (&tpk)[2][16], size_t m, int h, int lane, int* IDX, float* Gw, unsigned* SCL, const LAS unsigned* SCT  , LAS char* scr  ) {
    { u32x4 w0, w1, w2, w3;
#pragma unroll
      for (int q = 0; q < 4; ++q) {
          w0[q] = (tpk[0][4 * q] & 127u) | ((tpk[0][4 * q + 1] & 127u) << 8) | ((tpk[0][4 * q + 2] & 127u) << 16) | ((tpk[0][4 * q + 3] & 127u) << 24);
          w1[q] = (tpk[1][4 * q] & 127u) | ((tpk[1][4 * q + 1] & 127u) << 8) | ((tpk[1][4 * q + 2] & 127u) << 16) | ((tpk[1][4 * q + 3] & 127u) << 24); }
      (void)w2; (void)w3;
      *(LAS u32x4*)(scr + lane * 48) = w0; *(LAS u32x4*)(scr + lane * 48 + 16) = w1; }
    float av[16], bv[16];
#pragma unroll
    for (int i = 0; i < 16; ++i) { av[i] = key_val(tpk[0][i], 127u); bv[i] = key_val(tpk[1][i], 127u); }
    unsigned cv[16];
#pragma unroll
    for (int i = 0; i < 16; ++i) cv[i] = 0u;
#pragma unroll
    for (int i = 0; i < 16; ++i)
#pragma unroll
        for (int jj = 0; jj < 16; ++jj) if ((i + 1) * (jj + 1) <= 16) {
            unsigned x = key_pack(av[i] + bv[jj], (unsigned)(i * 16 + jj), 255u);
#pragma unroll
            for (int pos = (i + 1) * (jj + 1) - 1; pos < 16; ++pos) CE(cv[pos], x);
        }
    const float cmax = key_val(cv[0], 255u);
    float e[16]; float sum = 0.f;
#pragma unroll
    for (int k = 0; k < 16; ++k) { e[k] = fexp2((key_val(cv[k], 255u) - cmax) * LOG2E); sum += e[k]; }
    const float inv = 1.0f / sum;
    int id[16];
#pragma unroll
    for (int k = 0; k < 16; ++k) {
        const unsigned ij = cv[k] & 255u;
        const unsigned n0 = *(LAS const unsigned char*)(scr + lane * 48 + (ij >> 4)), n1 = *(LAS const unsigned char*)(scr + lane * 48 + 16 + (ij & 15u));
        id[k] = (int)(n0 * 128u + n1);
    }
    { int* ip = IDX + m * 128 + h * 16;
#pragma unroll
      for (int k = 0; k < 16; k += 4) *(int4*)(ip + k) = make_int4(id[k], id[k + 1], id[k + 2], id[k + 3]);
      if (SCT != nullptr) {
      unsigned* sp = SCL + m * 128 + h * 16;
#pragma unroll
      for (int k = 0; k < 16; k += 4) { u32x4 w;
#pragma unroll
          for (int q = 0; q < 4; ++q) w[q] = SCT[id[k + q]];
          *(u32x4*)(sp + k) = w; } }
      float* gp = Gw + m * 128 + h * 16;
#pragma unroll
      for (int k = 0; k < 16; k += 4) *(f32x4*)(gp + k) = (f32x4){e[k] * inv, e[k + 1] * inv, e[k + 2] * inv, e[k + 3] * inv}; }
}
DI void route_pair(const bf16_t* PQ, const bf16_t* SK, int* IDX, float* Gw, unsigned* SCL, const LAS unsigned* SCT, int tileA, int h, int lane, LAS char* scr) {
    unsigned tA[2][16], tB[2][16];
    route_level1(PQ, SK, tileA, h, lane, tA);
    route_level1(PQ, SK, tileA + 1, h, lane, tB);
    const bool hi = lane >= 32;
#pragma unroll
    for (int p = 0; p < 2; ++p)
#pragma unroll
        for (int i = 0; i < 16; ++i) tA[p][i] = hi ? tB[p][i] : tA[p][i];
    route_level2(tA, (size_t)(tileA + (hi ? 1 : 0)) * 32 + (lane & 31), h, lane, IDX, Gw, SCL, SCT, scr);
}

DI void route_heads(const bf16_t* PQ, const bf16_t* SK, int* IDX, float* Gw, int tile, int ha, int lane, LAS char* scr) {
    unsigned tA[2][16], tB[2][16];
    route_level1(PQ, SK, tile, ha, lane, tA);
    route_level1(PQ, SK, tile, ha + 1, lane, tB);
    const bool hi = lane >= 32;
#pragma unroll
    for (int p = 0; p < 2; ++p)
#pragma unroll
        for (int i = 0; i < 16; ++i) tA[p][i] = hi ? tB[p][i] : tA[p][i];
    route_level2(tA, (size_t)tile * 32 + (lane & 31), hi ? ha + 1 : ha, lane, IDX, Gw, nullptr, nullptr, scr);
}

#define FP4PAIR(w, bsel) __builtin_amdgcn_cvt_scalef32_pk_f32_fp4((w), 1.0f, (bsel))
typedef __bf16 bf16p_t __attribute__((ext_vector_type(2)));
#define FP4BF(w, bsel) __builtin_amdgcn_cvt_scalef32_pk_bf16_fp4((w), 1.0f, (bsel))
#define DOT2(accf, xw, ub) accf = __builtin_amdgcn_fdot2_f32_bf16(__builtin_bit_cast(bf16p_t, (xw)), (ub), accf, false)
typedef int v8i_t __attribute__((ext_vector_type(8)));
typedef short s16x2_t __attribute__((ext_vector_type(2)));
DI f32x4 mfma_x4u4(const u32x4 a, const u32x4 b, const f32x4 c) {
    const v8i_t aa = {(int)a.x, (int)a.y, (int)a.z, (int)a.w, 0, 0, 0, 0}, bb = {(int)b.x, (int)b.y, (int)b.z, (int)b.w, 0, 0, 0, 0};
    return __builtin_amdgcn_mfma_scale_f32_16x16x128_f8f6f4(aa, bb, c, 4, 4, 0, 0x7F7F7F7F, 0, 0x7F7F7F7F);
}
constexpr int PJ_NR = 2;
constexpr int PJ_XS = 0, PJ_ZR = NWAVES * 1536, PJ_STG = PJ_ZR + 1024, PJ_UPITCH = 528, PJ_SCR = PJ_STG + NWAVES * 16 * PJ_UPITCH;
constexpr int PJ_FLG = PJ_SCR + PJ_NR * 3072;
static_assert(PJ_FLG + 32 <= LDS_BYTES - 64, "PEER phase LDS map");
static_assert(8 * 3072 <= NWAVES * 16 * PJ_UPITCH, "tile 0's routing scratch borrows the staging images");
#define PJ_TOK(t_) ((size_t)(F.bx + GRID * ((t_) >> 5)) * 32 + ((t_) & 31))
DI void pj_wait_tile(const Frame& F, int tile) {
    volatile LAS unsigned* fl = (volatile LAS unsigned*)(F.lds + PJ_FLG);
    const unsigned need = tile == 0 ? (unsigned)NWAVES : (unsigned)PJ_NR;
    while (fl[tile] < need) __builtin_amdgcn_s_sleep(2);
    asm volatile("" ::: "memory");
}
DI int pj_pop(const Frame& F) { int v = 0; if (F.lane == 0) v = (int)__atomic_fetch_add((LAS unsigned*)(F.lds + PJ_FLG) + 4, 1u, __ATOMIC_RELAXED); return __builtin_amdgcn_readfirstlane(v); }
DI void peer_u_stream(const Frame& F, const unsigned char* Ub, const unsigned* SCTg, const int* IDX, const float* Gw, const bf16_t* XB, const float* SS, int uw, float* cs) {
    const int lane = F.lane, j16 = lane & 15, kb = lane >> 4;
    LAS unsigned char* xs = F.lds + PJ_XS + uw * 1536;
    LAS unsigned char* zr = F.lds + PJ_ZR;
    { unsigned zz; asm volatile("v_mov_b32 %0, 0" : "=v"(zz)); *(LAS u32x4*)(zr + 16 * lane) = (u32x4){zz, zz, zz, zz}; }
    const LAS unsigned char* xrd = j16 < 3 ? xs + 512 * j16 + 16 * kb : zr;
    constexpr int UPITCH = PJ_UPITCH;
    LAS unsigned char* stg = F.lds + PJ_STG + uw * (16 * UPITCH);
    LAS unsigned char* stw = stg + (lane >> 5) * UPITCH + 16 * (lane & 31);
    const LAS unsigned char* strd = stg + j16 * UPITCH + 16 * kb;
    u32x4 UA[8], UB[8];
#define PU_ISSUE(buf, idv, sub) do { _Pragma("unroll") for (int i_ = 0; i_ < 8; ++i_) { const int e_ = __shfl(idv, (sub) * 16 + 2 * i_ + (lane >> 5)); \
            buf[i_] = *(const u32x4*)(Ub + (size_t)e_ * 512 + 16 * (lane & 31)); } } while (0)
#define PU_DOTS(buf, sub, dreg) do { f32x4 c_ = {0.f, 0.f, 0.f, 0.f}; asm volatile("" ::: "memory"); \
        _Pragma("unroll") for (int i_ = 0; i_ < 8; ++i_) *(LAS u32x4*)(stw + i_ * (2 * UPITCH)) = buf[i_];        \
        _Pragma("unroll") for (int s_ = 0; s_ < 8; ++s_) { const u32x4 xq_ = *(const LAS u32x4*)(xrd + 64 * s_), bq_ = *(const LAS u32x4*)(strd + 64 * s_); c_ = mfma_x4u4(xq_, bq_, c_); } \
        const float dv_ = __shfl(fmaf(c_[2], xs3, fmaf(c_[1], xs2, c_[0] * xs1)), j16); if (kb == (sub)) dreg = dv_; } while (0)
    int t = pj_pop(F);
    if (t >= 128) return;
    pj_wait_tile(F, t >> 5);
    size_t m = PJ_TOK(t);
    u32x4 xa = *(const u32x4*)(XB + m * 1024 + 16 * lane), xb = *(const u32x4*)(XB + m * 1024 + 16 * lane + 8);
    int id0 = IDX[m * 128 + lane], id1 = IDX[m * 128 + 64 + lane];
    float g0 = Gw[m * 128 + lane], g1 = Gw[m * 128 + 64 + lane];
    float ssl = lane < 16 ? SS[m * 16 + lane] : 0.f;
    PU_ISSUE(UA, id0, 0);
#pragma unroll 1
    for (int tnx = 0; t < 128; t = tnx) {
        unsigned xp[8];
#pragma unroll
        for (int i = 0; i < 4; ++i) { xp[i] = xa[i]; xp[4 + i] = xb[i]; }
        PU_ISSUE(UB, id0, 1);
        const unsigned sc0 = SCTg[id0], sc1 = SCTg[id1];
        float xs1, xs2, xs3;
        {
          float xr_[16]; float am = 0.f;
#pragma unroll
          for (int i = 0; i < 8; ++i) { xr_[2 * i] = bflo(xp[i]); xr_[2 * i + 1] = bfhi(xp[i]); am = fmaxf(am, fmaxf(fabsf(xr_[2 * i]), fabsf(xr_[2 * i + 1]))); }
          am = wave_max(am);
          int eb = (int)((__builtin_bit_cast(unsigned, am) >> 23) & 0xFFu); eb = eb < 40 ? 40 : eb;
          xs1 = __builtin_bit_cast(float, (unsigned)(eb - 1) << 23); xs2 = xs1 * 0.25f; xs3 = xs1 * 0.03125f;
#pragma unroll
          for (int t = 0; t < 3; ++t) {
              const float sc_ = t == 0 ? xs1 : t == 1 ? xs2 : xs3;
              u32x2 w;
#pragma unroll
              for (int hw = 0; hw < 2; ++hw) {
                  unsigned ww = 0;
                  ww = __builtin_amdgcn_cvt_scalef32_pk_fp4_f32(ww, xr_[8 * hw + 0], xr_[8 * hw + 1], sc_, 0); ww = __builtin_amdgcn_cvt_scalef32_pk_fp4_f32(ww, xr_[8 * hw + 2], xr_[8 * hw + 3], sc_, 1);
                  ww = __builtin_amdgcn_cvt_scalef32_pk_fp4_f32(ww, xr_[8 * hw + 4], xr_[8 * hw + 5], sc_, 2); ww = __builtin_amdgcn_cvt_scalef32_pk_fp4_f32(ww, xr_[8 * hw + 6], xr_[8 * hw + 7], sc_, 3);
                  w[hw] = ww;
                  if (t < 2) {
                      const f32x2 q0 = __builtin_amdgcn_cvt_scalef32_pk_f32_fp4(ww, sc_, 0), q1 = __builtin_amdgcn_cvt_scalef32_pk_f32_fp4(ww, sc_, 1), q2 = __builtin_amdgcn_cvt_scalef32_pk_f32_fp4(ww, sc_, 2), q3 = __builtin_amdgcn_cvt_scalef32_pk_f32_fp4(ww, sc_, 3);
                      xr_[8 * hw + 0] -= q0.x; xr_[8 * hw + 1] -= q0.y; xr_[8 * hw + 2] -= q1.x; xr_[8 * hw + 3] -= q1.y; xr_[8 * hw + 4] -= q2.x; xr_[8 * hw + 5] -= q2.y; xr_[8 * hw + 6] -= q3.x; xr_[8 * hw + 7] -= q3.y;
                  }
              }
              *(LAS u32x2*)(xs + 512 * t + 8 * lane) = w;
          }
        }
        tnx = pj_pop(F);
        const int tn = tnx < 128 ? tnx : t;
        pj_wait_tile(F, tn >> 5);
        const size_t mn = PJ_TOK(tn);
        const u32x4 nxa = *(const u32x4*)(XB + mn * 1024 + 16 * lane), nxb = *(const u32x4*)(XB + mn * 1024 + 16 * lane + 8);
        const int nid0 = IDX[mn * 128 + lane], nid1 = IDX[mn * 128 + 64 + lane];
        const float ng0 = Gw[mn * 128 + lane], ng1 = Gw[mn * 128 + 64 + lane];
        const float nssl = lane < 16 ? SS[mn * 16 + lane] : 0.f;
        const float rstd = 1.0f / sqrtf(wave_sum(ssl) * (1.0f / 1024.0f) + EPS);
        float d0 = 0.f, d1 = 0.f;
        PU_DOTS(UA, 0, d0); PU_ISSUE(UA, id0, 2);
        PU_DOTS(UB, 1, d0); PU_ISSUE(UB, id0, 3);
        PU_DOTS(UA, 2, d0); PU_ISSUE(UA, id1, 0);
        PU_DOTS(UB, 3, d0); PU_ISSUE(UB, id1, 1);
        PU_DOTS(UA, 0, d1); PU_ISSUE(UA, id1, 2);
        PU_DOTS(UB, 1, d1); PU_ISSUE(UB, id1, 3);
        PU_DOTS(UA, 2, d1); PU_ISSUE(UA, nid0, 0);
        PU_DOTS(UB, 3, d1);
        const float c0 = g0 * gelu_tanh(d0 * (bflo(sc0) * rstd)) * bfhi(sc0), c1 = g1 * gelu_tanh(d1 * (bflo(sc1) * rstd)) * bfhi(sc1);
        m = PJ_TOK(t); cs[m * 128 + lane] = c0; cs[m * 128 + 64 + lane] = c1;
        xa = nxa; xb = nxb; id0 = nid0; id1 = nid1; g0 = ng0; g1 = ng1; ssl = nssl;
    }
#undef PU_ISSUE
#undef PU_DOTS
}
DI void peer_v_pass(const Frame& F, const Args& args, bool last, const unsigned char* Vb, const int* IDX, bf16_t* XB, float* SS, const float* csw) {
    const int lane = F.lane;
    u32x2 A[16], B[16];
#define PW_ISSUE(buf, tab, idv, sub) do { _Pragma("unroll") for (int i_ = 0; i_ < 16; ++i_) { const int e_ = __builtin_amdgcn_readlane(idv, (sub) * 16 + i_); buf[i_] = *(const u32x2*)((tab) + (size_t)e_ * 512 + 8 * lane); } } while (0)
#define PW_ACCUM(buf, cv, sub) do { _Pragma("unroll") for (int i_ = 0; i_ < 16; ++i_) { \
            const float cf_ = __builtin_bit_cast(float, __builtin_amdgcn_readlane(__builtin_bit_cast(int, cv), (sub) * 16 + i_)); const f32x2 cf2_ = {cf_, cf_}; \
            _Pragma("unroll") for (int q_ = 0; q_ < 2; ++q_) { acc[4 * q_] += cf2_ * FP4PAIR(buf[i_][q_], 0); acc[4 * q_ + 1] += cf2_ * FP4PAIR(buf[i_][q_], 1); acc[4 * q_ + 2] += cf2_ * FP4PAIR(buf[i_][q_], 2); acc[4 * q_ + 3] += cf2_ * FP4PAIR(buf[i_][q_], 3); } } } while (0)
#define PV_TOK(t_) ((size_t)(F.bx + GRID * ((t_) >> 5)) * 32 + ((t_) & 31))
    const int t0 = F.wave * 16;
    size_t m = PV_TOK(t0);
    u32x4 xa = *(const u32x4*)(XB + m * 1024 + 16 * lane), xb = *(const u32x4*)(XB + m * 1024 + 16 * lane + 8);
    int id0 = IDX[m * 128 + lane], id1 = IDX[m * 128 + 64 + lane];
    PW_ISSUE(A, Vb, id0, 0);
#pragma unroll 1
    for (int it = 0; it < 16; ++it) {
        m = PV_TOK(t0 + it);
        unsigned xp[8];
#pragma unroll
        for (int i = 0; i < 4; ++i) { xp[i] = xa[i]; xp[4 + i] = xb[i]; }
        const float c0 = csw[m * 128 + lane], c1 = csw[m * 128 + 64 + lane];
        const size_t mn = PV_TOK(t0 + (it < 15 ? it + 1 : it));
        const u32x4 nxa = *(const u32x4*)(XB + mn * 1024 + 16 * lane), nxb = *(const u32x4*)(XB + mn * 1024 + 16 * lane + 8);
        const int nid0 = IDX[mn * 128 + lane], nid1 = IDX[mn * 128 + 64 + lane];
        f32x2 acc[8];
#pragma unroll
        for (int q = 0; q < 8; ++q) acc[q] = (f32x2){0.f, 0.f};
        PW_ISSUE(B, Vb, id0, 1); PW_ACCUM(A, c0, 0);
        PW_ISSUE(A, Vb, id0, 2); PW_ACCUM(B, c0, 1);
        PW_ISSUE(B, Vb, id0, 3); PW_ACCUM(A, c0, 2);
        PW_ISSUE(A, Vb, id1, 0); PW_ACCUM(B, c0, 3);
        PW_ISSUE(B, Vb, id1, 1); PW_ACCUM(A, c1, 0);
        PW_ISSUE(A, Vb, id1, 2); PW_ACCUM(B, c1, 1);
        PW_ISSUE(B, Vb, id1, 3); PW_ACCUM(A, c1, 2);
        PW_ISSUE(A, Vb, nid0, 0); PW_ACCUM(B, c1, 3);
        float xo[16]; float s = 0.f;
#pragma unroll
        for (int q = 0; q < 8; ++q) { xo[2 * q] = bflo(xp[q]) + acc[q].x; xo[2 * q + 1] = bfhi(xp[q]) + acc[q].y; }
        if (!last) {
            u32x4 w0, w1;
#pragma unroll
            for (int q = 0; q < 4; ++q) { w0[q] = cvtpk(xo[2 * q], xo[2 * q + 1]); w1[q] = cvtpk(xo[8 + 2 * q], xo[8 + 2 * q + 1]);
                s += (bflo(w0[q]) * bflo(w0[q]) + bfhi(w0[q]) * bfhi(w0[q])) + (bflo(w1[q]) * bflo(w1[q]) + bfhi(w1[q]) * bfhi(w1[q])); }
            s = wave_sum(s);
            *(u32x4*)(XB + (size_t)m * 1024 + 16 * lane) = w0; *(u32x4*)(XB + (size_t)m * 1024 + 16 * lane + 8) = w1;
            if (lane < 16) SS[(size_t)m * 16 + lane] = lane == 0 ? s : 0.f;
        } else {
#pragma unroll
            for (int q = 0; q < 16; ++q) s += xo[q] * xo[q];
            s = wave_sum(s);
            const float rf = 1.0f / sqrtf(s * (1.0f / 1024.0f) + EPS); const float* fg = INP(I_FINAL_G) + 16 * lane; float* xr = F.X + (size_t)m * 1024 + 16 * lane;
#pragma unroll
            for (int q = 0; q < 4; ++q) { const f32x4 gq = *(const f32x4*)(fg + 4 * q); *(f32x4*)(xr + 4 * q) = (f32x4){xo[4 * q], xo[4 * q + 1], xo[4 * q + 2], xo[4 * q + 3]} * rf * gq; }
        }
        xa = nxa; xb = nxb; id0 = nid0; id1 = nid1;
    }
#undef PV_TOK
#undef PW_ISSUE
#undef PW_ACCUM
}

constexpr int PPL = 7;
constexpr int NPHASE = 1 + DEPTH * PPL;
__global__ void __launch_bounds__(NTHR, 2) trunk_fwd(Args args) {
    extern __shared__ __attribute__((aligned(16))) unsigned char lds_raw[];
    Frame F;
    F.lds = (LAS unsigned char*)lds_raw;
    F.tid = threadIdx.x; F.lane = F.tid & 63; F.wave = __builtin_amdgcn_readfirstlane(F.tid >> 6);
    F.bx = blockIdx.x; F.gw = F.bx * NWAVES + F.wave;
    F.X = args.out; F.ws = args.ws;
    const int lo = args.ph_lo, hi = args.ph_hi;
#if MK_ONE_LAUNCH
    volatile LAS unsigned* bst = (volatile LAS unsigned*)(F.lds + LDS_BYTES - 64);
    if (F.tid < 16) bst[F.tid] = 0u;
    __syncthreads();
    const XcdBarrier gbar = xcd_barrier_post((unsigned*)(args.ws + WS_CTL) + 4096, bst);
    cg::this_grid().sync();
#endif
#define REFRESH() int t_ = threadIdx.x; asm volatile("" : "+v"(t_)); F.tid = t_; F.lane = t_ & 63; F.wave = __builtin_amdgcn_readfirstlane(t_ >> 6); \
    F.gw = F.bx * NWAVES + F.wave; size_t z_ = 0; asm volatile("" : "+s"(z_)); unsigned char* ws = args.ws + z_; F.ws = ws; \
    bf16_t* XB = (bf16_t*)(ws + WS_XB); float* SS = (float*)(ws + WS_SS); bf16_t* YC = (bf16_t*)(ws + WS_YCAT); bf16_t* PROJ = (bf16_t*)(ws + WS_PROJ); \
    bf16_t* CQ = PROJ; bf16_t* PP = (bf16_t*)(ws + WS_PROJ + 64 * MiB); int* IDX = (int*)(ws + WS_PROJ + 64 * MiB); float* GW = (float*)(ws + WS_PROJ + 80 * MiB); \
    bf16_t* Wl = (bf16_t*)(ws + WS_W + l * W_LAYER); bf16_t* Kl = (bf16_t*)(ws + WS_KMEM + (size_t)l * 16 * MiB); bf16_t* VTl = Kl + (size_t)4096 * 1024; \
    (void)XB; (void)SS; (void)YC; (void)PROJ; (void)CQ; (void)PP; (void)IDX; (void)GW; (void)Wl; (void)Kl; (void)VTl;
#pragma unroll 1
    for (int ph = lo; ph < hi; ++ph) {
        const int l = ph == 0 ? 0 : (ph - 1) / PPL, k = ph == 0 ? -1 : (ph - 1) % PPL;
        for (int rep = 0; rep < ((k == PROBE_REP_K) ? 2 : 1); ++rep) {
        if (rep) { WG_SYNC(); xcd_barrier(gbar); }
        switch (k) {
        case -1: if (EN(0)) { REFRESH(); p0_prologue(F, args); } break;
        case 0: case 3: case 5: if (EN(1)) {
            REFRESH();
            if (k == 0 && l == 0) {
#pragma unroll 1
                for (int l2 = 0; l2 < DEPTH; ++l2) {
                    bf16_t* W2 = (bf16_t*)(ws + WS_W + l2 * W_LAYER); bf16_t* K2 = (bf16_t*)(ws + WS_KMEM + (size_t)l2 * 16 * MiB);
                    pg8::Gemm g{(const bf16_t*)(ws + WS_MEMB), W2 + W_CKV / 2, 1024, 1024, 1024}; pg8::StaticOrder S; S.init(MMEM, 2048, F.G, (F.bx + 128 * l2) % F.G, 1024, 1024);
                    pg8::EpiKV E{K2, K2 + (size_t)4096 * 1024, (const float*)(ws + WS_RSTDM)};
                    pg8::gemm_phase<pg8::EpiKV, pg8::StaticOrder, true>(F.lds, g, S, E);
                }
            }
            const bf16_t* Bt = Wl + (k == 0 ? W_IN : k == 3 ? W_CQ : W_PQ) / 2; const int N = k == 0 ? NPROJ : 1024, ldc = k == 0 ? LDP : 1024;
            pg8::Gemm g{XB, Bt, 1024, 1024, 1024}; pg8::StaticOrder S; S.init(MTOK, N, F.G, F.bx, 1024, 1024);
            pg8::EpiBf16 E{k == 0 ? PROJ : CQ, ldc, SS, k == 3 ? 0.0625f * LOG2E : 1.0f, ldc};
            pg8::gemm_phase<pg8::EpiBf16, pg8::StaticOrder, true>(F.lds, g, S, E);
            if (k == 3) {
                pg8::Unit u;
                for (int i = 0; S.next(i, u); ++i) xattn_unit(F, CQ, Kl, VTl, YC, u.pm, u.pn);
            }
        } break;
        case 1: {
            REFRESH();
            if (F.bx < 64) { if (EN(2)) gla_chain(F, args, l, F.bx >> 2, F.bx & 3, PROJ, YC); }
            else {
                if (l == 0) {
                    const int wv = (F.bx - 64) * NWAVES + F.wave, nwv = (F.G - 64) * NWAVES;
                    transpose_list(F, args, (LAS float*)(F.lds + F.wave * 16384), wv, nwv, 1);
                    convert_tables(F, args, 0, wv, nwv); convert_tables(F, args, 1, wv, nwv);
                    WG_SYNC();
                }
                if (EN(3)) { for (int u = F.bx - 64; u < 256; u += F.G - 64) sgu_unit(F, args, l, u >> 4, u & 15, PROJ, YC); }
            }
            if (EN(4)) { LAS char* vl = (LAS char*)F.lds + F.wave * 8192; unsigned* ctr = (unsigned*)(ws + WS_CTL) + 15360 + 64 * l;
                for (;;) { int u0 = 0; if (F.lane == 0) u0 = (int)atomicAdd(ctr, 2u); u0 = __builtin_amdgcn_readfirstlane(u0); if (u0 >= BATCH * 8 * 32) break;
                    for (int u = u0; u < u0 + 2; ++u) sb_unit2(PROJ, YC, u >> 8, (u >> 5) & 7, u & 31, vl, F.lane); } }
        } break;
        case 2: case 4: if (EN(5)) {
            REFRESH();
            pg8::Gemm g{YC, Wl + (k == 2 ? W_OUT : W_CO) / 2, 1024, 1024, 1024}; pg8::StaticOrder S; S.init(MTOK, 1024, F.G, F.bx, 1024, 1024);
            pg8::EpiResid E{XB, SS};
            pg8::gemm_phase<pg8::EpiResid, pg8::StaticOrder, true>(F.lds, g, S, E);
        } break;
        default: if (EN(12)) {
            REFRESH();
            const unsigned char* Ub = ws + WS_TAB + (size_t)l * 16 * MiB; const unsigned char* Vb = Ub + 8 * MiB;
            const bf16_t* SK = (const bf16_t*)(ws + WS_SUBK) + (size_t)l * 8 * 2 * 128 * 64;
            const unsigned* SCTg = (const unsigned*)(ws + WS_TAB + 32 * MiB + (size_t)l * 65536);
            float* cs = (float*)(ws + WS_PROJ + 96 * MiB);
            if (F.tid < 8) ((volatile LAS unsigned*)(F.lds + PJ_FLG))[F.tid] = 0u;
            LDS_SYNC();
            {
                unsigned tA[2][16];
                route_level1(CQ, SK, F.bx, F.wave, F.lane, tA);
                route_level2(tA, (size_t)F.bx * 32 + (F.lane & 31), F.wave, F.lane, IDX, GW, nullptr, nullptr, (LAS char*)F.lds + PJ_STG + F.wave * 3072);
                asm volatile("s_waitcnt vmcnt(0)" ::: "memory");
                if (F.lane == 0) __atomic_fetch_add((LAS unsigned*)(F.lds + PJ_FLG), 1u, __ATOMIC_RELAXED);
            }
            if (F.wave < PJ_NR) {
#pragma unroll 1
                for (int st = 1; st < 4; ++st) {
#pragma unroll 1
                    for (int hq = 0; hq < 2; ++hq) route_heads(CQ, SK, IDX, GW, F.bx + GRID * st, 4 * F.wave + 2 * hq, F.lane, (LAS char*)F.lds + PJ_SCR + F.wave * 3072);
                    asm volatile("s_waitcnt vmcnt(0)" ::: "memory");
                    if (F.lane == 0) __atomic_fetch_add((LAS unsigned*)(F.lds + PJ_FLG) + st, 1u, __ATOMIC_RELAXED);
                }
            }
            peer_u_stream(F, Ub, SCTg, IDX, GW, XB, SS, F.wave, cs);
            WG_SYNC();
            peer_v_pass(F, args, l == DEPTH - 1, Vb, IDX, XB, SS, cs);
        } break;
        }
        }
        WG_SYNC();
#if MK_ONE_LAUNCH
        if (ph + 1 < hi) xcd_barrier(gbar);
#endif
    }
#undef REFRESH
}

extern "C" void kernel_launch(void* const* d_in, const int* in_sizes, int n_in, void* d_out, int out_size, void* d_ws, size_t ws_size, hipStream_t stream) {
    static int grid = 0;
    if (grid == 0) {
        if (n_in != 22 || out_size != MTOK * DM || ws_size < WS_END) { fprintf(stderr, "kernel_launch: unexpected problem (n_in %d out %d ws %zu)\n", n_in, out_size, ws_size); grid = -1; return; }
        int dev = 0, cus = 0, per_cu = 0;
        if (hipGetDevice(&dev) != hipSuccess || hipDeviceGetAttribute(&cus, hipDeviceAttributeMultiprocessorCount, dev) != hipSuccess) { grid = -1; return; }
        if (hipFuncSetAttribute((const void*)trunk_fwd, hipFuncAttributeMaxDynamicSharedMemorySize, LDS_BYTES) != hipSuccess) { fprintf(stderr, "kernel_launch: hipFuncSetAttribute failed\n"); grid = -1; return; }
        if (hipOccupancyMaxActiveBlocksPerMultiprocessor(&per_cu, (const void*)trunk_fwd, NTHR, LDS_BYTES) != hipSuccess || per_cu < 1) { fprintf(stderr, "kernel_launch: occupancy query says %d\n", per_cu); (void)hipGetLastError(); grid = -1; return; }
        if (cus * per_cu < GRID) { fprintf(stderr, "kernel_launch: built for a %d-workgroup resident grid, this device holds %d\n", GRID, cus * per_cu); grid = -1; return; }
        grid = GRID;
    }
    if (grid < 0) return;
    Args a{};
    for (int i = 0; i < 22; ++i) a.in[i] = (const float*)d_in[i];
    a.out = (float*)d_out; a.ws = (unsigned char*)d_ws;
#if MK_ONE_LAUNCH
    if (hipMemsetAsync((char*)d_ws + WS_CTL, 0, 65536, stream) != hipSuccess) { fprintf(stderr, "kernel_launch: memset of the control words failed\n"); return; }
    a.ph_lo = 0; a.ph_hi = NPHASE;
    void* kargs[] = {&a};
    hipError_t e = hipLaunchCooperativeKernel((const void*)trunk_fwd, dim3(grid), dim3(NTHR), kargs, LDS_BYTES, stream);
    if (e != hipSuccess) fprintf(stderr, "cooperative launch failed: %s (grid %d)\n", hipGetErrorString(e), grid);
#else
    for (int p = 0; p < NPHASE; ++p) { a.ph_lo = p; a.ph_hi = p + 1; hipLaunchKernelGGL(trunk_fwd, dim3(grid), dim3(NTHR), LDS_BYTES, stream, a); }
#endif
}
```

```cpp
#include <hip/hip_runtime.h>
#include <hip/hip_cooperative_groups.h>
#include <cstdio>
#include <cstdint>
#include <cmath>
namespace cg = cooperative_groups;

#ifndef PHMASK
#define PHMASK 0xFFFF
#endif
#define EN(n) (((PHMASK) >> (n)) & 1)
#ifndef PROBE_REP_K
#define PROBE_REP_K (-2)
#endif
#ifndef MK_ONE_LAUNCH
#define MK_ONE_LAUNCH 1
#endif

#define LAS __attribute__((address_space(3)))
typedef unsigned short bf16_t;
typedef short bf16x8 __attribute__((ext_vector_type(8)));
typedef short s16x4 __attribute__((ext_vector_type(4)));
typedef short v4i16_t __attribute__((ext_vector_type(4)));
typedef float f32x4 __attribute__((ext_vector_type(4)));
typedef float f32x2 __attribute__((ext_vector_type(2)));
typedef float f32x16 __attribute__((ext_vector_type(16)));
typedef unsigned u32x4 __attribute__((ext_vector_type(4)));
typedef unsigned u32x2 __attribute__((ext_vector_type(2)));
typedef __bf16 bf16x2_t __attribute__((ext_vector_type(2)));
#define DI __device__ __forceinline__
#define MFMA32(a, b, c) __builtin_amdgcn_mfma_f32_32x32x16_bf16((a), (b), (c), 0, 0, 0)

constexpr int BATCH = 16, SEQ = 2048, DM = 1024, MTOK = BATCH * SEQ, DEPTH = 2;
constexpr int NMEM = 256, MMEM = BATCH * NMEM;
constexpr int INW = 2832, LDP = 2944, NPROJ = 3072;
constexpr int C_SBQ = 0, C_SBK = 512, C_SBV = 1024, C_SGU = 1536, C_SGV = 1792, C_GQ = 2048, C_GK = 2176, C_GV = 2304, C_GO = 2560, C_GA = 2816;
constexpr float EPS = 1e-6f;
constexpr float LOG2E = 1.4426950408889634f;

constexpr size_t MiB = 1u << 20;
constexpr size_t WS_CTL = 0;
constexpr size_t WS_SUBK = 1 * MiB;
constexpr size_t WS_WSP = WS_SUBK + 512 * 1024;
constexpr size_t WS_RSTDM = WS_WSP + 256 * 1024;
constexpr size_t WS_SS = 2 * MiB;
constexpr size_t WS_W = 8 * MiB;
constexpr size_t W_IN = 0, W_OUT = 6 * MiB, W_CQ = 8 * MiB, W_CKV = 10 * MiB, W_CO = 14 * MiB, W_PQ = 16 * MiB, W_LAYER = 18 * MiB;
constexpr size_t WS_MEMB = 44 * MiB;
constexpr size_t WS_KMEM = 52 * MiB;
constexpr size_t WS_TAB = 84 * MiB;
constexpr size_t WS_XB = 148 * MiB;
constexpr size_t WS_YCAT = 212 * MiB;
constexpr size_t WS_PROJ = 276 * MiB;
constexpr size_t WS_GKV = 460 * MiB;
constexpr size_t WS_GD = 468 * MiB;
constexpr size_t WS_END = 469 * MiB;

DI unsigned cvtpk(float lo, float hi) { f32x2 v = {lo, hi}; bf16x2_t b = __builtin_convertvector(v, bf16x2_t); return __builtin_bit_cast(unsigned, b); }
DI bf16_t cvt1(float v) { return (bf16_t)(cvtpk(v, 0.f) & 0xffffu); }
DI float bf2f(unsigned short b) { return __uint_as_float((unsigned)b << 16); }
DI float bflo(unsigned w) { return __uint_as_float(w << 16); }
DI float bfhi(unsigned w) { return __uint_as_float(w & 0xffff0000u); }
DI int crow(int r, int hi) { return (r & 3) + 8 * (r >> 2) + 4 * hi; }
DI float fexp2(float x) { return __builtin_amdgcn_exp2f(x); }
DI float flog2(float x) { return __builtin_amdgcn_logf(x); }
DI float frcp(float x) { return __builtin_amdgcn_rcpf(x); }
DI float gelu_tanh(float x) { const float y2 = x * (1.5957691216057308f + 0.0713548162726009f * x * x); return x * frcp(1.f + fexp2(-y2 * LOG2E)); }
DI float silu(float x) { return x * frcp(1.f + fexp2(-x * LOG2E)); }
DI float wave_sum(float v) {
#pragma unroll
    for (int o = 1; o < 64; o <<= 1) v += __shfl_xor(v, o);
    return v;
}
DI s16x4 vtr(LAS const char* p) { return __builtin_bit_cast(s16x4, __builtin_amdgcn_ds_read_tr16_b64_v4i16((LAS v4i16_t*)p)); }
DI bf16x8 cat8(s16x4 lo, s16x4 hi) { return __builtin_shufflevector(lo, hi, 0, 1, 2, 3, 4, 5, 6, 7); }
DI bf16x8 pack8(float a0, float a1, float a2, float a3, float a4, float a5, float a6, float a7) {
    u32x4 p; p[0] = cvtpk(a0, a1); p[1] = cvtpk(a2, a3); p[2] = cvtpk(a4, a5); p[3] = cvtpk(a6, a7); return __builtin_bit_cast(bf16x8, p);
}
#define LDS_WAIT() asm volatile("s_waitcnt lgkmcnt(0)" ::: "memory")
#define LDS_SYNC() do { asm volatile("s_waitcnt lgkmcnt(0)" ::: "memory"); __builtin_amdgcn_s_barrier(); asm volatile("" ::: "memory"); } while (0)
#define WG_SYNC() do { asm volatile("s_waitcnt vmcnt(0) lgkmcnt(0)" ::: "memory"); __builtin_amdgcn_s_barrier(); asm volatile("" ::: "memory"); } while (0)

namespace pg8 {
constexpr int BM = 256, BK = 64, HALF = 128, HTB = HALF * BK * 2, STAGE_BYTES = 8 * HTB, NXCD = 8, WGM = 8;
__host__ __device__ __forceinline__ int lds_byte(int r, int c) { const int st = (r >> 4) * 2 + (c >> 5), rr = r & 15, cc = c & 31, ob = rr * 64 + cc * 2; return st * 1024 + (ob ^ (((ob >> 9) & 1) << 5)); }
__host__ __device__ __forceinline__ void stage_rc(int b, int& R, int& C) { const int st = b / 1024, sb = b % 1024, swz = sb ^ (((sb >> 9) & 1) << 5); R = (st >> 1) * 16 + swz / 64; C = (st & 1) * 32 + (swz % 64) / 2; }
__host__ __device__ __forceinline__ int perm32(int rho) { const int n = rho >> 4, i = rho & 15; return 8 * (i >> 2) + 4 * n + (i & 3); }

struct Unit { int pm, pn; size_t aoff, boff; };
struct Gemm { const bf16_t* A; const bf16_t* Bt; int lda, ldb, K; };

struct StaticOrder {
    int nM, nN, nwg, G, c, lda, ldb;
    __device__ void init(int M, int N, int G_, int c_, int lda_, int ldb_) { nM = M / BM; nN = N / BM; nwg = nM * nN; G = G_; c = c_; lda = lda_; ldb = ldb_; }
    __device__ bool next(int i, Unit& u) const {
        const long L = (long)i * G + c; if (L >= nwg) return false;
        int wgid = (int)L; { const int q = nwg / NXCD, r = nwg % NXCD, xcd = wgid % NXCD, off = wgid / NXCD; wgid = (xcd < r ? xcd * (q + 1) : r * (q + 1) + (xcd - r) * q) + off; }
        const int nig = WGM * nN, gid = wgid / nig, fm = gid * WGM, gsz = (nM - fm) < WGM ? (nM - fm) : WGM;
        u.pm = fm + ((wgid % nig) % gsz); u.pn = (wgid % nig) / gsz;
        u.aoff = (size_t)u.pm * BM * lda; u.boff = (size_t)u.pn * BM * ldb; return true;
    }
};
struct XOrder {
    int G, c, mode;
    __device__ bool next(int i, Unit& u) const {
        const int L = i * G + c; if (L >= 512) return false;
        u.pm = L >> 2; u.pn = L & 3; const int b = u.pm >> 3;
        u.aoff = (size_t)u.pm * 256 * 1024 + u.pn * 256;
        u.boff = mode == 0 ? (size_t)b * 256 * 1024 + u.pn * 256 : (size_t)(b * 4 + u.pn) * 256 * 256;
        return true;
    }
};

struct XOrder2 {
    StaticOrder S; int mode;
    __device__ bool next(int i, Unit& u) const {
        if (!S.next(i, u)) return false; const int b = u.pm >> 3;
        u.aoff = (size_t)u.pm * 256 * 1024 + u.pn * 256;
        u.boff = mode == 0 ? (size_t)b * 256 * 1024 + u.pn * 256 : (size_t)(b * 4 + u.pn) * 256 * 256;
        return true;
    }
};

DI float row_rstd_from_ss(const float* ss, int row, int fq) {
    const f32x4 v = *(const f32x4*)(ss + (size_t)row * 16 + 4 * fq);
    float s = (v[0] + v[1]) + (v[2] + v[3]); s += __shfl_xor(s, 16); s += __shfl_xor(s, 32);
    return 1.0f / sqrtf(s * (1.0f / 1024.0f) + EPS);
}
struct EpiBf16 {
    static constexpr bool PERM = true;
    bf16_t* O; int ldc; const float* ss; float cscale; int ncols;
    DI void operator()(f32x4 (&acc)[2][2][4][2], const Unit& u, int wr, int wc, int fr, int fq) const {
        const int row0 = u.pm * BM + wr * 64 + fr, col0 = u.pn * BM + wc * 32 + 8 * fq;
#pragma unroll
        for (int ai = 0; ai < 2; ++ai)
#pragma unroll
            for (int m = 0; m < 4; ++m) {
                const int row = row0 + ai * HALF + m * 16;
                float rs = cscale; if (ss) rs *= row_rstd_from_ss(ss, row, fq);
                bf16_t* rowp = O + (size_t)row * ldc + col0;
#pragma unroll
                for (int bj = 0; bj < 2; ++bj) if (col0 + bj * HALF < ncols) {
                    const f32x4 v0 = acc[ai][bj][m][0] * rs, v1 = acc[ai][bj][m][1] * rs;
                    u32x4 w; w.x = cvtpk(v0[0], v0[1]); w.y = cvtpk(v0[2], v0[3]); w.z = cvtpk(v1[0], v1[1]); w.w = cvtpk(v1[2], v1[3]);
                    *(u32x4*)(rowp + bj * HALF) = w; }
            }
    }
};
struct EpiKV {
    static constexpr bool PERM = true;
    bf16_t* Kd; bf16_t* VT; const float* rvec;
    DI void operator()(f32x4 (&acc)[2][2][4][2], const Unit& u, int wr, int wc, int fr, int fq) const {
        const int row0 = u.pm * BM + wr * 64 + fr;
#pragma unroll
        for (int ai = 0; ai < 2; ++ai)
#pragma unroll
            for (int m = 0; m < 4; ++m) {
                const int row = row0 + ai * HALF + m * 16; const float rs = rvec[row];
#pragma unroll
                for (int bj = 0; bj < 2; ++bj) {
                    const f32x4 v0 = acc[ai][bj][m][0] * rs, v1 = acc[ai][bj][m][1] * rs;
                    const unsigned w0 = cvtpk(v0[0], v0[1]), w1 = cvtpk(v0[2], v0[3]), w2 = cvtpk(v1[0], v1[1]), w3 = cvtpk(v1[2], v1[3]);
                    if (u.pn < 4) {
                        u32x4 w; w.x = w0; w.y = w1; w.z = w2; w.w = w3;
                        *(u32x4*)(Kd + (size_t)row * 1024 + u.pn * BM + bj * HALF + wc * 32 + 8 * fq) = w;
                    } else {
                        const int key = row & 255, dv0 = bj * HALF + wc * 32 + 8 * fq;
                        bf16_t* p = VT + ((size_t)(u.pm * 4 + (u.pn - 4)) * 256 + dv0) * 256 + key;
                        p[0 * 256] = (bf16_t)w0; p[1 * 256] = (bf16_t)(w0 >> 16); p[2 * 256] = (bf16_t)w1; p[3 * 256] = (bf16_t)(w1 >> 16);
                        p[4 * 256] = (bf16_t)w2; p[5 * 256] = (bf16_t)(w2 >> 16); p[6 * 256] = (bf16_t)w3; p[7 * 256] = (bf16_t)(w3 >> 16);
                    }
                }
            }
    }
};
struct EpiResid {
    static constexpr bool PERM = true;
    bf16_t* XB; float* ss;
    DI void operator()(f32x4 (&acc)[2][2][4][2], const Unit& u, int wr, int wc, int fr, int fq) const {
        const int row0 = u.pm * BM + wr * 64 + fr, col0 = u.pn * BM + wc * 32 + 8 * fq;
#pragma unroll
        for (int ai = 0; ai < 2; ++ai)
#pragma unroll
            for (int m = 0; m < 4; ++m) {
                const int row = row0 + ai * HALF + m * 16; float s = 0.f;
#pragma unroll
                for (int bj = 0; bj < 2; ++bj) {
                    const size_t off = (size_t)row * 1024 + col0 + bj * HALF;
                    const u32x4 o = *(const u32x4*)(XB + off); const f32x4 a0 = acc[ai][bj][m][0], a1 = acc[ai][bj][m][1];
                    u32x4 w; w.x = cvtpk(bflo(o.x) + a0[0], bfhi(o.x) + a0[1]); w.y = cvtpk(bflo(o.y) + a0[2], bfhi(o.y) + a0[3]);
                    w.z = cvtpk(bflo(o.z) + a1[0], bfhi(o.z) + a1[1]); w.w = cvtpk(bflo(o.w) + a1[2], bfhi(o.w) + a1[3]);
                    *(u32x4*)(XB + off) = w;
#pragma unroll
                    for (int q = 0; q < 4; ++q) { const float x0 = bflo(w[q]), x1 = bfhi(w[q]); s += x0 * x0 + x1 * x1; }
                }
                s += __shfl_xor(s, 16); s += __shfl_xor(s, 32);
                if (fq == 0) ss[(size_t)row * 16 + u.pn * 4 + wc] = s;
            }
    }
};
struct EpiSoftmax {
    static constexpr bool PERM = true;
    bf16_t* P; LAS float* xm; LAS float* xs;
    DI void operator()(f32x4 (&acc)[2][2][4][2], const Unit& u, int wr, int wc, int fr, int fq) const {
#pragma unroll
        for (int ai = 0; ai < 2; ++ai)
#pragma unroll
            for (int m = 0; m < 4; ++m) {
                float v = -INFINITY;
#pragma unroll
                for (int bj = 0; bj < 2; ++bj)
#pragma unroll
                    for (int n = 0; n < 2; ++n) { const f32x4 x = acc[ai][bj][m][n]; v = fmaxf(v, fmaxf(fmaxf(x[0], x[1]), fmaxf(x[2], x[3]))); }
                v = fmaxf(v, __shfl_xor(v, 16)); v = fmaxf(v, __shfl_xor(v, 32));
                if (fq == 0) xm[(ai * HALF + wr * 64 + m * 16 + fr) * 4 + wc] = v;
            }
        LDS_WAIT(); __builtin_amdgcn_s_barrier(); asm volatile("" ::: "memory");
#pragma unroll
        for (int ai = 0; ai < 2; ++ai)
#pragma unroll
            for (int m = 0; m < 4; ++m) {
                const f32x4 q = *(LAS const f32x4*)(xm + (ai * HALF + wr * 64 + m * 16 + fr) * 4);
                const float g = fmaxf(fmaxf(q[0], q[1]), fmaxf(q[2], q[3])); float s = 0.f;
#pragma unroll
                for (int bj = 0; bj < 2; ++bj)
#pragma unroll
                    for (int n = 0; n < 2; ++n) { f32x4 x = acc[ai][bj][m][n]; x[0] = fexp2(x[0] - g); x[1] = fexp2(x[1] - g); x[2] = fexp2(x[2] - g); x[3] = fexp2(x[3] - g); acc[ai][bj][m][n] = x; s += (x[0] + x[1]) + (x[2] + x[3]); }
                s += __shfl_xor(s, 16); s += __shfl_xor(s, 32);
                if (fq == 0) xs[(ai * HALF + wr * 64 + m * 16 + fr) * 4 + wc] = s;
            }
        LDS_WAIT(); __builtin_amdgcn_s_barrier(); asm volatile("" ::: "memory");
        const int row0 = u.pm * BM + wr * 64 + fr, col0 = u.pn * BM + wc * 32 + 8 * fq;
#pragma unroll
        for (int ai = 0; ai < 2; ++ai)
#pragma unroll
            for (int m = 0; m < 4; ++m) {
                const f32x4 q = *(LAS const f32x4*)(xs + (ai * HALF + wr * 64 + m * 16 + fr) * 4);
                const float inv = 1.0f / ((q[0] + q[1]) + (q[2] + q[3]));
                bf16_t* rowp = P + (size_t)(row0 + ai * HALF + m * 16) * 1024 + col0;
#pragma unroll
                for (int bj = 0; bj < 2; ++bj) {
                    const f32x4 v0 = acc[ai][bj][m][0] * inv, v1 = acc[ai][bj][m][1] * inv;
                    u32x4 w; w.x = cvtpk(v0[0], v0[1]); w.y = cvtpk(v0[2], v0[3]); w.z = cvtpk(v1[0], v1[1]); w.w = cvtpk(v1[2], v1[3]);
                    *(u32x4*)(rowp + bj * HALF) = w; }
            }
    }
};

template <class Epi, class Sched, bool ALIGN_EPI>
__device__ __forceinline__ void gemm_phase(LAS unsigned char* lds, const Gemm g, const Sched& S, const Epi& E) {
    int tid = threadIdx.x; asm volatile("" : "+v"(tid));
    const int wid = __builtin_amdgcn_readfirstlane(tid >> 6), lane = tid & 63, wr = wid >> 2, wc = wid & 3, fr = lane & 15, fq = lane >> 4;
    const int K = g.K, nt = K / BK;
    unsigned voffA[2], voffB[2];
#pragma unroll
    for (int i = 0; i < 2; ++i) { int R, C; stage_rc(tid * 16 + i * 8192, R, C); const int Rb = Epi::PERM ? ((R & ~31) + perm32(R & 31)) : R;
        voffA[i] = (unsigned)(R * g.lda + C) * 2u; voffB[i] = (unsigned)(Rb * g.ldb + C) * 2u; }
    const size_t kstep = (size_t)(BK * 2);
    const size_t hstepA = (size_t)HALF * g.lda * 2, hstepB = (size_t)HALF * g.ldb * 2;
    const unsigned ldsw = (unsigned)wid * 1024u;
    const int aoff = lds_byte(wr * 64 + fr, fq * 8), boff = lds_byte(wc * 32 + fr, fq * 8);
#define PG8_SA(b, h) (((b) * 2 + (h)) * HTB)
#define PG8_SB(b, h) ((4 + (b) * 2 + (h)) * HTB)
#define PG8_STAGE(bufoff, gbase, voff) do { _Pragma("unroll") for (int _i = 0; _i < 2; ++_i) \
        __builtin_amdgcn_global_load_lds((const unsigned*)((const char*)(gbase) + (voff)[_i]), (LAS unsigned*)(lds + (bufoff) + ldsw + _i * 8192), 16, 0, 0); } while (0)
#define PG8_LDA(dst, b, h) do { _Pragma("unroll") for (int m = 0; m < 4; ++m) _Pragma("unroll") for (int k = 0; k < 2; ++k) dst[m][k] = *(const LAS bf16x8*)(lds + PG8_SA(b, h) + aoff + m * 2048 + k * 1024); } while (0)
#define PG8_LDB(dst, b, h) do { _Pragma("unroll") for (int n = 0; n < 2; ++n) _Pragma("unroll") for (int k = 0; k < 2; ++k) dst[n][k] = *(const LAS bf16x8*)(lds + PG8_SB(b, h) + boff + n * 2048 + k * 1024); } while (0)
#define PG8_MMA(ai, bj, At, Bt) do { __builtin_amdgcn_s_setprio(1); _Pragma("unroll") for (int m = 0; m < 4; ++m) _Pragma("unroll") for (int n = 0; n < 2; ++n) _Pragma("unroll") for (int k = 0; k < 2; ++k) \
        acc[ai][bj][m][n] = __builtin_amdgcn_mfma_f32_16x16x32_bf16(Bt[n][k], At[m][k], acc[ai][bj][m][n], 0, 0, 0); __builtin_amdgcn_s_setprio(0); } while (0)
#define PG8_WAIT_V(n) asm volatile("s_waitcnt vmcnt(" #n ")" ::: "memory")
#define PG8_WAIT_L(n) asm volatile("s_waitcnt lgkmcnt(" #n ")" ::: "memory")
#define PG8_BAR __builtin_amdgcn_s_barrier()
#define PG8_SCHED __builtin_amdgcn_sched_barrier(0)
    Unit cur, nxt; int ui = 0;
    if (!S.next(0, cur)) return;
    f32x4 acc[2][2][4][2];
#pragma unroll
    for (int a = 0; a < 2; ++a)
#pragma unroll
        for (int b = 0; b < 2; ++b)
#pragma unroll
            for (int m = 0; m < 4; ++m)
#pragma unroll
                for (int n = 0; n < 2; ++n) acc[a][b][m][n] = (f32x4){0.f, 0.f, 0.f, 0.f};
    bf16x8 At[4][2], B0[2][2], B1[2][2];
    const char* cA = (const char*)g.A + cur.aoff * 2; const char* cB = (const char*)g.Bt + cur.boff * 2;
    PG8_STAGE(PG8_SB(0, 0), cB, voffB); PG8_STAGE(PG8_SB(0, 1), cB + hstepB, voffB); PG8_STAGE(PG8_SA(0, 0), cA, voffA); PG8_STAGE(PG8_SA(0, 1), cA + hstepA, voffA);
    if (wr == 1) PG8_BAR;
    PG8_WAIT_V(2); PG8_BAR;
    PG8_STAGE(PG8_SB(1, 0), cB + kstep, voffB); PG8_STAGE(PG8_SA(1, 0), cA + kstep, voffA); PG8_STAGE(PG8_SB(1, 1), cB + hstepB + kstep, voffB);
    PG8_WAIT_V(6); PG8_BAR;
    for (;;) {
        const bool has_next = S.next(ui + 1, nxt);
        const char* nA = has_next ? (const char*)g.A + nxt.aoff * 2 : cA; const char* nB = has_next ? (const char*)g.Bt + nxt.boff * 2 : cB;
#pragma unroll 1
        for (int t = 0; t < nt; t += 2) {
            const bool last = (t == nt - 2);
            const char* a1 = cA + (size_t)(t + 1) * kstep;
            const char* a2 = last ? nA : cA + (size_t)(t + 2) * kstep; const char* b2 = last ? nB : cB + (size_t)(t + 2) * kstep;
            const char* a3 = a2 + kstep; const char* b3 = b2 + kstep;
            PG8_LDB(B0, 0, 0); PG8_LDB(B1, 0, 1); PG8_SCHED; PG8_LDA(At, 0, 0); PG8_STAGE(PG8_SA(1, 1), a1 + hstepA, voffA);
            PG8_WAIT_V(8); PG8_WAIT_L(0); PG8_BAR; PG8_MMA(0, 0, At, B0); PG8_MMA(0, 1, At, B1); PG8_BAR; PG8_SCHED;
            PG8_LDA(At, 0, 1); PG8_STAGE(PG8_SB(0, 0), b2, voffB); PG8_STAGE(PG8_SB(0, 1), b2 + hstepB, voffB); PG8_STAGE(PG8_SA(0, 0), a2, voffA);
            PG8_WAIT_V(8); PG8_WAIT_L(0); PG8_BAR; PG8_MMA(1, 0, At, B0); PG8_MMA(1, 1, At, B1); PG8_BAR; PG8_SCHED;
            PG8_LDB(B0, 1, 0); PG8_LDB(B1, 1, 1); PG8_SCHED; PG8_LDA(At, 1, 0); PG8_STAGE(PG8_SA(0, 1), a2 + hstepA, voffA);
            PG8_WAIT_V(8); PG8_WAIT_L(0); PG8_BAR; PG8_MMA(0, 0, At, B0); PG8_MMA(0, 1, At, B1); PG8_BAR; PG8_SCHED;
            PG8_LDA(At, 1, 1); PG8_STAGE(PG8_SB(1, 0), b3, voffB); PG8_STAGE(PG8_SB(1, 1), b3 + hstepB, voffB); PG8_STAGE(PG8_SA(1, 0), a3, voffA);
            PG8_WAIT_V(8); PG8_WAIT_L(0); PG8_BAR; PG8_MMA(1, 0, At, B0); PG8_MMA(1, 1, At, B1); PG8_BAR; PG8_SCHED;
        }
        if constexpr (ALIGN_EPI) { if (wr == 0) PG8_BAR; }
        E(acc, cur, wr, wc, fr, fq);
        if (!has_next) break;
#pragma unroll
        for (int a = 0; a < 2; ++a)
#pragma unroll
            for (int b = 0; b < 2; ++b)
#pragma unroll
                for (int m = 0; m < 4; ++m)
#pragma unroll
                    for (int n = 0; n < 2; ++n) acc[a][b][m][n] = (f32x4){0.f, 0.f, 0.f, 0.f};
        cur = nxt; cA = nA; cB = nB; ++ui;
        if constexpr (ALIGN_EPI) { if (wr == 1) PG8_BAR; }
    }
    PG8_WAIT_V(0);
    if constexpr (!ALIGN_EPI) { if (wr == 0) PG8_BAR; }
    PG8_BAR;
#undef PG8_SA
#undef PG8_SB
#undef PG8_STAGE
#undef PG8_LDA
#undef PG8_LDB
#undef PG8_MMA
#undef PG8_WAIT_V
#undef PG8_WAIT_L
#undef PG8_BAR
#undef PG8_SCHED
}
}

constexpr int NWAVES = 8, NTHR = 512, GRID = 256;
constexpr int RING_BYTES = 131072, XCH_OFF = RING_BYTES, LDS_BYTES = 147456;
struct Args { const float* in[22]; float* out; unsigned char* ws; int ph_lo, ph_hi; };
enum { I_X = 0, I_MEM, I_NORM_MIX, I_W_IN, I_SG_VG, I_SG_W, I_SG_B, I_GLA_WG, I_GLA_BG, I_GLA_OG, I_W_OUT, I_NORM_MEM, I_MEM_GAIN, I_W_CQ, I_W_CKV, I_W_CO, I_NORM_FFN, I_PEER_WQ, I_PEER_SK, I_PEER_U, I_PEER_V, I_FINAL_G };

struct Frame {
    LAS unsigned char* lds; int tid, lane, wave, bx, gw; static constexpr int G = GRID, NGW = GRID * NWAVES;
    float* X; unsigned char* ws;
};
#define INP(i) (args.in[(i)])

#define XB_TMO      128
#define XB_XCNT(j)  (256  + 64 * (j))
#define XB_XSUB(j)  (1280 + 64 * (j))
#define XB_XGEN(j)  (2304 + 64 * (j))
#define XB_TOP      3328
#define XB_TOPGEN   3392
#define XCD_BAR_WORDS 3456
#define XB_SPIN_CAP (1u << 22)
DI unsigned xb_ld(unsigned* p)              { return __hip_atomic_load(p, __ATOMIC_RELAXED, __HIP_MEMORY_SCOPE_AGENT); }
DI unsigned xb_add(unsigned* p, unsigned v) { return __hip_atomic_fetch_add(p, v, __ATOMIC_RELAXED, __HIP_MEMORY_SCOPE_AGENT); }
DI unsigned xb_xcc_id() { return (unsigned)__builtin_amdgcn_s_getreg((3 << 11) | 20) & 0xFu; }
#define XB_SPIN(cond, bar) do { unsigned _sp = 0; while (cond) { __builtin_amdgcn_s_sleep(1); \
    if ((++_sp & 255u) == 0u) { if (xb_ld(&(bar)[XB_TMO])) break; if (_sp > XB_SPIN_CAP) { atomicAdd(&(bar)[XB_TMO], 1u); break; } } } } while (0)
struct XcdBarrier { unsigned* bar; unsigned x; volatile LAS unsigned* st; };
DI XcdBarrier xcd_barrier_post(unsigned* bar, volatile LAS unsigned* st) {
    XcdBarrier b; b.bar = bar; b.x = xb_xcc_id(); b.st = st;
    if (threadIdx.x == 0) (void)xb_add(&bar[XB_XCNT(b.x)], 1u);
    return b;
}
DI void xcd_barrier_complete(unsigned* bar, unsigned x, unsigned& nloc, unsigned& nx) {
    const unsigned G = gridDim.x * gridDim.y * gridDim.z;
    unsigned sum, cnt, mine, sp = 0u;
    for (;;) {
        sum = 0u; cnt = 0u; mine = 0u;
#pragma unroll
        for (unsigned j = 0; j < 16; ++j) { const unsigned c = xb_ld(&bar[XB_XCNT(j)]); sum += c; cnt += (c > 0u) ? 1u : 0u; mine = (j == x) ? c : mine; }
        if (sum == G) break;
        __builtin_amdgcn_s_sleep(1);
        if ((++sp & 255u) == 0u) { if (xb_ld(&bar[XB_TMO])) break; if (sp > XB_SPIN_CAP) { atomicAdd(&bar[XB_TMO], 1u); break; } }
    }
    nloc = mine > 0u ? mine : 1u; nx = cnt > 0u ? cnt : 1u;
}
DI void xcd_barrier(const XcdBarrier& b) {
    asm volatile("s_waitcnt vmcnt(0)" ::: "memory");
    __syncthreads();
    if (threadIdx.x == 0) {
        unsigned* bar = b.bar;
        __builtin_amdgcn_s_waitcnt(0);
        unsigned nloc = b.st[0], nx = b.st[1];
        if (nloc == 0u) { xcd_barrier_complete(bar, b.x, nloc, nx); b.st[0] = nloc; b.st[1] = nx; }
        const unsigned old = xb_add(&bar[XB_XSUB(b.x)], 1u);
        const unsigned gen = old / nloc;
        if (old + 1u == (gen + 1u) * nloc) {
            __builtin_amdgcn_fence(__ATOMIC_RELEASE, "agent");
            asm volatile("s_waitcnt vmcnt(0)" ::: "memory");
            const unsigned og = xb_add(&bar[XB_TOP], 1u);
            const unsigned tg = og / nx;
            if (og + 1u == (tg + 1u) * nx) xb_add(&bar[XB_TOPGEN], 1u);
            else XB_SPIN(xb_ld(&bar[XB_TOPGEN]) == tg, bar);
            __builtin_amdgcn_fence(__ATOMIC_ACQUIRE, "agent");
            xb_add(&bar[XB_XGEN(b.x)], 1u);
            asm volatile("s_waitcnt vmcnt(0)" ::: "memory");
        } else {
            XB_SPIN(xb_ld(&bar[XB_XGEN(b.x)]) == gen, bar);
            __builtin_amdgcn_fence(__ATOMIC_ACQUIRE, "agent");
            asm volatile("s_waitcnt vmcnt(0)" ::: "memory");
        }
    }
    __syncthreads();
}

DI void p0_transpose_item(const float* W, int ldw, int N, int K, const float* gain, bf16_t* WT, LAS float* scr, int item, int lane) {
    const int nblk = N / 32, kb = item / nblk, nb = item % nblk, k0 = 64 * kb, n0 = 32 * nb;
#pragma unroll 8
    for (int i = 0; i < 32; ++i) { const int kk = 2 * i + (lane >> 5); float w = W[(size_t)(k0 + kk) * ldw + n0 + (lane & 31)]; if (gain) w *= gain[k0 + kk]; scr[kk * 33 + (lane & 31)] = w; }
    LDS_WAIT(); asm volatile("" ::: "memory");
    const int c = lane & 7;
#pragma unroll
    for (int j = 0; j < 4; ++j) { const int n = (lane >> 3) + 8 * j; const LAS float* s = scr + (8 * c) * 33 + n;
        u32x4 o; o.x = cvtpk(s[0 * 33], s[1 * 33]); o.y = cvtpk(s[2 * 33], s[3 * 33]); o.z = cvtpk(s[4 * 33], s[5 * 33]); o.w = cvtpk(s[6 * 33], s[7 * 33]);
        *(u32x4*)(WT + (size_t)(n0 + n) * K + k0 + 8 * c) = o; }
    LDS_WAIT(); asm volatile("" ::: "memory");
}
DI unsigned fp4x8(const f32x4 a, const f32x4 b, float inv) {
    unsigned w = 0;
    w = __builtin_amdgcn_cvt_scalef32_pk_fp4_f32(w, a[0] * inv, a[1] * inv, 1.0f, 0); w = __builtin_amdgcn_cvt_scalef32_pk_fp4_f32(w, a[2] * inv, a[3] * inv, 1.0f, 1);
    w = __builtin_amdgcn_cvt_scalef32_pk_fp4_f32(w, b[0] * inv, b[1] * inv, 1.0f, 2); w = __builtin_amdgcn_cvt_scalef32_pk_fp4_f32(w, b[2] * inv, b[3] * inv, 1.0f, 3);
    return w;
}
DI float wave_max(float v) {
#pragma unroll
    for (int o = 1; o < 64; o <<= 1) v = fmaxf(v, __shfl_xor(v, o));
    return v;
}
DI void convert_tables(const Frame& F, const Args& args, int l, int wv, int nwv) {
    const float* gn = INP(I_NORM_FFN) + l * 1024 + 16 * F.lane;
    f32x4 g[4];
#pragma unroll
    for (int q = 0; q < 4; ++q) g[q] = *(const f32x4*)(gn + 4 * q);
    for (int r0 = wv; r0 < 2 * 16384; r0 += 4 * nwv) {
        f32x4 v[4][4];
#pragma unroll
        for (int j = 0; j < 4; ++j) { const int r = min(r0 + j * nwv, 2 * 16384 - 1), isv = r >= 16384, e = r & 16383;
            const float* src = (isv ? INP(I_PEER_V) : INP(I_PEER_U)) + ((size_t)l * 16384 + e) * 1024 + 16 * F.lane;
#pragma unroll
            for (int q = 0; q < 4; ++q) v[j][q] = *(const f32x4*)(src + 4 * q); }
#pragma unroll
        for (int j = 0; j < 4; ++j) { const int r = r0 + j * nwv, isv = r >= 16384, e = r & 16383; float am = 0.f;
            if (r < 2 * 16384) {
#pragma unroll
            for (int q = 0; q < 4; ++q) { if (!isv) v[j][q] = v[j][q] * g[q];
                am = fmaxf(am, fmaxf(fmaxf(fabsf(v[j][q][0]), fabsf(v[j][q][1])), fmaxf(fabsf(v[j][q][2]), fabsf(v[j][q][3])))); }
            am = wave_max(am);
            const float sc = bf2f(cvt1(am > 0.f ? am * (1.0f / 6.0f) : 1.0f)), inv = 1.0f / sc;
            u32x2 w; w.x = fp4x8(v[j][0], v[j][1], inv); w.y = fp4x8(v[j][2], v[j][3], inv);
            *(u32x2*)(F.ws + WS_TAB + (size_t)l * 16 * MiB + (size_t)isv * 8 * MiB + (size_t)e * 512 + 8 * F.lane) = w;
            if (F.lane == 0) ((bf16_t*)(F.ws + WS_TAB + 32 * MiB))[((size_t)l * 16384 + e) * 2 + isv] = cvt1(sc); } }
    }
}
struct TDesc { const float* W; const float* gain; bf16_t* WT; int ldw, nblk; };
DI TDesc tdesc(const Frame& F, const Args& args, int l, int t) {
    TDesc D; D.gain = nullptr; D.ldw = 1024; D.nblk = 32; size_t woff;
    switch (t) {
    case 0: D.W = INP(I_W_IN) + (size_t)l * 1024 * INW; D.ldw = INW; D.nblk = 88; D.gain = INP(I_NORM_MIX) + l * 1024; woff = W_IN; break;
    case 1: D.W = INP(I_W_OUT) + (size_t)l * 1024 * 1024; woff = W_OUT; break;
    case 2: D.W = INP(I_W_CQ) + (size_t)l * 1024 * 1024; D.gain = INP(I_NORM_MEM) + l * 1024; woff = W_CQ; break;
    case 3: D.W = INP(I_W_CKV) + (size_t)l * 1024 * 2048; D.ldw = 2048; D.nblk = 64; D.gain = INP(I_MEM_GAIN) + l * 1024; woff = W_CKV; break;
    case 4: D.W = INP(I_W_CO) + (size_t)l * 1024 * 1024; woff = W_CO; break;
    default: D.W = INP(I_PEER_WQ) + (size_t)l * 1024 * 1024; D.gain = INP(I_NORM_FFN) + l * 1024; woff = W_PQ; break;
    }
    D.WT = (bf16_t*)(F.ws + WS_W + l * W_LAYER + woff); return D;
}
DI void titem_load(const TDesc& D, int item, int lane, float (&v)[32]) {
    const int kb = item / D.nblk, nb = item % D.nblk, k0 = 64 * kb, n0 = 32 * nb;
#pragma unroll
    for (int i = 0; i < 32; ++i) { const int kk = 2 * i + (lane >> 5); float w = D.W[(size_t)(k0 + kk) * D.ldw + n0 + (lane & 31)]; if (D.gain) w *= D.gain[k0 + kk]; v[i] = w; }
}
DI void titem_store(const TDesc& D, int item, int lane, LAS float* scr, const float (&v)[32]) {
    const int kb = item / D.nblk, nb = item % D.nblk, k0 = 64 * kb, n0 = 32 * nb;
#pragma unroll
    for (int i = 0; i < 32; ++i) scr[(2 * i + (lane >> 5)) * 33 + (lane & 31)] = v[i];
    LDS_WAIT(); asm volatile("" ::: "memory");
    const int c = lane & 7;
#pragma unroll
    for (int j = 0; j < 4; ++j) { const int n = (lane >> 3) + 8 * j; const LAS float* s = scr + (8 * c) * 33 + n;
        u32x4 o; o.x = cvtpk(s[0 * 33], s[1 * 33]); o.y = cvtpk(s[2 * 33], s[3 * 33]); o.z = cvtpk(s[4 * 33], s[5 * 33]); o.w = cvtpk(s[6 * 33], s[7 * 33]);
        *(u32x4*)(D.WT + (size_t)(n0 + n) * 1024 + k0 + 8 * c) = o; }
    LDS_WAIT(); asm volatile("" ::: "memory");
}
DI int tl_index(int part, int e) {
    if (part == 0) return e < 1408 ? e : e < 2432 ? 2432 + (e - 1408) : 4480 + 2432 + (e - 2432);
    return e < 1024 ? 1408 + e : e < 2048 ? 3456 + (e - 1024) : e < 4480 ? 4480 + (e - 2048) : 4480 + 3456 + (e - 4480);
}
DI void transpose_list(const Frame& F, const Args& args, LAS float* scr, int wv, int nwv, int part) {
    constexpr int NIT_L = 16 * 88 + 4 * 16 * 32 + 16 * 64;
    const int NIT = part == 0 ? 3456 : 5504;
    float va[32], vb[32]; TDesc Da{}, Db{}; int la = 0, lb = 0;
#define TI_DECODE(e_, D_, loc_) do { const int it_ = tl_index(part, (e_)); const int l_ = it_ / NIT_L; int r_ = it_ % NIT_L; int t_; \
        if (r_ < 1408) t_ = 0; else if (r_ < 1920) { t_ = 1; r_ -= 1408; } else if (r_ < 2432) { t_ = 2; r_ -= 1920; } else if (r_ < 3456) { t_ = 3; r_ -= 2432; } else if (r_ < 3968) { t_ = 4; r_ -= 3456; } else { t_ = 5; r_ -= 3968; } \
        D_ = tdesc(F, args, l_, t_); loc_ = r_; } while (0)
    int it = wv;
    if (it < NIT) { TI_DECODE(it, Da, la); titem_load(Da, la, F.lane, va); }
    for (;;) {
        int itn = it + nwv;
        if (itn < NIT) { TI_DECODE(itn, Db, lb); titem_load(Db, lb, F.lane, vb); }
        if (it < NIT) titem_store(Da, la, F.lane, scr, va);
        it = itn; if (it >= NIT) break;
        itn = it + nwv;
        if (itn < NIT) { TI_DECODE(itn, Da, la); titem_load(Da, la, F.lane, va); }
        titem_store(Db, lb, F.lane, scr, vb);
        it = itn; if (it >= NIT) break;
    }
#undef TI_DECODE
}
DI void p0_prologue(const Frame& F, const Args& args) {
    LAS float* scr = (LAS float*)(F.lds + F.wave * 16384);
    transpose_list(F, args, scr, F.gw, F.NGW, 0);
    const int gt = F.bx * NTHR + F.tid, nthr = F.G * NTHR;
    for (int i = gt; i < DEPTH * 256 * 1024; i += nthr) {
        const int l = i / (256 * 1024), r = i % (256 * 1024), j = r >> 10, k = r & 1023;
        bf16_t* Wi = (bf16_t*)(F.ws + WS_W + l * W_LAYER) + W_IN / 2;
        float v = 0.f;
        if (j < 128) {
            const float* wi = INP(I_W_IN) + (size_t)l * 1024 * INW + (size_t)k * INW + 2816; const float* wg = INP(I_GLA_WG) + l * 16 * 128 + j;
#pragma unroll
            for (int q4 = 0; q4 < 4; ++q4) { const f32x4 w4 = *(const f32x4*)(wi + 4 * q4);
#pragma unroll
                for (int e = 0; e < 4; ++e) v += w4[e] * wg[(4 * q4 + e) * 128]; }
            v *= INP(I_NORM_MIX)[l * 1024 + k];
        }
        Wi[(size_t)(2816 + j) * 1024 + k] = cvt1(v);
    }
    { bf16_t* WSP = (bf16_t*)(F.ws + WS_WSP); const float* sw = INP(I_SG_W);
      for (int i = gt; i < DEPTH * 4 * 128 * 128; i += nthr) { const int s = i & 127, t = (i >> 7) & 127; WSP[i] = cvt1(s <= t ? sw[i] : 0.f); }
      bf16_t* SK = (bf16_t*)(F.ws + WS_SUBK); const float* sk = INP(I_PEER_SK);
      for (int i = gt; i < DEPTH * 8 * 2 * 128 * 64; i += nthr) SK[i] = cvt1(sk[i]); }
    { float* SS = (float*)(F.ws + WS_SS); bf16_t* XB = (bf16_t*)(F.ws + WS_XB); const float* x = INP(I_X);
      for (int m0 = F.gw; m0 < MTOK; m0 += 4 * F.NGW) {
          f32x4 v[4][4];
#pragma unroll
          for (int i = 0; i < 4; ++i) { const f32x4* xr = (const f32x4*)(x + (size_t)(m0 + i * F.NGW) * 1024) + F.lane;
#pragma unroll
              for (int j = 0; j < 4; ++j) v[i][j] = xr[64 * j]; }
#pragma unroll
          for (int i = 0; i < 4; ++i) { const int m = m0 + i * F.NGW; float s = 0.f; u32x2 w[4];
#pragma unroll
              for (int j = 0; j < 4; ++j) { w[j].x = cvtpk(v[i][j][0], v[i][j][1]); w[j].y = cvtpk(v[i][j][2], v[i][j][3]);
                  s += (bflo(w[j].x) * bflo(w[j].x) + bfhi(w[j].x) * bfhi(w[j].x)) + (bflo(w[j].y) * bflo(w[j].y) + bfhi(w[j].y) * bfhi(w[j].y)); }
              s = wave_sum(s);
              u32x2* xb = (u32x2*)(XB + (size_t)m * 1024) + F.lane;
#pragma unroll
              for (int j = 0; j < 4; ++j) xb[64 * j] = w[j];
              if (F.lane < 16) SS[(size_t)m * 16 + F.lane] = F.lane == 0 ? s : 0.f; }
      }
      bf16_t* MB = (bf16_t*)(F.ws + WS_MEMB); float* RM = (float*)(F.ws + WS_RSTDM); const float* mem = INP(I_MEM);
      for (int m = F.gw; m < MMEM; m += F.NGW) {
          const f32x4* xr = (const f32x4*)(mem + (size_t)m * 1024) + F.lane; f32x4 v[4]; float s = 0.f;
#pragma unroll
          for (int j = 0; j < 4; ++j) { v[j] = xr[64 * j]; s += (v[j][0] * v[j][0] + v[j][1] * v[j][1]) + (v[j][2] * v[j][2] + v[j][3] * v[j][3]); }
          s = wave_sum(s);
          u32x2* xb = (u32x2*)(MB + (size_t)m * 1024) + F.lane;
#pragma unroll
          for (int j = 0; j < 4; ++j) { u32x2 w; w.x = cvtpk(v[j][0], v[j][1]); w.y = cvtpk(v[j][2], v[j][3]); xb[64 * j] = w; }
          if (F.lane == 0) RM[m] = 1.0f / sqrtf(s * (1.0f / 1024.0f) + EPS);
      } }
}

constexpr int SBV_PITCH = 192;
DI void sb_unit2(const bf16_t* PROJ, bf16_t* YCAT, int b, int h, int qp, LAS char* vl, int lane) {
    const int q = lane & 31, hh = lane >> 5;
    const size_t rowbase = (size_t)b * SEQ; const int qa = 2 * qp, qb = qa + 1;
    bf16x8 qfA[4], qfB[4];
    { const bf16_t* qrow = PROJ + (rowbase + qa * 32 + q) * LDP + C_SBQ + h * 64 + hh * 8;
#pragma unroll
      for (int s = 0; s < 4; ++s) { qfA[s] = *(const bf16x8*)(qrow + 16 * s); qfB[s] = *(const bf16x8*)(qrow + 32 * LDP + 16 * s); } }
    f32x16 oA0, oA1, oB0, oB1;
#pragma unroll
    for (int r = 0; r < 16; ++r) { oA0[r] = 0.f; oA1[r] = 0.f; oB0[r] = 0.f; oB1[r] = 0.f; }
    float RA = 0.f, RB = 0.f;
    const float zs = 0.125f * LOG2E;
    const int i16 = lane & 15, tq = i16 >> 2, tp = i16 & 3, blk = (lane >> 4) & 1;
    bf16x8 kf[4]; u32x4 vr[4];
#define SB_LOAD_TILE(kt_, kf, vr) do { const bf16_t* krow_ = PROJ + (rowbase + (kt_) * 32 + q) * LDP + C_SBK + h * 64 + hh * 8; \
        _Pragma("unroll") for (int s_ = 0; s_ < 4; ++s_) kf[s_] = *(const bf16x8*)(krow_ + 16 * s_); \
        _Pragma("unroll") for (int i_ = 0; i_ < 4; ++i_) { const int c_ = lane + 64 * i_, row_ = c_ >> 3, ch_ = c_ & 7; vr[i_] = *(const u32x4*)(PROJ + (rowbase + (kt_) * 32 + row_) * LDP + C_SBV + h * 64 + ch_ * 8); } } while (0)
#define SB_MATH(Z, DIAG, R, O0, O1) { \
        float L[16]; \
        _Pragma("unroll") for (int r = 0; r < 16; ++r) { \
            const float zl = Z[r] * zs; float l2 = flog2(1.f + fexp2(zl)); l2 = zl > 60.f ? zl : l2; \
            const bool valid = !(DIAG) || (crow(r, hh) < q); \
            L[r] = valid ? l2 : 0.f; Z[r] = valid ? zl : -INFINITY; } \
        float G[4], Go[4]; \
        _Pragma("unroll") for (int g = 0; g < 4; ++g) { G[g] = (L[4 * g] + L[4 * g + 1]) + (L[4 * g + 2] + L[4 * g + 3]); Go[g] = __shfl_xor(G[g], 32); } \
        float base[4]; float run = 0.f; \
        _Pragma("unroll") for (int g = 3; g >= 0; --g) { base[g] = run + (hh == 0 ? Go[g] : 0.f); run += G[g] + Go[g]; } \
        float P[16]; \
        _Pragma("unroll") for (int g = 0; g < 4; ++g) { \
            const float c3 = R + base[g], c2 = c3 + L[4 * g + 3], c1 = c2 + L[4 * g + 2], c0 = c1 + L[4 * g + 1]; \
            P[4 * g + 3] = fexp2(Z[4 * g + 3] - L[4 * g + 3] - c3); P[4 * g + 2] = fexp2(Z[4 * g + 2] - L[4 * g + 2] - c2); \
            P[4 * g + 1] = fexp2(Z[4 * g + 1] - L[4 * g + 1] - c1); P[4 * g + 0] = fexp2(Z[4 * g + 0] - L[4 * g + 0] - c0); } \
        R += run; \
        const bf16x8 p0 = pack8(P[0], P[1], P[2], P[3], P[4], P[5], P[6], P[7]), p1 = pack8(P[8], P[9], P[10], P[11], P[12], P[13], P[14], P[15]); \
        _Pragma("unroll") for (int s = 0; s < 2; ++s) { \
            const LAS char* vb = vl + (16 * s + 4 * hh + tq) * SBV_PITCH + blk * 32 + tp * 8; \
            const bf16x8 a0 = cat8(vtr(vb), vtr(vb + 8 * SBV_PITCH)), a1 = cat8(vtr(vb + 64), vtr(vb + 8 * SBV_PITCH + 64)); \
            O0 = MFMA32(a0, s == 0 ? p0 : p1, O0); O1 = MFMA32(a1, s == 0 ? p0 : p1, O1); } }
#define SB_ZERO(Z) _Pragma("unroll") for (int r = 0; r < 16; ++r) Z[r] = 0.f;
#define SB_VTOLDS(VR) _Pragma("unroll") for (int i = 0; i < 4; ++i) { const int c = lane + 64 * i, row = c >> 3, ch = c & 7; *(LAS u32x4*)(vl + row * SBV_PITCH + ch * 16) = VR[i]; }
    SB_LOAD_TILE(qb, kf, vr);
    {
        f32x16 zB; SB_ZERO(zB)
#pragma unroll
        for (int s = 0; s < 4; ++s) zB = MFMA32(kf[s], qfB[s], zB);
        SB_VTOLDS(vr)
        SB_LOAD_TILE(qa, kf, vr);
        SB_MATH(zB, true, RB, oB0, oB1)
    }
#define SB_STEP2(kt) { \
        f32x16 zA, zB; SB_ZERO(zA) SB_ZERO(zB) \
        _Pragma("unroll") for (int s = 0; s < 4; ++s) { zA = MFMA32(kf[s], qfA[s], zA); zB = MFMA32(kf[s], qfB[s], zB); } \
        SB_VTOLDS(vr) \
        if (kt > 0) SB_LOAD_TILE(kt - 1, kf, vr); \
        SB_MATH(zA, (kt == qa), RA, oA0, oA1) \
        SB_MATH(zB, false, RB, oB0, oB1) \
        if (__all(RA > 57.7f && RB > 57.7f)) break;            \
    }
    for (int kt = qa; kt >= 0; --kt) SB_STEP2(kt)
#undef SB_STEP2
#undef SB_VTOLDS
#undef SB_ZERO
#undef SB_MATH
#undef SB_LOAD_TILE
    bf16_t* orow = YCAT + (rowbase + qa * 32 + q) * 1024 + h * 64 + 4 * hh;
#pragma unroll
    for (int g = 0; g < 4; ++g) {
        u32x2 w0; w0.x = cvtpk(oA0[4 * g], oA0[4 * g + 1]); w0.y = cvtpk(oA0[4 * g + 2], oA0[4 * g + 3]); *(u32x2*)(orow + 8 * g) = w0;
        u32x2 w1; w1.x = cvtpk(oA1[4 * g], oA1[4 * g + 1]); w1.y = cvtpk(oA1[4 * g + 2], oA1[4 * g + 3]); *(u32x2*)(orow + 32 + 8 * g) = w1;
        u32x2 w2; w2.x = cvtpk(oB0[4 * g], oB0[4 * g + 1]); w2.y = cvtpk(oB0[4 * g + 2], oB0[4 * g + 3]); *(u32x2*)(orow + 32 * 1024 + 8 * g) = w2;
        u32x2 w3; w3.x = cvtpk(oB1[4 * g], oB1[4 * g + 1]); w3.y = cvtpk(oB1[4 * g + 2], oB1[4 * g + 3]); *(u32x2*)(orow + 32 * 1024 + 32 + 8 * g) = w3;
    }
}

constexpr int SGV_PITCH = 576;
DI void sgu_unit(const Frame& F, const Args& args, int l, int b, int c, const bf16_t* PROJ, bf16_t* YCAT) {
    const size_t m0 = (size_t)b * SEQ + c * 128;
    LAS char* Vn = (LAS char*)F.lds;
    {
      const int t = F.tid >> 2, part = F.tid & 3; const bf16_t* vrow = PROJ + (m0 + t) * LDP + C_SGV + part * 64; const float* gn = INP(I_SG_VG) + l * 256 + part * 64;
      float gv[64]; float s = 0.f;
#pragma unroll
      for (int i = 0; i < 8; ++i) { const u32x4 w = *(const u32x4*)(vrow + 8 * i);
#pragma unroll
          for (int j = 0; j < 4; ++j) { const float a = gelu_tanh(bflo(w[j])), bb = gelu_tanh(bfhi(w[j])); gv[8 * i + 2 * j] = a; gv[8 * i + 2 * j + 1] = bb; s += a * a + bb * bb; } }
      s += __shfl_xor(s, 1); s += __shfl_xor(s, 2);
      const float rstd = 1.0f / sqrtf(s * (1.0f / 256.0f) + EPS);
#pragma unroll
      for (int i = 0; i < 8; ++i) { const f32x4 g0 = *(const f32x4*)(gn + 8 * i), g1 = *(const f32x4*)(gn + 8 * i + 4);
          u32x4 w; w.x = cvtpk(gv[8 * i] * rstd * g0[0], gv[8 * i + 1] * rstd * g0[1]); w.y = cvtpk(gv[8 * i + 2] * rstd * g0[2], gv[8 * i + 3] * rstd * g0[3]);
          w.z = cvtpk(gv[8 * i + 4] * rstd * g1[0], gv[8 * i + 5] * rstd * g1[1]); w.w = cvtpk(gv[8 * i + 6] * rstd * g1[2], gv[8 * i + 7] * rstd * g1[3]);
          *(LAS u32x4*)(Vn + t * SGV_PITCH + (part * 64 + 8 * i) * 2) = w; } }
    WG_SYNC();
    {
      const int g = F.wave >> 1, db = F.wave & 1, lane = F.lane, r32 = lane & 31, hh = lane >> 5;
      const int i16 = lane & 15, tq = i16 >> 2, tp = i16 & 3, blk = (lane >> 4) & 1;
      const bf16_t* Wg = (const bf16_t*)(F.ws + WS_WSP) + ((size_t)(l * 4 + g) * 128) * 128;
      const float* bias = INP(I_SG_B) + (l * 4 + g) * 128;
      const int ch0 = g * 64 + db * 32 + 4 * hh;
      for (int tb = 0; tb < 4; ++tb) {
          const int t = tb * 32 + r32;
          u32x2 uw[4];
#pragma unroll
          for (int gi = 0; gi < 4; ++gi) uw[gi] = *(const u32x2*)(PROJ + (m0 + t) * LDP + C_SGU + ch0 + 8 * gi);
          const float bt = bias[t];
          f32x16 acc;
#pragma unroll
          for (int r = 0; r < 16; ++r) acc[r] = 0.f;
          for (int sb = 0; sb <= tb; ++sb) {
#pragma unroll
              for (int ks = 0; ks < 2; ++ks) {
                  const bf16x8 wf = *(const bf16x8*)(Wg + (size_t)t * 128 + sb * 32 + 16 * ks + 8 * hh);
                  const LAS char* vb = Vn + (sb * 32 + 16 * ks + 8 * hh + tq) * SGV_PITCH + (g * 64 + db * 32 + blk * 16) * 2 + tp * 8;
                  const bf16x8 vf = cat8(vtr(vb), vtr(vb + 4 * SGV_PITCH));
                  acc = MFMA32(vf, wf, acc);
              }
          }
          bf16_t* yo = YCAT + (m0 + t) * 1024 + 512 + ch0;
#pragma unroll
          for (int gi = 0; gi < 4; ++gi) {
              const float y0 = gelu_tanh(bflo(uw[gi].x)) * (acc[4 * gi] + bt), y1 = gelu_tanh(bfhi(uw[gi].x)) * (acc[4 * gi + 1] + bt);
              const float y2 = gelu_tanh(bflo(uw[gi].y)) * (acc[4 * gi + 2] + bt), y3 = gelu_tanh(bfhi(uw[gi].y)) * (acc[4 * gi + 3] + bt);
              u32x2 wv; wv.x = cvtpk(y0, y1); wv.y = cvtpk(y2, y3); *(u32x2*)(yo + 8 * gi) = wv;
          }
      } }
    WG_SYNC();
}

constexpr int GQ_PITCH = 80, GV_PITCH = 192, GS_PITCH = 80;
constexpr int GL_QT = 0, GL_KT = GL_QT + 128 * GQ_PITCH, GL_VV = GL_KT + 128 * GQ_PITCH, GL_ST = GL_VV + 128 * GV_PITCH, GL_SEG = GL_ST + 64 * GS_PITCH,
              GL_D = GL_SEG + 16 * 32 * 4, GL_SSQ = GL_D + 32 * 4, GL_END = GL_SSQ + 128 * 2 * 4;
DI void gla_chain(const Frame& F, const Args& args, int l, int b, int h, const bf16_t* PROJ, bf16_t* YCAT) {
    LAS char* L = (LAS char*)F.lds;
    LAS float* SEG = (LAS float*)(L + GL_SEG); LAS float* Dd = (LAS float*)(L + GL_D); LAS float* SSQ = (LAS float*)(L + GL_SSQ);
    const int tid = F.tid, lane = F.lane, w = F.wave, r32 = lane & 31, hh = lane >> 5;
    const int i16 = lane & 15, tq = i16 >> 2, tp = i16 & 3, blk = (lane >> 4) & 1;
    for (int i = tid; i < 64 * GS_PITCH / 4; i += NTHR) ((LAS unsigned*)(L + GL_ST))[i] = 0u;
    f32x16 st;
#pragma unroll
    for (int r = 0; r < 16; ++r) st[r] = 0.f;
    const int j = tid & 31, seg = tid >> 5;
    const float bg = INP(I_GLA_BG)[l * 128 + h * 32 + j];
    const int tb = w & 3, dh = w >> 2;
    float ga[8], kr[8], qr[8]; u32x4 vv[2];
#define GC_LOAD(c_) do { const size_t m0_ = (size_t)b * SEQ + (c_) * 128; \
        _Pragma("unroll") for (int i_ = 0; i_ < 8; ++i_) { const bf16_t* p_ = PROJ + (m0_ + seg * 8 + i_) * LDP + h * 32 + j; ga[i_] = bf2f(p_[C_GA]); kr[i_] = bf2f(p_[C_GK]); qr[i_] = bf2f(p_[C_GQ]); } \
        _Pragma("unroll") for (int i_ = 0; i_ < 2; ++i_) { const int cc_ = tid + 512 * i_, row_ = cc_ >> 3, ch_ = cc_ & 7; vv[i_] = *(const u32x4*)(PROJ + (m0_ + row_) * LDP + C_GV + h * 64 + ch_ * 8); } } while (0)
    GC_LOAD(0);
    LDS_SYNC();
#pragma unroll 1
    for (int c = 0; c < 16; ++c) {
        const size_t m0 = (size_t)b * SEQ + c * 128;
        float bc[8]; float run = 0.f;
#pragma unroll
        for (int i = 0; i < 8; ++i) {
            const float g = ga[i] + bg;
            const float sp = fmaxf(-g, 0.f) + flog2(1.f + fexp2(-fabsf(g) * LOG2E)) * 0.6931471805599453f;
            run += -sp * (1.0f / 16.0f); bc[i] = run;
        }
        SEG[seg * 32 + j] = run;
#pragma unroll
        for (int i = 0; i < 2; ++i) { const int cc = tid + 512 * i, row = cc >> 3, ch = cc & 7; *(LAS u32x4*)(L + GL_VV + row * GV_PITCH + ch * 16) = vv[i]; }
        LDS_SYNC();
        float pre = 0.f;
#pragma unroll
        for (int s2 = 0; s2 < 15; ++s2) { const float v_ = SEG[s2 * 32 + j]; pre += s2 < seg ? v_ : 0.f; }
#pragma unroll
        for (int i = 0; i < 8; ++i) {
            const int t = seg * 8 + i; const float bb = pre + bc[i];
            *(LAS bf16_t*)(L + GL_QT + t * GQ_PITCH + j * 2) = cvt1(qr[i] * 0.17677669529663687f * fexp2(bb * LOG2E));
            *(LAS bf16_t*)(L + GL_KT + t * GQ_PITCH + j * 2) = cvt1(kr[i] * fexp2(-bb * LOG2E));
            if (t == 127) Dd[j] = fexp2(bb * LOG2E);
        }
        if (c < 15) GC_LOAD(c + 1);
        u32x2 gov[4];
        { const bf16_t* go = PROJ + (m0 + tb * 32 + r32) * LDP + C_GO + h * 64 + dh * 32 + 4 * hh;
#pragma unroll
          for (int g = 0; g < 4; ++g) gov[g] = *(const u32x2*)(go + 8 * g); }
        LDS_SYNC();
        f32x16 o;
#pragma unroll
        for (int r = 0; r < 16; ++r) o[r] = 0.f;
        bf16x8 qf[2];
#pragma unroll
        for (int ks = 0; ks < 2; ++ks) qf[ks] = *(LAS const bf16x8*)(L + GL_QT + (tb * 32 + r32) * GQ_PITCH + (16 * ks + 8 * hh) * 2);
        for (int sb = 0; sb <= tb; ++sb) {
            f32x16 sT;
#pragma unroll
            for (int r = 0; r < 16; ++r) sT[r] = 0.f;
#pragma unroll
            for (int ks = 0; ks < 2; ++ks) { const bf16x8 kf = *(LAS const bf16x8*)(L + GL_KT + (sb * 32 + r32) * GQ_PITCH + (16 * ks + 8 * hh) * 2); sT = MFMA32(kf, qf[ks], sT); }
            if (sb == tb) {
#pragma unroll
                for (int r = 0; r < 16; ++r) if (crow(r, hh) > r32) sT[r] = 0.f;
            }
            const bf16x8 p0 = pack8(sT[0], sT[1], sT[2], sT[3], sT[4], sT[5], sT[6], sT[7]), p1 = pack8(sT[8], sT[9], sT[10], sT[11], sT[12], sT[13], sT[14], sT[15]);
#pragma unroll
            for (int s = 0; s < 2; ++s) {
                const LAS char* vb = L + GL_VV + (sb * 32 + 16 * s + 4 * hh + tq) * GV_PITCH + (dh * 32 + blk * 16) * 2 + tp * 8;
                const bf16x8 a = cat8(vtr(vb), vtr(vb + 8 * GV_PITCH));
                o = MFMA32(a, s == 0 ? p0 : p1, o);
            }
        }
#pragma unroll
        for (int ks = 0; ks < 2; ++ks) {
            const bf16x8 a = *(LAS const bf16x8*)(L + GL_ST + (dh * 32 + r32) * GS_PITCH + (16 * ks + 8 * hh) * 2);
            o = MFMA32(a, qf[ks], o);
        }
        if (tb == 0) {
#pragma unroll
            for (int ks = 0; ks < 8; ++ks) {
                const LAS char* kb = L + GL_KT + (16 * ks + 8 * hh + tq) * GQ_PITCH + (blk * 16) * 2 + tp * 8;
                const bf16x8 a = cat8(vtr(kb), vtr(kb + 4 * GQ_PITCH));
                const LAS char* vb = L + GL_VV + (16 * ks + 8 * hh + tq) * GV_PITCH + (dh * 32 + blk * 16) * 2 + tp * 8;
                const bf16x8 bfr = cat8(vtr(vb), vtr(vb + 4 * GV_PITCH));
                st = MFMA32(a, bfr, st);
            }
#pragma unroll
            for (int r = 0; r < 16; ++r) st[r] *= Dd[crow(r, hh)];
        }
        float ssq = 0.f;
#pragma unroll
        for (int r = 0; r < 16; ++r) ssq += o[r] * o[r];
        ssq += __shfl_xor(ssq, 32);
        if (hh == 0) SSQ[(tb * 32 + r32) * 2 + dh] = ssq;
        LDS_SYNC();
        {
            const int t = tb * 32 + r32; const float tot = SSQ[t * 2] + SSQ[t * 2 + 1]; const float rstd = 1.0f / sqrtf(tot * (1.0f / 64.0f) + EPS);
            const float* gn = INP(I_GLA_OG) + l * 256 + h * 64 + dh * 32 + 4 * hh;
            bf16_t* yo = YCAT + (m0 + t) * 1024 + 768 + h * 64 + dh * 32 + 4 * hh;
#pragma unroll
            for (int g = 0; g < 4; ++g) {
                const u32x2 gw = gov[g]; const f32x4 gg = *(const f32x4*)(gn + 8 * g);
                const float y0 = o[4 * g] * rstd * gg[0] * silu(bflo(gw.x)), y1 = o[4 * g + 1] * rstd * gg[1] * silu(bfhi(gw.x));
                const float y2 = o[4 * g + 2] * rstd * gg[2] * silu(bflo(gw.y)), y3 = o[4 * g + 3] * rstd * gg[3] * silu(bfhi(gw.y));
                u32x2 wv; wv.x = cvtpk(y0, y1); wv.y = cvtpk(y2, y3); *(u32x2*)(yo + 8 * g) = wv;
            }
        }
        if (tb == 0) {
#pragma unroll
            for (int g = 0; g < 4; ++g) { u32x2 wv; wv.x = cvtpk(st[4 * g], st[4 * g + 1]); wv.y = cvtpk(st[4 * g + 2], st[4 * g + 3]);
                *(LAS u32x2*)(L + GL_ST + (dh * 32 + r32) * GS_PITCH + (8 * g + 4 * hh) * 2) = wv; }
        }
        LDS_SYNC();
    }
#undef GC_LOAD
}

constexpr int XA_PITCH = 528;
template <int PITCH, int I0, int N> DI void xattn_load(const bf16_t* src, int tid, u32x4 (&v)[N]) {
    const bf16_t* p = src + (size_t)(tid >> 5) * PITCH + (tid & 31) * 8;
#pragma unroll
    for (int i = 0; i < N; ++i) v[i] = *(const u32x4*)(p + (size_t)(I0 + i) * 16 * PITCH);
}
template <int I0, int N> DI void xattn_store(LAS char* img, int tid, const u32x4 (&v)[N]) {
    LAS char* d = img + (tid >> 5) * XA_PITCH + (tid & 31) * 16;
#pragma unroll
    for (int i = 0; i < N; ++i) *(LAS u32x4*)(d + (I0 + i) * 16 * XA_PITCH) = v[i];
}
DI void xattn_unit(const Frame& F, const bf16_t* CQ, const bf16_t* Kl, const bf16_t* VTl, bf16_t* O, int pm, int h) {
    LAS char* img = (LAS char*)F.lds;
    const int lane = F.lane, r32 = lane & 31, hh = lane >> 5, b = pm >> 3;
    const size_t tok = (size_t)pm * 256 + F.wave * 32 + r32;
    { u32x4 sk[16]; xattn_load<1024, 0, 16>(Kl + (size_t)b * 256 * 1024 + h * 256, F.tid, sk); xattn_store<0, 16>(img, F.tid, sk); }
    const bf16_t* qrow = CQ + tok * 1024 + h * 256 + 8 * hh;
    bf16x8 qn = *(const bf16x8*)qrow;
    LDS_SYNC();
    u32x4 sv0[8]; xattn_load<256, 0, 8>(VTl + (size_t)(b * 4 + h) * 256 * 256, F.tid, sv0);
    f32x16 acc[8];
#pragma unroll
    for (int kb = 0; kb < 8; ++kb)
#pragma unroll
        for (int r = 0; r < 16; ++r) acc[kb][r] = 0.f;
#pragma unroll 1
    for (int ks = 0; ks < 16; ++ks) {
        const bf16x8 q = qn;
        qn = *(const bf16x8*)(qrow + 16 * (ks < 15 ? ks + 1 : ks));
        const LAS char* kp = img + r32 * XA_PITCH + (16 * ks + 8 * hh) * 2;
#pragma unroll
        for (int kb = 0; kb < 8; ++kb) acc[kb] = MFMA32(*(LAS const bf16x8*)(kp + kb * 32 * XA_PITCH), q, acc[kb]);
    }
    float mx = -INFINITY;
#pragma unroll
    for (int kb = 0; kb < 8; ++kb)
#pragma unroll
        for (int r = 0; r < 16; ++r) mx = fmaxf(mx, acc[kb][r]);
    mx = fmaxf(mx, __shfl_xor(mx, 32));
    float sum = 0.f;
#pragma unroll
    for (int kb = 0; kb < 8; ++kb)
#pragma unroll
        for (int r = 0; r < 16; ++r) { const float p = fexp2(acc[kb][r] - mx); acc[kb][r] = p; sum += p; }
    sum += __shfl_xor(sum, 32);
    const float inv = 1.0f / sum;
    bf16x8 pf[8][2];
#pragma unroll
    for (int kb = 0; kb < 8; ++kb) {
        pf[kb][0] = pack8(acc[kb][0], acc[kb][1], acc[kb][2], acc[kb][3], acc[kb][4], acc[kb][5], acc[kb][6], acc[kb][7]);
        pf[kb][1] = pack8(acc[kb][8], acc[kb][9], acc[kb][10], acc[kb][11], acc[kb][12], acc[kb][13], acc[kb][14], acc[kb][15]);
    }
    LDS_SYNC();
    { u32x4 sv1[8]; xattn_load<256, 8, 8>(VTl + (size_t)(b * 4 + h) * 256 * 256, F.tid, sv1); xattn_store<0, 8>(img, F.tid, sv0); xattn_store<8, 8>(img, F.tid, sv1); }
    LDS_SYNC();
    bf16_t* orow = O + tok * 1024 + h * 256 + 4 * hh;
#pragma unroll 1
    for (int db = 0; db < 8; ++db) {
        f32x16 o;
#pragma unroll
        for (int r = 0; r < 16; ++r) o[r] = 0.f;
#pragma unroll
        for (int kb = 0; kb < 8; ++kb)
#pragma unroll
            for (int s2 = 0; s2 < 2; ++s2) {
                const LAS char* vp = img + (db * 32 + r32) * XA_PITCH + (32 * kb + 16 * s2 + 4 * hh) * 2;
                const bf16x8 vf = cat8(*(LAS const s16x4*)vp, *(LAS const s16x4*)(vp + 16));
                o = MFMA32(vf, pf[kb][s2], o);
            }
#pragma unroll
        for (int g = 0; g < 4; ++g) { u32x2 w; w.x = cvtpk(o[4 * g] * inv, o[4 * g + 1] * inv); w.y = cvtpk(o[4 * g + 2] * inv, o[4 * g + 3] * inv); *(u32x2*)(orow + 32 * db + 8 * g) = w; }
    }
    LDS_SYNC();
}

DI unsigned key_pack(float v, unsigned tag, unsigned mask) { const unsigned b = __float_as_uint(v); const unsigned mono = b ^ ((unsigned)((int)b >> 31) | 0x80000000u); return (mono & ~mask) | tag; }
DI float key_val(unsigned k, unsigned mask) { const unsigned mono = k & ~mask; const unsigned b = (mono & 0x80000000u) ? (mono ^ 0x80000000u) : ~mono; return __uint_as_float(b); }
#define CE(a, b) do { const unsigned _h = (a) > (b) ? (a) : (b); const unsigned _l = (a) > (b) ? (b) : (a); (a) = _h; (b) = _l; } while (0)
#define SORT16_DESC(v) do { CE(v[0], v[1]); CE(v[2], v[3]); CE(v[0], v[2]); CE(v[1], v[3]); CE(v[1], v[2]); CE(v[4], v[5]); CE(v[6], v[7]); CE(v[4], v[6]); CE(v[5], v[7]); CE(v[5], v[6]); CE(v[0], v[4]); CE(v[2], v[6]); CE(v[2], v[4]); CE(v[1], v[5]); CE(v[3], v[7]); CE(v[3], v[5]); CE(v[1], v[2]); CE(v[3], v[4]); CE(v[5], v[6]); CE(v[8], v[9]); CE(v[10], v[11]); CE(v[8], v[10]); CE(v[9], v[11]); CE(v[9], v[10]); CE(v[12], v[13]); CE(v[14], v[15]); CE(v[12], v[14]); CE(v[13], v[15]); CE(v[13], v[14]); CE(v[8], v[12]); CE(v[10], v[14]); CE(v[10], v[12]); CE(v[9], v[13]); CE(v[11], v[15]); CE(v[11], v[13]); CE(v[9], v[10]); CE(v[11], v[12]); CE(v[13], v[14]); CE(v[0], v[8]); CE(v[4], v[12]); CE(v[4], v[8]); CE(v[2], v[10]); CE(v[6], v[14]); CE(v[6], v[10]); CE(v[2], v[4]); CE(v[6], v[8]); CE(v[10], v[12]); CE(v[1], v[9]); CE(v[5], v[13]); CE(v[5], v[9]); CE(v[3], v[11]); CE(v[7], v[15]); CE(v[7], v[11]); CE(v[3], v[5]); CE(v[7], v[9]); CE(v[11], v[13]); CE(v[1], v[2]); CE(v[3], v[4]); CE(v[5], v[6]); CE(v[7], v[8]); CE(v[9], v[10]); CE(v[11], v[12]); CE(v[13], v[14]); } while (0)
#define BITONIC16_DESC(v) do { CE(v[0], v[8]); CE(v[1], v[9]); CE(v[2], v[10]); CE(v[3], v[11]); CE(v[4], v[12]); CE(v[5], v[13]); CE(v[6], v[14]); CE(v[7], v[15]); CE(v[0], v[4]); CE(v[1], v[5]); CE(v[2], v[6]); CE(v[3], v[7]); CE(v[8], v[12]); CE(v[9], v[13]); CE(v[10], v[14]); CE(v[11], v[15]); CE(v[0], v[2]); CE(v[1], v[3]); CE(v[4], v[6]); CE(v[5], v[7]); CE(v[8], v[10]); CE(v[9], v[11]); CE(v[12], v[14]); CE(v[13], v[15]); CE(v[0], v[1]); CE(v[2], v[3]); CE(v[4], v[5]); CE(v[6], v[7]); CE(v[8], v[9]); CE(v[10], v[11]); CE(v[12], v[13]); CE(v[14], v[15]); } while (0)
#define MERGE_TOP16(T, v) do { _Pragma("unroll") for (int _i = 0; _i < 16; ++_i) T[_i] = T[_i] > v[15 - _i] ? T[_i] : v[15 - _i]; BITONIC16_T(T); } while (0)
DI void bitonic16(unsigned (&v)[16]) { BITONIC16_DESC(v); }
#define BITONIC16_T(T) bitonic16(T)
DI void route_level1(const bf16_t* PQ, const bf16_t* SK  , int tile, int h, int lane, unsigned (&tpk)[2][16]) {
    const int r32 = lane & 31, hh = lane >> 5; const size_t m = (size_t)tile * 32 + r32;
    bf16x8 qfa[2][4];
#pragma unroll
    for (int p = 0; p < 2; ++p)
#pragma unroll
        for (int ks = 0; ks < 4; ++ks) qfa[p][ks] = *(const bf16x8*)(PQ + m * 1024 + h * 128 + p * 64 + 16 * ks + 8 * hh);
    bf16x8 an[4];
#define RT_LOADA(p_, nb_) do { const bf16_t* skp_ = SK + ((size_t)(h * 2 + (p_)) * 128) * 64; _Pragma("unroll") for (int ks_ = 0; ks_ < 4; ++ks_) an[ks_] = *(const bf16x8*)(skp_ + (size_t)((nb_) * 32 + r32) * 64 + 16 * ks_ + 8 * hh); } while (0)
    RT_LOADA(0, 0);
#pragma unroll
    for (int p = 0; p < 2; ++p) {
        unsigned T[16];
#pragma unroll
        for (int i = 0; i < 16; ++i) T[i] = 0u;
#pragma unroll 1
        for (int nb = 0; nb < 4; ++nb) {
            bf16x8 a[4];
#pragma unroll
            for (int ks = 0; ks < 4; ++ks) a[ks] = an[ks];
            if (nb < 3) RT_LOADA(p, nb + 1); else if (p == 0) RT_LOADA(1, 0);
            f32x16 acc;
#pragma unroll
            for (int r = 0; r < 16; ++r) acc[r] = 0.f;
#pragma unroll
            for (int ks = 0; ks < 4; ++ks) acc = MFMA32(a[ks], qfa[p][ks], acc);
            unsigned v[16];
#pragma unroll
            for (int r = 0; r < 16; ++r) v[r] = key_pack(acc[r], (unsigned)(nb * 32 + crow(r, hh)), 127u);
            SORT16_DESC(v);
            MERGE_TOP16(T, v);
        }
        unsigned pv[16];
#pragma unroll
        for (int i = 0; i < 16; ++i) pv[i] = (unsigned)__shfl_xor((int)T[i], 32);
        MERGE_TOP16(T, pv);
#pragma unroll
        for (int i = 0; i < 16; ++i) tpk[p][i] = T[i];
    }
#undef RT_LOADA
}
DI void route_level2(const unsigned (&tpk)[2][16], size_t m, int h, int lane, int* IDX, float* Gw, unsigned* SCL, const LAS unsigned* SCT  , LAS char* scr  ) {
    { u32x4 w0, w1, w2, w3;
#pragma unroll
      for (int q = 0; q < 4; ++q) {
          w0[q] = (tpk[0][4 * q] & 127u) | ((tpk[0][4 * q + 1] & 127u) << 8) | ((tpk[0][4 * q + 2] & 127u) << 16) | ((tpk[0][4 * q + 3] & 127u) << 24);
          w1[q] = (tpk[1][4 * q] & 127u) | ((tpk[1][4 * q + 1] & 127u) << 8) | ((tpk[1][4 * q + 2] & 127u) << 16) | ((tpk[1][4 * q + 3] & 127u) << 24); }
      (void)w2; (void)w3;
      *(LAS u32x4*)(scr + lane * 48) = w0; *(LAS u32x4*)(scr + lane * 48 + 16) = w1; }
    float av[16], bv[16];
#pragma unroll
    for (int i = 0; i < 16; ++i) { av[i] = key_val(tpk[0][i], 127u); bv[i] = key_val(tpk[1][i], 127u); }
    unsigned cv[16];
#pragma unroll
    for (int i = 0; i < 16; ++i) cv[i] = 0u;
#pragma unroll
    for (int i = 0; i < 16; ++i)
#pragma unroll
        for (int jj = 0; jj < 16; ++jj) if ((i + 1) * (jj + 1) <= 16) {
            unsigned x = key_pack(av[i] + bv[jj], (unsigned)(i * 16 + jj), 255u);
#pragma unroll
            for (int pos = (i + 1) * (jj + 1) - 1; pos < 16; ++pos) CE(cv[pos], x);
        }
    const float cmax = key_val(cv[0], 255u);
    float e[16]; float sum = 0.f;
#pragma unroll
    for (int k = 0; k < 16; ++k) { e[k] = fexp2((key_val(cv[k], 255u) - cmax) * LOG2E); sum += e[k]; }
    const float inv = 1.0f / sum;
    int id[16];
#pragma unroll
    for (int k = 0; k < 16; ++k) {
        const unsigned ij = cv[k] & 255u;
        const unsigned n0 = *(LAS const unsigned char*)(scr + lane * 48 + (ij >> 4)), n1 = *(LAS const unsigned char*)(scr + lane * 48 + 16 + (ij & 15u));
        id[k] = (int)(n0 * 128u + n1);
    }
    { int* ip = IDX + m * 128 + h * 16;
#pragma unroll
      for (int k = 0; k < 16; k += 4) *(int4*)(ip + k) = make_int4(id[k], id[k + 1], id[k + 2], id[k + 3]);
      if (SCT != nullptr) {
      unsigned* sp = SCL + m * 128 + h * 16;
#pragma unroll
      for (int k = 0; k < 16; k += 4) { u32x4 w;
#pragma unroll
          for (int q = 0; q < 4; ++q) w[q] = SCT[id[k + q]];
          *(u32x4*)(sp + k) = w; } }
      float* gp = Gw + m * 128 + h * 16;
#pragma unroll
      for (int k = 0; k < 16; k += 4) *(f32x4*)(gp + k) = (f32x4){e[k] * inv, e[k + 1] * inv, e[k + 2] * inv, e[k + 3] * inv}; }
}
DI void route_pair(const bf16_t* PQ, const bf16_t* SK, int* IDX, float* Gw, unsigned* SCL, const LAS unsigned* SCT, int tileA, int h, int lane, LAS char* scr) {
    unsigned tA[2][16], tB[2][16];
    route_level1(PQ, SK, tileA, h, lane, tA);
    route_level1(PQ, SK, tileA + 1, h, lane, tB);
    const bool hi = lane >= 32;
#pragma unroll
    for (int p = 0; p < 2; ++p)
#pragma unroll
        for (int i = 0; i < 16; ++i) tA[p][i] = hi ? tB[p][i] : tA[p][i];
    route_level2(tA, (size_t)(tileA + (hi ? 1 : 0)) * 32 + (lane & 31), h, lane, IDX, Gw, SCL, SCT, scr);
}

DI void route_heads(const bf16_t* PQ, const bf16_t* SK, int* IDX, float* Gw, int tile, int ha, int lane, LAS char* scr) {
    unsigned tA[2][16], tB[2][16];
    route_level1(PQ, SK, tile, ha, lane, tA);
    route_level1(PQ, SK, tile, ha + 1, lane, tB);
    const bool hi = lane >= 32;
#pragma unroll
    for (int p = 0; p < 2; ++p)
#pragma unroll
        for (int i = 0; i < 16; ++i) tA[p][i] = hi ? tB[p][i] : tA[p][i];
    route_level2(tA, (size_t)tile * 32 + (lane & 31), hi ? ha + 1 : ha, lane, IDX, Gw, nullptr, nullptr, scr);
}

#define FP4PAIR(w, bsel) __builtin_amdgcn_cvt_scalef32_pk_f32_fp4((w), 1.0f, (bsel))
typedef __bf16 bf16p_t __attribute__((ext_vector_type(2)));
#define FP4BF(w, bsel) __builtin_amdgcn_cvt_scalef32_pk_bf16_fp4((w), 1.0f, (bsel))
#define DOT2(accf, xw, ub) accf = __builtin_amdgcn_fdot2_f32_bf16(__builtin_bit_cast(bf16p_t, (xw)), (ub), accf, false)
typedef int v8i_t __attribute__((ext_vector_type(8)));
typedef short s16x2_t __attribute__((ext_vector_type(2)));
DI f32x4 mfma_x4u4(const u32x4 a, const u32x4 b, const f32x4 c) {
    const v8i_t aa = {(int)a.x, (int)a.y, (int)a.z, (int)a.w, 0, 0, 0, 0}, bb = {(int)b.x, (int)b.y, (int)b.z, (int)b.w, 0, 0, 0, 0};
    return __builtin_amdgcn_mfma_scale_f32_16x16x128_f8f6f4(aa, bb, c, 4, 4, 0, 0x7F7F7F7F, 0, 0x7F7F7F7F);
}
constexpr int PJ_NR = 1, PJ_T0 = 2;
constexpr int PJ_XS = 0, PJ_ZR = NWAVES * 1536, PJ_STG = PJ_ZR + 1024, PJ_UPITCH = 528, PJ_SCR = PJ_STG + NWAVES * 16 * PJ_UPITCH;
constexpr int PJ_FLG = PJ_SCR + PJ_NR * 3072;
static_assert(PJ_FLG + 32 <= LDS_BYTES - 64, "PEER phase LDS map");
constexpr int PJ_SCR0 = PJ_FLG + 32;
static_assert(PJ_SCR0 + NWAVES * 3072 <= LDS_BYTES - 64, "PEER phase LDS map");
#define PJ_TOK(t_) ((size_t)(F.bx + GRID * ((t_) >> 5)) * 32 + ((t_) & 31))
DI void pj_wait_tile(const Frame& F, int tile) {
    volatile LAS unsigned* fl = (volatile LAS unsigned*)(F.lds + PJ_FLG);
    const unsigned need = tile < PJ_T0 ? (unsigned)NWAVES : (unsigned)PJ_NR;
    while (fl[tile] < need) __builtin_amdgcn_s_sleep(2);
    asm volatile("" ::: "memory");
}
DI int pj_pop(const Frame& F) { int v = 0; if (F.lane == 0) v = (int)__atomic_fetch_add((LAS unsigned*)(F.lds + PJ_FLG) + 4, 1u, __ATOMIC_RELAXED); return __builtin_amdgcn_readfirstlane(v); }
DI void peer_u_stream(const Frame& F, const unsigned char* Ub, const unsigned* SCTg, const int* IDX, const float* Gw, const bf16_t* XB, const float* SS, int uw, float* cs) {
    const int lane = F.lane, j16 = lane & 15, kb = lane >> 4;
    LAS unsigned char* xs = F.lds + PJ_XS + uw * 1536;
    LAS unsigned char* zr = F.lds + PJ_ZR;
    { unsigned zz; asm volatile("v_mov_b32 %0, 0" : "=v"(zz)); *(LAS u32x4*)(zr + 16 * lane) = (u32x4){zz, zz, zz, zz}; }
    const LAS unsigned char* xrd = j16 < 3 ? xs + 512 * j16 + 16 * kb : zr;
    constexpr int UPITCH = PJ_UPITCH;
    LAS unsigned char* stg = F.lds + PJ_STG + uw * (16 * UPITCH);
    LAS unsigned char* stw = stg + (lane >> 5) * UPITCH + 16 * (lane & 31);
    const LAS unsigned char* strd = stg + j16 * UPITCH + 16 * kb;
    u32x4 UA[8], UB[8];
#define PU_ISSUE(buf, idv, sub) do { _Pragma("unroll") for (int i_ = 0; i_ < 8; ++i_) { const int e_ = __shfl(idv, (sub) * 16 + 2 * i_ + (lane >> 5)); \
            buf[i_] = *(const u32x4*)(Ub + (size_t)e_ * 512 + 16 * (lane & 31)); } } while (0)
#define PU_DOTS(buf, sub, dreg) do { f32x4 c_ = {0.f, 0.f, 0.f, 0.f}; asm volatile("" ::: "memory"); \
        _Pragma("unroll") for (int i_ = 0; i_ < 8; ++i_) *(LAS u32x4*)(stw + i_ * (2 * UPITCH)) = buf[i_];        \
        _Pragma("unroll") for (int s_ = 0; s_ < 8; ++s_) { const u32x4 xq_ = *(const LAS u32x4*)(xrd + 64 * s_), bq_ = *(const LAS u32x4*)(strd + 64 * s_); c_ = mfma_x4u4(xq_, bq_, c_); } \
        const float dv_ = __shfl(fmaf(c_[2], xs3, fmaf(c_[1], xs2, c_[0] * xs1)), j16); if (kb == (sub)) dreg = dv_; } while (0)
    int t = pj_pop(F);
    if (t >= 128) return;
    pj_wait_tile(F, t >> 5);
    size_t m = PJ_TOK(t);
    u32x4 xa = *(const u32x4*)(XB + m * 1024 + 16 * lane), xb = *(const u32x4*)(XB + m * 1024 + 16 * lane + 8);
    int id0 = IDX[m * 128 + lane], id1 = IDX[m * 128 + 64 + lane];
    float g0 = Gw[m * 128 + lane], g1 = Gw[m * 128 + 64 + lane];
    float ssl = lane < 16 ? SS[m * 16 + lane] : 0.f;
    PU_ISSUE(UA, id0, 0);
#pragma unroll 1
    for (int tnx = 0; t < 128; t = tnx) {
        unsigned xp[8];
#pragma unroll
        for (int i = 0; i < 4; ++i) { xp[i] = xa[i]; xp[4 + i] = xb[i]; }
        PU_ISSUE(UB, id0, 1);
        const unsigned sc0 = SCTg[id0], sc1 = SCTg[id1];
        float xs1, xs2, xs3;
        {
          float xr_[16]; float am = 0.f;
#pragma unroll
          for (int i = 0; i < 8; ++i) { xr_[2 * i] = bflo(xp[i]); xr_[2 * i + 1] = bfhi(xp[i]); am = fmaxf(am, fmaxf(fabsf(xr_[2 * i]), fabsf(xr_[2 * i + 1]))); }
          am = wave_max(am);
          int eb = (int)((__builtin_bit_cast(unsigned, am) >> 23) & 0xFFu); eb = eb < 40 ? 40 : eb;
          xs1 = __builtin_bit_cast(float, (unsigned)(eb - 1) << 23); xs2 = xs1 * 0.25f; xs3 = xs1 * 0.03125f;
#pragma unroll
          for (int t = 0; t < 3; ++t) {
              const float sc_ = t == 0 ? xs1 : t == 1 ? xs2 : xs3;
              u32x2 w;
#pragma unroll
              for (int hw = 0; hw < 2; ++hw) {
                  unsigned ww = 0;
                  ww = __builtin_amdgcn_cvt_scalef32_pk_fp4_f32(ww, xr_[8 * hw + 0], xr_[8 * hw + 1], sc_, 0); ww = __builtin_amdgcn_cvt_scalef32_pk_fp4_f32(ww, xr_[8 * hw + 2], xr_[8 * hw + 3], sc_, 1);
                  ww = __builtin_amdgcn_cvt_scalef32_pk_fp4_f32(ww, xr_[8 * hw + 4], xr_[8 * hw + 5], sc_, 2); ww = __builtin_amdgcn_cvt_scalef32_pk_fp4_f32(ww, xr_[8 * hw + 6], xr_[8 * hw + 7], sc_, 3);
                  w[hw] = ww;
                  if (t < 2) {
                      const f32x2 q0 = __builtin_amdgcn_cvt_scalef32_pk_f32_fp4(ww, sc_, 0), q1 = __builtin_amdgcn_cvt_scalef32_pk_f32_fp4(ww, sc_, 1), q2 = __builtin_amdgcn_cvt_scalef32_pk_f32_fp4(ww, sc_, 2), q3 = __builtin_amdgcn_cvt_scalef32_pk_f32_fp4(ww, sc_, 3);
                      xr_[8 * hw + 0] -= q0.x; xr_[8 * hw + 1] -= q0.y; xr_[8 * hw + 2] -= q1.x; xr_[8 * hw + 3] -= q1.y; xr_[8 * hw + 4] -= q2.x; xr_[8 * hw + 5] -= q2.y; xr_[8 * hw + 6] -= q3.x; xr_[8 * hw + 7] -= q3.y;
                  }
              }
              *(LAS u32x2*)(xs + 512 * t + 8 * lane) = w;
          }
        }
        tnx = pj_pop(F);
        const int tn = tnx < 128 ? tnx : t;
        pj_wait_tile(F, tn >> 5);
        const size_t mn = PJ_TOK(tn);
        const u32x4 nxa = *(const u32x4*)(XB + mn * 1024 + 16 * lane), nxb = *(const u32x4*)(XB + mn * 1024 + 16 * lane + 8);
        const int nid0 = IDX[mn * 128 + lane], nid1 = IDX[mn * 128 + 64 + lane];
        const float ng0 = Gw[mn * 128 + lane], ng1 = Gw[mn * 128 + 64 + lane];
        const float nssl = lane < 16 ? SS[mn * 16 + lane] : 0.f;
        const float rstd = 1.0f / sqrtf(wave_sum(ssl) * (1.0f / 1024.0f) + EPS);
        float d0 = 0.f, d1 = 0.f;
        PU_DOTS(UA, 0, d0); PU_ISSUE(UA, id0, 2);
        PU_DOTS(UB, 1, d0); PU_ISSUE(UB, id0, 3);
        PU_DOTS(UA, 2, d0); PU_ISSUE(UA, id1, 0);
        PU_DOTS(UB, 3, d0); PU_ISSUE(UB, id1, 1);
        PU_DOTS(UA, 0, d1); PU_ISSUE(UA, id1, 2);
        PU_DOTS(UB, 1, d1); PU_ISSUE(UB, id1, 3);
        PU_DOTS(UA, 2, d1); PU_ISSUE(UA, nid0, 0);
        PU_DOTS(UB, 3, d1);
        const float c0 = g0 * gelu_tanh(d0 * (bflo(sc0) * rstd)) * bfhi(sc0), c1 = g1 * gelu_tanh(d1 * (bflo(sc1) * rstd)) * bfhi(sc1);
        m = PJ_TOK(t); cs[m * 128 + lane] = c0; cs[m * 128 + 64 + lane] = c1;
        xa = nxa; xb = nxb; id0 = nid0; id1 = nid1; g0 = ng0; g1 = ng1; ssl = nssl;
    }
#undef PU_ISSUE
#undef PU_DOTS
}
DI void peer_v_pass(const Frame& F, const Args& args, bool last, const unsigned char* Vb, const int* IDX, bf16_t* XB, float* SS, const float* csw) {
    const int lane = F.lane;
    u32x2 A[16], B[16];
#define PW_ISSUE(buf, tab, idv, sub) do { _Pragma("unroll") for (int i_ = 0; i_ < 16; ++i_) { const int e_ = __builtin_amdgcn_readlane(idv, (sub) * 16 + i_); buf[i_] = *(const u32x2*)((tab) + (size_t)e_ * 512 + 8 * lane); } } while (0)
#define PW_ACCUM(buf, cv, sub) do { _Pragma("unroll") for (int i_ = 0; i_ < 16; ++i_) { \
            const float cf_ = __builtin_bit_cast(float, __builtin_amdgcn_readlane(__builtin_bit_cast(int, cv), (sub) * 16 + i_)); const f32x2 cf2_ = {cf_, cf_}; \
            _Pragma("unroll") for (int q_ = 0; q_ < 2; ++q_) { acc[4 * q_] += cf2_ * FP4PAIR(buf[i_][q_], 0); acc[4 * q_ + 1] += cf2_ * FP4PAIR(buf[i_][q_], 1); acc[4 * q_ + 2] += cf2_ * FP4PAIR(buf[i_][q_], 2); acc[4 * q_ + 3] += cf2_ * FP4PAIR(buf[i_][q_], 3); } } } while (0)
#define PV_TOK(t_) ((size_t)(F.bx + GRID * ((t_) >> 5)) * 32 + ((t_) & 31))
    const int t0 = F.wave * 16;
    size_t m = PV_TOK(t0);
    u32x4 xa = *(const u32x4*)(XB + m * 1024 + 16 * lane), xb = *(const u32x4*)(XB + m * 1024 + 16 * lane + 8);
    int id0 = IDX[m * 128 + lane], id1 = IDX[m * 128 + 64 + lane];
    PW_ISSUE(A, Vb, id0, 0);
#pragma unroll 1
    for (int it = 0; it < 16; ++it) {
        m = PV_TOK(t0 + it);
        unsigned xp[8];
#pragma unroll
        for (int i = 0; i < 4; ++i) { xp[i] = xa[i]; xp[4 + i] = xb[i]; }
        const float c0 = csw[m * 128 + lane], c1 = csw[m * 128 + 64 + lane];
        const size_t mn = PV_TOK(t0 + (it < 15 ? it + 1 : it));
        const u32x4 nxa = *(const u32x4*)(XB + mn * 1024 + 16 * lane), nxb = *(const u32x4*)(XB + mn * 1024 + 16 * lane + 8);
        const int nid0 = IDX[mn * 128 + lane], nid1 = IDX[mn * 128 + 64 + lane];
        f32x2 acc[8];
#pragma unroll
        for (int q = 0; q < 8; ++q) acc[q] = (f32x2){0.f, 0.f};
        PW_ISSUE(B, Vb, id0, 1); PW_ACCUM(A, c0, 0);
        PW_ISSUE(A, Vb, id0, 2); PW_ACCUM(B, c0, 1);
        PW_ISSUE(B, Vb, id0, 3); PW_ACCUM(A, c0, 2);
        PW_ISSUE(A, Vb, id1, 0); PW_ACCUM(B, c0, 3);
        PW_ISSUE(B, Vb, id1, 1); PW_ACCUM(A, c1, 0);
        PW_ISSUE(A, Vb, id1, 2); PW_ACCUM(B, c1, 1);
        PW_ISSUE(B, Vb, id1, 3); PW_ACCUM(A, c1, 2);
        PW_ISSUE(A, Vb, nid0, 0); PW_ACCUM(B, c1, 3);
        float xo[16]; float s = 0.f;
#pragma unroll
        for (int q = 0; q < 8; ++q) { xo[2 * q] = bflo(xp[q]) + acc[q].x; xo[2 * q + 1] = bfhi(xp[q]) + acc[q].y; }
        if (!last) {
            u32x4 w0, w1;
#pragma unroll
            for (int q = 0; q < 4; ++q) { w0[q] = cvtpk(xo[2 * q], xo[2 * q + 1]); w1[q] = cvtpk(xo[8 + 2 * q], xo[8 + 2 * q + 1]);
                s += (bflo(w0[q]) * bflo(w0[q]) + bfhi(w0[q]) * bfhi(w0[q])) + (bflo(w1[q]) * bflo(w1[q]) + bfhi(w1[q]) * bfhi(w1[q])); }
            s = wave_sum(s);
            *(u32x4*)(XB + (size_t)m * 1024 + 16 * lane) = w0; *(u32x4*)(XB + (size_t)m * 1024 + 16 * lane + 8) = w1;
            if (lane < 16) SS[(size_t)m * 16 + lane] = lane == 0 ? s : 0.f;
        } else {
#pragma unroll
            for (int q = 0; q < 16; ++q) s += xo[q] * xo[q];
            s = wave_sum(s);
            const float rf = 1.0f / sqrtf(s * (1.0f / 1024.0f) + EPS); const float* fg = INP(I_FINAL_G) + 16 * lane; float* xr = F.X + (size_t)m * 1024 + 16 * lane;
#pragma unroll
            for (int q = 0; q < 4; ++q) { const f32x4 gq = *(const f32x4*)(fg + 4 * q); *(f32x4*)(xr + 4 * q) = (f32x4){xo[4 * q], xo[4 * q + 1], xo[4 * q + 2], xo[4 * q + 3]} * rf * gq; }
        }
        xa = nxa; xb = nxb; id0 = nid0; id1 = nid1;
    }
#undef PV_TOK
#undef PW_ISSUE
#undef PW_ACCUM
}

constexpr int PPL = 7;
constexpr int NPHASE = 1 + DEPTH * PPL;
__global__ void __launch_bounds__(NTHR, 2) trunk_fwd(Args args) {
    extern __shared__ __attribute__((aligned(16))) unsigned char lds_raw[];
    Frame F;
    F.lds = (LAS unsigned char*)lds_raw;
    F.tid = threadIdx.x; F.lane = F.tid & 63; F.wave = __builtin_amdgcn_readfirstlane(F.tid >> 6);
    F.bx = blockIdx.x; F.gw = F.bx * NWAVES + F.wave;
    F.X = args.out; F.ws = args.ws;
    const int lo = args.ph_lo, hi = args.ph_hi;
#if MK_ONE_LAUNCH
    volatile LAS unsigned* bst = (volatile LAS unsigned*)(F.lds + LDS_BYTES - 64);
    if (F.tid < 16) bst[F.tid] = 0u;
    __syncthreads();
    const XcdBarrier gbar = xcd_barrier_post((unsigned*)(args.ws + WS_CTL) + 4096, bst);
    cg::this_grid().sync();
#endif
#define REFRESH() int t_ = threadIdx.x; asm volatile("" : "+v"(t_)); F.tid = t_; F.lane = t_ & 63; F.wave = __builtin_amdgcn_readfirstlane(t_ >> 6); \
    F.gw = F.bx * NWAVES + F.wave; size_t z_ = 0; asm volatile("" : "+s"(z_)); unsigned char* ws = args.ws + z_; F.ws = ws; \
    bf16_t* XB = (bf16_t*)(ws + WS_XB); float* SS = (float*)(ws + WS_SS); bf16_t* YC = (bf16_t*)(ws + WS_YCAT); bf16_t* PROJ = (bf16_t*)(ws + WS_PROJ); \
    bf16_t* CQ = PROJ; bf16_t* PP = (bf16_t*)(ws + WS_PROJ + 64 * MiB); int* IDX = (int*)(ws + WS_PROJ + 64 * MiB); float* GW = (float*)(ws + WS_PROJ + 80 * MiB); \
    bf16_t* Wl = (bf16_t*)(ws + WS_W + l * W_LAYER); bf16_t* Kl = (bf16_t*)(ws + WS_KMEM + (size_t)l * 16 * MiB); bf16_t* VTl = Kl + (size_t)4096 * 1024; \
    (void)XB; (void)SS; (void)YC; (void)PROJ; (void)CQ; (void)PP; (void)IDX; (void)GW; (void)Wl; (void)Kl; (void)VTl;
#pragma unroll 1
    for (int ph = lo; ph < hi; ++ph) {
        const int l = ph == 0 ? 0 : (ph - 1) / PPL, k = ph == 0 ? -1 : (ph - 1) % PPL;
        for (int rep = 0; rep < ((k == PROBE_REP_K) ? 2 : 1); ++rep) {
        if (rep) { WG_SYNC(); xcd_barrier(gbar); }
        switch (k) {
        case -1: if (EN(0)) { REFRESH(); p0_prologue(F, args); } break;
        case 0: case 3: case 5: if (EN(1)) {
            REFRESH();
            if (k == 0 && l == 0) {
#pragma unroll 1
                for (int l2 = 0; l2 < DEPTH; ++l2) {
                    bf16_t* W2 = (bf16_t*)(ws + WS_W + l2 * W_LAYER); bf16_t* K2 = (bf16_t*)(ws + WS_KMEM + (size_t)l2 * 16 * MiB);
                    pg8::Gemm g{(const bf16_t*)(ws + WS_MEMB), W2 + W_CKV / 2, 1024, 1024, 1024}; pg8::StaticOrder S; S.init(MMEM, 2048, F.G, (F.bx + 128 * l2) % F.G, 1024, 1024);
                    pg8::EpiKV E{K2, K2 + (size_t)4096 * 1024, (const float*)(ws + WS_RSTDM)};
                    pg8::gemm_phase<pg8::EpiKV, pg8::StaticOrder, true>(F.lds, g, S, E);
                }
            }
            const bf16_t* Bt = Wl + (k == 0 ? W_IN : k == 3 ? W_CQ : W_PQ) / 2; const int N = k == 0 ? NPROJ : 1024, ldc = k == 0 ? LDP : 1024;
            pg8::Gemm g{XB, Bt, 1024, 1024, 1024}; pg8::StaticOrder S; S.init(MTOK, N, F.G, F.bx, 1024, 1024);
            pg8::EpiBf16 E{k == 0 ? PROJ : CQ, ldc, SS, k == 3 ? 0.0625f * LOG2E : 1.0f, ldc};
            pg8::gemm_phase<pg8::EpiBf16, pg8::StaticOrder, true>(F.lds, g, S, E);
            if (k == 3) {
                pg8::Unit u;
                for (int i = 0; S.next(i, u); ++i) xattn_unit(F, CQ, Kl, VTl, YC, u.pm, u.pn);
            }
        } break;
        case 1: {
            REFRESH();
            if (F.bx < 64) { if (EN(2)) gla_chain(F, args, l, F.bx >> 2, F.bx & 3, PROJ, YC); }
            else {
                if (l == 0) {
                    const int wv = (F.bx - 64) * NWAVES + F.wave, nwv = (F.G - 64) * NWAVES;
                    transpose_list(F, args, (LAS float*)(F.lds + F.wave * 16384), wv, nwv, 1);
                    convert_tables(F, args, 0, wv, nwv); convert_tables(F, args, 1, wv, nwv);
                    WG_SYNC();
                }
                if (EN(3)) { for (int u = F.bx - 64; u < 256; u += F.G - 64) sgu_unit(F, args, l, u >> 4, u & 15, PROJ, YC); }
            }
            if (EN(4)) { LAS char* vl = (LAS char*)F.lds + F.wave * 8192; unsigned* ctr = (unsigned*)(ws + WS_CTL) + 15360 + 64 * l;
                for (;;) { int u0 = 0; if (F.lane == 0) u0 = (int)atomicAdd(ctr, 2u); u0 = __builtin_amdgcn_readfirstlane(u0); if (u0 >= BATCH * 8 * 32) break;
                    for (int u = u0; u < u0 + 2; ++u) sb_unit2(PROJ, YC, u >> 8, (u >> 5) & 7, u & 31, vl, F.lane); } }
        } break;
        case 2: case 4: if (EN(5)) {
            REFRESH();
            pg8::Gemm g{YC, Wl + (k == 2 ? W_OUT : W_CO) / 2, 1024, 1024, 1024}; pg8::StaticOrder S; S.init(MTOK, 1024, F.G, F.bx, 1024, 1024);
            pg8::EpiResid E{XB, SS};
            pg8::gemm_phase<pg8::EpiResid, pg8::StaticOrder, true>(F.lds, g, S, E);
        } break;
        default: if (EN(12)) {
            REFRESH();
            const unsigned char* Ub = ws + WS_TAB + (size_t)l * 16 * MiB; const unsigned char* Vb = Ub + 8 * MiB;
            const bf16_t* SK = (const bf16_t*)(ws + WS_SUBK) + (size_t)l * 8 * 2 * 128 * 64;
            const unsigned* SCTg = (const unsigned*)(ws + WS_TAB + 32 * MiB + (size_t)l * 65536);
            float* cs = (float*)(ws + WS_PROJ + 96 * MiB);
            if (F.tid < 8) ((volatile LAS unsigned*)(F.lds + PJ_FLG))[F.tid] = 0u;
            LDS_SYNC();
#pragma unroll 1
            for (int st = 0; st < PJ_T0; ++st) {
                unsigned tA[2][16];
                route_level1(CQ, SK, F.bx + GRID * st, F.wave, F.lane, tA);
                route_level2(tA, (size_t)(F.bx + GRID * st) * 32 + (F.lane & 31), F.wave, F.lane, IDX, GW, nullptr, nullptr, (LAS char*)F.lds + PJ_SCR0 + F.wave * 3072);
                asm volatile("s_waitcnt vmcnt(0)" ::: "memory");
                if (F.lane == 0) __atomic_fetch_add((LAS unsigned*)(F.lds + PJ_FLG) + st, 1u, __ATOMIC_RELAXED);
            }
            if (F.wave < PJ_NR) {
#pragma unroll 1
                for (int st = PJ_T0; st < 4; ++st) {
#pragma unroll 1
                    for (int hq = 0; hq < 8 / (2 * PJ_NR); ++hq) route_heads(CQ, SK, IDX, GW, F.bx + GRID * st, (8 / PJ_NR) * F.wave + 2 * hq, F.lane, (LAS char*)F.lds + PJ_SCR + F.wave * 3072);
                    asm volatile("s_waitcnt vmcnt(0)" ::: "memory");
                    if (F.lane == 0) __atomic_fetch_add((LAS unsigned*)(F.lds + PJ_FLG) + st, 1u, __ATOMIC_RELAXED);
                }
            }
            peer_u_stream(F, Ub, SCTg, IDX, GW, XB, SS, F.wave, cs);
            WG_SYNC();
            peer_v_pass(F, args, l == DEPTH - 1, Vb, IDX, XB, SS, cs);
        } break;
        }
        }
        WG_SYNC();
#if MK_ONE_LAUNCH
        if (ph + 1 < hi) xcd_barrier(gbar);
#endif
    }
#undef REFRESH
}

extern "C" void kernel_launch(void* const* d_in, const int* in_sizes, int n_in, void* d_out, int out_size, void* d_ws, size_t ws_size, hipStream_t stream) {
    static int grid = 0;
    if (grid == 0) {
        if (n_in != 22 || out_size != MTOK * DM || ws_size < WS_END) { fprintf(stderr, "kernel_launch: unexpected problem (n_in %d out %d ws %zu)\n", n_in, out_size, ws_size); grid = -1; return; }
        int dev = 0, cus = 0, per_cu = 0;
        if (hipGetDevice(&dev) != hipSuccess || hipDeviceGetAttribute(&cus, hipDeviceAttributeMultiprocessorCount, dev) != hipSuccess) { grid = -1; return; }
        if (hipFuncSetAttribute((const void*)trunk_fwd, hipFuncAttributeMaxDynamicSharedMemorySize, LDS_BYTES) != hipSuccess) { fprintf(stderr, "kernel_launch: hipFuncSetAttribute failed\n"); grid = -1; return; }
        if (hipOccupancyMaxActiveBlocksPerMultiprocessor(&per_cu, (const void*)trunk_fwd, NTHR, LDS_BYTES) != hipSuccess || per_cu < 1) { fprintf(stderr, "kernel_launch: occupancy query says %d\n", per_cu); (void)hipGetLastError(); grid = -1; return; }
        if (cus * per_cu < GRID) { fprintf(stderr, "kernel_launch: built for a %d-workgroup resident grid, this device holds %d\n", GRID, cus * per_cu); grid = -1; return; }
        grid = GRID;
    }
    if (grid < 0) return;
    Args a{};
    for (int i = 0; i < 22; ++i) a.in[i] = (const float*)d_in[i];
    a.out = (float*)d_out; a.ws = (unsigned char*)d_ws;
#if MK_ONE_LAUNCH
    if (hipMemsetAsync((char*)d_ws + WS_CTL, 0, 65536, stream) != hipSuccess) { fprintf(stderr, "kernel_launch: memset of the control words failed\n"); return; }
    a.ph_lo = 0; a.ph_hi = NPHASE;
    void* kargs[] = {&a};
    hipError_t e = hipLaunchCooperativeKernel((const void*)trunk_fwd, dim3(grid), dim3(NTHR), kargs, LDS_BYTES, stream);
    if (e != hipSuccess) fprintf(stderr, "cooperative launch failed: %s (grid %d)\n", hipGetErrorString(e), grid);
#else
    for (int p = 0; p < NPHASE; ++p) { a.ph_lo = p; a.ph_hi = p + 1; hipLaunchKernelGGL(trunk_fwd, dim3(grid), dim3(NTHR), LDS_BYTES, stream, a); }
#endif
}
```

```cpp
#include <hip/hip_runtime.h>
#include <hip/hip_cooperative_groups.h>
#include <cstdio>
#include <cstdint>
#include <cmath>
namespace cg = cooperative_groups;

#ifndef PHMASK
#define PHMASK 0xFFFF
#endif
#define EN(n) (((PHMASK) >> (n)) & 1)
#ifndef PROBE_REP_K
#define PROBE_REP_K (-2)
#endif
#ifndef MK_ONE_LAUNCH
#define MK_ONE_LAUNCH 1
#endif

#define LAS __attribute__((address_space(3)))
typedef unsigned short bf16_t;
typedef short bf16x8 __attribute__((ext_vector_type(8)));
typedef short s16x4 __attribute__((ext_vector_type(4)));
typedef short v4i16_t __attribute__((ext_vector_type(4)));
typedef float f32x4 __attribute__((ext_vector_type(4)));
typedef float f32x2 __attribute__((ext_vector_type(2)));
typedef float f32x16 __attribute__((ext_vector_type(16)));
typedef unsigned u32x4 __attribute__((ext_vector_type(4)));
typedef unsigned u32x2 __attribute__((ext_vector_type(2)));
typedef __bf16 bf16x2_t __attribute__((ext_vector_type(2)));
#define DI __device__ __forceinline__
#define MFMA32(a, b, c) __builtin_amdgcn_mfma_f32_32x32x16_bf16((a), (b), (c), 0, 0, 0)

constexpr int BATCH = 16, SEQ = 2048, DM = 1024, MTOK = BATCH * SEQ, DEPTH = 2;
constexpr int NMEM = 256, MMEM = BATCH * NMEM;
constexpr int INW = 2832, LDP = 2944, NPROJ = 3072;
constexpr int C_SBQ = 0, C_SBK = 512, C_SBV = 1024, C_SGU = 1536, C_SGV = 1792, C_GQ = 2048, C_GK = 2176, C_GV = 2304, C_GO = 2560, C_GA = 2816;
constexpr float EPS = 1e-6f;
constexpr float LOG2E = 1.4426950408889634f;

constexpr size_t MiB = 1u << 20;
constexpr size_t WS_CTL = 0;
constexpr size_t WS_SUBK = 1 * MiB;
constexpr size_t WS_WSP = WS_SUBK + 512 * 1024;
constexpr size_t WS_RSTDM = WS_WSP + 256 * 1024;
constexpr size_t WS_SS = 2 * MiB;
constexpr size_t WS_W = 8 * MiB;
constexpr size_t W_IN = 0, W_OUT = 6 * MiB, W_CQ = 8 * MiB, W_CKV = 10 * MiB, W_CO = 14 * MiB, W_PQ = 16 * MiB, W_LAYER = 18 * MiB;
constexpr size_t WS_MEMB = 44 * MiB;
constexpr size_t WS_KMEM = 52 * MiB;
constexpr size_t WS_TAB = 84 * MiB;
constexpr size_t WS_XB = 148 * MiB;
constexpr size_t WS_YCAT = 212 * MiB;
constexpr size_t WS_PROJ = 276 * MiB;
constexpr size_t WS_GKV = 460 * MiB;
constexpr size_t WS_GD = 468 * MiB;
constexpr size_t WS_END = 469 * MiB;

DI unsigned cvtpk(float lo, float hi) { f32x2 v = {lo, hi}; bf16x2_t b = __builtin_convertvector(v, bf16x2_t); return __builtin_bit_cast(unsigned, b); }
DI bf16_t cvt1(float v) { return (bf16_t)(cvtpk(v, 0.f) & 0xffffu); }
DI float bf2f(unsigned short b) { return __uint_as_float((unsigned)b << 16); }
DI float bflo(unsigned w) { return __uint_as_float(w << 16); }
DI float bfhi(unsigned w) { return __uint_as_float(w & 0xffff0000u); }
DI int crow(int r, int hi) { return (r & 3) + 8 * (r >> 2) + 4 * hi; }
DI float fexp2(float x) { return __builtin_amdgcn_exp2f(x); }
DI float flog2(float x) { return __builtin_amdgcn_logf(x); }
DI float frcp(float x) { return __builtin_amdgcn_rcpf(x); }
DI float gelu_tanh(float x) { const float y2 = x * (1.5957691216057308f + 0.0713548162726009f * x * x); return x * frcp(1.f + fexp2(-y2 * LOG2E)); }
DI float silu(float x) { return x * frcp(1.f + fexp2(-x * LOG2E)); }
DI float wave_sum(float v) {
#pragma unroll
    for (int o = 1; o < 64; o <<= 1) v += __shfl_xor(v, o);
    return v;
}
DI s16x4 vtr(LAS const char* p) { return __builtin_bit_cast(s16x4, __builtin_amdgcn_ds_read_tr16_b64_v4i16((LAS v4i16_t*)p)); }
DI bf16x8 cat8(s16x4 lo, s16x4 hi) { return __builtin_shufflevector(lo, hi, 0, 1, 2, 3, 4, 5, 6, 7); }
DI bf16x8 pack8(float a0, float a1, float a2, float a3, float a4, float a5, float a6, float a7) {
    u32x4 p; p[0] = cvtpk(a0, a1); p[1] = cvtpk(a2, a3); p[2] = cvtpk(a4, a5); p[3] = cvtpk(a6, a7); return __builtin_bit_cast(bf16x8, p);
}
#define LDS_WAIT() asm volatile("s_waitcnt lgkmcnt(0)" ::: "memory")
#define LDS_SYNC() do { asm volatile("s_waitcnt lgkmcnt(0)" ::: "memory"); __builtin_amdgcn_s_barrier(); asm volatile("" ::: "memory"); } while (0)
#define WG_SYNC() do { asm volatile("s_waitcnt vmcnt(0) lgkmcnt(0)" ::: "memory"); __builtin_amdgcn_s_barrier(); asm volatile("" ::: "memory"); } while (0)

namespace pg8 {
constexpr int BM = 256, BK = 64, HALF = 128, HTB = HALF * BK * 2, STAGE_BYTES = 8 * HTB, NXCD = 8, WGM = 8;
__host__ __device__ __forceinline__ int lds_byte(int r, int c) { const int st = (r >> 4) * 2 + (c >> 5), rr = r & 15, cc = c & 31, ob = rr * 64 + cc * 2; return st * 1024 + (ob ^ (((ob >> 9) & 1) << 5)); }
__host__ __device__ __forceinline__ void stage_rc(int b, int& R, int& C) { const int st = b / 1024, sb = b % 1024, swz = sb ^ (((sb >> 9) & 1) << 5); R = (st >> 1) * 16 + swz / 64; C = (st & 1) * 32 + (swz % 64) / 2; }
__host__ __device__ __forceinline__ int perm32(int rho) { const int n = rho >> 4, i = rho & 15; return 8 * (i >> 2) + 4 * n + (i & 3); }

struct Unit { int pm, pn; size_t aoff, boff; };
struct Gemm { const bf16_t* A; const bf16_t* Bt; int lda, ldb, K; };

struct StaticOrder {
    int nM, nN, nwg, G, c, lda, ldb;
    __device__ void init(int M, int N, int G_, int c_, int lda_, int ldb_) { nM = M / BM; nN = N / BM; nwg = nM * nN; G = G_; c = c_; lda = lda_; ldb = ldb_; }
    __device__ bool next(int i, Unit& u) const {
        const long L = (long)i * G + c; if (L >= nwg) return false;
        int wgid = (int)L; { const int q = nwg / NXCD, r = nwg % NXCD, xcd = wgid % NXCD, off = wgid / NXCD; wgid = (xcd < r ? xcd * (q + 1) : r * (q + 1) + (xcd - r) * q) + off; }
        const int nig = WGM * nN, gid = wgid / nig, fm = gid * WGM, gsz = (nM - fm) < WGM ? (nM - fm) : WGM;
        u.pm = fm + ((wgid % nig) % gsz); u.pn = (wgid % nig) / gsz;
        u.aoff = (size_t)u.pm * BM * lda; u.boff = (size_t)u.pn * BM * ldb; return true;
    }
};
struct XOrder {
    int G, c, mode;
    __device__ bool next(int i, Unit& u) const {
        const int L = i * G + c; if (L >= 512) return false;
        u.pm = L >> 2; u.pn = L & 3; const int b = u.pm >> 3;
        u.aoff = (size_t)u.pm * 256 * 1024 + u.pn * 256;
        u.boff = mode == 0 ? (size_t)b * 256 * 1024 + u.pn * 256 : (size_t)(b * 4 + u.pn) * 256 * 256;
        return true;
    }
};

struct XOrder2 {
    StaticOrder S; int mode;
    __device__ bool next(int i, Unit& u) const {
        if (!S.next(i, u)) return false; const int b = u.pm >> 3;
        u.aoff = (size_t)u.pm * 256 * 1024 + u.pn * 256;
        u.boff = mode == 0 ? (size_t)b * 256 * 1024 + u.pn * 256 : (size_t)(b * 4 + u.pn) * 256 * 256;
        return true;
    }
};

DI float row_rstd_from_ss(const float* ss, int row, int fq) {
    const f32x4 v = *(const f32x4*)(ss + (size_t)row * 16 + 4 * fq);
    float s = (v[0] + v[1]) + (v[2] + v[3]); s += __shfl_xor(s, 16); s += __shfl_xor(s, 32);
    return 1.0f / sqrtf(s * (1.0f / 1024.0f) + EPS);
}
struct EpiBf16 {
    static constexpr bool PERM = true;
    bf16_t* O; int ldc; const float* ss; float cscale; int ncols;
    DI void operator()(f32x4 (&acc)[2][2][4][2], const Unit& u, int wr, int wc, int fr, int fq) const {
        const int row0 = u.pm * BM + wr * 64 + fr, col0 = u.pn * BM + wc * 32 + 8 * fq;
#pragma unroll
        for (int ai = 0; ai < 2; ++ai)
#pragma unroll
            for (int m = 0; m < 4; ++m) {
                const int row = row0 + ai * HALF + m * 16;
                float rs = cscale; if (ss) rs *= row_rstd_from_ss(ss, row, fq);
                bf16_t* rowp = O + (size_t)row * ldc + col0;
#pragma unroll
                for (int bj = 0; bj < 2; ++bj) if (col0 + bj * HALF < ncols) {
                    const f32x4 v0 = acc[ai][bj][m][0] * rs, v1 = acc[ai][bj][m][1] * rs;
                    u32x4 w; w.x = cvtpk(v0[0], v0[1]); w.y = cvtpk(v0[2], v0[3]); w.z = cvtpk(v1[0], v1[1]); w.w = cvtpk(v1[2], v1[3]);
                    *(u32x4*)(rowp + bj * HALF) = w; }
            }
    }
};
struct EpiKV {
    static constexpr bool PERM = true;
    bf16_t* Kd; bf16_t* VT; const float* rvec;
    DI void operator()(f32x4 (&acc)[2][2][4][2], const Unit& u, int wr, int wc, int fr, int fq) const {
        const int row0 = u.pm * BM + wr * 64 + fr;
#pragma unroll
        for (int ai = 0; ai < 2; ++ai)
#pragma unroll
            for (int m = 0; m < 4; ++m) {
                const int row = row0 + ai * HALF + m * 16; const float rs = rvec[row];
#pragma unroll
                for (int bj = 0; bj < 2; ++bj) {
                    const f32x4 v0 = acc[ai][bj][m][0] * rs, v1 = acc[ai][bj][m][1] * rs;
                    const unsigned w0 = cvtpk(v0[0], v0[1]), w1 = cvtpk(v0[2], v0[3]), w2 = cvtpk(v1[0], v1[1]), w3 = cvtpk(v1[2], v1[3]);
                    if (u.pn < 4) {
                        u32x4 w; w.x = w0; w.y = w1; w.z = w2; w.w = w3;
                        *(u32x4*)(Kd + (size_t)row * 1024 + u.pn * BM + bj * HALF + wc * 32 + 8 * fq) = w;
                    } else {
                        const int key = row & 255, dv0 = bj * HALF + wc * 32 + 8 * fq;
                        bf16_t* p = VT + ((size_t)(u.pm * 4 + (u.pn - 4)) * 256 + dv0) * 256 + key;
                        p[0 * 256] = (bf16_t)w0; p[1 * 256] = (bf16_t)(w0 >> 16); p[2 * 256] = (bf16_t)w1; p[3 * 256] = (bf16_t)(w1 >> 16);
                        p[4 * 256] = (bf16_t)w2; p[5 * 256] = (bf16_t)(w2 >> 16); p[6 * 256] = (bf16_t)w3; p[7 * 256] = (bf16_t)(w3 >> 16);
                    }
                }
            }
    }
};
struct EpiResid {
    static constexpr bool PERM = true;
    bf16_t* XB; float* ss;
    DI void operator()(f32x4 (&acc)[2][2][4][2], const Unit& u, int wr, int wc, int fr, int fq) const {
        const int row0 = u.pm * BM + wr * 64 + fr, col0 = u.pn * BM + wc * 32 + 8 * fq;
#pragma unroll
        for (int ai = 0; ai < 2; ++ai)
#pragma unroll
            for (int m = 0; m < 4; ++m) {
                const int row = row0 + ai * HALF + m * 16; float s = 0.f;
#pragma unroll
                for (int bj = 0; bj < 2; ++bj) {
                    const size_t off = (size_t)row * 1024 + col0 + bj * HALF;
                    const u32x4 o = *(const u32x4*)(XB + off); const f32x4 a0 = acc[ai][bj][m][0], a1 = acc[ai][bj][m][1];
                    u32x4 w; w.x = cvtpk(bflo(o.x) + a0[0], bfhi(o.x) + a0[1]); w.y = cvtpk(bflo(o.y) + a0[2], bfhi(o.y) + a0[3]);
                    w.z = cvtpk(bflo(o.z) + a1[0], bfhi(o.z) + a1[1]); w.w = cvtpk(bflo(o.w) + a1[2], bfhi(o.w) + a1[3]);
                    *(u32x4*)(XB + off) = w;
#pragma unroll
                    for (int q = 0; q < 4; ++q) { const float x0 = bflo(w[q]), x1 = bfhi(w[q]); s += x0 * x0 + x1 * x1; }
                }
                s += __shfl_xor(s, 16); s += __shfl_xor(s, 32);
                if (fq == 0) ss[(size_t)row * 16 + u.pn * 4 + wc] = s;
            }
    }
};
struct EpiSoftmax {
    static constexpr bool PERM = true;
    bf16_t* P; LAS float* xm; LAS float* xs;
    DI void operator()(f32x4 (&acc)[2][2][4][2], const Unit& u, int wr, int wc, int fr, int fq) const {
#pragma unroll
        for (int ai = 0; ai < 2; ++ai)
#pragma unroll
            for (int m = 0; m < 4; ++m) {
                float v = -INFINITY;
#pragma unroll
                for (int bj = 0; bj < 2; ++bj)
#pragma unroll
                    for (int n = 0; n < 2; ++n) { const f32x4 x = acc[ai][bj][m][n]; v = fmaxf(v, fmaxf(fmaxf(x[0], x[1]), fmaxf(x[2], x[3]))); }
                v = fmaxf(v, __shfl_xor(v, 16)); v = fmaxf(v, __shfl_xor(v, 32));
                if (fq == 0) xm[(ai * HALF + wr * 64 + m * 16 + fr) * 4 + wc] = v;
            }
        LDS_WAIT(); __builtin_amdgcn_s_barrier(); asm volatile("" ::: "memory");
#pragma unroll
        for (int ai = 0; ai < 2; ++ai)
#pragma unroll
            for (int m = 0; m < 4; ++m) {
                const f32x4 q = *(LAS const f32x4*)(xm + (ai * HALF + wr * 64 + m * 16 + fr) * 4);
                const float g = fmaxf(fmaxf(q[0], q[1]), fmaxf(q[2], q[3])); float s = 0.f;
#pragma unroll
                for (int bj = 0; bj < 2; ++bj)
#pragma unroll
                    for (int n = 0; n < 2; ++n) { f32x4 x = acc[ai][bj][m][n]; x[0] = fexp2(x[0] - g); x[1] = fexp2(x[1] - g); x[2] = fexp2(x[2] - g); x[3] = fexp2(x[3] - g); acc[ai][bj][m][n] = x; s += (x[0] + x[1]) + (x[2] + x[3]); }
                s += __shfl_xor(s, 16); s += __shfl_xor(s, 32);
                if (fq == 0) xs[(ai * HALF + wr * 64 + m * 16 + fr) * 4 + wc] = s;
            }
        LDS_WAIT(); __builtin_amdgcn_s_barrier(); asm volatile("" ::: "memory");
        const int row0 = u.pm * BM + wr * 64 + fr, col0 = u.pn * BM + wc * 32 + 8 * fq;
#pragma unroll
        for (int ai = 0; ai < 2; ++ai)
#pragma unroll
            for (int m = 0; m < 4; ++m) {
                const f32x4 q = *(LAS const f32x4*)(xs + (ai * HALF + wr * 64 + m * 16 + fr) * 4);
                const float inv = 1.0f / ((q[0] + q[1]) + (q[2] + q[3]));
                bf16_t* rowp = P + (size_t)(row0 + ai * HALF + m * 16) * 1024 + col0;
#pragma unroll
                for (int bj = 0; bj < 2; ++bj) {
                    const f32x4 v0 = acc[ai][bj][m][0] * inv, v1 = acc[ai][bj][m][1] * inv;
                    u32x4 w; w.x = cvtpk(v0[0], v0[1]); w.y = cvtpk(v0[2], v0[3]); w.z = cvtpk(v1[0], v1[1]); w.w = cvtpk(v1[2], v1[3]);
                    *(u32x4*)(rowp + bj * HALF) = w; }
            }
    }
};

template <class Epi, class Sched, bool ALIGN_EPI>
__device__ __forceinline__ void gemm_phase(LAS unsigned char* lds, const Gemm g, const Sched& S, const Epi& E) {
    int tid = threadIdx.x; asm volatile("" : "+v"(tid));
    const int wid = __builtin_amdgcn_readfirstlane(tid >> 6), lane = tid & 63, wr = wid >> 2, wc = wid & 3, fr = lane & 15, fq = lane >> 4;
    const int K = g.K, nt = K / BK;
    unsigned voffA[2], voffB[2];
#pragma unroll
    for (int i = 0; i < 2; ++i) { int R, C; stage_rc(tid * 16 + i * 8192, R, C); const int Rb = Epi::PERM ? ((R & ~31) + perm32(R & 31)) : R;
        voffA[i] = (unsigned)(R * g.lda + C) * 2u; voffB[i] = (unsigned)(Rb * g.ldb + C) * 2u; }
    const size_t kstep = (size_t)(BK * 2);
    const size_t hstepA = (size_t)HALF * g.lda * 2, hstepB = (size_t)HALF * g.ldb * 2;
    const unsigned ldsw = (unsigned)wid * 1024u;
    const int aoff = lds_byte(wr * 64 + fr, fq * 8), boff = lds_byte(wc * 32 + fr, fq * 8);
#define PG8_SA(b, h) (((b) * 2 + (h)) * HTB)
#define PG8_SB(b, h) ((4 + (b) * 2 + (h)) * HTB)
#define PG8_STAGE(bufoff, gbase, voff) do { _Pragma("unroll") for (int _i = 0; _i < 2; ++_i) \
        __builtin_amdgcn_global_load_lds((const unsigned*)((const char*)(gbase) + (voff)[_i]), (LAS unsigned*)(lds + (bufoff) + ldsw + _i * 8192), 16, 0, 0); } while (0)
#define PG8_LDA(dst, b, h) do { _Pragma("unroll") for (int m = 0; m < 4; ++m) _Pragma("unroll") for (int k = 0; k < 2; ++k) dst[m][k] = *(const LAS bf16x8*)(lds + PG8_SA(b, h) + aoff + m * 2048 + k * 1024); } while (0)
#define PG8_LDB(dst, b, h) do { _Pragma("unroll") for (int n = 0; n < 2; ++n) _Pragma("unroll") for (int k = 0; k < 2; ++k) dst[n][k] = *(const LAS bf16x8*)(lds + PG8_SB(b, h) + boff + n * 2048 + k * 1024); } while (0)
#define PG8_MMA(ai, bj, At, Bt) do { __builtin_amdgcn_s_setprio(1); _Pragma("unroll") for (int m = 0; m < 4; ++m) _Pragma("unroll") for (int n = 0; n < 2; ++n) _Pragma("unroll") for (int k = 0; k < 2; ++k) \
        acc[ai][bj][m][n] = __builtin_amdgcn_mfma_f32_16x16x32_bf16(Bt[n][k], At[m][k], acc[ai][bj][m][n], 0, 0, 0); __builtin_amdgcn_s_setprio(0); } while (0)
#define PG8_WAIT_V(n) asm volatile("s_waitcnt vmcnt(" #n ")" ::: "memory")
#define PG8_WAIT_L(n) asm volatile("s_waitcnt lgkmcnt(" #n ")" ::: "memory")
#define PG8_BAR __builtin_amdgcn_s_barrier()
#define PG8_SCHED __builtin_amdgcn_sched_barrier(0)
    Unit cur, nxt; int ui = 0;
    if (!S.next(0, cur)) return;
    f32x4 acc[2][2][4][2];
#pragma unroll
    for (int a = 0; a < 2; ++a)
#pragma unroll
        for (int b = 0; b < 2; ++b)
#pragma unroll
            for (int m = 0; m < 4; ++m)
#pragma unroll
                for (int n = 0; n < 2; ++n) acc[a][b][m][n] = (f32x4){0.f, 0.f, 0.f, 0.f};
    bf16x8 At[4][2], B0[2][2], B1[2][2];
    const char* cA = (const char*)g.A + cur.aoff * 2; const char* cB = (const char*)g.Bt + cur.boff * 2;
    PG8_STAGE(PG8_SB(0, 0), cB, voffB); PG8_STAGE(PG8_SB(0, 1), cB + hstepB, voffB); PG8_STAGE(PG8_SA(0, 0), cA, voffA); PG8_STAGE(PG8_SA(0, 1), cA + hstepA, voffA);
    if (wr == 1) PG8_BAR;
    PG8_WAIT_V(2); PG8_BAR;
    PG8_STAGE(PG8_SB(1, 0), cB + kstep, voffB); PG8_STAGE(PG8_SA(1, 0), cA + kstep, voffA); PG8_STAGE(PG8_SB(1, 1), cB + hstepB + kstep, voffB);
    PG8_WAIT_V(6); PG8_BAR;
    for (;;) {
        const bool has_next = S.next(ui + 1, nxt);
        const char* nA = has_next ? (const char*)g.A + nxt.aoff * 2 : cA; const char* nB = has_next ? (const char*)g.Bt + nxt.boff * 2 : cB;
#pragma unroll 1
        for (int t = 0; t < nt; t += 2) {
            const bool last = (t == nt - 2);
            const char* a1 = cA + (size_t)(t + 1) * kstep;
            const char* a2 = last ? nA : cA + (size_t)(t + 2) * kstep; const char* b2 = last ? nB : cB + (size_t)(t + 2) * kstep;
            const char* a3 = a2 + kstep; const char* b3 = b2 + kstep;
            PG8_LDB(B0, 0, 0); PG8_LDB(B1, 0, 1); PG8_SCHED; PG8_LDA(At, 0, 0); PG8_STAGE(PG8_SA(1, 1), a1 + hstepA, voffA);
            PG8_WAIT_V(8); PG8_WAIT_L(0); PG8_BAR; PG8_MMA(0, 0, At, B0); PG8_MMA(0, 1, At, B1); PG8_BAR; PG8_SCHED;
            PG8_LDA(At, 0, 1); PG8_STAGE(PG8_SB(0, 0), b2, voffB); PG8_STAGE(PG8_SB(0, 1), b2 + hstepB, voffB); PG8_STAGE(PG8_SA(0, 0), a2, voffA);
            PG8_WAIT_V(8); PG8_WAIT_L(0); PG8_BAR; PG8_MMA(1, 0, At, B0); PG8_MMA(1, 1, At, B1); PG8_BAR; PG8_SCHED;
            PG8_LDB(B0, 1, 0); PG8_LDB(B1, 1, 1); PG8_SCHED; PG8_LDA(At, 1, 0); PG8_STAGE(PG8_SA(0, 1), a2 + hstepA, voffA);
            PG8_WAIT_V(8); PG8_WAIT_L(0); PG8_BAR; PG8_MMA(0, 0, At, B0); PG8_MMA(0, 1, At, B1); PG8_BAR; PG8_SCHED;
            PG8_LDA(At, 1, 1); PG8_STAGE(PG8_SB(1, 0), b3, voffB); PG8_STAGE(PG8_SB(1, 1), b3 + hstepB, voffB); PG8_STAGE(PG8_SA(1, 0), a3, voffA);
            PG8_WAIT_V(8); PG8_WAIT_L(0); PG8_BAR; PG8_MMA(1, 0, At, B0); PG8_MMA(1, 1, At, B1); PG8_BAR; PG8_SCHED;
        }
        if constexpr (ALIGN_EPI) { if (wr == 0) PG8_BAR; }
        E(acc, cur, wr, wc, fr, fq);
        if (!has_next) break;
#pragma unroll
        for (int a = 0; a < 2; ++a)
#pragma unroll
            for (int b = 0; b < 2; ++b)
#pragma unroll
                for (int m = 0; m < 4; ++m)
#pragma unroll
                    for (int n = 0; n < 2; ++n) acc[a][b][m][n] = (f32x4){0.f, 0.f, 0.f, 0.f};
        cur = nxt; cA = nA; cB = nB; ++ui;
        if constexpr (ALIGN_EPI) { if (wr == 1) PG8_BAR; }
    }
    PG8_WAIT_V(0);
    if constexpr (!ALIGN_EPI) { if (wr == 0) PG8_BAR; }
    PG8_BAR;
#undef PG8_SA
#undef PG8_SB
#undef PG8_STAGE
#undef PG8_LDA
#undef PG8_LDB
#undef PG8_MMA
#undef PG8_WAIT_V
#undef PG8_WAIT_L
#undef PG8_BAR
#undef PG8_SCHED
}
}

constexpr int NWAVES = 8, NTHR = 512, GRID = 256;
constexpr int RING_BYTES = 131072, XCH_OFF = RING_BYTES, LDS_BYTES = 147456;
struct Args { const float* in[22]; float* out; unsigned char* ws; int ph_lo, ph_hi; };
enum { I_X = 0, I_MEM, I_NORM_MIX, I_W_IN, I_SG_VG, I_SG_W, I_SG_B, I_GLA_WG, I_GLA_BG, I_GLA_OG, I_W_OUT, I_NORM_MEM, I_MEM_GAIN, I_W_CQ, I_W_CKV, I_W_CO, I_NORM_FFN, I_PEER_WQ, I_PEER_SK, I_PEER_U, I_PEER_V, I_FINAL_G };

struct Frame {
    LAS unsigned char* lds; int tid, lane, wave, bx, gw; static constexpr int G = GRID, NGW = GRID * NWAVES;
    float* X; unsigned char* ws;
};
#define INP(i) (args.in[(i)])

#define XB_TMO      128
#define XB_XCNT(j)  (256  + 64 * (j))
#define XB_XSUB(j)  (1280 + 64 * (j))
#define XB_XGEN(j)  (2304 + 64 * (j))
#define XB_TOP      3328
#define XB_TOPGEN   3392
#define XCD_BAR_WORDS 3456
#define XB_SPIN_CAP (1u << 22)
DI unsigned xb_ld(unsigned* p)              { return __hip_atomic_load(p, __ATOMIC_RELAXED, __HIP_MEMORY_SCOPE_AGENT); }
DI unsigned xb_add(unsigned* p, unsigned v) { return __hip_atomic_fetch_add(p, v, __ATOMIC_RELAXED, __HIP_MEMORY_SCOPE_AGENT); }
DI unsigned xb_xcc_id() { return (unsigned)__builtin_amdgcn_s_getreg((3 << 11) | 20) & 0xFu; }
#define XB_SPIN(cond, bar) do { unsigned _sp = 0; while (cond) { __builtin_amdgcn_s_sleep(1); \
    if ((++_sp & 255u) == 0u) { if (xb_ld(&(bar)[XB_TMO])) break; if (_sp > XB_SPIN_CAP) { atomicAdd(&(bar)[XB_TMO], 1u); break; } } } } while (0)
struct XcdBarrier { unsigned* bar; unsigned x; volatile LAS unsigned* st; };
DI XcdBarrier xcd_barrier_post(unsigned* bar, volatile LAS unsigned* st) {
    XcdBarrier b; b.bar = bar; b.x = xb_xcc_id(); b.st = st;
    if (threadIdx.x == 0) (void)xb_add(&bar[XB_XCNT(b.x)], 1u);
    return b;
}
DI void xcd_barrier_complete(unsigned* bar, unsigned x, unsigned& nloc, unsigned& nx) {
    const unsigned G = gridDim.x * gridDim.y * gridDim.z;
    unsigned sum, cnt, mine, sp = 0u;
    for (;;) {
        sum = 0u; cnt = 0u; mine = 0u;
#pragma unroll
        for (unsigned j = 0; j < 16; ++j) { const unsigned c = xb_ld(&bar[XB_XCNT(j)]); sum += c; cnt += (c > 0u) ? 1u : 0u; mine = (j == x) ? c : mine; }
        if (sum == G) break;
        __builtin_amdgcn_s_sleep(1);
        if ((++sp & 255u) == 0u) { if (xb_ld(&bar[XB_TMO])) break; if (sp > XB_SPIN_CAP) { atomicAdd(&bar[XB_TMO], 1u); break; } }
    }
    nloc = mine > 0u ? mine : 1u; nx = cnt > 0u ? cnt : 1u;
}
DI void xcd_barrier(const XcdBarrier& b) {
    asm volatile("s_waitcnt vmcnt(0)" ::: "memory");
    __syncthreads();
    if (threadIdx.x == 0) {
        unsigned* bar = b.bar;
        __builtin_amdgcn_s_waitcnt(0);
        unsigned nloc = b.st[0], nx = b.st[1];
        if (nloc == 0u) { xcd_barrier_complete(bar, b.x, nloc, nx); b.st[0] = nloc; b.st[1] = nx; }
        const unsigned old = xb_add(&bar[XB_XSUB(b.x)], 1u);
        const unsigned gen = old / nloc;
        if (old + 1u == (gen + 1u) * nloc) {
            __builtin_amdgcn_fence(__ATOMIC_RELEASE, "agent");
            asm volatile("s_waitcnt vmcnt(0)" ::: "memory");
            const unsigned og = xb_add(&bar[XB_TOP], 1u);
            const unsigned tg = og / nx;
            if (og + 1u == (tg + 1u) * nx) xb_add(&bar[XB_TOPGEN], 1u);
            else XB_SPIN(xb_ld(&bar[XB_TOPGEN]) == tg, bar);
            __builtin_amdgcn_fence(__ATOMIC_ACQUIRE, "agent");
            xb_add(&bar[XB_XGEN(b.x)], 1u);
            asm volatile("s_waitcnt vmcnt(0)" ::: "memory");
        } else {
            XB_SPIN(xb_ld(&bar[XB_XGEN(b.x)]) == gen, bar);
            __builtin_amdgcn_fence(__ATOMIC_ACQUIRE, "agent");
            asm volatile("s_waitcnt vmcnt(0)" ::: "memory");
        }
    }
    __syncthreads();
}

DI void p0_transpose_item(const float* W, int ldw, int N, int K, const float* gain, bf16_t* WT, LAS float* scr, int item, int lane) {
    const int nblk = N / 32, kb = item / nblk, nb = item % nblk, k0 = 64 * kb, n0 = 32 * nb;
#pragma unroll 8
    for (int i = 0; i < 32; ++i) { const int kk = 2 * i + (lane >> 5); float w = W[(size_t)(k0 + kk) * ldw + n0 + (lane & 31)]; if (gain) w *= gain[k0 + kk]; scr[kk * 33 + (lane & 31)] = w; }
    LDS_WAIT(); asm volatile("" ::: "memory");
    const int c = lane & 7;
#pragma unroll
    for (int j = 0; j < 4; ++j) { const int n = (lane >> 3) + 8 * j; const LAS float* s = scr + (8 * c) * 33 + n;
        u32x4 o; o.x = cvtpk(s[0 * 33], s[1 * 33]); o.y = cvtpk(s[2 * 33], s[3 * 33]); o.z = cvtpk(s[4 * 33], s[5 * 33]); o.w = cvtpk(s[6 * 33], s[7 * 33]);
        *(u32x4*)(WT + (size_t)(n0 + n) * K + k0 + 8 * c) = o; }
    LDS_WAIT(); asm volatile("" ::: "memory");
}
DI unsigned fp4x8(const f32x4 a, const f32x4 b, float inv) {
    unsigned w = 0;
    w = __builtin_amdgcn_cvt_scalef32_pk_fp4_f32(w, a[0] * inv, a[1] * inv, 1.0f, 0); w = __builtin_amdgcn_cvt_scalef32_pk_fp4_f32(w, a[2] * inv, a[3] * inv, 1.0f, 1);
    w = __builtin_amdgcn_cvt_scalef32_pk_fp4_f32(w, b[0] * inv, b[1] * inv, 1.0f, 2); w = __builtin_amdgcn_cvt_scalef32_pk_fp4_f32(w, b[2] * inv, b[3] * inv, 1.0f, 3);
    return w;
}
DI float wave_max(float v) {
#pragma unroll
    for (int o = 1; o < 64; o <<= 1) v = fmaxf(v, __shfl_xor(v, o));
    return v;
}
DI void convert_tables(const Frame& F, const Args& args, int l, int wv, int nwv) {
    const float* gn = INP(I_NORM_FFN) + l * 1024 + 16 * F.lane;
    f32x4 g[4];
#pragma unroll
    for (int q = 0; q < 4; ++q) g[q] = *(const f32x4*)(gn + 4 * q);
    for (int r0 = wv; r0 < 2 * 16384; r0 += 4 * nwv) {
        f32x4 v[4][4];
#pragma unroll
        for (int j = 0; j < 4; ++j) { const int r = min(r0 + j * nwv, 2 * 16384 - 1), isv = r >= 16384, e = r & 16383;
            const float* src = (isv ? INP(I_PEER_V) : INP(I_PEER_U)) + ((size_t)l * 16384 + e) * 1024 + 16 * F.lane;
#pragma unroll
            for (int q = 0; q < 4; ++q) v[j][q] = *(const f32x4*)(src + 4 * q); }
#pragma unroll
        for (int j = 0; j < 4; ++j) { const int r = r0 + j * nwv, isv = r >= 16384, e = r & 16383; float am = 0.f;
            if (r < 2 * 16384) {
#pragma unroll
            for (int q = 0; q < 4; ++q) { if (!isv) v[j][q] = v[j][q] * g[q];
                am = fmaxf(am, fmaxf(fmaxf(fabsf(v[j][q][0]), fabsf(v[j][q][1])), fmaxf(fabsf(v[j][q][2]), fabsf(v[j][q][3])))); }
            am = wave_max(am);
            const float sc = bf2f(cvt1(am > 0.f ? am * (1.0f / 6.0f) : 1.0f)), inv = 1.0f / sc;
            u32x2 w; w.x = fp4x8(v[j][0], v[j][1], inv); w.y = fp4x8(v[j][2], v[j][3], inv);
            *(u32x2*)(F.ws + WS_TAB + (size_t)l * 16 * MiB + (size_t)isv * 8 * MiB + (size_t)e * 512 + 8 * F.lane) = w;
            if (F.lane == 0) ((bf16_t*)(F.ws + WS_TAB + 32 * MiB))[((size_t)l * 16384 + e) * 2 + isv] = cvt1(sc); } }
    }
}
struct TDesc { const float* W; const float* gain; bf16_t* WT; int ldw, nblk; };
DI TDesc tdesc(const Frame& F, const Args& args, int l, int t) {
    TDesc D; D.gain = nullptr; D.ldw = 1024; D.nblk = 32; size_t woff;
    switch (t) {
    case 0: D.W = INP(I_W_IN) + (size_t)l * 1024 * INW; D.ldw = INW; D.nblk = 88; D.gain = INP(I_NORM_MIX) + l * 1024; woff = W_IN; break;
    case 1: D.W = INP(I_W_OUT) + (size_t)l * 1024 * 1024; woff = W_OUT; break;
    case 2: D.W = INP(I_W_CQ) + (size_t)l * 1024 * 1024; D.gain = INP(I_NORM_MEM) + l * 1024; woff = W_CQ; break;
    case 3: D.W = INP(I_W_CKV) + (size_t)l * 1024 * 2048; D.ldw = 2048; D.nblk = 64; D.gain = INP(I_MEM_GAIN) + l * 1024; woff = W_CKV; break;
    case 4: D.W = INP(I_W_CO) + (size_t)l * 1024 * 1024; woff = W_CO; break;
    default: D.W = INP(I_PEER_WQ) + (size_t)l * 1024 * 1024; D.gain = INP(I_NORM_FFN) + l * 1024; woff = W_PQ; break;
    }
    D.WT = (bf16_t*)(F.ws + WS_W + l * W_LAYER + woff); return D;
}
DI void titem_load(const TDesc& D, int item, int lane, float (&v)[32]) {
    const int kb = item / D.nblk, nb = item % D.nblk, k0 = 64 * kb, n0 = 32 * nb;
#pragma unroll
    for (int i = 0; i < 32; ++i) { const int kk = 2 * i + (lane >> 5); float w = D.W[(size_t)(k0 + kk) * D.ldw + n0 + (lane & 31)]; if (D.gain) w *= D.gain[k0 + kk]; v[i] = w; }
}
DI void titem_store(const TDesc& D, int item, int lane, LAS float* scr, const float (&v)[32]) {
    const int kb = item / D.nblk, nb = item % D.nblk, k0 = 64 * kb, n0 = 32 * nb;
#pragma unroll
    for (int i = 0; i < 32; ++i) scr[(2 * i + (lane >> 5)) * 33 + (lane & 31)] = v[i];
    LDS_WAIT(); asm volatile("" ::: "memory");
    const int c = lane & 7;
#pragma unroll
    for (int j = 0; j < 4; ++j) { const int n = (lane >> 3) + 8 * j; const LAS float* s = scr + (8 * c) * 33 + n;
        u32x4 o; o.x = cvtpk(s[0 * 33], s[1 * 33]); o.y = cvtpk(s[2 * 33], s[3 * 33]); o.z = cvtpk(s[4 * 33], s[5 * 33]); o.w = cvtpk(s[6 * 33], s[7 * 33]);
        *(u32x4*)(D.WT + (size_t)(n0 + n) * 1024 + k0 + 8 * c) = o; }
    LDS_WAIT(); asm volatile("" ::: "memory");
}
DI int tl_index(int part, int e) {
    if (part == 0) return e < 1408 ? e : e < 2432 ? 2432 + (e - 1408) : 4480 + 2432 + (e - 2432);
    return e < 1024 ? 1408 + e : e < 2048 ? 3456 + (e - 1024) : e < 4480 ? 4480 + (e - 2048) : 4480 + 3456 + (e - 4480);
}
DI void transpose_list(const Frame& F, const Args& args, LAS float* scr, int wv, int nwv, int part) {
    constexpr int NIT_L = 16 * 88 + 4 * 16 * 32 + 16 * 64;
    const int NIT = part == 0 ? 3456 : 5504;
    float va[32], vb[32]; TDesc Da{}, Db{}; int la = 0, lb = 0;
#define TI_DECODE(e_, D_, loc_) do { const int it_ = tl_index(part, (e_)); const int l_ = it_ / NIT_L; int r_ = it_ % NIT_L; int t_; \
        if (r_ < 1408) t_ = 0; else if (r_ < 1920) { t_ = 1; r_ -= 1408; } else if (r_ < 2432) { t_ = 2; r_ -= 1920; } else if (r_ < 3456) { t_ = 3; r_ -= 2432; } else if (r_ < 3968) { t_ = 4; r_ -= 3456; } else { t_ = 5; r_ -= 3968; } \
        D_ = tdesc(F, args, l_, t_); loc_ = r_; } while (0)
    int it = wv;
    if (it < NIT) { TI_DECODE(it, Da, la); titem_load(Da, la, F.lane, va); }
    for (;;) {
        int itn = it + nwv;
        if (itn < NIT) { TI_DECODE(itn, Db, lb); titem_load(Db, lb, F.lane, vb); }
        if (it < NIT) titem_store(Da, la, F.lane, scr, va);
        it = itn; if (it >= NIT) break;
        itn = it + nwv;
        if (itn < NIT) { TI_DECODE(itn, Da, la); titem_load(Da, la, F.lane, va); }
        titem_store(Db, lb, F.lane, scr, vb);
        it = itn; if (it >= NIT) break;
    }
#undef TI_DECODE
}
DI void p0_prologue(const Frame& F, const Args& args) {
    LAS float* scr = (LAS float*)(F.lds + F.wave * 16384);
    transpose_list(F, args, scr, F.gw, F.NGW, 0);
    const int gt = F.bx * NTHR + F.tid, nthr = F.G * NTHR;
    for (int i = gt; i < DEPTH * 256 * 1024; i += nthr) {
        const int l = i / (256 * 1024), r = i % (256 * 1024), j = r >> 10, k = r & 1023;
        bf16_t* Wi = (bf16_t*)(F.ws + WS_W + l * W_LAYER) + W_IN / 2;
        float v = 0.f;
        if (j < 128) {
            const float* wi = INP(I_W_IN) + (size_t)l * 1024 * INW + (size_t)k * INW + 2816; const float* wg = INP(I_GLA_WG) + l * 16 * 128 + j;
#pragma unroll
            for (int q4 = 0; q4 < 4; ++q4) { const f32x4 w4 = *(const f32x4*)(wi + 4 * q4);
#pragma unroll
                for (int e = 0; e < 4; ++e) v += w4[e] * wg[(4 * q4 + e) * 128]; }
            v *= INP(I_NORM_MIX)[l * 1024 + k];
        }
        Wi[(size_t)(2816 + j) * 1024 + k] = cvt1(v);
    }
    { bf16_t* WSP = (bf16_t*)(F.ws + WS_WSP); const float* sw = INP(I_SG_W);
      for (int i = gt; i < DEPTH * 4 * 128 * 128; i += nthr) { const int s = i & 127, t = (i >> 7) & 127; WSP[i] = cvt1(s <= t ? sw[i] : 0.f); }
      bf16_t* SK = (bf16_t*)(F.ws + WS_SUBK); const float* sk = INP(I_PEER_SK);
      for (int i = gt; i < DEPTH * 8 * 2 * 128 * 64; i += nthr) SK[i] = cvt1(sk[i]); }
    { float* SS = (float*)(F.ws + WS_SS); bf16_t* XB = (bf16_t*)(F.ws + WS_XB); const float* x = INP(I_X);
      for (int m0 = F.gw; m0 < MTOK; m0 += 4 * F.NGW) {
          f32x4 v[4][4];
#pragma unroll
          for (int i = 0; i < 4; ++i) { const f32x4* xr = (const f32x4*)(x + (size_t)(m0 + i * F.NGW) * 1024) + F.lane;
#pragma unroll
              for (int j = 0; j < 4; ++j) v[i][j] = xr[64 * j]; }
#pragma unroll
          for (int i = 0; i < 4; ++i) { const int m = m0 + i * F.NGW; float s = 0.f; u32x2 w[4];
#pragma unroll
              for (int j = 0; j < 4; ++j) { w[j].x = cvtpk(v[i][j][0], v[i][j][1]); w[j].y = cvtpk(v[i][j][2], v[i][j][3]);
                  s += (bflo(w[j].x) * bflo(w[j].x) + bfhi(w[j].x) * bfhi(w[j].x)) + (bflo(w[j].y) * bflo(w[j].y) + bfhi(w[j].y) * bfhi(w[j].y)); }
              s = wave_sum(s);
              u32x2* xb = (u32x2*)(XB + (size_t)m * 1024) + F.lane;
#pragma unroll
              for (int j = 0; j < 4; ++j) xb[64 * j] = w[j];
              if (F.lane < 16) SS[(size_t)m * 16 + F.lane] = F.lane == 0 ? s : 0.f; }
      }
      bf16_t* MB = (bf16_t*)(F.ws + WS_MEMB); float* RM = (float*)(F.ws + WS_RSTDM); const float* mem = INP(I_MEM);
      for (int m = F.gw; m < MMEM; m += F.NGW) {
          const f32x4* xr = (const f32x4*)(mem + (size_t)m * 1024) + F.lane; f32x4 v[4]; float s = 0.f;
#pragma unroll
          for (int j = 0; j < 4; ++j) { v[j] = xr[64 * j]; s += (v[j][0] * v[j][0] + v[j][1] * v[j][1]) + (v[j][2] * v[j][2] + v[j][3] * v[j][3]); }
          s = wave_sum(s);
          u32x2* xb = (u32x2*)(MB + (size_t)m * 1024) + F.lane;
#pragma unroll
          for (int j = 0; j < 4; ++j) { u32x2 w; w.x = cvtpk(v[j][0], v[j][1]); w.y = cvtpk(v[j][2], v[j][3]); xb[64 * j] = w; }
          if (F.lane == 0) RM[m] = 1.0f / sqrtf(s * (1.0f / 1024.0f) + EPS);
      } }
}

constexpr int SBV_PITCH = 192;
DI void sb_unit2(const bf16_t* PROJ, bf16_t* YCAT, int b, int h, int qp, LAS char* vl, int lane) {
    const int q = lane & 31, hh = lane >> 5;
    const size_t rowbase = (size_t)b * SEQ; const int qa = 2 * qp, qb = qa + 1;
    bf16x8 qfA[4], qfB[4];
    { const bf16_t* qrow = PROJ + (rowbase + qa * 32 + q) * LDP + C_SBQ + h * 64 + hh * 8;
#pragma unroll
      for (int s = 0; s < 4; ++s) { qfA[s] = *(const bf16x8*)(qrow + 16 * s); qfB[s] = *(const bf16x8*)(qrow + 32 * LDP + 16 * s); } }
    f32x16 oA0, oA1, oB0, oB1;
#pragma unroll
    for (int r = 0; r < 16; ++r) { oA0[r] = 0.f; oA1[r] = 0.f; oB0[r] = 0.f; oB1[r] = 0.f; }
    float RA = 1.f, RB = 1.f;
    const float zs = 0.125f * LOG2E;
    const int i16 = lane & 15, tq = i16 >> 2, tp = i16 & 3, blk = (lane >> 4) & 1;
    bf16x8 kf[4]; u32x4 vr[4];
#define SB_LOAD_TILE(kt_, kf, vr) do { const bf16_t* krow_ = PROJ + (rowbase + (kt_) * 32 + q) * LDP + C_SBK + h * 64 + hh * 8; \
        _Pragma("unroll") for (int s_ = 0; s_ < 4; ++s_) kf[s_] = *(const bf16x8*)(krow_ + 16 * s_); \
        _Pragma("unroll") for (int i_ = 0; i_ < 4; ++i_) { const int c_ = lane + 64 * i_, row_ = c_ >> 3, ch_ = c_ & 7; vr[i_] = *(const u32x4*)(PROJ + (rowbase + (kt_) * 32 + row_) * LDP + C_SBV + h * 64 + ch_ * 8); } } while (0)
#define SB_MATH(Z, DIAG, R, O0, O1) { \
        float L[16];                                        \
        _Pragma("unroll") for (int r = 0; r < 16; ++r) { \
            const float e = fexp2(fminf(Z[r] * zs, 100.f)), nb = __builtin_amdgcn_rcpf(1.f + e), be = e * nb; \
            const bool valid = !(DIAG) || (crow(r, hh) < q); \
            L[r] = valid ? nb : 1.f; Z[r] = valid ? be : 0.f; } \
        float G[4], Go[4]; \
        _Pragma("unroll") for (int g = 0; g < 4; ++g) { G[g] = (L[4 * g] * L[4 * g + 1]) * (L[4 * g + 2] * L[4 * g + 3]); Go[g] = __shfl_xor(G[g], 32); } \
        float base[4]; float run = 1.f; \
        _Pragma("unroll") for (int g = 3; g >= 0; --g) { base[g] = run * (hh == 0 ? Go[g] : 1.f); run *= G[g] * Go[g]; } \
        float P[16]; \
        _Pragma("unroll") for (int g = 0; g < 4; ++g) { \
            const float c3 = R * base[g], c2 = c3 * L[4 * g + 3], c1 = c2 * L[4 * g + 2], c0 = c1 * L[4 * g + 1]; \
            P[4 * g + 3] = Z[4 * g + 3] * c3; P[4 * g + 2] = Z[4 * g + 2] * c2; P[4 * g + 1] = Z[4 * g + 1] * c1; P[4 * g + 0] = Z[4 * g + 0] * c0; } \
        R *= run; \
        const bf16x8 p0 = pack8(P[0], P[1], P[2], P[3], P[4], P[5], P[6], P[7]), p1 = pack8(P[8], P[9], P[10], P[11], P[12], P[13], P[14], P[15]); \
        _Pragma("unroll") for (int s = 0; s < 2; ++s) { \
            const LAS char* vb = vl + (16 * s + 4 * hh + tq) * SBV_PITCH + blk * 32 + tp * 8; \
            const bf16x8 a0 = cat8(vtr(vb), vtr(vb + 8 * SBV_PITCH)), a1 = cat8(vtr(vb + 64), vtr(vb + 8 * SBV_PITCH + 64)); \
            O0 = MFMA32(a0, s == 0 ? p0 : p1, O0); O1 = MFMA32(a1, s == 0 ? p0 : p1, O1); } }
#define SB_ZERO(Z) _Pragma("unroll") for (int r = 0; r < 16; ++r) Z[r] = 0.f;
#define SB_VTOLDS(VR) _Pragma("unroll") for (int i = 0; i < 4; ++i) { const int c = lane + 64 * i, row = c >> 3, ch = c & 7; *(LAS u32x4*)(vl + row * SBV_PITCH + ch * 16) = VR[i]; }
    SB_LOAD_TILE(qb, kf, vr);
    {
        f32x16 zB; SB_ZERO(zB)
#pragma unroll
        for (int s = 0; s < 4; ++s) zB = MFMA32(kf[s], qfB[s], zB);
        SB_VTOLDS(vr)
        SB_LOAD_TILE(qa, kf, vr);
        SB_MATH(zB, true, RB, oB0, oB1)
    }
#define SB_STEP2(kt) { \
        f32x16 zA, zB; SB_ZERO(zA) SB_ZERO(zB) \
        _Pragma("unroll") for (int s = 0; s < 4; ++s) { zA = MFMA32(kf[s], qfA[s], zA); zB = MFMA32(kf[s], qfB[s], zB); } \
        SB_VTOLDS(vr) \
        if (kt > 0) SB_LOAD_TILE(kt - 1, kf, vr); \
        SB_MATH(zA, (kt == qa), RA, oA0, oA1) \
        SB_MATH(zB, false, RB, oB0, oB1) \
        if (__all(RA < 4.2e-18f && RB < 4.2e-18f)) break;        \
    }
    for (int kt = qa; kt >= 0; --kt) SB_STEP2(kt)
#undef SB_STEP2
#undef SB_VTOLDS
#undef SB_ZERO
#undef SB_MATH
#undef SB_LOAD_TILE
    bf16_t* orow = YCAT + (rowbase + qa * 32 + q) * 1024 + h * 64 + 4 * hh;
#pragma unroll
    for (int g = 0; g < 4; ++g) {
        u32x2 w0; w0.x = cvtpk(oA0[4 * g], oA0[4 * g + 1]); w0.y = cvtpk(oA0[4 * g + 2], oA0[4 * g + 3]); *(u32x2*)(orow + 8 * g) = w0;
        u32x2 w1; w1.x = cvtpk(oA1[4 * g], oA1[4 * g + 1]); w1.y = cvtpk(oA1[4 * g + 2], oA1[4 * g + 3]); *(u32x2*)(orow + 32 + 8 * g) = w1;
        u32x2 w2; w2.x = cvtpk(oB0[4 * g], oB0[4 * g + 1]); w2.y = cvtpk(oB0[4 * g + 2], oB0[4 * g + 3]); *(u32x2*)(orow + 32 * 1024 + 8 * g) = w2;
        u32x2 w3; w3.x = cvtpk(oB1[4 * g], oB1[4 * g + 1]); w3.y = cvtpk(oB1[4 * g + 2], oB1[4 * g + 3]); *(u32x2*)(orow + 32 * 1024 + 32 + 8 * g) = w3;
    }
}

constexpr int SGV_PITCH = 576;
DI void sgu_unit(const Frame& F, const Args& args, int l, int b, int c, const bf16_t* PROJ, bf16_t* YCAT) {
    const size_t m0 = (size_t)b * SEQ + c * 128;
    LAS char* Vn = (LAS char*)F.lds;
    {
      const int t = F.tid >> 2, part = F.tid & 3; const bf16_t* vrow = PROJ + (m0 + t) * LDP + C_SGV + part * 64; const float* gn = INP(I_SG_VG) + l * 256 + part * 64;
      float gv[64]; float s = 0.f;
#pragma unroll
      for (int i = 0; i < 8; ++i) { const u32x4 w = *(const u32x4*)(vrow + 8 * i);
#pragma unroll
          for (int j = 0; j < 4; ++j) { const float a = gelu_tanh(bflo(w[j])), bb = gelu_tanh(bfhi(w[j])); gv[8 * i + 2 * j] = a; gv[8 * i + 2 * j + 1] = bb; s += a * a + bb * bb; } }
      s += __shfl_xor(s, 1); s += __shfl_xor(s, 2);
      const float rstd = 1.0f / sqrtf(s * (1.0f / 256.0f) + EPS);
#pragma unroll
      for (int i = 0; i < 8; ++i) { const f32x4 g0 = *(const f32x4*)(gn + 8 * i), g1 = *(const f32x4*)(gn + 8 * i + 4);
          u32x4 w; w.x = cvtpk(gv[8 * i] * rstd * g0[0], gv[8 * i + 1] * rstd * g0[1]); w.y = cvtpk(gv[8 * i + 2] * rstd * g0[2], gv[8 * i + 3] * rstd * g0[3]);
          w.z = cvtpk(gv[8 * i + 4] * rstd * g1[0], gv[8 * i + 5] * rstd * g1[1]); w.w = cvtpk(gv[8 * i + 6] * rstd * g1[2], gv[8 * i + 7] * rstd * g1[3]);
          *(LAS u32x4*)(Vn + t * SGV_PITCH + (part * 64 + 8 * i) * 2) = w; } }
    WG_SYNC();
    {
      const int g = F.wave >> 1, db = F.wave & 1, lane = F.lane, r32 = lane & 31, hh = lane >> 5;
      const int i16 = lane & 15, tq = i16 >> 2, tp = i16 & 3, blk = (lane >> 4) & 1;
      const bf16_t* Wg = (const bf16_t*)(F.ws + WS_WSP) + ((size_t)(l * 4 + g) * 128) * 128;
      const float* bias = INP(I_SG_B) + (l * 4 + g) * 128;
      const int ch0 = g * 64 + db * 32 + 4 * hh;
      for (int tb = 0; tb < 4; ++tb) {
          const int t = tb * 32 + r32;
          u32x2 uw[4];
#pragma unroll
          for (int gi = 0; gi < 4; ++gi) uw[gi] = *(const u32x2*)(PROJ + (m0 + t) * LDP + C_SGU + ch0 + 8 * gi);
          const float bt = bias[t];
          f32x16 acc;
#pragma unroll
          for (int r = 0; r < 16; ++r) acc[r] = 0.f;
          for (int sb = 0; sb <= tb; ++sb) {
#pragma unroll
              for (int ks = 0; ks < 2; ++ks) {
                  const bf16x8 wf = *(const bf16x8*)(Wg + (size_t)t * 128 + sb * 32 + 16 * ks + 8 * hh);
                  const LAS char* vb = Vn + (sb * 32 + 16 * ks + 8 * hh + tq) * SGV_PITCH + (g * 64 + db * 32 + blk * 16) * 2 + tp * 8;
                  const bf16x8 vf = cat8(vtr(vb), vtr(vb + 4 * SGV_PITCH));
                  acc = MFMA32(vf, wf, acc);
              }
          }
          bf16_t* yo = YCAT + (m0 + t) * 1024 + 512 + ch0;
#pragma unroll
          for (int gi = 0; gi < 4; ++gi) {
              const float y0 = gelu_tanh(bflo(uw[gi].x)) * (acc[4 * gi] + bt), y1 = gelu_tanh(bfhi(uw[gi].x)) * (acc[4 * gi + 1] + bt);
              const float y2 = gelu_tanh(bflo(uw[gi].y)) * (acc[4 * gi + 2] + bt), y3 = gelu_tanh(bfhi(uw[gi].y)) * (acc[4 * gi + 3] + bt);
              u32x2 wv; wv.x = cvtpk(y0, y1); wv.y = cvtpk(y2, y3); *(u32x2*)(yo + 8 * gi) = wv;
          }
      } }
    WG_SYNC();
}

constexpr int GQ_PITCH = 80, GV_PITCH = 192, GS_PITCH = 80;
constexpr int GL_QT = 0, GL_KT = GL_QT + 128 * GQ_PITCH, GL_VV = GL_KT + 128 * GQ_PITCH, GL_ST = GL_VV + 128 * GV_PITCH, GL_SEG = GL_ST + 64 * GS_PITCH,
              GL_D = GL_SEG + 16 * 32 * 4, GL_SSQ = GL_D + 32 * 4, GL_END = GL_SSQ + 128 * 2 * 4;
DI void gla_chain(const Frame& F, const Args& args, int l, int b, int h, const bf16_t* PROJ, bf16_t* YCAT) {
    LAS char* L = (LAS char*)F.lds;
    LAS float* SEG = (LAS float*)(L + GL_SEG); LAS float* Dd = (LAS float*)(L + GL_D); LAS float* SSQ = (LAS float*)(L + GL_SSQ);
    const int tid = F.tid, lane = F.lane, w = F.wave, r32 = lane & 31, hh = lane >> 5;
    const int i16 = lane & 15, tq = i16 >> 2, tp = i16 & 3, blk = (lane >> 4) & 1;
    for (int i = tid; i < 64 * GS_PITCH / 4; i += NTHR) ((LAS unsigned*)(L + GL_ST))[i] = 0u;
    f32x16 st;
#pragma unroll
    for (int r = 0; r < 16; ++r) st[r] = 0.f;
    const int j = tid & 31, seg = tid >> 5;
    const float bg = INP(I_GLA_BG)[l * 128 + h * 32 + j];
    const int tb = w & 3, dh = w >> 2;
    float ga[8], kr[8], qr[8]; u32x4 vv[2];
#define GC_LOAD(c_) do { const size_t m0_ = (size_t)b * SEQ + (c_) * 128; \
        _Pragma("unroll") for (int i_ = 0; i_ < 8; ++i_) { const bf16_t* p_ = PROJ + (m0_ + seg * 8 + i_) * LDP + h * 32 + j; ga[i_] = bf2f(p_[C_GA]); kr[i_] = bf2f(p_[C_GK]); qr[i_] = bf2f(p_[C_GQ]); } \
        _Pragma("unroll") for (int i_ = 0; i_ < 2; ++i_) { const int cc_ = tid + 512 * i_, row_ = cc_ >> 3, ch_ = cc_ & 7; vv[i_] = *(const u32x4*)(PROJ + (m0_ + row_) * LDP + C_GV + h * 64 + ch_ * 8); } } while (0)
    GC_LOAD(0);
    LDS_SYNC();
#pragma unroll 1
    for (int c = 0; c < 16; ++c) {
        const size_t m0 = (size_t)b * SEQ + c * 128;
        float bc[8]; float run = 0.f;
#pragma unroll
        for (int i = 0; i < 8; ++i) {
            const float g = ga[i] + bg;
            const float sp = fmaxf(-g, 0.f) + flog2(1.f + fexp2(-fabsf(g) * LOG2E)) * 0.6931471805599453f;
            run += -sp * (1.0f / 16.0f); bc[i] = run;
        }
        SEG[seg * 32 + j] = run;
#pragma unroll
        for (int i = 0; i < 2; ++i) { const int cc = tid + 512 * i, row = cc >> 3, ch = cc & 7; *(LAS u32x4*)(L + GL_VV + row * GV_PITCH + ch * 16) = vv[i]; }
        LDS_SYNC();
        float pre = 0.f;
#pragma unroll
        for (int s2 = 0; s2 < 15; ++s2) { const float v_ = SEG[s2 * 32 + j]; pre += s2 < seg ? v_ : 0.f; }
#pragma unroll
        for (int i = 0; i < 8; ++i) {
            const int t = seg * 8 + i; const float bb = pre + bc[i];
            *(LAS bf16_t*)(L + GL_QT + t * GQ_PITCH + j * 2) = cvt1(qr[i] * 0.17677669529663687f * fexp2(bb * LOG2E));
            *(LAS bf16_t*)(L + GL_KT + t * GQ_PITCH + j * 2) = cvt1(kr[i] * fexp2(-bb * LOG2E));
            if (t == 127) Dd[j] = fexp2(bb * LOG2E);
        }
        if (c < 15) GC_LOAD(c + 1);
        u32x2 gov[4];
        { const bf16_t* go = PROJ + (m0 + tb * 32 + r32) * LDP + C_GO + h * 64 + dh * 32 + 4 * hh;
#pragma unroll
          for (int g = 0; g < 4; ++g) gov[g] = *(const u32x2*)(go + 8 * g); }
        LDS_SYNC();
        f32x16 o;
#pragma unroll
        for (int r = 0; r < 16; ++r) o[r] = 0.f;
        bf16x8 qf[2];
#pragma unroll
        for (int ks = 0; ks < 2; ++ks) qf[ks] = *(LAS const bf16x8*)(L + GL_QT + (tb * 32 + r32) * GQ_PITCH + (16 * ks + 8 * hh) * 2);
        for (int sb = 0; sb <= tb; ++sb) {
            f32x16 sT;
#pragma unroll
            for (int r = 0; r < 16; ++r) sT[r] = 0.f;
#pragma unroll
            for (int ks = 0; ks < 2; ++ks) { const bf16x8 kf = *(LAS const bf16x8*)(L + GL_KT + (sb * 32 + r32) * GQ_PITCH + (16 * ks + 8 * hh) * 2); sT = MFMA32(kf, qf[ks], sT); }
            if (sb == tb) {
#pragma unroll
                for (int r = 0; r < 16; ++r) if (crow(r, hh) > r32) sT[r] = 0.f;
            }
            const bf16x8 p0 = pack8(sT[0], sT[1], sT[2], sT[3], sT[4], sT[5], sT[6], sT[7]), p1 = pack8(sT[8], sT[9], sT[10], sT[11], sT[12], sT[13], sT[14], sT[15]);
#pragma unroll
            for (int s = 0; s < 2; ++s) {
                const LAS char* vb = L + GL_VV + (sb * 32 + 16 * s + 4 * hh + tq) * GV_PITCH + (dh * 32 + blk * 16) * 2 + tp * 8;
                const bf16x8 a = cat8(vtr(vb), vtr(vb + 8 * GV_PITCH));
                o = MFMA32(a, s == 0 ? p0 : p1, o);
            }
        }
#pragma unroll
        for (int ks = 0; ks < 2; ++ks) {
            const bf16x8 a = *(LAS const bf16x8*)(L + GL_ST + (dh * 32 + r32) * GS_PITCH + (16 * ks + 8 * hh) * 2);
            o = MFMA32(a, qf[ks], o);
        }
        if (tb == 0) {
#pragma unroll
            for (int ks = 0; ks < 8; ++ks) {
                const LAS char* kb = L + GL_KT + (16 * ks + 8 * hh + tq) * GQ_PITCH + (blk * 16) * 2 + tp * 8;
                const bf16x8 a = cat8(vtr(kb), vtr(kb + 4 * GQ_PITCH));
                const LAS char* vb = L + GL_VV + (16 * ks + 8 * hh + tq) * GV_PITCH + (dh * 32 + blk * 16) * 2 + tp * 8;
                const bf16x8 bfr = cat8(vtr(vb), vtr(vb + 4 * GV_PITCH));
                st = MFMA32(a, bfr, st);
            }
#pragma unroll
            for (int r = 0; r < 16; ++r) st[r] *= Dd[crow(r, hh)];
        }
        float ssq = 0.f;
#pragma unroll
        for (int r = 0; r < 16; ++r) ssq += o[r] * o[r];
        ssq += __shfl_xor(ssq, 32);
        if (hh == 0) SSQ[(tb * 32 + r32) * 2 + dh] = ssq;
        LDS_SYNC();
        {
            const int t = tb * 32 + r32; const float tot = SSQ[t * 2] + SSQ[t * 2 + 1]; const float rstd = 1.0f / sqrtf(tot * (1.0f / 64.0f) + EPS);
            const float* gn = INP(I_GLA_OG) + l * 256 + h * 64 + dh * 32 + 4 * hh;
            bf16_t* yo = YCAT + (m0 + t) * 1024 + 768 + h * 64 + dh * 32 + 4 * hh;
#pragma unroll
            for (int g = 0; g < 4; ++g) {
                const u32x2 gw = gov[g]; const f32x4 gg = *(const f32x4*)(gn + 8 * g);
                const float y0 = o[4 * g] * rstd * gg[0] * silu(bflo(gw.x)), y1 = o[4 * g + 1] * rstd * gg[1] * silu(bfhi(gw.x));
                const float y2 = o[4 * g + 2] * rstd * gg[2] * silu(bflo(gw.y)), y3 = o[4 * g + 3] * rstd * gg[3] * silu(bfhi(gw.y));
                u32x2 wv; wv.x = cvtpk(y0, y1); wv.y = cvtpk(y2, y3); *(u32x2*)(yo + 8 * g) = wv;
            }
        }
        if (tb == 0) {
#pragma unroll
            for (int g = 0; g < 4; ++g) { u32x2 wv; wv.x = cvtpk(st[4 * g], st[4 * g + 1]); wv.y = cvtpk(st[4 * g + 2], st[4 * g + 3]);
                *(LAS u32x2*)(L + GL_ST + (dh * 32 + r32) * GS_PITCH + (8 * g + 4 * hh) * 2) = wv; }
        }
        LDS_SYNC();
    }
#undef GC_LOAD
}

constexpr int XA_PITCH = 528;
template <int PITCH, int I0, int N> DI void xattn_load(const bf16_t* src, int tid, u32x4 (&v)[N]) {
    const bf16_t* p = src + (size_t)(tid >> 5) * PITCH + (tid & 31) * 8;
#pragma unroll
    for (int i = 0; i < N; ++i) v[i] = *(const u32x4*)(p + (size_t)(I0 + i) * 16 * PITCH);
}
template <int I0, int N> DI void xattn_store(LAS char* img, int tid, const u32x4 (&v)[N]) {
    LAS char* d = img + (tid >> 5) * XA_PITCH + (tid & 31) * 16;
#pragma unroll
    for (int i = 0; i < N; ++i) *(LAS u32x4*)(d + (I0 + i) * 16 * XA_PITCH) = v[i];
}
DI void xattn_unit(const Frame& F, const bf16_t* CQ, const bf16_t* Kl, const bf16_t* VTl, bf16_t* O, int pm, int h) {
    LAS char* img = (LAS char*)F.lds;
    const int lane = F.lane, r32 = lane & 31, hh = lane >> 5, b = pm >> 3;
    const size_t tok = (size_t)pm * 256 + F.wave * 32 + r32;
    { u32x4 sk[16]; xattn_load<1024, 0, 16>(Kl + (size_t)b * 256 * 1024 + h * 256, F.tid, sk); xattn_store<0, 16>(img, F.tid, sk); }
    const bf16_t* qrow = CQ + tok * 1024 + h * 256 + 8 * hh;
    bf16x8 qn = *(const bf16x8*)qrow;
    LDS_SYNC();
    u32x4 sv0[8]; xattn_load<256, 0, 8>(VTl + (size_t)(b * 4 + h) * 256 * 256, F.tid, sv0);
    f32x16 acc[8];
#pragma unroll
    for (int kb = 0; kb < 8; ++kb)
#pragma unroll
        for (int r = 0; r < 16; ++r) acc[kb][r] = 0.f;
#pragma unroll 1
    for (int ks = 0; ks < 16; ++ks) {
        const bf16x8 q = qn;
        qn = *(const bf16x8*)(qrow + 16 * (ks < 15 ? ks + 1 : ks));
        const LAS char* kp = img + r32 * XA_PITCH + (16 * ks + 8 * hh) * 2;
#pragma unroll
        for (int kb = 0; kb < 8; ++kb) acc[kb] = MFMA32(*(LAS const bf16x8*)(kp + kb * 32 * XA_PITCH), q, acc[kb]);
    }
    float mx = -INFINITY;
#pragma unroll
    for (int kb = 0; kb < 8; ++kb)
#pragma unroll
        for (int r = 0; r < 16; ++r) mx = fmaxf(mx, acc[kb][r]);
    mx = fmaxf(mx, __shfl_xor(mx, 32));
    float sum = 0.f;
#pragma unroll
    for (int kb = 0; kb < 8; ++kb)
#pragma unroll
        for (int r = 0; r < 16; ++r) { const float p = fexp2(acc[kb][r] - mx); acc[kb][r] = p; sum += p; }
    sum += __shfl_xor(sum, 32);
    const float inv = 1.0f / sum;
    bf16x8 pf[8][2];
#pragma unroll
    for (int kb = 0; kb < 8; ++kb) {
        pf[kb][0] = pack8(acc[kb][0], acc[kb][1], acc[kb][2], acc[kb][3], acc[kb][4], acc[kb][5], acc[kb][6], acc[kb][7]);
        pf[kb][1] = pack8(acc[kb][8], acc[kb][9], acc[kb][10], acc[kb][11], acc[kb][12], acc[kb][13], acc[kb][14], acc[kb][15]);
    }
    LDS_SYNC();
    { u32x4 sv1[8]; xattn_load<256, 8, 8>(VTl + (size_t)(b * 4 + h) * 256 * 256, F.tid, sv1); xattn_store<0, 8>(img, F.tid, sv0); xattn_store<8, 8>(img, F.tid, sv1); }
    LDS_SYNC();
    bf16_t* orow = O + tok * 1024 + h * 256 + 4 * hh;
#pragma unroll 1
    for (int db = 0; db < 8; ++db) {
        f32x16 o;
#pragma unroll
        for (int r = 0; r < 16; ++r) o[r] = 0.f;
#pragma unroll
        for (int kb = 0; kb < 8; ++kb)
#pragma unroll
            for (int s2 = 0; s2 < 2; ++s2) {
                const LAS char* vp = img + (db * 32 + r32) * XA_PITCH + (32 * kb + 16 * s2 + 4 * hh) * 2;
                const bf16x8 vf = cat8(*(LAS const s16x4*)vp, *(LAS const s16x4*)(vp + 16));
                o = MFMA32(vf, pf[kb][s2], o);
            }
#pragma unroll
        for (int g = 0; g < 4; ++g) { u32x2 w; w.x = cvtpk(o[4 * g] * inv, o[4 * g + 1] * inv); w.y = cvtpk(o[4 * g + 2] * inv, o[4 * g + 3] * inv); *(u32x2*)(orow + 32 * db + 8 * g) = w; }
    }
    LDS_SYNC();
}

DI unsigned key_pack(float v, unsigned tag, unsigned mask) { const unsigned b = __float_as_uint(v); const unsigned mono = b ^ ((unsigned)((int)b >> 31) | 0x80000000u); return (mono & ~mask) | tag; }
DI float key_val(unsigned k, unsigned mask) { const unsigned mono = k & ~mask; const unsigned b = (mono & 0x80000000u) ? (mono ^ 0x80000000u) : ~mono; return __uint_as_float(b); }
#define CE(a, b) do { const unsigned _h = (a) > (b) ? (a) : (b); const unsigned _l = (a) > (b) ? (b) : (a); (a) = _h; (b) = _l; } while (0)
#define SORT16_DESC(v) do { CE(v[0], v[1]); CE(v[2], v[3]); CE(v[0], v[2]); CE(v[1], v[3]); CE(v[1], v[2]); CE(v[4], v[5]); CE(v[6], v[7]); CE(v[4], v[6]); CE(v[5], v[7]); CE(v[5], v[6]); CE(v[0], v[4]); CE(v[2], v[6]); CE(v[2], v[4]); CE(v[1], v[5]); CE(v[3], v[7]); CE(v[3], v[5]); CE(v[1], v[2]); CE(v[3], v[4]); CE(v[5], v[6]); CE(v[8], v[9]); CE(v[10], v[11]); CE(v[8], v[10]); CE(v[9], v[11]); CE(v[9], v[10]); CE(v[12], v[13]); CE(v[14], v[15]); CE(v[12], v[14]); CE(v[13], v[15]); CE(v[13], v[14]); CE(v[8], v[12]); CE(v[10], v[14]); CE(v[10], v[12]); CE(v[9], v[13]); CE(v[11], v[15]); CE(v[11], v[13]); CE(v[9], v[10]); CE(v[11], v[12]); CE(v[13], v[14]); CE(v[0], v[8]); CE(v[4], v[12]); CE(v[4], v[8]); CE(v[2], v[10]); CE(v[6], v[14]); CE(v[6], v[10]); CE(v[2], v[4]); CE(v[6], v[8]); CE(v[10], v[12]); CE(v[1], v[9]); CE(v[5], v[13]); CE(v[5], v[9]); CE(v[3], v[11]); CE(v[7], v[15]); CE(v[7], v[11]); CE(v[3], v[5]); CE(v[7], v[9]); CE(v[11], v[13]); CE(v[1], v[2]); CE(v[3], v[4]); CE(v[5], v[6]); CE(v[7], v[8]); CE(v[9], v[10]); CE(v[11], v[12]); CE(v[13], v[14]); } while (0)
#define BITONIC16_DESC(v) do { CE(v[0], v[8]); CE(v[1], v[9]); CE(v[2], v[10]); CE(v[3], v[11]); CE(v[4], v[12]); CE(v[5], v[13]); CE(v[6], v[14]); CE(v[7], v[15]); CE(v[0], v[4]); CE(v[1], v[5]); CE(v[2], v[6]); CE(v[3], v[7]); CE(v[8], v[12]); CE(v[9], v[13]); CE(v[10], v[14]); CE(v[11], v[15]); CE(v[0], v[2]); CE(v[1], v[3]); CE(v[4], v[6]); CE(v[5], v[7]); CE(v[8], v[10]); CE(v[9], v[11]); CE(v[12], v[14]); CE(v[13], v[15]); CE(v[0], v[1]); CE(v[2], v[3]); CE(v[4], v[5]); CE(v[6], v[7]); CE(v[8], v[9]); CE(v[10], v[11]); CE(v[12], v[13]); CE(v[14], v[15]); } while (0)
#define MERGE_TOP16(T, v) do { _Pragma("unroll") for (int _i = 0; _i < 16; ++_i) T[_i] = T[_i] > v[15 - _i] ? T[_i] : v[15 - _i]; BITONIC16_T(T); } while (0)
DI void bitonic16(unsigned (&v)[16]) { BITONIC16_DESC(v); }
#define BITONIC16_T(T) bitonic16(T)
DI void route_level1(const bf16_t* PQ, const bf16_t* SK  , int tile, int h, int lane, unsigned (&tpk)[2][16]) {
    const int r32 = lane & 31, hh = lane >> 5; const size_t m = (size_t)tile * 32 + r32;
    bf16x8 qfa[2][4];
#pragma unroll
    for (int p = 0; p < 2; ++p)
#pragma unroll
        for (int ks = 0; ks < 4; ++ks) qfa[p][ks] = *(const bf16x8*)(PQ + m * 1024 + h * 128 + p * 64 + 16 * ks + 8 * hh);
    bf16x8 an[4];
#define RT_LOADA(p_, nb_) do { const bf16_t* skp_ = SK + ((size_t)(h * 2 + (p_)) * 128) * 64; _Pragma("unroll") for (int ks_ = 0; ks_ < 4; ++ks_) an[ks_] = *(const bf16x8*)(skp_ + (size_t)((nb_) * 32 + r32) * 64 + 16 * ks_ + 8 * hh); } while (0)
    RT_LOADA(0, 0);
#pragma unroll
    for (int p = 0; p < 2; ++p) {
        unsigned T[16];
#pragma unroll
        for (int i = 0; i < 16; ++i) T[i] = 0u;
#pragma unroll 1
        for (int nb = 0; nb < 4; ++nb) {
            bf16x8 a[4];
#pragma unroll
            for (int ks = 0; ks < 4; ++ks) a[ks] = an[ks];
            if (nb < 3) RT_LOADA(p, nb + 1); else if (p == 0) RT_LOADA(1, 0);
            f32x16 acc;
#pragma unroll
            for (int r = 0; r < 16; ++r) acc[r] = 0.f;
#pragma unroll
            for (int ks = 0; ks < 4; ++ks) acc = MFMA32(a[ks], qfa[p][ks], acc);
            unsigned v[16];
#pragma unroll
            for (int r = 0; r < 16; ++r) v[r] = key_pack(acc[r], (unsigned)(nb * 32 + crow(r, hh)), 127u);
            SORT16_DESC(v);
            MERGE_TOP16(T, v);
        }
        unsigned pv[16];
#pragma unroll
        for (int i = 0; i < 16; ++i) pv[i] = (unsigned)__shfl_xor((int)T[i], 32);
        MERGE_TOP16(T, pv);
#pragma unroll
        for (int i = 0; i < 16; ++i) tpk[p][i] = T[i];
    }
#undef RT_LOADA
}
DI void route_level2(const unsigned (&tpk)[2][16], size_t m, int h, int lane, int* IDX, float* Gw, unsigned* SCL, const LAS unsigned* SCT  , LAS char* scr  ) {
    { u32x4 w0, w1, w2, w3;
#pragma unroll
      for (int q = 0; q < 4; ++q) {
          w0[q] = (tpk[0][4 * q] & 127u) | ((tpk[0][4 * q + 1] & 127u) << 8) | ((tpk[0][4 * q + 2] & 127u) << 16) | ((tpk[0][4 * q + 3] & 127u) << 24);
          w1[q] = (tpk[1][4 * q] & 127u) | ((tpk[1][4 * q + 1] & 127u) << 8) | ((tpk[1][4 * q + 2] & 127u) << 16) | ((tpk[1][4 * q + 3] & 127u) << 24); }
      (void)w2; (void)w3;
      *(LAS u32x4*)(scr + lane * 48) = w0; *(LAS u32x4*)(scr + lane * 48 + 16) = w1; }
    float av[16], bv[16];
#pragma unroll
    for (int i = 0; i < 16; ++i) { av[i] = key_val(tpk[0][i], 127u); bv[i] = key_val(tpk[1][i], 127u); }
    unsigned cv[16];
#pragma unroll
    for (int i = 0; i < 16; ++i) cv[i] = 0u;
#pragma unroll
    for (int i = 0; i < 16; ++i)
#pragma unroll
        for (int jj = 0; jj < 16; ++jj) if ((i + 1) * (jj + 1) <= 16) {
            unsigned x = key_pack(av[i] + bv[jj], (unsigned)(i * 16 + jj), 255u);
#pragma unroll
            for (int pos = (i + 1) * (jj + 1) - 1; pos < 16; ++pos) CE(cv[pos], x);
        }
    const float cmax = key_val(cv[0], 255u);
    float e[16]; float sum = 0.f;
#pragma unroll
    for (int k = 0; k < 16; ++k) { e[k] = fexp2((key_val(cv[k], 255u) - cmax) * LOG2E); sum += e[k]; }
    const float inv = 1.0f / sum;
    int id[16];
#pragma unroll
    for (int k = 0; k < 16; ++k) {
        const unsigned ij = cv[k] & 255u;
        const unsigned n0 = *(LAS const unsigned char*)(scr + lane * 48 + (ij >> 4)), n1 = *(LAS const unsigned char*)(scr + lane * 48 + 16 + (ij & 15u));
        id[k] = (int)(n0 * 128u + n1);
    }
    { int* ip = IDX + m * 128 + h * 16;
#pragma unroll
      for (int k = 0; k < 16; k += 4) *(int4*)(ip + k) = make_int4(id[k], id[k + 1], id[k + 2], id[k + 3]);
      if (SCT != nullptr) {
      unsigned* sp = SCL + m * 128 + h * 16;
#pragma unroll
      for (int k = 0; k < 16; k += 4) { u32x4 w;
#pragma unroll
          for (int q = 0; q < 4; ++q) w[q] = SCT[id[k + q]];
          *(u32x4*)(sp + k) = w; } }
      float* gp = Gw + m * 128 + h * 16;
#pragma unroll
      for (int k = 0; k < 16; k += 4) *(f32x4*)(gp + k) = (f32x4){e[k] * inv, e[k + 1] * inv, e[k + 2] * inv, e[k + 3] * inv}; }
}
DI void route_pair(const bf16_t* PQ, const bf16_t* SK, int* IDX, float* Gw, unsigned* SCL, const LAS unsigned* SCT, int tileA, int h, int lane, LAS char* scr) {
    unsigned tA[2][16], tB[2][16];
    route_level1(PQ, SK, tileA, h, lane, tA);
    route_level1(PQ, SK, tileA + 1, h, lane, tB);
    const bool hi = lane >= 32;
#pragma unroll
    for (int p = 0; p < 2; ++p)
#pragma unroll
        for (int i = 0; i < 16; ++i) tA[p][i] = hi ? tB[p][i] : tA[p][i];
    route_level2(tA, (size_t)(tileA + (hi ? 1 : 0)) * 32 + (lane & 31), h, lane, IDX, Gw, SCL, SCT, scr);
}

DI void route_heads(const bf16_t* PQ, const bf16_t* SK, int* IDX, float* Gw, int tile, int ha, int lane, LAS char* scr) {
    unsigned tA[2][16], tB[2][16];
    route_level1(PQ, SK, tile, ha, lane, tA);
    route_level1(PQ, SK, tile, ha + 1, lane, tB);
    const bool hi = lane >= 32;
#pragma unroll
    for (int p = 0; p < 2; ++p)
#pragma unroll
        for (int i = 0; i < 16; ++i) tA[p][i] = hi ? tB[p][i] : tA[p][i];
    route_level2(tA, (size_t)tile * 32 + (lane & 31), hi ? ha + 1 : ha, lane, IDX, Gw, nullptr, nullptr, scr);
}

#define FP4PAIR(w, bsel) __builtin_amdgcn_cvt_scalef32_pk_f32_fp4((w), 1.0f, (bsel))
typedef __bf16 bf16p_t __attribute__((ext_vector_type(2)));
#define FP4BF(w, bsel) __builtin_amdgcn_cvt_scalef32_pk_bf16_fp4((w), 1.0f, (bsel))
#define DOT2(accf, xw, ub) accf = __builtin_amdgcn_fdot2_f32_bf16(__builtin_bit_cast(bf16p_t, (xw)), (ub), accf, false)
typedef int v8i_t __attribute__((ext_vector_type(8)));
typedef short s16x2_t __attribute__((ext_vector_type(2)));
DI f32x4 mfma_x4u4(const u32x4 a, const u32x4 b, const f32x4 c) {
    const v8i_t aa = {(int)a.x, (int)a.y, (int)a.z, (int)a.w, 0, 0, 0, 0}, bb = {(int)b.x, (int)b.y, (int)b.z, (int)b.w, 0, 0, 0, 0};
    return __builtin_amdgcn_mfma_scale_f32_16x16x128_f8f6f4(aa, bb, c, 4, 4, 0, 0x7F7F7F7F, 0, 0x7F7F7F7F);
}
constexpr int PJ_NR = 1, PJ_T0 = 2;
constexpr int PJ_XS = 0, PJ_ZR = NWAVES * 1536, PJ_STG = PJ_ZR + 1024, PJ_UPITCH = 528, PJ_SCR = PJ_STG + NWAVES * 16 * PJ_UPITCH;
constexpr int PJ_FLG = PJ_SCR + PJ_NR * 3072;
static_assert(PJ_FLG + 32 <= LDS_BYTES - 64, "PEER phase LDS map");
constexpr int PJ_SCR0 = PJ_FLG + 32;
static_assert(PJ_SCR0 + NWAVES * 3072 <= LDS_BYTES - 64, "PEER phase LDS map");
#define PJ_TOK(t_) ((size_t)(F.bx + GRID * ((t_) >> 5)) * 32 + ((t_) & 31))
DI void pj_wait_tile(const Frame& F, int tile) {
    volatile LAS unsigned* fl = (volatile LAS unsigned*)(F.lds + PJ_FLG);
    const unsigned need = tile < PJ_T0 ? (unsigned)NWAVES : (unsigned)PJ_NR;
    while (fl[tile] < need) __builtin_amdgcn_s_sleep(2);
    asm volatile("" ::: "memory");
}
DI int pj_pop(const Frame& F) { int v = 0; if (F.lane == 0) v = (int)__atomic_fetch_add((LAS unsigned*)(F.lds + PJ_FLG) + 4, 1u, __ATOMIC_RELAXED); return __builtin_amdgcn_readfirstlane(v); }
DI void peer_u_stream(const Frame& F, const unsigned char* Ub, const unsigned* SCTg, const int* IDX, const float* Gw, const bf16_t* XB, const float* SS, int uw, float* cs) {
    const int lane = F.lane, j16 = lane & 15, kb = lane >> 4;
    LAS unsigned char* xs = F.lds + PJ_XS + uw * 1536;
    LAS unsigned char* zr = F.lds + PJ_ZR;
    { unsigned zz; asm volatile("v_mov_b32 %0, 0" : "=v"(zz)); *(LAS u32x4*)(zr + 16 * lane) = (u32x4){zz, zz, zz, zz}; }
    const LAS unsigned char* xrd = j16 < 3 ? xs + 512 * j16 + 16 * kb : zr;
    constexpr int UPITCH = PJ_UPITCH;
    LAS unsigned char* stg = F.lds + PJ_STG + uw * (16 * UPITCH);
    LAS unsigned char* stw = stg + (lane >> 5) * UPITCH + 16 * (lane & 31);
    const LAS unsigned char* strd = stg + j16 * UPITCH + 16 * kb;
    u32x4 UA[8], UB[8];
#define PU_ISSUE(buf, idv, sub) do { _Pragma("unroll") for (int i_ = 0; i_ < 8; ++i_) { const int e_ = __shfl(idv, (sub) * 16 + 2 * i_ + (lane >> 5)); \
            buf[i_] = *(const u32x4*)(Ub + (size_t)e_ * 512 + 16 * (lane & 31)); } } while (0)
#define PU_DOTS(buf, sub, dreg) do { f32x4 c_ = {0.f, 0.f, 0.f, 0.f}; asm volatile("" ::: "memory"); \
        _Pragma("unroll") for (int i_ = 0; i_ < 8; ++i_) *(LAS u32x4*)(stw + i_ * (2 * UPITCH)) = buf[i_];        \
        _Pragma("unroll") for (int s_ = 0; s_ < 8; ++s_) { const u32x4 xq_ = *(const LAS u32x4*)(xrd + 64 * s_), bq_ = *(const LAS u32x4*)(strd + 64 * s_); c_ = mfma_x4u4(xq_, bq_, c_); } \
        const float dv_ = __shfl(fmaf(c_[2], xs3, fmaf(c_[1], xs2, c_[0] * xs1)), j16); if (kb == (sub)) dreg = dv_; } while (0)
    int t = pj_pop(F);
    if (t >= 128) return;
    pj_wait_tile(F, t >> 5);
    size_t m = PJ_TOK(t);
    u32x4 xa = *(const u32x4*)(XB + m * 1024 + 16 * lane), xb = *(const u32x4*)(XB + m * 1024 + 16 * lane + 8);
    int id0 = IDX[m * 128 + lane], id1 = IDX[m * 128 + 64 + lane];
    float g0 = Gw[m * 128 + lane], g1 = Gw[m * 128 + 64 + lane];
    float ssl = lane < 16 ? SS[m * 16 + lane] : 0.f;
    PU_ISSUE(UA, id0, 0);
#pragma unroll 1
    for (int tnx = 0; t < 128; t = tnx) {
        unsigned xp[8];
#pragma unroll
        for (int i = 0; i < 4; ++i) { xp[i] = xa[i]; xp[4 + i] = xb[i]; }
        PU_ISSUE(UB, id0, 1);
        const unsigned sc0 = SCTg[id0], sc1 = SCTg[id1];
        float xs1, xs2, xs3;
        {
          float xr_[16]; float am = 0.f;
#pragma unroll
          for (int i = 0; i < 8; ++i) { xr_[2 * i] = bflo(xp[i]); xr_[2 * i + 1] = bfhi(xp[i]); am = fmaxf(am, fmaxf(fabsf(xr_[2 * i]), fabsf(xr_[2 * i + 1]))); }
          am = wave_max(am);
          int eb = (int)((__builtin_bit_cast(unsigned, am) >> 23) & 0xFFu); eb = eb < 40 ? 40 : eb;
          xs1 = __builtin_bit_cast(float, (unsigned)(eb - 1) << 23); xs2 = xs1 * 0.25f; xs3 = xs1 * 0.03125f;
#pragma unroll
          for (int t = 0; t < 3; ++t) {
              const float sc_ = t == 0 ? xs1 : t == 1 ? xs2 : xs3;
              u32x2 w;
#pragma unroll
              for (int hw = 0; hw < 2; ++hw) {
                  unsigned ww = 0;
                  ww = __builtin_amdgcn_cvt_scalef32_pk_fp4_f32(ww, xr_[8 * hw + 0], xr_[8 * hw + 1], sc_, 0); ww = __builtin_amdgcn_cvt_scalef32_pk_fp4_f32(ww, xr_[8 * hw + 2], xr_[8 * hw + 3], sc_, 1);
                  ww = __builtin_amdgcn_cvt_scalef32_pk_fp4_f32(ww, xr_[8 * hw + 4], xr_[8 * hw + 5], sc_, 2); ww = __builtin_amdgcn_cvt_scalef32_pk_fp4_f32(ww, xr_[8 * hw + 6], xr_[8 * hw + 7], sc_, 3);
                  w[hw] = ww;
                  if (t < 2) {
                      const f32x2 q0 = __builtin_amdgcn_cvt_scalef32_pk_f32_fp4(ww, sc_, 0), q1 = __builtin_amdgcn_cvt_scalef32_pk_f32_fp4(ww, sc_, 1), q2 = __builtin_amdgcn_cvt_scalef32_pk_f32_fp4(ww, sc_, 2), q3 = __builtin_amdgcn_cvt_scalef32_pk_f32_fp4(ww, sc_, 3);
                      xr_[8 * hw + 0] -= q0.x; xr_[8 * hw + 1] -= q0.y; xr_[8 * hw + 2] -= q1.x; xr_[8 * hw + 3] -= q1.y; xr_[8 * hw + 4] -= q2.x; xr_[8 * hw + 5] -= q2.y; xr_[8 * hw + 6] -= q3.x; xr_[8 * hw + 7] -= q3.y;
                  }
              }
              *(LAS u32x2*)(xs + 512 * t + 8 * lane) = w;
          }
        }
        tnx = pj_pop(F);
        const int tn = tnx < 128 ? tnx : t;
        pj_wait_tile(F, tn >> 5);
        const size_t mn = PJ_TOK(tn);
        const u32x4 nxa = *(const u32x4*)(XB + mn * 1024 + 16 * lane), nxb = *(const u32x4*)(XB + mn * 1024 + 16 * lane + 8);
        const int nid0 = IDX[mn * 128 + lane], nid1 = IDX[mn * 128 + 64 + lane];
        const float ng0 = Gw[mn * 128 + lane], ng1 = Gw[mn * 128 + 64 + lane];
        const float nssl = lane < 16 ? SS[mn * 16 + lane] : 0.f;
        const float rstd = 1.0f / sqrtf(wave_sum(ssl) * (1.0f / 1024.0f) + EPS);
        float d0 = 0.f, d1 = 0.f;
        PU_DOTS(UA, 0, d0); PU_ISSUE(UA, id0, 2);
        PU_DOTS(UB, 1, d0); PU_ISSUE(UB, id0, 3);
        PU_DOTS(UA, 2, d0); PU_ISSUE(UA, id1, 0);
        PU_DOTS(UB, 3, d0); PU_ISSUE(UB, id1, 1);
        PU_DOTS(UA, 0, d1); PU_ISSUE(UA, id1, 2);
        PU_DOTS(UB, 1, d1); PU_ISSUE(UB, id1, 3);
        PU_DOTS(UA, 2, d1); PU_ISSUE(UA, nid0, 0);
        PU_DOTS(UB, 3, d1);
        const float c0 = g0 * gelu_tanh(d0 * (bflo(sc0) * rstd)) * bfhi(sc0), c1 = g1 * gelu_tanh(d1 * (bflo(sc1) * rstd)) * bfhi(sc1);
        m = PJ_TOK(t); cs[m * 128 + lane] = c0; cs[m * 128 + 64 + lane] = c1;
        xa = nxa; xb = nxb; id0 = nid0; id1 = nid1; g0 = ng0; g1 = ng1; ssl = nssl;
    }
#undef PU_ISSUE
#undef PU_DOTS
}
DI void peer_v_pass(const Frame& F, const Args& args, bool last, const unsigned char* Vb, const int* IDX, bf16_t* XB, float* SS, const float* csw) {
    const int lane = F.lane;
    u32x2 A[16], B[16];
#define PW_ISSUE(buf, tab, idv, sub) do { _Pragma("unroll") for (int i_ = 0; i_ < 16; ++i_) { const int e_ = __builtin_amdgcn_readlane(idv, (sub) * 16 + i_); buf[i_] = *(const u32x2*)((tab) + (size_t)e_ * 512 + 8 * lane); } } while (0)
#define PW_ACCUM(buf, cv, sub) do { _Pragma("unroll") for (int i_ = 0; i_ < 16; ++i_) { \
            const float cf_ = __builtin_bit_cast(float, __builtin_amdgcn_readlane(__builtin_bit_cast(int, cv), (sub) * 16 + i_)); const f32x2 cf2_ = {cf_, cf_}; \
            _Pragma("unroll") for (int q_ = 0; q_ < 2; ++q_) { acc[4 * q_] += cf2_ * FP4PAIR(buf[i_][q_], 0); acc[4 * q_ + 1] += cf2_ * FP4PAIR(buf[i_][q_], 1); acc[4 * q_ + 2] += cf2_ * FP4PAIR(buf[i_][q_], 2); acc[4 * q_ + 3] += cf2_ * FP4PAIR(buf[i_][q_], 3); } } } while (0)
#define PV_TOK(t_) ((size_t)(F.bx + GRID * ((t_) >> 5)) * 32 + ((t_) & 31))
    const int t0 = F.wave * 16;
    size_t m = PV_TOK(t0);
    u32x4 xa = *(const u32x4*)(XB + m * 1024 + 16 * lane), xb = *(const u32x4*)(XB + m * 1024 + 16 * lane + 8);
    int id0 = IDX[m * 128 + lane], id1 = IDX[m * 128 + 64 + lane];
    PW_ISSUE(A, Vb, id0, 0);
#pragma unroll 1
    for (int it = 0; it < 16; ++it) {
        m = PV_TOK(t0 + it);
        unsigned xp[8];
#pragma unroll
        for (int i = 0; i < 4; ++i) { xp[i] = xa[i]; xp[4 + i] = xb[i]; }
        const float c0 = csw[m * 128 + lane], c1 = csw[m * 128 + 64 + lane];
        const size_t mn = PV_TOK(t0 + (it < 15 ? it + 1 : it));
        const u32x4 nxa = *(const u32x4*)(XB + mn * 1024 + 16 * lane), nxb = *(const u32x4*)(XB + mn * 1024 + 16 * lane + 8);
        const int nid0 = IDX[mn * 128 + lane], nid1 = IDX[mn * 128 + 64 + lane];
        f32x2 acc[8];
#pragma unroll
        for (int q = 0; q < 8; ++q) acc[q] = (f32x2){0.f, 0.f};
        PW_ISSUE(B, Vb, id0, 1); PW_ACCUM(A, c0, 0);
        PW_ISSUE(A, Vb, id0, 2); PW_ACCUM(B, c0, 1);
        PW_ISSUE(B, Vb, id0, 3); PW_ACCUM(A, c0, 2);
        PW_ISSUE(A, Vb, id1, 0); PW_ACCUM(B, c0, 3);
        PW_ISSUE(B, Vb, id1, 1); PW_ACCUM(A, c1, 0);
        PW_ISSUE(A, Vb, id1, 2); PW_ACCUM(B, c1, 1);
        PW_ISSUE(B, Vb, id1, 3); PW_ACCUM(A, c1, 2);
        PW_ISSUE(A, Vb, nid0, 0); PW_ACCUM(B, c1, 3);
        float xo[16]; float s = 0.f;
#pragma unroll
        for (int q = 0; q < 8; ++q) { xo[2 * q] = bflo(xp[q]) + acc[q].x; xo[2 * q + 1] = bfhi(xp[q]) + acc[q].y; }
        if (!last) {
            u32x4 w0, w1;
#pragma unroll
            for (int q = 0; q < 4; ++q) { w0[q] = cvtpk(xo[2 * q], xo[2 * q + 1]); w1[q] = cvtpk(xo[8 + 2 * q], xo[8 + 2 * q + 1]);
                s += (bflo(w0[q]) * bflo(w0[q]) + bfhi(w0[q]) * bfhi(w0[q])) + (bflo(w1[q]) * bflo(w1[q]) + bfhi(w1[q]) * bfhi(w1[q])); }
            s = wave_sum(s);
            *(u32x4*)(XB + (size_t)m * 1024 + 16 * lane) = w0; *(u32x4*)(XB + (size_t)m * 1024 + 16 * lane + 8) = w1;
            if (lane < 16) SS[(size_t)m * 16 + lane] = lane == 0 ? s : 0.f;
        } else {
#pragma unroll
            for (int q = 0; q < 16; ++q) s += xo[q] * xo[q];
            s = wave_sum(s);
            const float rf = 1.0f / sqrtf(s * (1.0f / 1024.0f) + EPS); const float* fg = INP(I_FINAL_G) + 16 * lane; float* xr = F.X + (size_t)m * 1024 + 16 * lane;
#pragma unroll
            for (int q = 0; q < 4; ++q) { const f32x4 gq = *(const f32x4*)(fg + 4 * q); *(f32x4*)(xr + 4 * q) = (f32x4){xo[4 * q], xo[4 * q + 1], xo[4 * q + 2], xo[4 * q + 3]} * rf * gq; }
        }
        xa = nxa; xb = nxb; id0 = nid0; id1 = nid1;
    }
#undef PV_TOK
#undef PW_ISSUE
#undef PW_ACCUM
}

constexpr int PPL = 7;
constexpr int NPHASE = 1 + DEPTH * PPL;
__global__ void __launch_bounds__(NTHR, 2) trunk_fwd(Args args) {
    extern __shared__ __attribute__((aligned(16))) unsigned char lds_raw[];
    Frame F;
    F.lds = (LAS unsigned char*)lds_raw;
    F.tid = threadIdx.x; F.lane = F.tid & 63; F.wave = __builtin_amdgcn_readfirstlane(F.tid >> 6);
    F.bx = blockIdx.x; F.gw = F.bx * NWAVES + F.wave;
    F.X = args.out; F.ws = args.ws;
    const int lo = args.ph_lo, hi = args.ph_hi;
#if MK_ONE_LAUNCH
    volatile LAS unsigned* bst = (volatile LAS unsigned*)(F.lds + LDS_BYTES - 64);
    if (F.tid < 16) bst[F.tid] = 0u;
    __syncthreads();
    const XcdBarrier gbar = xcd_barrier_post((unsigned*)(args.ws + WS_CTL) + 4096, bst);
    cg::this_grid().sync();
#endif
#define REFRESH() int t_ = threadIdx.x; asm volatile("" : "+v"(t_)); F.tid = t_; F.lane = t_ & 63; F.wave = __builtin_amdgcn_readfirstlane(t_ >> 6); \
    F.gw = F.bx * NWAVES + F.wave; size_t z_ = 0; asm volatile("" : "+s"(z_)); unsigned char* ws = args.ws + z_; F.ws = ws; \
    bf16_t* XB = (bf16_t*)(ws + WS_XB); float* SS = (float*)(ws + WS_SS); bf16_t* YC = (bf16_t*)(ws + WS_YCAT); bf16_t* PROJ = (bf16_t*)(ws + WS_PROJ); \
    bf16_t* CQ = PROJ; bf16_t* PP = (bf16_t*)(ws + WS_PROJ + 64 * MiB); int* IDX = (int*)(ws + WS_PROJ + 64 * MiB); float* GW = (float*)(ws + WS_PROJ + 80 * MiB); \
    bf16_t* Wl = (bf16_t*)(ws + WS_W + l * W_LAYER); bf16_t* Kl = (bf16_t*)(ws + WS_KMEM + (size_t)l * 16 * MiB); bf16_t* VTl = Kl + (size_t)4096 * 1024; \
    (void)XB; (void)SS; (void)YC; (void)PROJ; (void)CQ; (void)PP; (void)IDX; (void)GW; (void)Wl; (void)Kl; (void)VTl;
#pragma unroll 1
    for (int ph = lo; ph < hi; ++ph) {
        const int l = ph == 0 ? 0 : (ph - 1) / PPL, k = ph == 0 ? -1 : (ph - 1) % PPL;
        for (int rep = 0; rep < ((k == PROBE_REP_K) ? 2 : 1); ++rep) {
        if (rep) { WG_SYNC(); xcd_barrier(gbar); }
        switch (k) {
        case -1: if (EN(0)) { REFRESH(); p0_prologue(F, args); } break;
        case 0: case 3: case 5: if (EN(1)) {
            REFRESH();
            if (k == 0 && l == 0) {
#pragma unroll 1
                for (int l2 = 0; l2 < DEPTH; ++l2) {
                    bf16_t* W2 = (bf16_t*)(ws + WS_W + l2 * W_LAYER); bf16_t* K2 = (bf16_t*)(ws + WS_KMEM + (size_t)l2 * 16 * MiB);
                    pg8::Gemm g{(const bf16_t*)(ws + WS_MEMB), W2 + W_CKV / 2, 1024, 1024, 1024}; pg8::StaticOrder S; S.init(MMEM, 2048, F.G, (F.bx + 128 * l2) % F.G, 1024, 1024);
                    pg8::EpiKV E{K2, K2 + (size_t)4096 * 1024, (const float*)(ws + WS_RSTDM)};
                    pg8::gemm_phase<pg8::EpiKV, pg8::StaticOrder, true>(F.lds, g, S, E);
                }
            }
            const bf16_t* Bt = Wl + (k == 0 ? W_IN : k == 3 ? W_CQ : W_PQ) / 2; const int N = k == 0 ? NPROJ : 1024, ldc = k == 0 ? LDP : 1024;
            pg8::Gemm g{XB, Bt, 1024, 1024, 1024}; pg8::StaticOrder S; S.init(MTOK, N, F.G, F.bx, 1024, 1024);
            pg8::EpiBf16 E{k == 0 ? PROJ : CQ, ldc, SS, k == 3 ? 0.0625f * LOG2E : 1.0f, ldc};
            pg8::gemm_phase<pg8::EpiBf16, pg8::StaticOrder, true>(F.lds, g, S, E);
            if (k == 3) {
                pg8::Unit u;
                for (int i = 0; S.next(i, u); ++i) xattn_unit(F, CQ, Kl, VTl, YC, u.pm, u.pn);
            }
        } break;
        case 1: {
            REFRESH();
            if (F.bx < 64) { if (EN(2)) gla_chain(F, args, l, F.bx >> 2, F.bx & 3, PROJ, YC); }
            else {
                if (l == 0) {
                    const int wv = (F.bx - 64) * NWAVES + F.wave, nwv = (F.G - 64) * NWAVES;
                    transpose_list(F, args, (LAS float*)(F.lds + F.wave * 16384), wv, nwv, 1);
                    convert_tables(F, args, 0, wv, nwv); convert_tables(F, args, 1, wv, nwv);
                    WG_SYNC();
                }
                if (EN(3)) { for (int u = F.bx - 64; u < 256; u += F.G - 64) sgu_unit(F, args, l, u >> 4, u & 15, PROJ, YC); }
            }
            if (EN(4)) { LAS char* vl = (LAS char*)F.lds + F.wave * 8192; unsigned* ctr = (unsigned*)(ws + WS_CTL) + 15360 + 64 * l;
                for (;;) { int u0 = 0; if (F.lane == 0) u0 = (int)atomicAdd(ctr, 2u); u0 = __builtin_amdgcn_readfirstlane(u0); if (u0 >= BATCH * 8 * 32) break;
                    for (int u = u0; u < u0 + 2; ++u) sb_unit2(PROJ, YC, u >> 8, (u >> 5) & 7, u & 31, vl, F.lane); } }
        } break;
        case 2: case 4: if (EN(5)) {
            REFRESH();
            pg8::Gemm g{YC, Wl + (k == 2 ? W_OUT : W_CO) / 2, 1024, 1024, 1024}; pg8::StaticOrder S; S.init(MTOK, 1024, F.G, F.bx, 1024, 1024);
            pg8::EpiResid E{XB, SS};
            pg8::gemm_phase<pg8::EpiResid, pg8::StaticOrder, true>(F.lds, g, S, E);
        } break;
        default: if (EN(12)) {
            REFRESH();
            const unsigned char* Ub = ws + WS_TAB + (size_t)l * 16 * MiB; const unsigned char* Vb = Ub + 8 * MiB;
            const bf16_t* SK = (const bf16_t*)(ws + WS_SUBK) + (size_t)l * 8 * 2 * 128 * 64;
            const unsigned* SCTg = (const unsigned*)(ws + WS_TAB + 32 * MiB + (size_t)l * 65536);
            float* cs = (float*)(ws + WS_PROJ + 96 * MiB);
            if (F.tid < 8) ((volatile LAS unsigned*)(F.lds + PJ_FLG))[F.tid] = 0u;
            LDS_SYNC();
#pragma unroll 1
            for (int st = 0; st < PJ_T0; ++st) {
                unsigned tA[2][16];
                route_level1(CQ, SK, F.bx + GRID * st, F.wave, F.lane, tA);
                route_level2(tA, (size_t)(F.bx + GRID * st) * 32 + (F.lane & 31), F.wave, F.lane, IDX, GW, nullptr, nullptr, (LAS char*)F.lds + PJ_SCR0 + F.wave * 3072);
                asm volatile("s_waitcnt vmcnt(0)" ::: "memory");
                if (F.lane == 0) __atomic_fetch_add((LAS unsigned*)(F.lds + PJ_FLG) + st, 1u, __ATOMIC_RELAXED);
            }
            if (F.wave < PJ_NR) {
#pragma unroll 1
                for (int st = PJ_T0; st < 4; ++st) {
#pragma unroll 1
                    for (int hq = 0; hq < 8 / (2 * PJ_NR); ++hq) route_heads(CQ, SK, IDX, GW, F.bx + GRID * st, (8 / PJ_NR) * F.wave + 2 * hq, F.lane, (LAS char*)F.lds + PJ_SCR + F.wave * 3072);
                    asm volatile("s_waitcnt vmcnt(0)" ::: "memory");
                    if (F.lane == 0) __atomic_fetch_add((LAS unsigned*)(F.lds + PJ_FLG) + st, 1u, __ATOMIC_RELAXED);
                }
            }
            peer_u_stream(F, Ub, SCTg, IDX, GW, XB, SS, F.wave, cs);
            WG_SYNC();
            peer_v_pass(F, args, l == DEPTH - 1, Vb, IDX, XB, SS, cs);
        } break;
        }
        }
        WG_SYNC();
#if MK_ONE_LAUNCH
        if (ph + 1 < hi) xcd_barrier(gbar);
#endif
    }
#undef REFRESH
}

extern "C" void kernel_launch(void* const* d_in, const int* in_sizes, int n_in, void* d_out, int out_size, void* d_ws, size_t ws_size, hipStream_t stream) {
    static int grid = 0;
    if (grid == 0) {
        if (n_in != 22 || out_size != MTOK * DM || ws_size < WS_END) { fprintf(stderr, "kernel_launch: unexpected problem (n_in %d out %d ws %zu)\n", n_in, out_size, ws_size); grid = -1; return; }
        int dev = 0, cus = 0, per_cu = 0;
        if (hipGetDevice(&dev) != hipSuccess || hipDeviceGetAttribute(&cus, hipDeviceAttributeMultiprocessorCount, dev) != hipSuccess) { grid = -1; return; }
        if (hipFuncSetAttribute((const void*)trunk_fwd, hipFuncAttributeMaxDynamicSharedMemorySize, LDS_BYTES) != hipSuccess) { fprintf(stderr, "kernel_launch: hipFuncSetAttribute failed\n"); grid = -1; return; }
        if (hipOccupancyMaxActiveBlocksPerMultiprocessor(&per_cu, (const void*)trunk_fwd, NTHR, LDS_BYTES) != hipSuccess || per_cu < 1) { fprintf(stderr, "kernel_launch: occupancy query says %d\n", per_cu); (void)hipGetLastError(); grid = -1; return; }
        if (cus * per_cu < GRID) { fprintf(stderr, "kernel_launch: built for a %d-workgroup resident grid, this device holds %d\n", GRID, cus * per_cu); grid = -1; return; }
        grid = GRID;
    }
    if (grid < 0) return;
    Args a{};
    for (int i = 0; i < 22; ++i) a.in[i] = (const float*)d_in[i];
    a.out = (float*)d_out; a.ws = (unsigned char*)d_ws;
#if MK_ONE_LAUNCH
    if (hipMemsetAsync((char*)d_ws + WS_CTL, 0, 65536, stream) != hipSuccess) { fprintf(stderr, "kernel_launch: memset of the control words failed\n"); return; }
    a.ph_lo = 0; a.ph_hi = NPHASE;
    void* kargs[] = {&a};
    hipError_t e = hipLaunchCooperativeKernel((const void*)trunk_fwd, dim3(grid), dim3(NTHR), kargs, LDS_BYTES, stream);
    if (e != hipSuccess) fprintf(stderr, "cooperative launch failed: %s (grid %d)\n", hipGetErrorString(e), grid);
#else
    for (int p = 0; p < NPHASE; ++p) { a.ph_lo = p; a.ph_hi = p + 1; hipLaunchKernelGGL(trunk_fwd, dim3(grid), dim3(NTHR), LDS_BYTES, stream, a); }
#endif
}
```

```cpp
#include <hip/hip_runtime.h>
#include <hip/hip_cooperative_groups.h>
#include <cstdio>
#include <cstdint>
#include <cmath>
namespace cg = cooperative_groups;

#ifndef PHMASK
#define PHMASK 0xFFFF
#endif
#define EN(n) (((PHMASK) >> (n)) & 1)
#ifndef PROBE_REP_K
#define PROBE_REP_K (-2)
#endif
#ifndef MK_ONE_LAUNCH
#define MK_ONE_LAUNCH 1
#endif

#define LAS __attribute__((address_space(3)))
typedef unsigned short bf16_t;
typedef short bf16x8 __attribute__((ext_vector_type(8)));
typedef short s16x4 __attribute__((ext_vector_type(4)));
typedef short v4i16_t __attribute__((ext_vector_type(4)));
typedef float f32x4 __attribute__((ext_vector_type(4)));
typedef float f32x2 __attribute__((ext_vector_type(2)));
typedef float f32x16 __attribute__((ext_vector_type(16)));
typedef unsigned u32x4 __attribute__((ext_vector_type(4)));
typedef unsigned u32x2 __attribute__((ext_vector_type(2)));
typedef __bf16 bf16x2_t __attribute__((ext_vector_type(2)));
#define DI __device__ __forceinline__
#define MFMA32(a, b, c) __builtin_amdgcn_mfma_f32_32x32x16_bf16((a), (b), (c), 0, 0, 0)

constexpr int BATCH = 16, SEQ = 2048, DM = 1024, MTOK = BATCH * SEQ, DEPTH = 2;
constexpr int NMEM = 256, MMEM = BATCH * NMEM;
constexpr int INW = 2832, LDP = 2944, NPROJ = 3072;
constexpr int C_SBQ = 0, C_SBK = 512, C_SBV = 1024, C_SGU = 1536, C_SGV = 1792, C_GQ = 2048, C_GK = 2176, C_GV = 2304, C_GO = 2560, C_GA = 2816;
constexpr float EPS = 1e-6f;
constexpr float LOG2E = 1.4426950408889634f;

constexpr size_t MiB = 1u << 20;
constexpr size_t WS_CTL = 0;
constexpr size_t WS_SUBK = 1 * MiB;
constexpr size_t WS_WSP = WS_SUBK + 512 * 1024;
constexpr size_t WS_RSTDM = WS_WSP + 256 * 1024;
constexpr size_t WS_SS = 2 * MiB;
constexpr size_t WS_W = 8 * MiB;
constexpr size_t W_IN = 0, W_OUT = 6 * MiB, W_CQ = 8 * MiB, W_CKV = 10 * MiB, W_CO = 14 * MiB, W_PQ = 16 * MiB, W_LAYER = 18 * MiB;
constexpr size_t WS_MEMB = 44 * MiB;
constexpr size_t WS_KMEM = 52 * MiB;
constexpr size_t WS_TAB = 84 * MiB;
constexpr size_t WS_XB = 148 * MiB;
constexpr size_t WS_YCAT = 212 * MiB;
constexpr size_t WS_PROJ = 276 * MiB;
constexpr size_t WS_GKV = 460 * MiB;
constexpr size_t WS_GD = 468 * MiB;
constexpr size_t WS_END = 469 * MiB;

DI unsigned cvtpk(float lo, float hi) { f32x2 v = {lo, hi}; bf16x2_t b = __builtin_convertvector(v, bf16x2_t); return __builtin_bit_cast(unsigned, b); }
DI bf16_t cvt1(float v) { return (bf16_t)(cvtpk(v, 0.f) & 0xffffu); }
DI float bf2f(unsigned short b) { return __uint_as_float((unsigned)b << 16); }
DI float bflo(unsigned w) { return __uint_as_float(w << 16); }
DI float bfhi(unsigned w) { return __uint_as_float(w & 0xffff0000u); }
DI int crow(int r, int hi) { return (r & 3) + 8 * (r >> 2) + 4 * hi; }
DI float fexp2(float x) { return __builtin_amdgcn_exp2f(x); }
DI float flog2(float x) { return __builtin_amdgcn_logf(x); }
DI float frcp(float x) { return __builtin_amdgcn_rcpf(x); }
DI float gelu_tanh(float x) { const float y2 = x * (1.5957691216057308f + 0.0713548162726009f * x * x); return x * frcp(1.f + fexp2(-y2 * LOG2E)); }
DI float silu(float x) { return x * frcp(1.f + fexp2(-x * LOG2E)); }
DI float wave_sum(float v) {
#pragma unroll
    for (int o = 1; o < 64; o <<= 1) v += __shfl_xor(v, o);
    return v;
}
DI s16x4 vtr(LAS const char* p) { return __builtin_bit_cast(s16x4, __builtin_amdgcn_ds_read_tr16_b64_v4i16((LAS v4i16_t*)p)); }
DI bf16x8 cat8(s16x4 lo, s16x4 hi) { return __builtin_shufflevector(lo, hi, 0, 1, 2, 3, 4, 5, 6, 7); }
DI bf16x8 pack8(float a0, float a1, float a2, float a3, float a4, float a5, float a6, float a7) {
    u32x4 p; p[0] = cvtpk(a0, a1); p[1] = cvtpk(a2, a3); p[2] = cvtpk(a4, a5); p[3] = cvtpk(a6, a7); return __builtin_bit_cast(bf16x8, p);
}
#define LDS_WAIT() asm volatile("s_waitcnt lgkmcnt(0)" ::: "memory")
#define LDS_SYNC() do { asm volatile("s_waitcnt lgkmcnt(0)" ::: "memory"); __builtin_amdgcn_s_barrier(); asm volatile("" ::: "memory"); } while (0)
#define WG_SYNC() do { asm volatile("s_waitcnt vmcnt(0) lgkmcnt(0)" ::: "memory"); __builtin_amdgcn_s_barrier(); asm volatile("" ::: "memory"); } while (0)

namespace pg8 {
constexpr int BM = 256, BK = 64, HALF = 128, HTB = HALF * BK * 2, STAGE_BYTES = 8 * HTB, NXCD = 8, WGM = 8;
__host__ __device__ __forceinline__ int lds_byte(int r, int c) { const int st = (r >> 4) * 2 + (c >> 5), rr = r & 15, cc = c & 31, ob = rr * 64 + cc * 2; return st * 1024 + (ob ^ (((ob >> 9) & 1) << 5)); }
__host__ __device__ __forceinline__ void stage_rc(int b, int& R, int& C) { const int st = b / 1024, sb = b % 1024, swz = sb ^ (((sb >> 9) & 1) << 5); R = (st >> 1) * 16 + swz / 64; C = (st & 1) * 32 + (swz % 64) / 2; }
__host__ __device__ __forceinline__ int perm32(int rho) { const int n = rho >> 4, i = rho & 15; return 8 * (i >> 2) + 4 * n + (i & 3); }

struct Unit { int pm, pn; size_t aoff, boff; };
struct Gemm { const bf16_t* A; const bf16_t* Bt; int lda, ldb, K; };

struct StaticOrder {
    int nM, nN, nwg, G, c, lda, ldb;
    __device__ void init(int M, int N, int G_, int c_, int lda_, int ldb_) { nM = M / BM; nN = N / BM; nwg = nM * nN; G = G_; c = c_; lda = lda_; ldb = ldb_; }
    __device__ bool next(int i, Unit& u) const {
        const long L = (long)i * G + c; if (L >= nwg) return false;
        int wgid = (int)L; { const int q = nwg / NXCD, r = nwg % NXCD, xcd = wgid % NXCD, off = wgid / NXCD; wgid = (xcd < r ? xcd * (q + 1) : r * (q + 1) + (xcd - r) * q) + off; }
        const int nig = WGM * nN, gid = wgid / nig, fm = gid * WGM, gsz = (nM - fm) < WGM ? (nM - fm) : WGM;
        u.pm = fm + ((wgid % nig) % gsz); u.pn = (wgid % nig) / gsz;
        u.aoff = (size_t)u.pm * BM * lda; u.boff = (size_t)u.pn * BM * ldb; return true;
    }
};
struct XOrder {
    int G, c, mode;
    __device__ bool next(int i, Unit& u) const {
        const int L = i * G + c; if (L >= 512) return false;
        u.pm = L >> 2; u.pn = L & 3; const int b = u.pm >> 3;
        u.aoff = (size_t)u.pm * 256 * 1024 + u.pn * 256;
        u.boff = mode == 0 ? (size_t)b * 256 * 1024 + u.pn * 256 : (size_t)(b * 4 + u.pn) * 256 * 256;
        return true;
    }
};

struct XOrder2 {
    StaticOrder S; int mode;
    __device__ bool next(int i, Unit& u) const {
        if (!S.next(i, u)) return false; const int b = u.pm >> 3;
        u.aoff = (size_t)u.pm * 256 * 1024 + u.pn * 256;
        u.boff = mode == 0 ? (size_t)b * 256 * 1024 + u.pn * 256 : (size_t)(b * 4 + u.pn) * 256 * 256;
        return true;
    }
};

DI float row_rstd_from_ss(const float* ss, int row, int fq) {
    const f32x4 v = *(const f32x4*)(ss + (size_t)row * 16 + 4 * fq);
    float s = (v[0] + v[1]) + (v[2] + v[3]); s += __shfl_xor(s, 16); s += __shfl_xor(s, 32);
    return 1.0f / sqrtf(s * (1.0f / 1024.0f) + EPS);
}
struct EpiBf16 {
    static constexpr bool PERM = true;
    bf16_t* O; int ldc; const float* ss; float cscale; int ncols;
    DI void operator()(f32x4 (&acc)[2][2][4][2], const Unit& u, int wr, int wc, int fr, int fq) const {
        const int row0 = u.pm * BM + wr * 64 + fr, col0 = u.pn * BM + wc * 32 + 8 * fq;
#pragma unroll
        for (int ai = 0; ai < 2; ++ai)
#pragma unroll
            for (int m = 0; m < 4; ++m) {
                const int row = row0 + ai * HALF + m * 16;
                float rs = cscale; if (ss) rs *= row_rstd_from_ss(ss, row, fq);
                bf16_t* rowp = O + (size_t)row * ldc + col0;
#pragma unroll
                for (int bj = 0; bj < 2; ++bj) if (col0 + bj * HALF < ncols) {
                    const f32x4 v0 = acc[ai][bj][m][0] * rs, v1 = acc[ai][bj][m][1] * rs;
                    u32x4 w; w.x = cvtpk(v0[0], v0[1]); w.y = cvtpk(v0[2], v0[3]); w.z = cvtpk(v1[0], v1[1]); w.w = cvtpk(v1[2], v1[3]);
                    *(u32x4*)(rowp + bj * HALF) = w; }
            }
    }
};
struct EpiKV {
    static constexpr bool PERM = true;
    bf16_t* Kd; bf16_t* VT; const float* rvec;
    DI void operator()(f32x4 (&acc)[2][2][4][2], const Unit& u, int wr, int wc, int fr, int fq) const {
        const int row0 = u.pm * BM + wr * 64 + fr;
#pragma unroll
        for (int ai = 0; ai < 2; ++ai)
#pragma unroll
            for (int m = 0; m < 4; ++m) {
                const int row = row0 + ai * HALF + m * 16; const float rs = rvec[row];
#pragma unroll
                for (int bj = 0; bj < 2; ++bj) {
                    const f32x4 v0 = acc[ai][bj][m][0] * rs, v1 = acc[ai][bj][m][1] * rs;
                    const unsigned w0 = cvtpk(v0[0], v0[1]), w1 = cvtpk(v0[2], v0[3]), w2 = cvtpk(v1[0], v1[1]), w3 = cvtpk(v1[2], v1[3]);
                    if (u.pn < 4) {
                        u32x4 w; w.x = w0; w.y = w1; w.z = w2; w.w = w3;
                        *(u32x4*)(Kd + (size_t)row * 1024 + u.pn * BM + bj * HALF + wc * 32 + 8 * fq) = w;
                    } else {
                        const int key = row & 255, dv0 = bj * HALF + wc * 32 + 8 * fq;
                        bf16_t* p = VT + ((size_t)(u.pm * 4 + (u.pn - 4)) * 256 + dv0) * 256 + key;
                        p[0 * 256] = (bf16_t)w0; p[1 * 256] = (bf16_t)(w0 >> 16); p[2 * 256] = (bf16_t)w1; p[3 * 256] = (bf16_t)(w1 >> 16);
                        p[4 * 256] = (bf16_t)w2; p[5 * 256] = (bf16_t)(w2 >> 16); p[6 * 256] = (bf16_t)w3; p[7 * 256] = (bf16_t)(w3 >> 16);
                    }
                }
            }
    }
};
struct EpiResid {
    static constexpr bool PERM = true;
    bf16_t* XB; float* ss;
    DI void operator()(f32x4 (&acc)[2][2][4][2], const Unit& u, int wr, int wc, int fr, int fq) const {
        const int row0 = u.pm * BM + wr * 64 + fr, col0 = u.pn * BM + wc * 32 + 8 * fq;
#pragma unroll
        for (int ai = 0; ai < 2; ++ai)
#pragma unroll
            for (int m = 0; m < 4; ++m) {
                const int row = row0 + ai * HALF + m * 16; float s = 0.f;
#pragma unroll
                for (int bj = 0; bj < 2; ++bj) {
                    const size_t off = (size_t)row * 1024 + col0 + bj * HALF;
                    const u32x4 o = *(const u32x4*)(XB + off); const f32x4 a0 = acc[ai][bj][m][0], a1 = acc[ai][bj][m][1];
                    u32x4 w; w.x = cvtpk(bflo(o.x) + a0[0], bfhi(o.x) + a0[1]); w.y = cvtpk(bflo(o.y) + a0[2], bfhi(o.y) + a0[3]);
                    w.z = cvtpk(bflo(o.z) + a1[0], bfhi(o.z) + a1[1]); w.w = cvtpk(bflo(o.w) + a1[2], bfhi(o.w) + a1[3]);
                    *(u32x4*)(XB + off) = w;
#pragma unroll
                    for (int q = 0; q < 4; ++q) { const float x0 = bflo(w[q]), x1 = bfhi(w[q]); s += x0 * x0 + x1 * x1; }
                }
                s += __shfl_xor(s, 16); s += __shfl_xor(s, 32);
                if (fq == 0) ss[(size_t)row * 16 + u.pn * 4 + wc] = s;
            }
    }
};
struct EpiSoftmax {
    static constexpr bool PERM = true;
    bf16_t* P; LAS float* xm; LAS float* xs;
    DI void operator()(f32x4 (&acc)[2][2][4][2], const Unit& u, int wr, int wc, int fr, int fq) const {
#pragma unroll
        for (int ai = 0; ai < 2; ++ai)
#pragma unroll
            for (int m = 0; m < 4; ++m) {
                float v = -INFINITY;
#pragma unroll
                for (int bj = 0; bj < 2; ++bj)
#pragma unroll
                    for (int n = 0; n < 2; ++n) { const f32x4 x = acc[ai][bj][m][n]; v = fmaxf(v, fmaxf(fmaxf(x[0], x[1]), fmaxf(x[2], x[3]))); }
                v = fmaxf(v, __shfl_xor(v, 16)); v = fmaxf(v, __shfl_xor(v, 32));
                if (fq == 0) xm[(ai * HALF + wr * 64 + m * 16 + fr) * 4 + wc] = v;
            }
        LDS_WAIT(); __builtin_amdgcn_s_barrier(); asm volatile("" ::: "memory");
#pragma unroll
        for (int ai = 0; ai < 2; ++ai)
#pragma unroll
            for (int m = 0; m < 4; ++m) {
                const f32x4 q = *(LAS const f32x4*)(xm + (ai * HALF + wr * 64 + m * 16 + fr) * 4);
                const float g = fmaxf(fmaxf(q[0], q[1]), fmaxf(q[2], q[3])); float s = 0.f;
#pragma unroll
                for (int bj = 0; bj < 2; ++bj)
#pragma unroll
                    for (int n = 0; n < 2; ++n) { f32x4 x = acc[ai][bj][m][n]; x[0] = fexp2(x[0] - g); x[1] = fexp2(x[1] - g); x[2] = fexp2(x[2] - g); x[3] = fexp2(x[3] - g); acc[ai][bj][m][n] = x; s += (x[0] + x[1]) + (x[2] + x[3]); }
                s += __shfl_xor(s, 16); s += __shfl_xor(s, 32);
                if (fq == 0) xs[(ai * HALF + wr * 64 + m * 16 + fr) * 4 + wc] = s;
            }
        LDS_WAIT(); __builtin_amdgcn_s_barrier(); asm volatile("" ::: "memory");
        const int row0 = u.pm * BM + wr * 64 + fr, col0 = u.pn * BM + wc * 32 + 8 * fq;
#pragma unroll
        for (int ai = 0; ai < 2; ++ai)
#pragma unroll
            for (int m = 0; m < 4; ++m) {
                const f32x4 q = *(LAS const f32x4*)(xs + (ai * HALF + wr * 64 + m * 16 + fr) * 4);
                const float inv = 1.0f / ((q[0] + q[1]) + (q[2] + q[3]));
                bf16_t* rowp = P + (size_t)(row0 + ai * HALF + m * 16) * 1024 + col0;
#pragma unroll
                for (int bj = 0; bj < 2; ++bj) {
                    const f32x4 v0 = acc[ai][bj][m][0] * inv, v1 = acc[ai][bj][m][1] * inv;
                    u32x4 w; w.x = cvtpk(v0[0], v0[1]); w.y = cvtpk(v0[2], v0[3]); w.z = cvtpk(v1[0], v1[1]); w.w = cvtpk(v1[2], v1[3]);
                    *(u32x4*)(rowp + bj * HALF) = w; }
            }
    }
};

template <class Epi, class Sched, bool ALIGN_EPI>
__device__ __forceinline__ void gemm_phase(LAS unsigned char* lds, const Gemm g, const Sched& S, const Epi& E) {
    int tid = threadIdx.x; asm volatile("" : "+v"(tid));
    const int wid = __builtin_amdgcn_readfirstlane(tid >> 6), lane = tid & 63, wr = wid >> 2, wc = wid & 3, fr = lane & 15, fq = lane >> 4;
    const int K = g.K, nt = K / BK;
    unsigned voffA[2], voffB[2];
#pragma unroll
    for (int i = 0; i < 2; ++i) { int R, C; stage_rc(tid * 16 + i * 8192, R, C); const int Rb = Epi::PERM ? ((R & ~31) + perm32(R & 31)) : R;
        voffA[i] = (unsigned)(R * g.lda + C) * 2u; voffB[i] = (unsigned)(Rb * g.ldb + C) * 2u; }
    const size_t kstep = (size_t)(BK * 2);
    const size_t hstepA = (size_t)HALF * g.lda * 2, hstepB = (size_t)HALF * g.ldb * 2;
    const unsigned ldsw = (unsigned)wid * 1024u;
    const int aoff = lds_byte(wr * 64 + fr, fq * 8), boff = lds_byte(wc * 32 + fr, fq * 8);
#define PG8_SA(b, h) (((b) * 2 + (h)) * HTB)
#define PG8_SB(b, h) ((4 + (b) * 2 + (h)) * HTB)
#define PG8_STAGE(bufoff, gbase, voff) do { _Pragma("unroll") for (int _i = 0; _i < 2; ++_i) \
        __builtin_amdgcn_global_load_lds((const unsigned*)((const char*)(gbase) + (voff)[_i]), (LAS unsigned*)(lds + (bufoff) + ldsw + _i * 8192), 16, 0, 0); } while (0)
#define PG8_LDA(dst, b, h) do { _Pragma("unroll") for (int m = 0; m < 4; ++m) _Pragma("unroll") for (int k = 0; k < 2; ++k) dst[m][k] = *(const LAS bf16x8*)(lds + PG8_SA(b, h) + aoff + m * 2048 + k * 1024); } while (0)
#define PG8_LDB(dst, b, h) do { _Pragma("unroll") for (int n = 0; n < 2; ++n) _Pragma("unroll") for (int k = 0; k < 2; ++k) dst[n][k] = *(const LAS bf16x8*)(lds + PG8_SB(b, h) + boff + n * 2048 + k * 1024); } while (0)
#define PG8_MMA(ai, bj, At, Bt) do { __builtin_amdgcn_s_setprio(1); _Pragma("unroll") for (int m = 0; m < 4; ++m) _Pragma("unroll") for (int n = 0; n < 2; ++n) _Pragma("unroll") for (int k = 0; k < 2; ++k) \
        acc[ai][bj][m][n] = __builtin_amdgcn_mfma_f32_16x16x32_bf16(Bt[n][k], At[m][k], acc[ai][bj][m][n], 0, 0, 0); __builtin_amdgcn_s_setprio(0); } while (0)
#define PG8_WAIT_V(n) asm volatile("s_waitcnt vmcnt(" #n ")" ::: "memory")
#define PG8_WAIT_L(n) asm volatile("s_waitcnt lgkmcnt(" #n ")" ::: "memory")
#define PG8_BAR __builtin_amdgcn_s_barrier()
#define PG8_SCHED __builtin_amdgcn_sched_barrier(0)
    Unit cur, nxt; int ui = 0;
    if (!S.next(0, cur)) return;
    f32x4 acc[2][2][4][2];
#pragma unroll
    for (int a = 0; a < 2; ++a)
#pragma unroll
        for (int b = 0; b < 2; ++b)
#pragma unroll
            for (int m = 0; m < 4; ++m)
#pragma unroll
                for (int n = 0; n < 2; ++n) acc[a][b][m][n] = (f32x4){0.f, 0.f, 0.f, 0.f};
    bf16x8 At[4][2], B0[2][2], B1[2][2];
    const char* cA = (const char*)g.A + cur.aoff * 2; const char* cB = (const char*)g.Bt + cur.boff * 2;
    PG8_STAGE(PG8_SB(0, 0), cB, voffB); PG8_STAGE(PG8_SB(0, 1), cB + hstepB, voffB); PG8_STAGE(PG8_SA(0, 0), cA, voffA); PG8_STAGE(PG8_SA(0, 1), cA + hstepA, voffA);
    if (wr == 1) PG8_BAR;
    PG8_WAIT_V(2); PG8_BAR;
    PG8_STAGE(PG8_SB(1, 0), cB + kstep, voffB); PG8_STAGE(PG8_SA(1, 0), cA + kstep, voffA); PG8_STAGE(PG8_SB(1, 1), cB + hstepB + kstep, voffB);
    PG8_WAIT_V(6); PG8_BAR;
    for (;;) {
        const bool has_next = S.next(ui + 1, nxt);
        const char* nA = has_next ? (const char*)g.A + nxt.aoff * 2 : cA; const char* nB = has_next ? (const char*)g.Bt + nxt.boff * 2 : cB;
#pragma unroll 1
        for (int t = 0; t < nt; t += 2) {
            const bool last = (t == nt - 2);
            const char* a1 = cA + (size_t)(t + 1) * kstep;
            const char* a2 = last ? nA : cA + (size_t)(t + 2) * kstep; const char* b2 = last ? nB : cB + (size_t)(t + 2) * kstep;
            const char* a3 = a2 + kstep; const char* b3 = b2 + kstep;
            PG8_LDB(B0, 0, 0); PG8_LDB(B1, 0, 1); PG8_SCHED; PG8_LDA(At, 0, 0); PG8_STAGE(PG8_SA(1, 1), a1 + hstepA, voffA);
            PG8_WAIT_V(8); PG8_WAIT_L(0); PG8_BAR; PG8_MMA(0, 0, At, B0); PG8_MMA(0, 1, At, B1); PG8_BAR; PG8_SCHED;
            PG8_LDA(At, 0, 1); PG8_STAGE(PG8_SB(0, 0), b2, voffB); PG8_STAGE(PG8_SB(0, 1), b2 + hstepB, voffB); PG8_STAGE(PG8_SA(0, 0), a2, voffA);
            PG8_WAIT_V(8); PG8_WAIT_L(0); PG8_BAR; PG8_MMA(1, 0, At, B0); PG8_MMA(1, 1, At, B1); PG8_BAR; PG8_SCHED;
            PG8_LDB(B0, 1, 0); PG8_LDB(B1, 1, 1); PG8_SCHED; PG8_LDA(At, 1, 0); PG8_STAGE(PG8_SA(0, 1), a2 + hstepA, voffA);
            PG8_WAIT_V(8); PG8_WAIT_L(0); PG8_BAR; PG8_MMA(0, 0, At, B0); PG8_MMA(0, 1, At, B1); PG8_BAR; PG8_SCHED;
            PG8_LDA(At, 1, 1); PG8_STAGE(PG8_SB(1, 0), b3, voffB); PG8_STAGE(PG8_SB(1, 1), b3 + hstepB, voffB); PG8_STAGE(PG8_SA(1, 0), a3, voffA);
            PG8_WAIT_V(8); PG8_WAIT_L(0); PG8_BAR; PG8_MMA(1, 0, At, B0); PG8_MMA(1, 1, At, B1); PG8_BAR; PG8_SCHED;
        }
        if constexpr (ALIGN_EPI) { if (wr == 0) PG8_BAR; }
        E(acc, cur, wr, wc, fr, fq);
        if (!has_next) break;
#pragma unroll
        for (int a = 0; a < 2; ++a)
#pragma unroll
            for (int b = 0; b < 2; ++b)
#pragma unroll
                for (int m = 0; m < 4; ++m)
#pragma unroll
                    for (int n = 0; n < 2; ++n) acc[a][b][m][n] = (f32x4){0.f, 0.f, 0.f, 0.f};
        cur = nxt; cA = nA; cB = nB; ++ui;
        if constexpr (ALIGN_EPI) { if (wr == 1) PG8_BAR; }
    }
    PG8_WAIT_V(0);
    if constexpr (!ALIGN_EPI) { if (wr == 0) PG8_BAR; }
    PG8_BAR;
#undef PG8_SA
#undef PG8_SB
#undef PG8_STAGE
#undef PG8_LDA
#undef PG8_LDB
#undef PG8_MMA
#undef PG8_WAIT_V
#undef PG8_WAIT_L
#undef PG8_BAR
#undef PG8_SCHED
}
}

constexpr int NWAVES = 8, NTHR = 512, GRID = 256;
constexpr int RING_BYTES = 131072, XCH_OFF = RING_BYTES, LDS_BYTES = 147456;
struct Args { const float* in[22]; float* out; unsigned char* ws; int ph_lo, ph_hi; };
enum { I_X = 0, I_MEM, I_NORM_MIX, I_W_IN, I_SG_VG, I_SG_W, I_SG_B, I_GLA_WG, I_GLA_BG, I_GLA_OG, I_W_OUT, I_NORM_MEM, I_MEM_GAIN, I_W_CQ, I_W_CKV, I_W_CO, I_NORM_FFN, I_PEER_WQ, I_PEER_SK, I_PEER_U, I_PEER_V, I_FINAL_G };

struct Frame {
    LAS unsigned char* lds; int tid, lane, wave, bx, gw; static constexpr int G = GRID, NGW = GRID * NWAVES;
    float* X; unsigned char* ws;
};
#define INP(i) (args.in[(i)])

#define XB_TMO      128
#define XB_XCNT(j)  (256  + 64 * (j))
#define XB_XSUB(j)  (1280 + 64 * (j))
#define XB_XGEN(j)  (2304 + 64 * (j))
#define XB_TOP      3328
#define XB_TOPGEN   3392
#define XCD_BAR_WORDS 3456
#define XB_SPIN_CAP (1u << 22)
DI unsigned xb_ld(unsigned* p)              { return __hip_atomic_load(p, __ATOMIC_RELAXED, __HIP_MEMORY_SCOPE_AGENT); }
DI unsigned xb_add(unsigned* p, unsigned v) { return __hip_atomic_fetch_add(p, v, __ATOMIC_RELAXED, __HIP_MEMORY_SCOPE_AGENT); }
DI unsigned xb_xcc_id() { return (unsigned)__builtin_amdgcn_s_getreg((3 << 11) | 20) & 0xFu; }
#define XB_SPIN(cond, bar) do { unsigned _sp = 0; while (cond) { __builtin_amdgcn_s_sleep(1); \
    if ((++_sp & 255u) == 0u) { if (xb_ld(&(bar)[XB_TMO])) break; if (_sp > XB_SPIN_CAP) { atomicAdd(&(bar)[XB_TMO], 1u); break; } } } } while (0)
struct XcdBarrier { unsigned* bar; unsigned x; volatile LAS unsigned* st; };
DI XcdBarrier xcd_barrier_post(unsigned* bar, volatile LAS unsigned* st) {
    XcdBarrier b; b.bar = bar; b.x = xb_xcc_id(); b.st = st;
    if (threadIdx.x == 0) (void)xb_add(&bar[XB_XCNT(b.x)], 1u);
    return b;
}
DI void xcd_barrier_complete(unsigned* bar, unsigned x, unsigned& nloc, unsigned& nx) {
    const unsigned G = gridDim.x * gridDim.y * gridDim.z;
    unsigned sum, cnt, mine, sp = 0u;
    for (;;) {
        sum = 0u; cnt = 0u; mine = 0u;
#pragma unroll
        for (unsigned j = 0; j < 16; ++j) { const unsigned c = xb_ld(&bar[XB_XCNT(j)]); sum += c; cnt += (c > 0u) ? 1u : 0u; mine = (j == x) ? c : mine; }
        if (sum == G) break;
        __builtin_amdgcn_s_sleep(1);
        if ((++sp & 255u) == 0u) { if (xb_ld(&bar[XB_TMO])) break; if (sp > XB_SPIN_CAP) { atomicAdd(&bar[XB_TMO], 1u); break; } }
    }
    nloc = mine > 0u ? mine : 1u; nx = cnt > 0u ? cnt : 1u;
}
DI void xcd_barrier(const XcdBarrier& b) {
    asm volatile("s_waitcnt vmcnt(0)" ::: "memory");
    __syncthreads();
    if (threadIdx.x == 0) {
        unsigned* bar = b.bar;
        __builtin_amdgcn_s_waitcnt(0);
        unsigned nloc = b.st[0], nx = b.st[1];
        if (nloc == 0u) { xcd_barrier_complete(bar, b.x, nloc, nx); b.st[0] = nloc; b.st[1] = nx; }
        const unsigned old = xb_add(&bar[XB_XSUB(b.x)], 1u);
        const unsigned gen = old / nloc;
        if (old + 1u == (gen + 1u) * nloc) {
            __builtin_amdgcn_fence(__ATOMIC_RELEASE, "agent");
            asm volatile("s_waitcnt vmcnt(0)" ::: "memory");
            const unsigned og = xb_add(&bar[XB_TOP], 1u);
            const unsigned tg = og / nx;
            if (og + 1u == (tg + 1u) * nx) xb_add(&bar[XB_TOPGEN], 1u);
            else XB_SPIN(xb_ld(&bar[XB_TOPGEN]) == tg, bar);
            __builtin_amdgcn_fence(__ATOMIC_ACQUIRE, "agent");
            xb_add(&bar[XB_XGEN(b.x)], 1u);
            asm volatile("s_waitcnt vmcnt(0)" ::: "memory");
        } else {
            XB_SPIN(xb_ld(&bar[XB_XGEN(b.x)]) == gen, bar);
            __builtin_amdgcn_fence(__ATOMIC_ACQUIRE, "agent");
            asm volatile("s_waitcnt vmcnt(0)" ::: "memory");
        }
    }
    __syncthreads();
}

DI void p0_transpose_item(const float* W, int ldw, int N, int K, const float* gain, bf16_t* WT, LAS float* scr, int item, int lane) {
    const int nblk = N / 32, kb = item / nblk, nb = item % nblk, k0 = 64 * kb, n0 = 32 * nb;
#pragma unroll 8
    for (int i = 0; i < 32; ++i) { const int kk = 2 * i + (lane >> 5); float w = W[(size_t)(k0 + kk) * ldw + n0 + (lane & 31)]; if (gain) w *= gain[k0 + kk]; scr[kk * 33 + (lane & 31)] = w; }
    LDS_WAIT(); asm volatile("" ::: "memory");
    const int c = lane & 7;
#pragma unroll
    for (int j = 0; j < 4; ++j) { const int n = (lane >> 3) + 8 * j; const LAS float* s = scr + (8 * c) * 33 + n;
        u32x4 o; o.x = cvtpk(s[0 * 33], s[1 * 33]); o.y = cvtpk(s[2 * 33], s[3 * 33]); o.z = cvtpk(s[4 * 33], s[5 * 33]); o.w = cvtpk(s[6 * 33], s[7 * 33]);
        *(u32x4*)(WT + (size_t)(n0 + n) * K + k0 + 8 * c) = o; }
    LDS_WAIT(); asm volatile("" ::: "memory");
}
DI unsigned fp4x8(const f32x4 a, const f32x4 b, float inv) {
    unsigned w = 0;
    w = __builtin_amdgcn_cvt_scalef32_pk_fp4_f32(w, a[0] * inv, a[1] * inv, 1.0f, 0); w = __builtin_amdgcn_cvt_scalef32_pk_fp4_f32(w, a[2] * inv, a[3] * inv, 1.0f, 1);
    w = __builtin_amdgcn_cvt_scalef32_pk_fp4_f32(w, b[0] * inv, b[1] * inv, 1.0f, 2); w = __builtin_amdgcn_cvt_scalef32_pk_fp4_f32(w, b[2] * inv, b[3] * inv, 1.0f, 3);
    return w;
}
DI float wave_max(float v) {
#pragma unroll
    for (int o = 1; o < 64; o <<= 1) v = fmaxf(v, __shfl_xor(v, o));
    return v;
}
DI void convert_tables(const Frame& F, const Args& args, int l, int wv, int nwv) {
    const float* gn = INP(I_NORM_FFN) + l * 1024 + 16 * F.lane;
    f32x4 g[4];
#pragma unroll
    for (int q = 0; q < 4; ++q) g[q] = *(const f32x4*)(gn + 4 * q);
    for (int r0 = wv; r0 < 2 * 16384; r0 += 4 * nwv) {
        f32x4 v[4][4];
#pragma unroll
        for (int j = 0; j < 4; ++j) { const int r = min(r0 + j * nwv, 2 * 16384 - 1), isv = r >= 16384, e = r & 16383;
            const float* src = (isv ? INP(I_PEER_V) : INP(I_PEER_U)) + ((size_t)l * 16384 + e) * 1024 + 16 * F.lane;
#pragma unroll
            for (int q = 0; q < 4; ++q) v[j][q] = *(const f32x4*)(src + 4 * q); }
#pragma unroll
        for (int j = 0; j < 4; ++j) { const int r = r0 + j * nwv, isv = r >= 16384, e = r & 16383; float am = 0.f;
            if (r < 2 * 16384) {
#pragma unroll
            for (int q = 0; q < 4; ++q) { if (!isv) v[j][q] = v[j][q] * g[q];
                am = fmaxf(am, fmaxf(fmaxf(fabsf(v[j][q][0]), fabsf(v[j][q][1])), fmaxf(fabsf(v[j][q][2]), fabsf(v[j][q][3])))); }
            am = wave_max(am);
            const float sc = bf2f(cvt1(am > 0.f ? am * (1.0f / 6.0f) : 1.0f)), inv = 1.0f / sc;
            u32x2 w; w.x = fp4x8(v[j][0], v[j][1], inv); w.y = fp4x8(v[j][2], v[j][3], inv);
            *(u32x2*)(F.ws + WS_TAB + (size_t)l * 16 * MiB + (size_t)isv * 8 * MiB + (size_t)e * 512 + 8 * F.lane) = w;
            if (F.lane == 0) ((bf16_t*)(F.ws + WS_TAB + 32 * MiB))[((size_t)l * 16384 + e) * 2 + isv] = cvt1(sc); } }
    }
}
struct TDesc { const float* W; const float* gain; bf16_t* WT; int ldw, nblk; };
DI TDesc tdesc(const Frame& F, const Args& args, int l, int t) {
    TDesc D; D.gain = nullptr; D.ldw = 1024; D.nblk = 32; size_t woff;
    switch (t) {
    case 0: D.W = INP(I_W_IN) + (size_t)l * 1024 * INW; D.ldw = INW; D.nblk = 88; D.gain = INP(I_NORM_MIX) + l * 1024; woff = W_IN; break;
    case 1: D.W = INP(I_W_OUT) + (size_t)l * 1024 * 1024; woff = W_OUT; break;
    case 2: D.W = INP(I_W_CQ) + (size_t)l * 1024 * 1024; D.gain = INP(I_NORM_MEM) + l * 1024; woff = W_CQ; break;
    case 3: D.W = INP(I_W_CKV) + (size_t)l * 1024 * 2048; D.ldw = 2048; D.nblk = 64; D.gain = INP(I_MEM_GAIN) + l * 1024; woff = W_CKV; break;
    case 4: D.W = INP(I_W_CO) + (size_t)l * 1024 * 1024; woff = W_CO; break;
    default: D.W = INP(I_PEER_WQ) + (size_t)l * 1024 * 1024; D.gain = INP(I_NORM_FFN) + l * 1024; woff = W_PQ; break;
    }
    D.WT = (bf16_t*)(F.ws + WS_W + l * W_LAYER + woff); return D;
}
DI void titem_load(const TDesc& D, int item, int lane, float (&v)[32]) {
    const int kb = item / D.nblk, nb = item % D.nblk, k0 = 64 * kb, n0 = 32 * nb;
#pragma unroll
    for (int i = 0; i < 32; ++i) { const int kk = 2 * i + (lane >> 5); float w = D.W[(size_t)(k0 + kk) * D.ldw + n0 + (lane & 31)]; if (D.gain) w *= D.gain[k0 + kk]; v[i] = w; }
}
DI void titem_store(const TDesc& D, int item, int lane, LAS float* scr, const float (&v)[32]) {
    const int kb = item / D.nblk, nb = item % D.nblk, k0 = 64 * kb, n0 = 32 * nb;
#pragma unroll
    for (int i = 0; i < 32; ++i) scr[(2 * i + (lane >> 5)) * 33 + (lane & 31)] = v[i];
    LDS_WAIT(); asm volatile("" ::: "memory");
    const int c = lane & 7;
#pragma unroll
    for (int j = 0; j < 4; ++j) { const int n = (lane >> 3) + 8 * j; const LAS float* s = scr + (8 * c) * 33 + n;
        u32x4 o; o.x = cvtpk(s[0 * 33], s[1 * 33]); o.y = cvtpk(s[2 * 33], s[3 * 33]); o.z = cvtpk(s[4 * 33], s[5 * 33]); o.w = cvtpk(s[6 * 33], s[7 * 33]);
        *(u32x4*)(D.WT + (size_t)(n0 + n) * 1024 + k0 + 8 * c) = o; }
    LDS_WAIT(); asm volatile("" ::: "memory");
}
DI int tl_index(int part, int e) {
    if (part == 0) return e < 1408 ? e : e < 2432 ? 2432 + (e - 1408) : 4480 + 2432 + (e - 2432);
    return e < 1024 ? 1408 + e : e < 2048 ? 3456 + (e - 1024) : e < 4480 ? 4480 + (e - 2048) : 4480 + 3456 + (e - 4480);
}
DI void transpose_list(const Frame& F, const Args& args, LAS float* scr, int wv, int nwv, int part) {
    constexpr int NIT_L = 16 * 88 + 4 * 16 * 32 + 16 * 64;
    const int NIT = part == 0 ? 3456 : 5504;
    float va[32], vb[32]; TDesc Da{}, Db{}; int la = 0, lb = 0;
#define TI_DECODE(e_, D_, loc_) do { const int it_ = tl_index(part, (e_)); const int l_ = it_ / NIT_L; int r_ = it_ % NIT_L; int t_; \
        if (r_ < 1408) t_ = 0; else if (r_ < 1920) { t_ = 1; r_ -= 1408; } else if (r_ < 2432) { t_ = 2; r_ -= 1920; } else if (r_ < 3456) { t_ = 3; r_ -= 2432; } else if (r_ < 3968) { t_ = 4; r_ -= 3456; } else { t_ = 5; r_ -= 3968; } \
        D_ = tdesc(F, args, l_, t_); loc_ = r_; } while (0)
    int it = wv;
    if (it < NIT) { TI_DECODE(it, Da, la); titem_load(Da, la, F.lane, va); }
    for (;;) {
        int itn = it + nwv;
        if (itn < NIT) { TI_DECODE(itn, Db, lb); titem_load(Db, lb, F.lane, vb); }
        if (it < NIT) titem_store(Da, la, F.lane, scr, va);
        it = itn; if (it >= NIT) break;
        itn = it + nwv;
        if (itn < NIT) { TI_DECODE(itn, Da, la); titem_load(Da, la, F.lane, va); }
        titem_store(Db, lb, F.lane, scr, vb);
        it = itn; if (it >= NIT) break;
    }
#undef TI_DECODE
}
DI void p0_prologue(const Frame& F, const Args& args) {
    LAS float* scr = (LAS float*)(F.lds + F.wave * 16384);
    transpose_list(F, args, scr, F.gw, F.NGW, 0);
    const int gt = F.bx * NTHR + F.tid, nthr = F.G * NTHR;
    for (int i = gt; i < DEPTH * 256 * 1024; i += nthr) {
        const int l = i / (256 * 1024), r = i % (256 * 1024), j = r >> 10, k = r & 1023;
        bf16_t* Wi = (bf16_t*)(F.ws + WS_W + l * W_LAYER) + W_IN / 2;
        float v = 0.f;
        if (j < 128) {
            const float* wi = INP(I_W_IN) + (size_t)l * 1024 * INW + (size_t)k * INW + 2816; const float* wg = INP(I_GLA_WG) + l * 16 * 128 + j;
#pragma unroll
            for (int q4 = 0; q4 < 4; ++q4) { const f32x4 w4 = *(const f32x4*)(wi + 4 * q4);
#pragma unroll
                for (int e = 0; e < 4; ++e) v += w4[e] * wg[(4 * q4 + e) * 128]; }
            v *= INP(I_NORM_MIX)[l * 1024 + k];
        }
        Wi[(size_t)(2816 + j) * 1024 + k] = cvt1(v);
    }
    { bf16_t* WSP = (bf16_t*)(F.ws + WS_WSP); const float* sw = INP(I_SG_W);
      for (int i = gt; i < DEPTH * 4 * 128 * 128; i += nthr) { const int s = i & 127, t = (i >> 7) & 127; WSP[i] = cvt1(s <= t ? sw[i] : 0.f); }
      bf16_t* SK = (bf16_t*)(F.ws + WS_SUBK); const float* sk = INP(I_PEER_SK);
      for (int i = gt; i < DEPTH * 8 * 2 * 128 * 64; i += nthr) SK[i] = cvt1(sk[i]); }
    { float* SS = (float*)(F.ws + WS_SS); bf16_t* XB = (bf16_t*)(F.ws + WS_XB); const float* x = INP(I_X);
      for (int m0 = F.gw; m0 < MTOK; m0 += 4 * F.NGW) {
          f32x4 v[4][4];
#pragma unroll
          for (int i = 0; i < 4; ++i) { const f32x4* xr = (const f32x4*)(x + (size_t)(m0 + i * F.NGW) * 1024) + F.lane;
#pragma unroll
              for (int j = 0; j < 4; ++j) v[i][j] = xr[64 * j]; }
#pragma unroll
          for (int i = 0; i < 4; ++i) { const int m = m0 + i * F.NGW; float s = 0.f; u32x2 w[4];
#pragma unroll
              for (int j = 0; j < 4; ++j) { w[j].x = cvtpk(v[i][j][0], v[i][j][1]); w[j].y = cvtpk(v[i][j][2], v[i][j][3]);
                  s += (bflo(w[j].x) * bflo(w[j].x) + bfhi(w[j].x) * bfhi(w[j].x)) + (bflo(w[j].y) * bflo(w[j].y) + bfhi(w[j].y) * bfhi(w[j].y)); }
              s = wave_sum(s);
              u32x2* xb = (u32x2*)(XB + (size_t)m * 1024) + F.lane;
#pragma unroll
              for (int j = 0; j < 4; ++j) xb[64 * j] = w[j];
              if (F.lane < 16) SS[(size_t)m * 16 + F.lane] = F.lane == 0 ? s : 0.f; }
      }
      bf16_t* MB = (bf16_t*)(F.ws + WS_MEMB); float* RM = (float*)(F.ws + WS_RSTDM); const float* mem = INP(I_MEM);
      for (int m = F.gw; m < MMEM; m += F.NGW) {
          const f32x4* xr = (const f32x4*)(mem + (size_t)m * 1024) + F.lane; f32x4 v[4]; float s = 0.f;
#pragma unroll
          for (int j = 0; j < 4; ++j) { v[j] = xr[64 * j]; s += (v[j][0] * v[j][0] + v[j][1] * v[j][1]) + (v[j][2] * v[j][2] + v[j][3] * v[j][3]); }
          s = wave_sum(s);
          u32x2* xb = (u32x2*)(MB + (size_t)m * 1024) + F.lane;
#pragma unroll
          for (int j = 0; j < 4; ++j) { u32x2 w; w.x = cvtpk(v[j][0], v[j][1]); w.y = cvtpk(v[j][2], v[j][3]); xb[64 * j] = w; }
          if (F.lane == 0) RM[m] = 1.0f / sqrtf(s * (1.0f / 1024.0f) + EPS);
      } }
}

constexpr int SBV_PITCH = 192;
DI void sb_unit2(const bf16_t* PROJ, bf16_t* YCAT, int b, int h, int qp, LAS char* vl, int lane) {
    const int q = lane & 31, hh = lane >> 5;
    const size_t rowbase = (size_t)b * SEQ; const int qa = 2 * qp, qb = qa + 1;
    bf16x8 qfA[4], qfB[4];
    { const bf16_t* qrow = PROJ + (rowbase + qa * 32 + q) * LDP + C_SBQ + h * 64 + hh * 8;
#pragma unroll
      for (int s = 0; s < 4; ++s) { qfA[s] = *(const bf16x8*)(qrow + 16 * s); qfB[s] = *(const bf16x8*)(qrow + 32 * LDP + 16 * s); } }
    f32x16 oA0, oA1, oB0, oB1;
#pragma unroll
    for (int r = 0; r < 16; ++r) { oA0[r] = 0.f; oA1[r] = 0.f; oB0[r] = 0.f; oB1[r] = 0.f; }
    float RA = 1.f, RB = 1.f;
    const float zs = 0.125f * LOG2E;
    const int i16 = lane & 15, tq = i16 >> 2, tp = i16 & 3, blk = (lane >> 4) & 1;
    bf16x8 kf[4]; u32x4 vr[4];
#define SB_LOAD_TILE(kt_, kf, vr) do { const bf16_t* krow_ = PROJ + (rowbase + (kt_) * 32 + q) * LDP + C_SBK + h * 64 + hh * 8; \
        _Pragma("unroll") for (int s_ = 0; s_ < 4; ++s_) kf[s_] = *(const bf16x8*)(krow_ + 16 * s_); \
        _Pragma("unroll") for (int i_ = 0; i_ < 4; ++i_) { const int c_ = lane + 64 * i_, row_ = c_ >> 3, ch_ = c_ & 7; vr[i_] = *(const u32x4*)(PROJ + (rowbase + (kt_) * 32 + row_) * LDP + C_SBV + h * 64 + ch_ * 8); } } while (0)
#define SB_MATH(Z, DIAG, R, O0, O1) { \
        float L[16];                                        \
        _Pragma("unroll") for (int r = 0; r < 16; ++r) { \
            const float e = fexp2(fminf(Z[r] * zs, 100.f)), nb = __builtin_amdgcn_rcpf(1.f + e), be = e * nb; \
            const bool valid = !(DIAG) || (crow(r, hh) < q); \
            L[r] = valid ? nb : 1.f; Z[r] = valid ? be : 0.f; } \
        float G[4], Go[4]; \
        _Pragma("unroll") for (int g = 0; g < 4; ++g) { G[g] = (L[4 * g] * L[4 * g + 1]) * (L[4 * g + 2] * L[4 * g + 3]); Go[g] = __shfl_xor(G[g], 32); } \
        float base[4]; float run = 1.f; \
        _Pragma("unroll") for (int g = 3; g >= 0; --g) { base[g] = run * (hh == 0 ? Go[g] : 1.f); run *= G[g] * Go[g]; } \
        float P[16]; \
        _Pragma("unroll") for (int g = 0; g < 4; ++g) { \
            const float c3 = R * base[g], c2 = c3 * L[4 * g + 3], c1 = c2 * L[4 * g + 2], c0 = c1 * L[4 * g + 1]; \
            P[4 * g + 3] = Z[4 * g + 3] * c3; P[4 * g + 2] = Z[4 * g + 2] * c2; P[4 * g + 1] = Z[4 * g + 1] * c1; P[4 * g + 0] = Z[4 * g + 0] * c0; } \
        R *= run; \
        const bf16x8 p0 = pack8(P[0], P[1], P[2], P[3], P[4], P[5], P[6], P[7]), p1 = pack8(P[8], P[9], P[10], P[11], P[12], P[13], P[14], P[15]); \
        _Pragma("unroll") for (int s = 0; s < 2; ++s) { \
            const LAS char* vb = vl + (16 * s + 4 * hh + tq) * SBV_PITCH + blk * 32 + tp * 8; \
            const bf16x8 a0 = cat8(vtr(vb), vtr(vb + 8 * SBV_PITCH)), a1 = cat8(vtr(vb + 64), vtr(vb + 8 * SBV_PITCH + 64)); \
            O0 = MFMA32(a0, s == 0 ? p0 : p1, O0); O1 = MFMA32(a1, s == 0 ? p0 : p1, O1); } }
#define SB_ZERO(Z) _Pragma("unroll") for (int r = 0; r < 16; ++r) Z[r] = 0.f;
#define SB_VTOLDS(VR) _Pragma("unroll") for (int i = 0; i < 4; ++i) { const int c = lane + 64 * i, row = c >> 3, ch = c & 7; *(LAS u32x4*)(vl + row * SBV_PITCH + ch * 16) = VR[i]; }
    SB_LOAD_TILE(qb, kf, vr);
    {
        f32x16 zB; SB_ZERO(zB)
#pragma unroll
        for (int s = 0; s < 4; ++s) zB = MFMA32(kf[s], qfB[s], zB);
        SB_VTOLDS(vr)
        SB_LOAD_TILE(qa, kf, vr);
        SB_MATH(zB, true, RB, oB0, oB1)
    }
#define SB_STEP2(kt) { \
        f32x16 zA, zB; SB_ZERO(zA) SB_ZERO(zB) \
        _Pragma("unroll") for (int s = 0; s < 4; ++s) { zA = MFMA32(kf[s], qfA[s], zA); zB = MFMA32(kf[s], qfB[s], zB); } \
        SB_VTOLDS(vr) \
        if (kt > 0) SB_LOAD_TILE(kt - 1, kf, vr); \
        SB_MATH(zA, (kt == qa), RA, oA0, oA1) \
        SB_MATH(zB, false, RB, oB0, oB1) \
        if (__all(RA < 4.2e-18f && RB < 4.2e-18f)) break;        \
    }
    for (int kt = qa; kt >= 0; --kt) SB_STEP2(kt)
#undef SB_STEP2
#undef SB_VTOLDS
#undef SB_ZERO
#undef SB_MATH
#undef SB_LOAD_TILE
    bf16_t* orow = YCAT + (rowbase + qa * 32 + q) * 1024 + h * 64 + 4 * hh;
#pragma unroll
    for (int g = 0; g < 4; ++g) {
        u32x2 w0; w0.x = cvtpk(oA0[4 * g], oA0[4 * g + 1]); w0.y = cvtpk(oA0[4 * g + 2], oA0[4 * g + 3]); *(u32x2*)(orow + 8 * g) = w0;
        u32x2 w1; w1.x = cvtpk(oA1[4 * g], oA1[4 * g + 1]); w1.y = cvtpk(oA1[4 * g + 2], oA1[4 * g + 3]); *(u32x2*)(orow + 32 + 8 * g) = w1;
        u32x2 w2; w2.x = cvtpk(oB0[4 * g], oB0[4 * g + 1]); w2.y = cvtpk(oB0[4 * g + 2], oB0[4 * g + 3]); *(u32x2*)(orow + 32 * 1024 + 8 * g) = w2;
        u32x2 w3; w3.x = cvtpk(oB1[4 * g], oB1[4 * g + 1]); w3.y = cvtpk(oB1[4 * g + 2], oB1[4 * g + 3]); *(u32x2*)(orow + 32 * 1024 + 32 + 8 * g) = w3;
    }
}

constexpr int SGV_PITCH = 576;
DI void sgu_unit(const Frame& F, const Args& args, int l, int b, int c, const bf16_t* PROJ, bf16_t* YCAT) {
    const size_t m0 = (size_t)b * SEQ + c * 128;
    LAS char* Vn = (LAS char*)F.lds;
    {
      const int t = F.tid >> 2, part = F.tid & 3; const bf16_t* vrow = PROJ + (m0 + t) * LDP + C_SGV + part * 64; const float* gn = INP(I_SG_VG) + l * 256 + part * 64;
      float gv[64]; float s = 0.f;
#pragma unroll
      for (int i = 0; i < 8; ++i) { const u32x4 w = *(const u32x4*)(vrow + 8 * i);
#pragma unroll
          for (int j = 0; j < 4; ++j) { const float a = gelu_tanh(bflo(w[j])), bb = gelu_tanh(bfhi(w[j])); gv[8 * i + 2 * j] = a; gv[8 * i + 2 * j + 1] = bb; s += a * a + bb * bb; } }
      s += __shfl_xor(s, 1); s += __shfl_xor(s, 2);
      const float rstd = 1.0f / sqrtf(s * (1.0f / 256.0f) + EPS);
#pragma unroll
      for (int i = 0; i < 8; ++i) { const f32x4 g0 = *(const f32x4*)(gn + 8 * i), g1 = *(const f32x4*)(gn + 8 * i + 4);
          u32x4 w; w.x = cvtpk(gv[8 * i] * rstd * g0[0], gv[8 * i + 1] * rstd * g0[1]); w.y = cvtpk(gv[8 * i + 2] * rstd * g0[2], gv[8 * i + 3] * rstd * g0[3]);
          w.z = cvtpk(gv[8 * i + 4] * rstd * g1[0], gv[8 * i + 5] * rstd * g1[1]); w.w = cvtpk(gv[8 * i + 6] * rstd * g1[2], gv[8 * i + 7] * rstd * g1[3]);
          *(LAS u32x4*)(Vn + t * SGV_PITCH + (part * 64 + 8 * i) * 2) = w; } }
    WG_SYNC();
    {
      const int g = F.wave >> 1, db = F.wave & 1, lane = F.lane, r32 = lane & 31, hh = lane >> 5;
      const int i16 = lane & 15, tq = i16 >> 2, tp = i16 & 3, blk = (lane >> 4) & 1;
      const bf16_t* Wg = (const bf16_t*)(F.ws + WS_WSP) + ((size_t)(l * 4 + g) * 128) * 128;
      const float* bias = INP(I_SG_B) + (l * 4 + g) * 128;
      const int ch0 = g * 64 + db * 32 + 4 * hh;
#pragma unroll 1
      for (int tb = 0; tb < 4; ++tb) {
          const int t = tb * 32 + r32;
          u32x2 uw[4];
#pragma unroll
          for (int gi = 0; gi < 4; ++gi) uw[gi] = *(const u32x2*)(PROJ + (m0 + t) * LDP + C_SGU + ch0 + 8 * gi);
          const float bt = bias[t];
          bf16x8 wfa[4][2];
#pragma unroll
          for (int sb = 0; sb < 4; ++sb) if (sb <= tb) {
#pragma unroll
              for (int ks = 0; ks < 2; ++ks) wfa[sb][ks] = *(const bf16x8*)(Wg + (size_t)t * 128 + sb * 32 + 16 * ks + 8 * hh);
          }
          f32x16 acc;
#pragma unroll
          for (int r = 0; r < 16; ++r) acc[r] = 0.f;
#pragma unroll
          for (int sb = 0; sb < 4; ++sb) if (sb <= tb) {
#pragma unroll
              for (int ks = 0; ks < 2; ++ks) {
                  const LAS char* vb = Vn + (sb * 32 + 16 * ks + 8 * hh + tq) * SGV_PITCH + (g * 64 + db * 32 + blk * 16) * 2 + tp * 8;
                  const bf16x8 vf = cat8(vtr(vb), vtr(vb + 4 * SGV_PITCH));
                  acc = MFMA32(vf, wfa[sb][ks], acc);
              }
          }
          bf16_t* yo = YCAT + (m0 + t) * 1024 + 512 + ch0;
#pragma unroll
          for (int gi = 0; gi < 4; ++gi) {
              const float y0 = gelu_tanh(bflo(uw[gi].x)) * (acc[4 * gi] + bt), y1 = gelu_tanh(bfhi(uw[gi].x)) * (acc[4 * gi + 1] + bt);
              const float y2 = gelu_tanh(bflo(uw[gi].y)) * (acc[4 * gi + 2] + bt), y3 = gelu_tanh(bfhi(uw[gi].y)) * (acc[4 * gi + 3] + bt);
              u32x2 wv; wv.x = cvtpk(y0, y1); wv.y = cvtpk(y2, y3); *(u32x2*)(yo + 8 * gi) = wv;
          }
      } }
    WG_SYNC();
}

constexpr int GQ_PITCH = 80, GV_PITCH = 192, GS_PITCH = 80;
constexpr int GL_QT = 0, GL_KT = GL_QT + 128 * GQ_PITCH, GL_VV = GL_KT + 128 * GQ_PITCH, GL_ST = GL_VV + 128 * GV_PITCH, GL_SEG = GL_ST + 64 * GS_PITCH,
              GL_D = GL_SEG + 16 * 32 * 4, GL_SSQ = GL_D + 32 * 4, GL_END = GL_SSQ + 128 * 2 * 4;
DI void gla_chain(const Frame& F, const Args& args, int l, int b, int h, const bf16_t* PROJ, bf16_t* YCAT) {
    LAS char* L = (LAS char*)F.lds;
    LAS float* SEG = (LAS float*)(L + GL_SEG); LAS float* Dd = (LAS float*)(L + GL_D); LAS float* SSQ = (LAS float*)(L + GL_SSQ);
    const int tid = F.tid, lane = F.lane, w = F.wave, r32 = lane & 31, hh = lane >> 5;
    const int i16 = lane & 15, tq = i16 >> 2, tp = i16 & 3, blk = (lane >> 4) & 1;
    for (int i = tid; i < 64 * GS_PITCH / 4; i += NTHR) ((LAS unsigned*)(L + GL_ST))[i] = 0u;
    f32x16 st;
#pragma unroll
    for (int r = 0; r < 16; ++r) st[r] = 0.f;
    const int j = tid & 31, seg = tid >> 5;
    const float bg = INP(I_GLA_BG)[l * 128 + h * 32 + j];
    const int tb = w & 3, dh = w >> 2;
    float ga[8], kr[8], qr[8]; u32x4 vv[2];
#define GC_LOAD(c_) do { const size_t m0_ = (size_t)b * SEQ + (c_) * 128; \
        _Pragma("unroll") for (int i_ = 0; i_ < 8; ++i_) { const bf16_t* p_ = PROJ + (m0_ + seg * 8 + i_) * LDP + h * 32 + j; ga[i_] = bf2f(p_[C_GA]); kr[i_] = bf2f(p_[C_GK]); qr[i_] = bf2f(p_[C_GQ]); } \
        _Pragma("unroll") for (int i_ = 0; i_ < 2; ++i_) { const int cc_ = tid + 512 * i_, row_ = cc_ >> 3, ch_ = cc_ & 7; vv[i_] = *(const u32x4*)(PROJ + (m0_ + row_) * LDP + C_GV + h * 64 + ch_ * 8); } } while (0)
    GC_LOAD(0);
    LDS_SYNC();
#pragma unroll 1
    for (int c = 0; c < 16; ++c) {
        const size_t m0 = (size_t)b * SEQ + c * 128;
        float bc[8]; float run = 0.f;
#pragma unroll
        for (int i = 0; i < 8; ++i) {
            const float g = ga[i] + bg;
            const float sp = fmaxf(-g, 0.f) + flog2(1.f + fexp2(-fabsf(g) * LOG2E)) * 0.6931471805599453f;
            run += -sp * (1.0f / 16.0f); bc[i] = run;
        }
        SEG[seg * 32 + j] = run;
#pragma unroll
        for (int i = 0; i < 2; ++i) { const int cc = tid + 512 * i, row = cc >> 3, ch = cc & 7; *(LAS u32x4*)(L + GL_VV + row * GV_PITCH + ch * 16) = vv[i]; }
        LDS_SYNC();
        float pre = 0.f;
#pragma unroll
        for (int s2 = 0; s2 < 15; ++s2) { const float v_ = SEG[s2 * 32 + j]; pre += s2 < seg ? v_ : 0.f; }
#pragma unroll
        for (int i = 0; i < 8; ++i) {
            const int t = seg * 8 + i; const float bb = pre + bc[i];
            *(LAS bf16_t*)(L + GL_QT + t * GQ_PITCH + j * 2) = cvt1(qr[i] * 0.17677669529663687f * fexp2(bb * LOG2E));
            *(LAS bf16_t*)(L + GL_KT + t * GQ_PITCH + j * 2) = cvt1(kr[i] * fexp2(-bb * LOG2E));
            if (t == 127) Dd[j] = fexp2(bb * LOG2E);
        }
        if (c < 15) GC_LOAD(c + 1);
        u32x2 gov[4];
        { const bf16_t* go = PROJ + (m0 + tb * 32 + r32) * LDP + C_GO + h * 64 + dh * 32 + 4 * hh;
#pragma unroll
          for (int g = 0; g < 4; ++g) gov[g] = *(const u32x2*)(go + 8 * g); }
        LDS_SYNC();
        f32x16 o;
#pragma unroll
        for (int r = 0; r < 16; ++r) o[r] = 0.f;
        bf16x8 qf[2];
#pragma unroll
        for (int ks = 0; ks < 2; ++ks) qf[ks] = *(LAS const bf16x8*)(L + GL_QT + (tb * 32 + r32) * GQ_PITCH + (16 * ks + 8 * hh) * 2);
        for (int sb = 0; sb <= tb; ++sb) {
            f32x16 sT;
#pragma unroll
            for (int r = 0; r < 16; ++r) sT[r] = 0.f;
#pragma unroll
            for (int ks = 0; ks < 2; ++ks) { const bf16x8 kf = *(LAS const bf16x8*)(L + GL_KT + (sb * 32 + r32) * GQ_PITCH + (16 * ks + 8 * hh) * 2); sT = MFMA32(kf, qf[ks], sT); }
            if (sb == tb) {
#pragma unroll
                for (int r = 0; r < 16; ++r) if (crow(r, hh) > r32) sT[r] = 0.f;
            }
            const bf16x8 p0 = pack8(sT[0], sT[1], sT[2], sT[3], sT[4], sT[5], sT[6], sT[7]), p1 = pack8(sT[8], sT[9], sT[10], sT[11], sT[12], sT[13], sT[14], sT[15]);
#pragma unroll
            for (int s = 0; s < 2; ++s) {
                const LAS char* vb = L + GL_VV + (sb * 32 + 16 * s + 4 * hh + tq) * GV_PITCH + (dh * 32 + blk * 16) * 2 + tp * 8;
                const bf16x8 a = cat8(vtr(vb), vtr(vb + 8 * GV_PITCH));
                o = MFMA32(a, s == 0 ? p0 : p1, o);
            }
        }
#pragma unroll
        for (int ks = 0; ks < 2; ++ks) {
            const bf16x8 a = *(LAS const bf16x8*)(L + GL_ST + (dh * 32 + r32) * GS_PITCH + (16 * ks + 8 * hh) * 2);
            o = MFMA32(a, qf[ks], o);
        }
        if (tb == 0) {
#pragma unroll
            for (int ks = 0; ks < 8; ++ks) {
                const LAS char* kb = L + GL_KT + (16 * ks + 8 * hh + tq) * GQ_PITCH + (blk * 16) * 2 + tp * 8;
                const bf16x8 a = cat8(vtr(kb), vtr(kb + 4 * GQ_PITCH));
                const LAS char* vb = L + GL_VV + (16 * ks + 8 * hh + tq) * GV_PITCH + (dh * 32 + blk * 16) * 2 + tp * 8;
                const bf16x8 bfr = cat8(vtr(vb), vtr(vb + 4 * GV_PITCH));
                st = MFMA32(a, bfr, st);
            }
#pragma unroll
            for (int r = 0; r < 16; ++r) st[r] *= Dd[crow(r, hh)];
        }
        float ssq = 0.f;
#pragma unroll
        for (int r = 0; r < 16; ++r) ssq += o[r] * o[r];
        ssq += __shfl_xor(ssq, 32);
        if (hh == 0) SSQ[(tb * 32 + r32) * 2 + dh] = ssq;
        LDS_SYNC();
        {
            const int t = tb * 32 + r32; const float tot = SSQ[t * 2] + SSQ[t * 2 + 1]; const float rstd = 1.0f / sqrtf(tot * (1.0f / 64.0f) + EPS);
            const float* gn = INP(I_GLA_OG) + l * 256 + h * 64 + dh * 32 + 4 * hh;
            bf16_t* yo = YCAT + (m0 + t) * 1024 + 768 + h * 64 + dh * 32 + 4 * hh;
#pragma unroll
            for (int g = 0; g < 4; ++g) {
                const u32x2 gw = gov[g]; const f32x4 gg = *(const f32x4*)(gn + 8 * g);
                const float y0 = o[4 * g] * rstd * gg[0] * silu(bflo(gw.x)), y1 = o[4 * g + 1] * rstd * gg[1] * silu(bfhi(gw.x));
                const float y2 = o[4 * g + 2] * rstd * gg[2] * silu(bflo(gw.y)), y3 = o[4 * g + 3] * rstd * gg[3] * silu(bfhi(gw.y));
                u32x2 wv; wv.x = cvtpk(y0, y1); wv.y = cvtpk(y2, y3); *(u32x2*)(yo + 8 * g) = wv;
            }
        }
        if (tb == 0) {
#pragma unroll
            for (int g = 0; g < 4; ++g) { u32x2 wv; wv.x = cvtpk(st[4 * g], st[4 * g + 1]); wv.y = cvtpk(st[4 * g + 2], st[4 * g + 3]);
                *(LAS u32x2*)(L + GL_ST + (dh * 32 + r32) * GS_PITCH + (8 * g + 4 * hh) * 2) = wv; }
        }
        LDS_SYNC();
    }
#undef GC_LOAD
}

constexpr int XA_PITCH = 528;
template <int PITCH, int I0, int N> DI void xattn_load(const bf16_t* src, int tid, u32x4 (&v)[N]) {
    const bf16_t* p = src + (size_t)(tid >> 5) * PITCH + (tid & 31) * 8;
#pragma unroll
    for (int i = 0; i < N; ++i) v[i] = *(const u32x4*)(p + (size_t)(I0 + i) * 16 * PITCH);
}
template <int I0, int N> DI void xattn_store(LAS char* img, int tid, const u32x4 (&v)[N]) {
    LAS char* d = img + (tid >> 5) * XA_PITCH + (tid & 31) * 16;
#pragma unroll
    for (int i = 0; i < N; ++i) *(LAS u32x4*)(d + (I0 + i) * 16 * XA_PITCH) = v[i];
}
DI void xattn_unit(const Frame& F, const bf16_t* CQ, const bf16_t* Kl, const bf16_t* VTl, bf16_t* O, int pm, int h) {
    LAS char* img = (LAS char*)F.lds;
    const int lane = F.lane, r32 = lane & 31, hh = lane >> 5, b = pm >> 3;
    const size_t tok = (size_t)pm * 256 + F.wave * 32 + r32;
    { u32x4 sk[16]; xattn_load<1024, 0, 16>(Kl + (size_t)b * 256 * 1024 + h * 256, F.tid, sk); xattn_store<0, 16>(img, F.tid, sk); }
    const bf16_t* qrow = CQ + tok * 1024 + h * 256 + 8 * hh;
    bf16x8 qn = *(const bf16x8*)qrow;
    LDS_SYNC();
    u32x4 sv0[8]; xattn_load<256, 0, 8>(VTl + (size_t)(b * 4 + h) * 256 * 256, F.tid, sv0);
    f32x16 acc[8];
#pragma unroll
    for (int kb = 0; kb < 8; ++kb)
#pragma unroll
        for (int r = 0; r < 16; ++r) acc[kb][r] = 0.f;
#pragma unroll 1
    for (int ks = 0; ks < 16; ++ks) {
        const bf16x8 q = qn;
        qn = *(const bf16x8*)(qrow + 16 * (ks < 15 ? ks + 1 : ks));
        const LAS char* kp = img + r32 * XA_PITCH + (16 * ks + 8 * hh) * 2;
#pragma unroll
        for (int kb = 0; kb < 8; ++kb) acc[kb] = MFMA32(*(LAS const bf16x8*)(kp + kb * 32 * XA_PITCH), q, acc[kb]);
    }
    float mx = -INFINITY;
#pragma unroll
    for (int kb = 0; kb < 8; ++kb)
#pragma unroll
        for (int r = 0; r < 16; ++r) mx = fmaxf(mx, acc[kb][r]);
    mx = fmaxf(mx, __shfl_xor(mx, 32));
    float sum = 0.f;
#pragma unroll
    for (int kb = 0; kb < 8; ++kb)
#pragma unroll
        for (int r = 0; r < 16; ++r) { const float p = fexp2(acc[kb][r] - mx); acc[kb][r] = p; sum += p; }
    sum += __shfl_xor(sum, 32);
    const float inv = 1.0f / sum;
    bf16x8 pf[8][2];
#pragma unroll
    for (int kb = 0; kb < 8; ++kb) {
        pf[kb][0] = pack8(acc[kb][0], acc[kb][1], acc[kb][2], acc[kb][3], acc[kb][4], acc[kb][5], acc[kb][6], acc[kb][7]);
        pf[kb][1] = pack8(acc[kb][8], acc[kb][9], acc[kb][10], acc[kb][11], acc[kb][12], acc[kb][13], acc[kb][14], acc[kb][15]);
    }
    LDS_SYNC();
    { u32x4 sv1[8]; xattn_load<256, 8, 8>(VTl + (size_t)(b * 4 + h) * 256 * 256, F.tid, sv1); xattn_store<0, 8>(img, F.tid, sv0); xattn_store<8, 8>(img, F.tid, sv1); }
    LDS_SYNC();
    bf16_t* orow = O + tok * 1024 + h * 256 + 4 * hh;
#pragma unroll 1
    for (int db = 0; db < 8; ++db) {
        f32x16 o;
#pragma unroll
        for (int r = 0; r < 16; ++r) o[r] = 0.f;
#pragma unroll
        for (int kb = 0; kb < 8; ++kb)
#pragma unroll
            for (int s2 = 0; s2 < 2; ++s2) {
                const LAS char* vp = img + (db * 32 + r32) * XA_PITCH + (32 * kb + 16 * s2 + 4 * hh) * 2;
                const bf16x8 vf = cat8(*(LAS const s16x4*)vp, *(LAS const s16x4*)(vp + 16));
                o = MFMA32(vf, pf[kb][s2], o);
            }
#pragma unroll
        for (int g = 0; g < 4; ++g) { u32x2 w; w.x = cvtpk(o[4 * g] * inv, o[4 * g + 1] * inv); w.y = cvtpk(o[4 * g + 2] * inv, o[4 * g + 3] * inv); *(u32x2*)(orow + 32 * db + 8 * g) = w; }
    }
    LDS_SYNC();
}

DI unsigned key_pack(float v, unsigned tag, unsigned mask) { const unsigned b = __float_as_uint(v); const unsigned mono = b ^ ((unsigned)((int)b >> 31) | 0x80000000u); return (mono & ~mask) | tag; }
DI float key_val(unsigned k, unsigned mask) { const unsigned mono = k & ~mask; const unsigned b = (mono & 0x80000000u) ? (mono ^ 0x80000000u) : ~mono; return __uint_as_float(b); }
#define CE(a, b) do { const unsigned _h = (a) > (b) ? (a) : (b); const unsigned _l = (a) > (b) ? (b) : (a); (a) = _h; (b) = _l; } while (0)
#define SORT16_DESC(v) do { CE(v[0], v[1]); CE(v[2], v[3]); CE(v[0], v[2]); CE(v[1], v[3]); CE(v[1], v[2]); CE(v[4], v[5]); CE(v[6], v[7]); CE(v[4], v[6]); CE(v[5], v[7]); CE(v[5], v[6]); CE(v[0], v[4]); CE(v[2], v[6]); CE(v[2], v[4]); CE(v[1], v[5]); CE(v[3], v[7]); CE(v[3], v[5]); CE(v[1], v[2]); CE(v[3], v[4]); CE(v[5], v[6]); CE(v[8], v[9]); CE(v[10], v[11]); CE(v[8], v[10]); CE(v[9], v[11]); CE(v[9], v[10]); CE(v[12], v[13]); CE(v[14], v[15]); CE(v[12], v[14]); CE(v[13], v[15]); CE(v[13], v[14]); CE(v[8], v[12]); CE(v[10], v[14]); CE(v[10], v[12]); CE(v[9], v[13]); CE(v[11], v[15]); CE(v[11], v[13]); CE(v[9], v[10]); CE(v[11], v[12]); CE(v[13], v[14]); CE(v[0], v[8]); CE(v[4], v[12]); CE(v[4], v[8]); CE(v[2], v[10]); CE(v[6], v[14]); CE(v[6], v[10]); CE(v[2], v[4]); CE(v[6], v[8]); CE(v[10], v[12]); CE(v[1], v[9]); CE(v[5], v[13]); CE(v[5], v[9]); CE(v[3], v[11]); CE(v[7], v[15]); CE(v[7], v[11]); CE(v[3], v[5]); CE(v[7], v[9]); CE(v[11], v[13]); CE(v[1], v[2]); CE(v[3], v[4]); CE(v[5], v[6]); CE(v[7], v[8]); CE(v[9], v[10]); CE(v[11], v[12]); CE(v[13], v[14]); } while (0)
#define BITONIC16_DESC(v) do { CE(v[0], v[8]); CE(v[1], v[9]); CE(v[2], v[10]); CE(v[3], v[11]); CE(v[4], v[12]); CE(v[5], v[13]); CE(v[6], v[14]); CE(v[7], v[15]); CE(v[0], v[4]); CE(v[1], v[5]); CE(v[2], v[6]); CE(v[3], v[7]); CE(v[8], v[12]); CE(v[9], v[13]); CE(v[10], v[14]); CE(v[11], v[15]); CE(v[0], v[2]); CE(v[1], v[3]); CE(v[4], v[6]); CE(v[5], v[7]); CE(v[8], v[10]); CE(v[9], v[11]); CE(v[12], v[14]); CE(v[13], v[15]); CE(v[0], v[1]); CE(v[2], v[3]); CE(v[4], v[5]); CE(v[6], v[7]); CE(v[8], v[9]); CE(v[10], v[11]); CE(v[12], v[13]); CE(v[14], v[15]); } while (0)
#define MERGE_TOP16(T, v) do { _Pragma("unroll") for (int _i = 0; _i < 16; ++_i) T[_i] = T[_i] > v[15 - _i] ? T[_i] : v[15 - _i]; BITONIC16_T(T); } while (0)
DI void bitonic16(unsigned (&v)[16]) { BITONIC16_DESC(v); }
#define BITONIC16_T(T) bitonic16(T)
DI void route_level1(const bf16_t* PQ, const bf16_t* SK  , int tile, int h, int lane, unsigned (&tpk)[2][16]) {
    const int r32 = lane & 31, hh = lane >> 5; const size_t m = (size_t)tile * 32 + r32;
    bf16x8 qfa[2][4];
#pragma unroll
    for (int p = 0; p < 2; ++p)
#pragma unroll
        for (int ks = 0; ks < 4; ++ks) qfa[p][ks] = *(const bf16x8*)(PQ + m * 1024 + h * 128 + p * 64 + 16 * ks + 8 * hh);
    bf16x8 an[4];
#define RT_LOADA(p_, nb_) do { const bf16_t* skp_ = SK + ((size_t)(h * 2 + (p_)) * 128) * 64; _Pragma("unroll") for (int ks_ = 0; ks_ < 4; ++ks_) an[ks_] = *(const bf16x8*)(skp_ + (size_t)((nb_) * 32 + r32) * 64 + 16 * ks_ + 8 * hh); } while (0)
    RT_LOADA(0, 0);
#pragma unroll
    for (int p = 0; p < 2; ++p) {
        unsigned T[16];
#pragma unroll
        for (int i = 0; i < 16; ++i) T[i] = 0u;
#pragma unroll 1
        for (int nb = 0; nb < 4; ++nb) {
            bf16x8 a[4];
#pragma unroll
            for (int ks = 0; ks < 4; ++ks) a[ks] = an[ks];
            if (nb < 3) RT_LOADA(p, nb + 1); else if (p == 0) RT_LOADA(1, 0);
            f32x16 acc;
#pragma unroll
            for (int r = 0; r < 16; ++r) acc[r] = 0.f;
#pragma unroll
            for (int ks = 0; ks < 4; ++ks) acc = MFMA32(a[ks], qfa[p][ks], acc);
            unsigned v[16];
#pragma unroll
            for (int r = 0; r < 16; ++r) v[r] = key_pack(acc[r], (unsigned)(nb * 32 + crow(r, hh)), 127u);
            SORT16_DESC(v);
            MERGE_TOP16(T, v);
        }
        unsigned pv[16];
#pragma unroll
        for (int i = 0; i < 16; ++i) pv[i] = (unsigned)__shfl_xor((int)T[i], 32);
        MERGE_TOP16(T, pv);
#pragma unroll
        for (int i = 0; i < 16; ++i) tpk[p][i] = T[i];
    }
#undef RT_LOADA
}
DI void route_level2(const unsigned (&tpk)[2][16], size_t m, int h, int lane, int* IDX, float* Gw, unsigned* SCL, const LAS unsigned* SCT  , LAS char* scr  ) {
    { u32x4 w0, w1, w2, w3;
#pragma unroll
      for (int q = 0; q < 4; ++q) {
          w0[q] = (tpk[0][4 * q] & 127u) | ((tpk[0][4 * q + 1] & 127u) << 8) | ((tpk[0][4 * q + 2] & 127u) << 16) | ((tpk[0][4 * q + 3] & 127u) << 24);
          w1[q] = (tpk[1][4 * q] & 127u) | ((tpk[1][4 * q + 1] & 127u) << 8) | ((tpk[1][4 * q + 2] & 127u) << 16) | ((tpk[1][4 * q + 3] & 127u) << 24); }
      (void)w2; (void)w3;
      *(LAS u32x4*)(scr + lane * 48) = w0; *(LAS u32x4*)(scr + lane * 48 + 16) = w1; }
    float av[16], bv[16];
#pragma unroll
    for (int i = 0; i < 16; ++i) { av[i] = key_val(tpk[0][i], 127u); bv[i] = key_val(tpk[1][i], 127u); }
    unsigned cv[16];
#pragma unroll
    for (int i = 0; i < 16; ++i) cv[i] = 0u;
#pragma unroll
    for (int i = 0; i < 16; ++i)
#pragma unroll
        for (int jj = 0; jj < 16; ++jj) if ((i + 1) * (jj + 1) <= 16) {
            unsigned x = key_pack(av[i] + bv[jj], (unsigned)(i * 16 + jj), 255u);
#pragma unroll
            for (int pos = (i + 1) * (jj + 1) - 1; pos < 16; ++pos) CE(cv[pos], x);
        }
    const float cmax = key_val(cv[0], 255u);
    float e[16]; float sum = 0.f;
#pragma unroll
    for (int k = 0; k < 16; ++k) { e[k] = fexp2((key_val(cv[k], 255u) - cmax) * LOG2E); sum += e[k]; }
    const float inv = 1.0f / sum;
    int id[16];
#pragma unroll
    for (int k = 0; k < 16; ++k) {
        const unsigned ij = cv[k] & 255u;
        const unsigned n0 = *(LAS const unsigned char*)(scr + lane * 48 + (ij >> 4)), n1 = *(LAS const unsigned char*)(scr + lane * 48 + 16 + (ij & 15u));
        id[k] = (int)(n0 * 128u + n1);
    }
    { int* ip = IDX + m * 128 + h * 16;
#pragma unroll
      for (int k = 0; k < 16; k += 4) *(int4*)(ip + k) = make_int4(id[k], id[k + 1], id[k + 2], id[k + 3]);
      if (SCT != nullptr) {
      unsigned* sp = SCL + m * 128 + h * 16;
#pragma unroll
      for (int k = 0; k < 16; k += 4) { u32x4 w;
#pragma unroll
          for (int q = 0; q < 4; ++q) w[q] = SCT[id[k + q]];
          *(u32x4*)(sp + k) = w; } }
      float* gp = Gw + m * 128 + h * 16;
#pragma unroll
      for (int k = 0; k < 16; k += 4) *(f32x4*)(gp + k) = (f32x4){e[k] * inv, e[k + 1] * inv, e[k + 2] * inv, e[k + 3] * inv}; }
}
DI void route_pair(const bf16_t* PQ, const bf16_t* SK, int* IDX, float* Gw, unsigned* SCL, const LAS unsigned* SCT, int tileA, int h, int lane, LAS char* scr) {
    unsigned tA[2][16], tB[2][16];
    route_level1(PQ, SK, tileA, h, lane, tA);
    route_level1(PQ, SK, tileA + 1, h, lane, tB);
    const bool hi = lane >= 32;
#pragma unroll
    for (int p = 0; p < 2; ++p)
#pragma unroll
        for (int i = 0; i < 16; ++i) tA[p][i] = hi ? tB[p][i] : tA[p][i];
    route_level2(tA, (size_t)(tileA + (hi ? 1 : 0)) * 32 + (lane & 31), h, lane, IDX, Gw, SCL, SCT, scr);
}

DI void route_heads(const bf16_t* PQ, const bf16_t* SK, int* IDX, float* Gw, int tile, int ha, int lane, LAS char* scr) {
    unsigned tA[2][16], tB[2][16];
    route_level1(PQ, SK, tile, ha, lane, tA);
    route_level1(PQ, SK, tile, ha + 1, lane, tB);
    const bool hi = lane >= 32;
#pragma unroll
    for (int p = 0; p < 2; ++p)
#pragma unroll
        for (int i = 0; i < 16; ++i) tA[p][i] = hi ? tB[p][i] : tA[p][i];
    route_level2(tA, (size_t)tile * 32 + (lane & 31), hi ? ha + 1 : ha, lane, IDX, Gw, nullptr, nullptr, scr);
}

#define FP4PAIR(w, bsel) __builtin_amdgcn_cvt_scalef32_pk_f32_fp4((w), 1.0f, (bsel))
typedef __bf16 bf16p_t __attribute__((ext_vector_type(2)));
#define FP4BF(w, bsel) __builtin_amdgcn_cvt_scalef32_pk_bf16_fp4((w), 1.0f, (bsel))
#define DOT2(accf, xw, ub) accf = __builtin_amdgcn_fdot2_f32_bf16(__builtin_bit_cast(bf16p_t, (xw)), (ub), accf, false)
typedef int v8i_t __attribute__((ext_vector_type(8)));
typedef short s16x2_t __attribute__((ext_vector_type(2)));
DI f32x4 mfma_x4u4(const u32x4 a, const u32x4 b, const f32x4 c) {
    const v8i_t aa = {(int)a.x, (int)a.y, (int)a.z, (int)a.w, 0, 0, 0, 0}, bb = {(int)b.x, (int)b.y, (int)b.z, (int)b.w, 0, 0, 0, 0};
    return __builtin_amdgcn_mfma_scale_f32_16x16x128_f8f6f4(aa, bb, c, 4, 4, 0, 0x7F7F7F7F, 0, 0x7F7F7F7F);
}
constexpr int PJ_NR = 1, PJ_T0 = 2;
constexpr int PJ_XS = 0, PJ_ZR = NWAVES * 1536, PJ_STG = PJ_ZR + 1024, PJ_UPITCH = 528, PJ_SCR = PJ_STG + NWAVES * 16 * PJ_UPITCH;
constexpr int PJ_FLG = PJ_SCR + PJ_NR * 3072;
static_assert(PJ_FLG + 32 <= LDS_BYTES - 64, "PEER phase LDS map");
constexpr int PJ_SCR0 = PJ_FLG + 32;
static_assert(PJ_SCR0 + NWAVES * 3072 <= LDS_BYTES - 64, "PEER phase LDS map");
#define PJ_TOK(t_) ((size_t)(F.bx + GRID * ((t_) >> 5)) * 32 + ((t_) & 31))
DI void pj_wait_tile(const Frame& F, int tile) {
    volatile LAS unsigned* fl = (volatile LAS unsigned*)(F.lds + PJ_FLG);
    const unsigned need = tile < PJ_T0 ? (unsigned)NWAVES : (unsigned)PJ_NR;
    while (fl[tile] < need) __builtin_amdgcn_s_sleep(2);
    asm volatile("" ::: "memory");
}
DI int pj_pop(const Frame& F) { int v = 0; if (F.lane == 0) v = (int)__atomic_fetch_add((LAS unsigned*)(F.lds + PJ_FLG) + 4, 1u, __ATOMIC_RELAXED); return __builtin_amdgcn_readfirstlane(v); }
DI void peer_u_stream(const Frame& F, const unsigned char* Ub, const unsigned* SCTg, const int* IDX, const float* Gw, const bf16_t* XB, const float* SS, int uw, float* cs) {
    const int lane = F.lane, j16 = lane & 15, kb = lane >> 4;
    LAS unsigned char* xs = F.lds + PJ_XS + uw * 1536;
    LAS unsigned char* zr = F.lds + PJ_ZR;
    { unsigned zz; asm volatile("v_mov_b32 %0, 0" : "=v"(zz)); *(LAS u32x4*)(zr + 16 * lane) = (u32x4){zz, zz, zz, zz}; }
    const LAS unsigned char* xrd = j16 < 3 ? xs + 512 * j16 + 16 * kb : zr;
    constexpr int UPITCH = PJ_UPITCH;
    LAS unsigned char* stg = F.lds + PJ_STG + uw * (16 * UPITCH);
    LAS unsigned char* stw = stg + (lane >> 5) * UPITCH + 16 * (lane & 31);
    const LAS unsigned char* strd = stg + j16 * UPITCH + 16 * kb;
    u32x4 UA[8], UB[8];
#define PU_ISSUE(buf, idv, sub) do { _Pragma("unroll") for (int i_ = 0; i_ < 8; ++i_) { const int e_ = __shfl(idv, (sub) * 16 + 2 * i_ + (lane >> 5)); \
            buf[i_] = *(const u32x4*)(Ub + (size_t)e_ * 512 + 16 * (lane & 31)); } } while (0)
#define PU_DOTS(buf, sub, dreg) do { f32x4 c_ = {0.f, 0.f, 0.f, 0.f}; asm volatile("" ::: "memory"); \
        _Pragma("unroll") for (int i_ = 0; i_ < 8; ++i_) *(LAS u32x4*)(stw + i_ * (2 * UPITCH)) = buf[i_];        \
        _Pragma("unroll") for (int s_ = 0; s_ < 8; ++s_) { const u32x4 xq_ = *(const LAS u32x4*)(xrd + 64 * s_), bq_ = *(const LAS u32x4*)(strd + 64 * s_); c_ = mfma_x4u4(xq_, bq_, c_); } \
        const float dv_ = __shfl(fmaf(c_[2], xs3, fmaf(c_[1], xs2, c_[0] * xs1)), j16); if (kb == (sub)) dreg = dv_; } while (0)
    int t = pj_pop(F);
    if (t >= 128) return;
    pj_wait_tile(F, t >> 5);
    size_t m = PJ_TOK(t);
    u32x4 xa = *(const u32x4*)(XB + m * 1024 + 16 * lane), xb = *(const u32x4*)(XB + m * 1024 + 16 * lane + 8);
    int id0 = IDX[m * 128 + lane], id1 = IDX[m * 128 + 64 + lane];
    float g0 = Gw[m * 128 + lane], g1 = Gw[m * 128 + 64 + lane];
    float ssl = lane < 16 ? SS[m * 16 + lane] : 0.f;
    PU_ISSUE(UA, id0, 0);
#pragma unroll 1
    for (int tnx = 0; t < 128; t = tnx) {
        unsigned xp[8];
#pragma unroll
        for (int i = 0; i < 4; ++i) { xp[i] = xa[i]; xp[4 + i] = xb[i]; }
        PU_ISSUE(UB, id0, 1);
        const unsigned sc0 = SCTg[id0], sc1 = SCTg[id1];
        float xs1, xs2, xs3;
        {
          float xr_[16]; float am = 0.f;
#pragma unroll
          for (int i = 0; i < 8; ++i) { xr_[2 * i] = bflo(xp[i]); xr_[2 * i + 1] = bfhi(xp[i]); am = fmaxf(am, fmaxf(fabsf(xr_[2 * i]), fabsf(xr_[2 * i + 1]))); }
          am = wave_max(am);
          int eb = (int)((__builtin_bit_cast(unsigned, am) >> 23) & 0xFFu); eb = eb < 40 ? 40 : eb;
          xs1 = __builtin_bit_cast(float, (unsigned)(eb - 1) << 23); xs2 = xs1 * 0.25f; xs3 = xs1 * 0.03125f;
#pragma unroll
          for (int t = 0; t < 3; ++t) {
              const float sc_ = t == 0 ? xs1 : t == 1 ? xs2 : xs3;
              u32x2 w;
#pragma unroll
              for (int hw = 0; hw < 2; ++hw) {
                  unsigned ww = 0;
                  ww = __builtin_amdgcn_cvt_scalef32_pk_fp4_f32(ww, xr_[8 * hw + 0], xr_[8 * hw + 1], sc_, 0); ww = __builtin_amdgcn_cvt_scalef32_pk_fp4_f32(ww, xr_[8 * hw + 2], xr_[8 * hw + 3], sc_, 1);
                  ww = __builtin_amdgcn_cvt_scalef32_pk_fp4_f32(ww, xr_[8 * hw + 4], xr_[8 * hw + 5], sc_, 2); ww = __builtin_amdgcn_cvt_scalef32_pk_fp4_f32(ww, xr_[8 * hw + 6], xr_[8 * hw + 7], sc_, 3);
                  w[hw] = ww;
                  if (t < 2) {
                      const f32x2 q0 = __builtin_amdgcn_cvt_scalef32_pk_f32_fp4(ww, sc_, 0), q1 = __builtin_amdgcn_cvt_scalef32_pk_f32_fp4(ww, sc_, 1), q2 = __builtin_amdgcn_cvt_scalef32_pk_f32_fp4(ww, sc_, 2), q3 = __builtin_amdgcn_cvt_scalef32_pk_f32_fp4(ww, sc_, 3);
                      xr_[8 * hw + 0] -= q0.x; xr_[8 * hw + 1] -= q0.y; xr_[8 * hw + 2] -= q1.x; xr_[8 * hw + 3] -= q1.y; xr_[8 * hw + 4] -= q2.x; xr_[8 * hw + 5] -= q2.y; xr_[8 * hw + 6] -= q3.x; xr_[8 * hw + 7] -= q3.y;
                  }
              }
              *(LAS u32x2*)(xs + 512 * t + 8 * lane) = w;
          }
        }
        tnx = pj_pop(F);
        const int tn = tnx < 128 ? tnx : t;
        pj_wait_tile(F, tn >> 5);
        const size_t mn = PJ_TOK(tn);
        const u32x4 nxa = *(const u32x4*)(XB + mn * 1024 + 16 * lane), nxb = *(const u32x4*)(XB + mn * 1024 + 16 * lane + 8);
        const int nid0 = IDX[mn * 128 + lane], nid1 = IDX[mn * 128 + 64 + lane];
        const float ng0 = Gw[mn * 128 + lane], ng1 = Gw[mn * 128 + 64 + lane];
        const float nssl = lane < 16 ? SS[mn * 16 + lane] : 0.f;
        const float rstd = 1.0f / sqrtf(wave_sum(ssl) * (1.0f / 1024.0f) + EPS);
        float d0 = 0.f, d1 = 0.f;
        PU_DOTS(UA, 0, d0); PU_ISSUE(UA, id0, 2);
        PU_DOTS(UB, 1, d0); PU_ISSUE(UB, id0, 3);
        PU_DOTS(UA, 2, d0); PU_ISSUE(UA, id1, 0);
        PU_DOTS(UB, 3, d0); PU_ISSUE(UB, id1, 1);
        PU_DOTS(UA, 0, d1); PU_ISSUE(UA, id1, 2);
        PU_DOTS(UB, 1, d1); PU_ISSUE(UB, id1, 3);
        PU_DOTS(UA, 2, d1); PU_ISSUE(UA, nid0, 0);
        PU_DOTS(UB, 3, d1);
        const float c0 = g0 * gelu_tanh(d0 * (bflo(sc0) * rstd)) * bfhi(sc0), c1 = g1 * gelu_tanh(d1 * (bflo(sc1) * rstd)) * bfhi(sc1);
        m = PJ_TOK(t); cs[m * 128 + lane] = c0; cs[m * 128 + 64 + lane] = c1;
        xa = nxa; xb = nxb; id0 = nid0; id1 = nid1; g0 = ng0; g1 = ng1; ssl = nssl;
    }
#undef PU_ISSUE
#undef PU_DOTS
}
DI void peer_v_pass(const Frame& F, const Args& args, bool last, const unsigned char* Vb, const int* IDX, bf16_t* XB, float* SS, const float* csw) {
    const int lane = F.lane;
    u32x2 A[16], B[16];
#define PW_ISSUE(buf, tab, idv, sub) do { _Pragma("unroll") for (int i_ = 0; i_ < 16; ++i_) { const int e_ = __builtin_amdgcn_readlane(idv, (sub) * 16 + i_); buf[i_] = *(const u32x2*)((tab) + (size_t)e_ * 512 + 8 * lane); } } while (0)
#define PW_ACCUM(buf, cv, sub) do { _Pragma("unroll") for (int i_ = 0; i_ < 16; ++i_) { \
            const float cf_ = __builtin_bit_cast(float, __builtin_amdgcn_readlane(__builtin_bit_cast(int, cv), (sub) * 16 + i_)); const f32x2 cf2_ = {cf_, cf_}; \
            _Pragma("unroll") for (int q_ = 0; q_ < 2; ++q_) { acc[4 * q_] += cf2_ * FP4PAIR(buf[i_][q_], 0); acc[4 * q_ + 1] += cf2_ * FP4PAIR(buf[i_][q_], 1); acc[4 * q_ + 2] += cf2_ * FP4PAIR(buf[i_][q_], 2); acc[4 * q_ + 3] += cf2_ * FP4PAIR(buf[i_][q_], 3); } } } while (0)
#define PV_TOK(t_) ((size_t)(F.bx + GRID * ((t_) >> 5)) * 32 + ((t_) & 31))
    const int t0 = F.wave * 16;
    size_t m = PV_TOK(t0);
    u32x4 xa = *(const u32x4*)(XB + m * 1024 + 16 * lane), xb = *(const u32x4*)(XB + m * 1024 + 16 * lane + 8);
    int id0 = IDX[m * 128 + lane], id1 = IDX[m * 128 + 64 + lane];
    PW_ISSUE(A, Vb, id0, 0);
#pragma unroll 1
    for (int it = 0; it < 16; ++it) {
        m = PV_TOK(t0 + it);
        unsigned xp[8];
#pragma unroll
        for (int i = 0; i < 4; ++i) { xp[i] = xa[i]; xp[4 + i] = xb[i]; }
        const float c0 = csw[m * 128 + lane], c1 = csw[m * 128 + 64 + lane];
        const size_t mn = PV_TOK(t0 + (it < 15 ? it + 1 : it));
        const u32x4 nxa = *(const u32x4*)(XB + mn * 1024 + 16 * lane), nxb = *(const u32x4*)(XB + mn * 1024 + 16 * lane + 8);
        const int nid0 = IDX[mn * 128 + lane], nid1 = IDX[mn * 128 + 64 + lane];
        f32x2 acc[8];
#pragma unroll
        for (int q = 0; q < 8; ++q) acc[q] = (f32x2){0.f, 0.f};
        PW_ISSUE(B, Vb, id0, 1); PW_ACCUM(A, c0, 0);
        PW_ISSUE(A, Vb, id0, 2); PW_ACCUM(B, c0, 1);
        PW_ISSUE(B, Vb, id0, 3); PW_ACCUM(A, c0, 2);
        PW_ISSUE(A, Vb, id1, 0); PW_ACCUM(B, c0, 3);
        PW_ISSUE(B, Vb, id1, 1); PW_ACCUM(A, c1, 0);
        PW_ISSUE(A, Vb, id1, 2); PW_ACCUM(B, c1, 1);
        PW_ISSUE(B, Vb, id1, 3); PW_ACCUM(A, c1, 2);
        PW_ISSUE(A, Vb, nid0, 0); PW_ACCUM(B, c1, 3);
        float xo[16]; float s = 0.f;
#pragma unroll
        for (int q = 0; q < 8; ++q) { xo[2 * q] = bflo(xp[q]) + acc[q].x; xo[2 * q + 1] = bfhi(xp[q]) + acc[q].y; }
        if (!last) {
            u32x4 w0, w1;
#pragma unroll
            for (int q = 0; q < 4; ++q) { w0[q] = cvtpk(xo[2 * q], xo[2 * q + 1]); w1[q] = cvtpk(xo[8 + 2 * q], xo[8 + 2 * q + 1]);
                s += (bflo(w0[q]) * bflo(w0[q]) + bfhi(w0[q]) * bfhi(w0[q])) + (bflo(w1[q]) * bflo(w1[q]) + bfhi(w1[q]) * bfhi(w1[q])); }
            s = wave_sum(s);
            *(u32x4*)(XB + (size_t)m * 1024 + 16 * lane) = w0; *(u32x4*)(XB + (size_t)m * 1024 + 16 * lane + 8) = w1;
            if (lane < 16) SS[(size_t)m * 16 + lane] = lane == 0 ? s : 0.f;
        } else {
#pragma unroll
            for (int q = 0; q < 16; ++q) s += xo[q] * xo[q];
            s = wave_sum(s);
            const float rf = 1.0f / sqrtf(s * (1.0f / 1024.0f) + EPS); const float* fg = INP(I_FINAL_G) + 16 * lane; float* xr = F.X + (size_t)m * 1024 + 16 * lane;
#pragma unroll
            for (int q = 0; q < 4; ++q) { const f32x4 gq = *(const f32x4*)(fg + 4 * q); *(f32x4*)(xr + 4 * q) = (f32x4){xo[4 * q], xo[4 * q + 1], xo[4 * q + 2], xo[4 * q + 3]} * rf * gq; }
        }
        xa = nxa; xb = nxb; id0 = nid0; id1 = nid1;
    }
#undef PV_TOK
#undef PW_ISSUE
#undef PW_ACCUM
}

constexpr int PPL = 7;
constexpr int NPHASE = 1 + DEPTH * PPL;
__global__ void __launch_bounds__(NTHR, 2) trunk_fwd(Args args) {
    extern __shared__ __attribute__((aligned(16))) unsigned char lds_raw[];
    Frame F;
    F.lds = (LAS unsigned char*)lds_raw;
    F.tid = threadIdx.x; F.lane = F.tid & 63; F.wave = __builtin_amdgcn_readfirstlane(F.tid >> 6);
    F.bx = blockIdx.x; F.gw = F.bx * NWAVES + F.wave;
    F.X = args.out; F.ws = args.ws;
    const int lo = args.ph_lo, hi = args.ph_hi;
#if MK_ONE_LAUNCH
    volatile LAS unsigned* bst = (volatile LAS unsigned*)(F.lds + LDS_BYTES - 64);
    if (F.tid < 16) bst[F.tid] = 0u;
    __syncthreads();
    const XcdBarrier gbar = xcd_barrier_post((unsigned*)(args.ws + WS_CTL) + 4096, bst);
    cg::this_grid().sync();
#endif
#define REFRESH() int t_ = threadIdx.x; asm volatile("" : "+v"(t_)); F.tid = t_; F.lane = t_ & 63; F.wave = __builtin_amdgcn_readfirstlane(t_ >> 6); \
    F.gw = F.bx * NWAVES + F.wave; size_t z_ = 0; asm volatile("" : "+s"(z_)); unsigned char* ws = args.ws + z_; F.ws = ws; \
    bf16_t* XB = (bf16_t*)(ws + WS_XB); float* SS = (float*)(ws + WS_SS); bf16_t* YC = (bf16_t*)(ws + WS_YCAT); bf16_t* PROJ = (bf16_t*)(ws + WS_PROJ); \
    bf16_t* CQ = PROJ; bf16_t* PP = (bf16_t*)(ws + WS_PROJ + 64 * MiB); int* IDX = (int*)(ws + WS_PROJ + 64 * MiB); float* GW = (float*)(ws + WS_PROJ + 80 * MiB); \
    bf16_t* Wl = (bf16_t*)(ws + WS_W + l * W_LAYER); bf16_t* Kl = (bf16_t*)(ws + WS_KMEM + (size_t)l * 16 * MiB); bf16_t* VTl = Kl + (size_t)4096 * 1024; \
    (void)XB; (void)SS; (void)YC; (void)PROJ; (void)CQ; (void)PP; (void)IDX; (void)GW; (void)Wl; (void)Kl; (void)VTl;
#pragma unroll 1
    for (int ph = lo; ph < hi; ++ph) {
        const int l = ph == 0 ? 0 : (ph - 1) / PPL, k = ph == 0 ? -1 : (ph - 1) % PPL;
        for (int rep = 0; rep < ((k == PROBE_REP_K) ? 2 : 1); ++rep) {
        if (rep) { WG_SYNC(); xcd_barrier(gbar); }
        switch (k) {
        case -1: if (EN(0)) { REFRESH(); p0_prologue(F, args); } break;
        case 0: case 3: case 5: if (EN(1)) {
            REFRESH();
            if (k == 0 && l == 0) {
#pragma unroll 1
                for (int l2 = 0; l2 < DEPTH; ++l2) {
                    bf16_t* W2 = (bf16_t*)(ws + WS_W + l2 * W_LAYER); bf16_t* K2 = (bf16_t*)(ws + WS_KMEM + (size_t)l2 * 16 * MiB);
                    pg8::Gemm g{(const bf16_t*)(ws + WS_MEMB), W2 + W_CKV / 2, 1024, 1024, 1024}; pg8::StaticOrder S; S.init(MMEM, 2048, F.G, (F.bx + 128 * l2) % F.G, 1024, 1024);
                    pg8::EpiKV E{K2, K2 + (size_t)4096 * 1024, (const float*)(ws + WS_RSTDM)};
                    pg8::gemm_phase<pg8::EpiKV, pg8::StaticOrder, true>(F.lds, g, S, E);
                }
            }
            const bf16_t* Bt = Wl + (k == 0 ? W_IN : k == 3 ? W_CQ : W_PQ) / 2; const int N = k == 0 ? NPROJ : 1024, ldc = k == 0 ? LDP : 1024;
            pg8::Gemm g{XB, Bt, 1024, 1024, 1024}; pg8::StaticOrder S; S.init(MTOK, N, F.G, F.bx, 1024, 1024);
            pg8::EpiBf16 E{k == 0 ? PROJ : CQ, ldc, SS, k == 3 ? 0.0625f * LOG2E : 1.0f, ldc};
            pg8::gemm_phase<pg8::EpiBf16, pg8::StaticOrder, true>(F.lds, g, S, E);
            if (k == 3) {
                pg8::Unit u;
                for (int i = 0; S.next(i, u); ++i) xattn_unit(F, CQ, Kl, VTl, YC, u.pm, u.pn);
            }
        } break;
        case 1: {
            REFRESH();
            if (F.bx < 64) { if (EN(2)) gla_chain(F, args, l, F.bx >> 2, F.bx & 3, PROJ, YC); }
            else {
                if (l == 0) {
                    const int wv = (F.bx - 64) * NWAVES + F.wave, nwv = (F.G - 64) * NWAVES;
                    transpose_list(F, args, (LAS float*)(F.lds + F.wave * 16384), wv, nwv, 1);
                    convert_tables(F, args, 0, wv, nwv); convert_tables(F, args, 1, wv, nwv);
                    WG_SYNC();
                }
                if (EN(3)) { for (int u = F.bx - 64; u < 256; u += F.G - 64) sgu_unit(F, args, l, u >> 4, u & 15, PROJ, YC); }
            }
            if (EN(4)) { LAS char* vl = (LAS char*)F.lds + F.wave * 8192; unsigned* ctr = (unsigned*)(ws + WS_CTL) + 15360 + 64 * l;
                for (;;) { int u0 = 0; if (F.lane == 0) u0 = (int)atomicAdd(ctr, 2u); u0 = __builtin_amdgcn_readfirstlane(u0); if (u0 >= BATCH * 8 * 32) break;
                    for (int u = u0; u < u0 + 2; ++u) sb_unit2(PROJ, YC, u >> 8, (u >> 5) & 7, u & 31, vl, F.lane); } }
        } break;
        case 2: case 4: if (EN(5)) {
            REFRESH();
            pg8::Gemm g{YC, Wl + (k == 2 ? W_OUT : W_CO) / 2, 1024, 1024, 1024}; pg8::StaticOrder S; S.init(MTOK, 1024, F.G, F.bx, 1024, 1024);
            pg8::EpiResid E{XB, SS};
            pg8::gemm_phase<pg8::EpiResid, pg8::StaticOrder, true>(F.lds, g, S, E);
        } break;
        default: if (EN(12)) {
            REFRESH();
            const unsigned char* Ub = ws + WS_TAB + (size_t)l * 16 * MiB; const unsigned char* Vb = Ub + 8 * MiB;
            const bf16_t* SK = (const bf16_t*)(ws + WS_SUBK) + (size_t)l * 8 * 2 * 128 * 64;
            const unsigned* SCTg = (const unsigned*)(ws + WS_TAB + 32 * MiB + (size_t)l * 65536);
            float* cs = (float*)(ws + WS_PROJ + 96 * MiB);
            if (F.tid < 8) ((volatile LAS unsigned*)(F.lds + PJ_FLG))[F.tid] = 0u;
            LDS_SYNC();
#pragma unroll 1
            for (int st = 0; st < PJ_T0; ++st) {
                unsigned tA[2][16];
                route_level1(CQ, SK, F.bx + GRID * st, F.wave, F.lane, tA);
                route_level2(tA, (size_t)(F.bx + GRID * st) * 32 + (F.lane & 31), F.wave, F.lane, IDX, GW, nullptr, nullptr, (LAS char*)F.lds + PJ_SCR0 + F.wave * 3072);
                asm volatile("s_waitcnt vmcnt(0)" ::: "memory");
                if (F.lane == 0) __atomic_fetch_add((LAS unsigned*)(F.lds + PJ_FLG) + st, 1u, __ATOMIC_RELAXED);
            }
            if (F.wave < PJ_NR) {
#pragma unroll 1
                for (int st = PJ_T0; st < 4; ++st) {
#pragma unroll 1
                    for (int hq = 0; hq < 8 / (2 * PJ_NR); ++hq) route_heads(CQ, SK, IDX, GW, F.bx + GRID * st, (8 / PJ_NR) * F.wave + 2 * hq, F.lane, (LAS char*)F.lds + PJ_SCR + F.wave * 3072);
                    asm volatile("s_waitcnt vmcnt(0)" ::: "memory");
                    if (F.lane == 0) __atomic_fetch_add((LAS unsigned*)(F.lds + PJ_FLG) + st, 1u, __ATOMIC_RELAXED);
                }
            }
            peer_u_stream(F, Ub, SCTg, IDX, GW, XB, SS, F.wave, cs);
            WG_SYNC();
            peer_v_pass(F, args, l == DEPTH - 1, Vb, IDX, XB, SS, cs);
        } break;
        }
        }
        WG_SYNC();
#if MK_ONE_LAUNCH
        if (ph + 1 < hi) xcd_barrier(gbar);
#endif
    }
#undef REFRESH
}

extern "C" void kernel_launch(void* const* d_in, const int* in_sizes, int n_in, void* d_out, int out_size, void* d_ws, size_t ws_size, hipStream_t stream) {
    static int grid = 0;
    if (grid == 0) {
        if (n_in != 22 || out_size != MTOK * DM || ws_size < WS_END) { fprintf(stderr, "kernel_launch: unexpected problem (n_in %d out %d ws %zu)\n", n_in, out_size, ws_size); grid = -1; return; }
        int dev = 0, cus = 0, per_cu = 0;
        if (hipGetDevice(&dev) != hipSuccess || hipDeviceGetAttribute(&cus, hipDeviceAttributeMultiprocessorCount, dev) != hipSuccess) { grid = -1; return; }
        if (hipFuncSetAttribute((const void*)trunk_fwd, hipFuncAttributeMaxDynamicSharedMemorySize, LDS_BYTES) != hipSuccess) { fprintf(stderr, "kernel_launch: hipFuncSetAttribute failed\n"); grid = -1; return; }
        if (hipOccupancyMaxActiveBlocksPerMultiprocessor(&per_cu, (const void*)trunk_fwd, NTHR, LDS_BYTES) != hipSuccess || per_cu < 1) { fprintf(stderr, "kernel_launch: occupancy query says %d\n", per_cu); (void)hipGetLastError(); grid = -1; return; }
        if (cus * per_cu < GRID) { fprintf(stderr, "kernel_launch: built for a %d-workgroup resident grid, this device holds %d\n", GRID, cus * per_cu); grid = -1; return; }
        grid = GRID;
    }
    if (grid < 0) return;
    Args a{};
    for (int i = 0; i < 22; ++i) a.in[i] = (const float*)d_in[i];
    a.out = (float*)d_out; a.ws = (unsigned char*)d_ws;
#if MK_ONE_LAUNCH
    if (hipMemsetAsync((char*)d_ws + WS_CTL, 0, 65536, stream) != hipSuccess) { fprintf(stderr, "kernel_launch: memset of the control words failed\n"); return; }
    a.ph_lo = 0; a.ph_hi = NPHASE;
    void* kargs[] = {&a};
    hipError_t e = hipLaunchCooperativeKernel((const void*)trunk_fwd, dim3(grid), dim3(NTHR), kargs, LDS_BYTES, stream);
    if (e != hipSuccess) fprintf(stderr, "cooperative launch failed: %s (grid %d)\n", hipGetErrorString(e), grid);
#else
    for (int p = 0; p < NPHASE; ++p) { a.ph_lo = p; a.ph_hi = p + 1; hipLaunchKernelGGL(trunk_fwd, dim3(grid), dim3(NTHR), LDS_BYTES, stream, a); }
#endif
}
```

```cpp
#include <hip/hip_runtime.h>
#include <hip/hip_cooperative_groups.h>
#include <cstdio>
#include <cstdint>
#include <cmath>
namespace cg = cooperative_groups;

#ifndef PHMASK
#define PHMASK 0xFFFF
#endif
#define EN(n) (((PHMASK) >> (n)) & 1)
#ifndef PROBE_REP_K
#define PROBE_REP_K (-2)
#endif
#ifndef MK_ONE_LAUNCH
#define MK_ONE_LAUNCH 1
#endif

#define LAS __attribute__((address_space(3)))
typedef unsigned short bf16_t;
typedef short bf16x8 __attribute__((ext_vector_type(8)));
typedef short s16x4 __attribute__((ext_vector_type(4)));
typedef short v4i16_t __attribute__((ext_vector_type(4)));
typedef float f32x4 __attribute__((ext_vector_type(4)));
typedef float f32x2 __attribute__((ext_vector_type(2)));
typedef float f32x16 __attribute__((ext_vector_type(16)));
typedef unsigned u32x4 __attribute__((ext_vector_type(4)));
typedef unsigned u32x2 __attribute__((ext_vector_type(2)));
typedef __bf16 bf16x2_t __attribute__((ext_vector_type(2)));
#define DI __device__ __forceinline__
#define MFMA32(a, b, c) __builtin_amdgcn_mfma_f32_32x32x16_bf16((a), (b), (c), 0, 0, 0)

constexpr int BATCH = 16, SEQ = 2048, DM = 1024, MTOK = BATCH * SEQ, DEPTH = 2;
constexpr int NMEM = 256, MMEM = BATCH * NMEM;
constexpr int INW = 2832, LDP = 2944, NPROJ = 3072;
constexpr int C_SBQ = 0, C_SBK = 512, C_SBV = 1024, C_SGU = 1536, C_SGV = 1792, C_GQ = 2048, C_GK = 2176, C_GV = 2304, C_GO = 2560, C_GA = 2816;
constexpr float EPS = 1e-6f;
constexpr float LOG2E = 1.4426950408889634f;

constexpr size_t MiB = 1u << 20;
constexpr size_t WS_CTL = 0;
constexpr size_t WS_SUBK = 1 * MiB;
constexpr size_t WS_WSP = WS_SUBK + 512 * 1024;
constexpr size_t WS_RSTDM = WS_WSP + 256 * 1024;
constexpr size_t WS_SS = 2 * MiB;
constexpr size_t WS_W = 8 * MiB;
constexpr size_t W_IN = 0, W_OUT = 6 * MiB, W_CQ = 8 * MiB, W_CKV = 10 * MiB, W_CO = 14 * MiB, W_PQ = 16 * MiB, W_LAYER = 18 * MiB;
constexpr size_t WS_MEMB = 44 * MiB;
constexpr size_t WS_KMEM = 52 * MiB;
constexpr size_t WS_TAB = 84 * MiB;
constexpr size_t WS_XB = 148 * MiB;
constexpr size_t WS_YCAT = 212 * MiB;
constexpr size_t WS_PROJ = 276 * MiB;
constexpr size_t WS_GKV = 460 * MiB;
constexpr size_t WS_GD = 468 * MiB;
constexpr size_t WS_END = 469 * MiB;

DI unsigned cvtpk(float lo, float hi) { f32x2 v = {lo, hi}; bf16x2_t b = __builtin_convertvector(v, bf16x2_t); return __builtin_bit_cast(unsigned, b); }
DI bf16_t cvt1(float v) { return (bf16_t)(cvtpk(v, 0.f) & 0xffffu); }
DI float bf2f(unsigned short b) { return __uint_as_float((unsigned)b << 16); }
DI float bflo(unsigned w) { return __uint_as_float(w << 16); }
DI float bfhi(unsigned w) { return __uint_as_float(w & 0xffff0000u); }
DI int crow(int r, int hi) { return (r & 3) + 8 * (r >> 2) + 4 * hi; }
DI float fexp2(float x) { return __builtin_amdgcn_exp2f(x); }
DI float flog2(float x) { return __builtin_amdgcn_logf(x); }
DI float frcp(float x) { return __builtin_amdgcn_rcpf(x); }
DI float gelu_tanh(float x) { const float y2 = x * (1.5957691216057308f + 0.0713548162726009f * x * x); return x * frcp(1.f + fexp2(-y2 * LOG2E)); }
DI float silu(float x) { return x * frcp(1.f + fexp2(-x * LOG2E)); }
#define DPP_F(v_, ctrl_) __builtin_bit_cast(float, __builtin_amdgcn_update_dpp(0, __builtin_bit_cast(int, (v_)), (ctrl_), 0xF, 0xF, false))
DI float wave_sum(float v) {
    v += DPP_F(v, 0xB1); v += DPP_F(v, 0x4E); v += DPP_F(v, 0x141); v += DPP_F(v, 0x140);
    const int vi = __builtin_bit_cast(int, v);
    return (__builtin_bit_cast(float, __builtin_amdgcn_readlane(vi, 0)) + __builtin_bit_cast(float, __builtin_amdgcn_readlane(vi, 16)))
         + (__builtin_bit_cast(float, __builtin_amdgcn_readlane(vi, 32)) + __builtin_bit_cast(float, __builtin_amdgcn_readlane(vi, 48)));
}
DI void pl32_pair(u32x2& a, u32x2& b) {
    const auto r0 = __builtin_amdgcn_permlane32_swap(a.x, b.x, false, false); const auto r1 = __builtin_amdgcn_permlane32_swap(a.y, b.y, false, false);
    a.x = r0[0]; b.x = r0[1]; a.y = r1[0]; b.y = r1[1];
}
DI void store_row32(bf16_t* rowbase  , int hh, u32x2 w0, u32x2 w1, u32x2 w2, u32x2 w3) {
    pl32_pair(w0, w1); pl32_pair(w2, w3);
    bf16_t* p = rowbase + 8 * hh;
    *(u32x4*)p = (u32x4){w0.x, w0.y, w1.x, w1.y}; *(u32x4*)(p + 16) = (u32x4){w2.x, w2.y, w3.x, w3.y};
}
DI void load_row32(const bf16_t* rowbase, int hh, u32x2& w0, u32x2& w1, u32x2& w2, u32x2& w3) {
    const bf16_t* p = rowbase + 8 * hh;
    const u32x4 v0 = *(const u32x4*)p, v1 = *(const u32x4*)(p + 16);
    w0 = (u32x2){v0.x, v0.y}; w1 = (u32x2){v0.z, v0.w}; w2 = (u32x2){v1.x, v1.y}; w3 = (u32x2){v1.z, v1.w};
    pl32_pair(w0, w1); pl32_pair(w2, w3);
}
DI s16x4 vtr(LAS const char* p) { return __builtin_bit_cast(s16x4, __builtin_amdgcn_ds_read_tr16_b64_v4i16((LAS v4i16_t*)p)); }
DI bf16x8 cat8(s16x4 lo, s16x4 hi) { return __builtin_shufflevector(lo, hi, 0, 1, 2, 3, 4, 5, 6, 7); }
DI bf16x8 pack8(float a0, float a1, float a2, float a3, float a4, float a5, float a6, float a7) {
    u32x4 p; p[0] = cvtpk(a0, a1); p[1] = cvtpk(a2, a3); p[2] = cvtpk(a4, a5); p[3] = cvtpk(a6, a7); return __builtin_bit_cast(bf16x8, p);
}
#define LDS_WAIT() asm volatile("s_waitcnt lgkmcnt(0)" ::: "memory")
#define LDS_SYNC() do { asm volatile("s_waitcnt lgkmcnt(0)" ::: "memory"); __builtin_amdgcn_s_barrier(); asm volatile("" ::: "memory"); } while (0)
#define WG_SYNC() do { asm volatile("s_waitcnt vmcnt(0) lgkmcnt(0)" ::: "memory"); __builtin_amdgcn_s_barrier(); asm volatile("" ::: "memory"); } while (0)

namespace pg8 {
constexpr int BM = 256, BK = 64, HALF = 128, HTB = HALF * BK * 2, STAGE_BYTES = 8 * HTB, NXCD = 8, WGM = 8;
__host__ __device__ __forceinline__ int lds_byte(int r, int c) { const int st = (r >> 4) * 2 + (c >> 5), rr = r & 15, cc = c & 31, ob = rr * 64 + cc * 2; return st * 1024 + (ob ^ (((ob >> 9) & 1) << 5)); }
__host__ __device__ __forceinline__ void stage_rc(int b, int& R, int& C) { const int st = b / 1024, sb = b % 1024, swz = sb ^ (((sb >> 9) & 1) << 5); R = (st >> 1) * 16 + swz / 64; C = (st & 1) * 32 + (swz % 64) / 2; }
__host__ __device__ __forceinline__ int perm32(int rho) { const int n = rho >> 4, i = rho & 15; return 8 * (i >> 2) + 4 * n + (i & 3); }

struct Unit { int pm, pn; size_t aoff, boff; };
struct Gemm { const bf16_t* A; const bf16_t* Bt; int lda, ldb, K; };

struct StaticOrder {
    int nM, nN, nwg, G, c, lda, ldb;
    __device__ void init(int M, int N, int G_, int c_, int lda_, int ldb_) { nM = M / BM; nN = N / BM; nwg = nM * nN; G = G_; c = c_; lda = lda_; ldb = ldb_; }
    __device__ bool next(int i, Unit& u) const {
        const long L = (long)i * G + c; if (L >= nwg) return false;
        int wgid = (int)L; { const int q = nwg / NXCD, r = nwg % NXCD, xcd = wgid % NXCD, off = wgid / NXCD; wgid = (xcd < r ? xcd * (q + 1) : r * (q + 1) + (xcd - r) * q) + off; }
        const int nig = WGM * nN, gid = wgid / nig, fm = gid * WGM, gsz = (nM - fm) < WGM ? (nM - fm) : WGM;
        u.pm = fm + ((wgid % nig) % gsz); u.pn = (wgid % nig) / gsz;
        u.aoff = (size_t)u.pm * BM * lda; u.boff = (size_t)u.pn * BM * ldb; return true;
    }
};
struct XOrder {
    int G, c, mode;
    __device__ bool next(int i, Unit& u) const {
        const int L = i * G + c; if (L >= 512) return false;
        u.pm = L >> 2; u.pn = L & 3; const int b = u.pm >> 3;
        u.aoff = (size_t)u.pm * 256 * 1024 + u.pn * 256;
        u.boff = mode == 0 ? (size_t)b * 256 * 1024 + u.pn * 256 : (size_t)(b * 4 + u.pn) * 256 * 256;
        return true;
    }
};

struct XOrder2 {
    StaticOrder S; int mode;
    __device__ bool next(int i, Unit& u) const {
        if (!S.next(i, u)) return false; const int b = u.pm >> 3;
        u.aoff = (size_t)u.pm * 256 * 1024 + u.pn * 256;
        u.boff = mode == 0 ? (size_t)b * 256 * 1024 + u.pn * 256 : (size_t)(b * 4 + u.pn) * 256 * 256;
        return true;
    }
};

DI float row_rstd_from_ss(const float* ss, int row, int fq) {
    const f32x4 v = *(const f32x4*)(ss + (size_t)row * 16 + 4 * fq);
    float s = (v[0] + v[1]) + (v[2] + v[3]); s += __shfl_xor(s, 16); s += __shfl_xor(s, 32);
    return 1.0f / sqrtf(s * (1.0f / 1024.0f) + EPS);
}
struct EpiBf16 {
    static constexpr bool PERM = true;
    bf16_t* O; int ldc; const float* ss; float cscale; int ncols;
    DI void operator()(f32x4 (&acc)[2][2][4][2], const Unit& u, int wr, int wc, int fr, int fq) const {
        const int row0 = u.pm * BM + wr * 64 + fr, col0 = u.pn * BM + wc * 32 + 8 * fq;
        float rsv[2][4];
        { f32x4 pv[2][4];
#pragma unroll
          for (int ai = 0; ai < 2; ++ai)
#pragma unroll
              for (int m = 0; m < 4; ++m) pv[ai][m] = ss ? *(const f32x4*)(ss + (size_t)(row0 + ai * HALF + m * 16) * 16 + 4 * fq) : (f32x4){0.f, 0.f, 0.f, 0.f};
#pragma unroll
          for (int ai = 0; ai < 2; ++ai)
#pragma unroll
              for (int m = 0; m < 4; ++m) { float sq = (pv[ai][m][0] + pv[ai][m][1]) + (pv[ai][m][2] + pv[ai][m][3]); sq += __shfl_xor(sq, 16); sq += __shfl_xor(sq, 32);
                  rsv[ai][m] = ss ? cscale * __builtin_amdgcn_rsqf(sq * (1.0f / 1024.0f) + EPS) : cscale; } }
#pragma unroll
        for (int ai = 0; ai < 2; ++ai)
#pragma unroll
            for (int m = 0; m < 4; ++m) {
                const int row = row0 + ai * HALF + m * 16;
                const float rs = rsv[ai][m];
                bf16_t* rowp = O + (size_t)row * ldc + col0;
#pragma unroll
                for (int bj = 0; bj < 2; ++bj) if (col0 + bj * HALF < ncols) {
                    const f32x4 v0 = acc[ai][bj][m][0] * rs, v1 = acc[ai][bj][m][1] * rs;
                    u32x4 w; w.x = cvtpk(v0[0], v0[1]); w.y = cvtpk(v0[2], v0[3]); w.z = cvtpk(v1[0], v1[1]); w.w = cvtpk(v1[2], v1[3]);
                    *(u32x4*)(rowp + bj * HALF) = w; }
            }
    }
};
struct EpiKV {
    static constexpr bool PERM = true;
    bf16_t* Kd; bf16_t* VT; const float* rvec;
    DI void operator()(f32x4 (&acc)[2][2][4][2], const Unit& u, int wr, int wc, int fr, int fq) const {
        const int row0 = u.pm * BM + wr * 64 + fr;
        float rsv[2][4];
#pragma unroll
        for (int ai = 0; ai < 2; ++ai)
#pragma unroll
            for (int m = 0; m < 4; ++m) rsv[ai][m] = rvec[row0 + ai * HALF + m * 16];
#pragma unroll
        for (int ai = 0; ai < 2; ++ai)
#pragma unroll
            for (int m = 0; m < 4; ++m) {
                const int row = row0 + ai * HALF + m * 16; const float rs = rsv[ai][m];
#pragma unroll
                for (int bj = 0; bj < 2; ++bj) {
                    const f32x4 v0 = acc[ai][bj][m][0] * rs, v1 = acc[ai][bj][m][1] * rs;
                    const unsigned w0 = cvtpk(v0[0], v0[1]), w1 = cvtpk(v0[2], v0[3]), w2 = cvtpk(v1[0], v1[1]), w3 = cvtpk(v1[2], v1[3]);
                    if (u.pn < 4) {
                        u32x4 w; w.x = w0; w.y = w1; w.z = w2; w.w = w3;
                        *(u32x4*)(Kd + (size_t)row * 1024 + u.pn * BM + bj * HALF + wc * 32 + 8 * fq) = w;
                    } else {
                        const int key = row & 255, dv0 = bj * HALF + wc * 32 + 8 * fq;
                        bf16_t* p = VT + ((size_t)(u.pm * 4 + (u.pn - 4)) * 256 + dv0) * 256 + key;
                        p[0 * 256] = (bf16_t)w0; p[1 * 256] = (bf16_t)(w0 >> 16); p[2 * 256] = (bf16_t)w1; p[3 * 256] = (bf16_t)(w1 >> 16);
                        p[4 * 256] = (bf16_t)w2; p[5 * 256] = (bf16_t)(w2 >> 16); p[6 * 256] = (bf16_t)w3; p[7 * 256] = (bf16_t)(w3 >> 16);
                    }
                }
            }
    }
};
struct EpiResid {
    static constexpr bool PERM = true;
    bf16_t* XB; float* ss;
    DI void operator()(f32x4 (&acc)[2][2][4][2], const Unit& u, int wr, int wc, int fr, int fq) const {
        const int row0 = u.pm * BM + wr * 64 + fr, col0 = u.pn * BM + wc * 32 + 8 * fq;
        float sv[2][4];
#pragma unroll
        for (int ai = 0; ai < 2; ++ai) {
        u32x4 ov[4][2];
#pragma unroll
        for (int m = 0; m < 4; ++m)
#pragma unroll
            for (int bj = 0; bj < 2; ++bj) ov[m][bj] = *(const u32x4*)(XB + (size_t)(row0 + ai * HALF + m * 16) * 1024 + col0 + bj * HALF);
#pragma unroll
            for (int m = 0; m < 4; ++m) {
                const int row = row0 + ai * HALF + m * 16; float s = 0.f;
#pragma unroll
                for (int bj = 0; bj < 2; ++bj) {
                    const size_t off = (size_t)row * 1024 + col0 + bj * HALF;
                    const u32x4 o = ov[m][bj]; const f32x4 a0 = acc[ai][bj][m][0], a1 = acc[ai][bj][m][1];
                    u32x4 w; w.x = cvtpk(bflo(o.x) + a0[0], bfhi(o.x) + a0[1]); w.y = cvtpk(bflo(o.y) + a0[2], bfhi(o.y) + a0[3]);
                    w.z = cvtpk(bflo(o.z) + a1[0], bfhi(o.z) + a1[1]); w.w = cvtpk(bflo(o.w) + a1[2], bfhi(o.w) + a1[3]);
                    *(u32x4*)(XB + off) = w;
#pragma unroll
                    for (int q = 0; q < 4; ++q) { const float x0 = bflo(w[q]), x1 = bfhi(w[q]); s += x0 * x0 + x1 * x1; }
                }
                sv[ai][m] = s;
            }
        }
#pragma unroll
        for (int ai = 0; ai < 2; ++ai)
#pragma unroll
            for (int m = 0; m < 4; ++m) { float s = sv[ai][m]; s += __shfl_xor(s, 16); s += __shfl_xor(s, 32);
                if (fq == 0) ss[(size_t)(row0 + ai * HALF + m * 16) * 16 + u.pn * 4 + wc] = s; }
    }
};
struct EpiSoftmax {
    static constexpr bool PERM = true;
    bf16_t* P; LAS float* xm; LAS float* xs;
    DI void operator()(f32x4 (&acc)[2][2][4][2], const Unit& u, int wr, int wc, int fr, int fq) const {
#pragma unroll
        for (int ai = 0; ai < 2; ++ai)
#pragma unroll
            for (int m = 0; m < 4; ++m) {
                float v = -INFINITY;
#pragma unroll
                for (int bj = 0; bj < 2; ++bj)
#pragma unroll
                    for (int n = 0; n < 2; ++n) { const f32x4 x = acc[ai][bj][m][n]; v = fmaxf(v, fmaxf(fmaxf(x[0], x[1]), fmaxf(x[2], x[3]))); }
                v = fmaxf(v, __shfl_xor(v, 16)); v = fmaxf(v, __shfl_xor(v, 32));
                if (fq == 0) xm[(ai * HALF + wr * 64 + m * 16 + fr) * 4 + wc] = v;
            }
        LDS_WAIT(); __builtin_amdgcn_s_barrier(); asm volatile("" ::: "memory");
#pragma unroll
        for (int ai = 0; ai < 2; ++ai)
#pragma unroll
            for (int m = 0; m < 4; ++m) {
                const f32x4 q = *(LAS const f32x4*)(xm + (ai * HALF + wr * 64 + m * 16 + fr) * 4);
                const float g = fmaxf(fmaxf(q[0], q[1]), fmaxf(q[2], q[3])); float s = 0.f;
#pragma unroll
                for (int bj = 0; bj < 2; ++bj)
#pragma unroll
                    for (int n = 0; n < 2; ++n) { f32x4 x = acc[ai][bj][m][n]; x[0] = fexp2(x[0] - g); x[1] = fexp2(x[1] - g); x[2] = fexp2(x[2] - g); x[3] = fexp2(x[3] - g); acc[ai][bj][m][n] = x; s += (x[0] + x[1]) + (x[2] + x[3]); }
                s += __shfl_xor(s, 16); s += __shfl_xor(s, 32);
                if (fq == 0) xs[(ai * HALF + wr * 64 + m * 16 + fr) * 4 + wc] = s;
            }
        LDS_WAIT(); __builtin_amdgcn_s_barrier(); asm volatile("" ::: "memory");
        const int row0 = u.pm * BM + wr * 64 + fr, col0 = u.pn * BM + wc * 32 + 8 * fq;
#pragma unroll
        for (int ai = 0; ai < 2; ++ai)
#pragma unroll
            for (int m = 0; m < 4; ++m) {
                const f32x4 q = *(LAS const f32x4*)(xs + (ai * HALF + wr * 64 + m * 16 + fr) * 4);
                const float inv = 1.0f / ((q[0] + q[1]) + (q[2] + q[3]));
                bf16_t* rowp = P + (size_t)(row0 + ai * HALF + m * 16) * 1024 + col0;
#pragma unroll
                for (int bj = 0; bj < 2; ++bj) {
                    const f32x4 v0 = acc[ai][bj][m][0] * inv, v1 = acc[ai][bj][m][1] * inv;
                    u32x4 w; w.x = cvtpk(v0[0], v0[1]); w.y = cvtpk(v0[2], v0[3]); w.z = cvtpk(v1[0], v1[1]); w.w = cvtpk(v1[2], v1[3]);
                    *(u32x4*)(rowp + bj * HALF) = w; }
            }
    }
};

template <class Epi, class Sched, bool ALIGN_EPI>
__device__ __forceinline__ void gemm_phase(LAS unsigned char* lds, const Gemm g, const Sched& S, const Epi& E) {
    int tid = threadIdx.x; asm volatile("" : "+v"(tid));
    const int wid = __builtin_amdgcn_readfirstlane(tid >> 6), lane = tid & 63, wr = wid >> 2, wc = wid & 3, fr = lane & 15, fq = lane >> 4;
    const int K = g.K, nt = K / BK;
    unsigned voffA[2], voffB[2];
#pragma unroll
    for (int i = 0; i < 2; ++i) { int R, C; stage_rc(tid * 16 + i * 8192, R, C); const int Rb = Epi::PERM ? ((R & ~31) + perm32(R & 31)) : R;
        voffA[i] = (unsigned)(R * g.lda + C) * 2u; voffB[i] = (unsigned)(Rb * g.ldb + C) * 2u; }
    const size_t kstep = (size_t)(BK * 2);
    const size_t hstepA = (size_t)HALF * g.lda * 2, hstepB = (size_t)HALF * g.ldb * 2;
    const unsigned ldsw = (unsigned)wid * 1024u;
    const int aoff = lds_byte(wr * 64 + fr, fq * 8), boff = lds_byte(wc * 32 + fr, fq * 8);
#define PG8_SA(b, h) (((b) * 2 + (h)) * HTB)
#define PG8_SB(b, h) ((4 + (b) * 2 + (h)) * HTB)
#define PG8_STAGE(bufoff, gbase, voff) do { _Pragma("unroll") for (int _i = 0; _i < 2; ++_i) \
        __builtin_amdgcn_global_load_lds((const unsigned*)((const char*)(gbase) + (voff)[_i]), (LAS unsigned*)(lds + (bufoff) + ldsw + _i * 8192), 16, 0, 0); } while (0)
#define PG8_LDA(dst, b, h) do { _Pragma("unroll") for (int m = 0; m < 4; ++m) _Pragma("unroll") for (int k = 0; k < 2; ++k) dst[m][k] = *(const LAS bf16x8*)(lds + PG8_SA(b, h) + aoff + m * 2048 + k * 1024); } while (0)
#define PG8_LDB(dst, b, h) do { _Pragma("unroll") for (int n = 0; n < 2; ++n) _Pragma("unroll") for (int k = 0; k < 2; ++k) dst[n][k] = *(const LAS bf16x8*)(lds + PG8_SB(b, h) + boff + n * 2048 + k * 1024); } while (0)
#define PG8_MMA(ai, bj, At, Bt) do { __builtin_amdgcn_s_setprio(1); _Pragma("unroll") for (int m = 0; m < 4; ++m) _Pragma("unroll") for (int n = 0; n < 2; ++n) _Pragma("unroll") for (int k = 0; k < 2; ++k) \
        acc[ai][bj][m][n] = __builtin_amdgcn_mfma_f32_16x16x32_bf16(Bt[n][k], At[m][k], acc[ai][bj][m][n], 0, 0, 0); __builtin_amdgcn_s_setprio(0); } while (0)
#define PG8_WAIT_V(n) asm volatile("s_waitcnt vmcnt(" #n ")" ::: "memory")
#define PG8_WAIT_L(n) asm volatile("s_waitcnt lgkmcnt(" #n ")" ::: "memory")
#define PG8_BAR __builtin_amdgcn_s_barrier()
#define PG8_SCHED __builtin_amdgcn_sched_barrier(0)
    Unit cur, nxt; int ui = 0;
    if (!S.next(0, cur)) return;
    f32x4 acc[2][2][4][2];
#pragma unroll
    for (int a = 0; a < 2; ++a)
#pragma unroll
        for (int b = 0; b < 2; ++b)
#pragma unroll
            for (int m = 0; m < 4; ++m)
#pragma unroll
                for (int n = 0; n < 2; ++n) acc[a][b][m][n] = (f32x4){0.f, 0.f, 0.f, 0.f};
    bf16x8 At[4][2], B0[2][2], B1[2][2];
    const char* cA = (const char*)g.A + cur.aoff * 2; const char* cB = (const char*)g.Bt + cur.boff * 2;
    PG8_STAGE(PG8_SB(0, 0), cB, voffB); PG8_STAGE(PG8_SB(0, 1), cB + hstepB, voffB); PG8_STAGE(PG8_SA(0, 0), cA, voffA); PG8_STAGE(PG8_SA(0, 1), cA + hstepA, voffA);
    if (wr == 1) PG8_BAR;
    PG8_WAIT_V(2); PG8_BAR;
    PG8_STAGE(PG8_SB(1, 0), cB + kstep, voffB); PG8_STAGE(PG8_SA(1, 0), cA + kstep, voffA); PG8_STAGE(PG8_SB(1, 1), cB + hstepB + kstep, voffB);
    PG8_WAIT_V(6); PG8_BAR;
    for (;;) {
        const bool has_next = S.next(ui + 1, nxt);
        const char* nA = has_next ? (const char*)g.A + nxt.aoff * 2 : cA; const char* nB = has_next ? (const char*)g.Bt + nxt.boff * 2 : cB;
#pragma unroll 1
        for (int t = 0; t < nt; t += 2) {
            const bool last = (t == nt - 2);
            const char* a1 = cA + (size_t)(t + 1) * kstep;
            const char* a2 = last ? nA : cA + (size_t)(t + 2) * kstep; const char* b2 = last ? nB : cB + (size_t)(t + 2) * kstep;
            const char* a3 = a2 + kstep; const char* b3 = b2 + kstep;
            PG8_LDB(B0, 0, 0); PG8_LDB(B1, 0, 1); PG8_SCHED; PG8_LDA(At, 0, 0); PG8_STAGE(PG8_SA(1, 1), a1 + hstepA, voffA);
            PG8_WAIT_V(8); PG8_WAIT_L(0); PG8_BAR; PG8_MMA(0, 0, At, B0); PG8_MMA(0, 1, At, B1); PG8_BAR; PG8_SCHED;
            PG8_LDA(At, 0, 1); PG8_STAGE(PG8_SB(0, 0), b2, voffB); PG8_STAGE(PG8_SB(0, 1), b2 + hstepB, voffB); PG8_STAGE(PG8_SA(0, 0), a2, voffA);
            PG8_WAIT_V(8); PG8_WAIT_L(0); PG8_BAR; PG8_MMA(1, 0, At, B0); PG8_MMA(1, 1, At, B1); PG8_BAR; PG8_SCHED;
            PG8_LDB(B0, 1, 0); PG8_LDB(B1, 1, 1); PG8_SCHED; PG8_LDA(At, 1, 0); PG8_STAGE(PG8_SA(0, 1), a2 + hstepA, voffA);
            PG8_WAIT_V(8); PG8_WAIT_L(0); PG8_BAR; PG8_MMA(0, 0, At, B0); PG8_MMA(0, 1, At, B1); PG8_BAR; PG8_SCHED;
            PG8_LDA(At, 1, 1); PG8_STAGE(PG8_SB(1, 0), b3, voffB); PG8_STAGE(PG8_SB(1, 1), b3 + hstepB, voffB); PG8_STAGE(PG8_SA(1, 0), a3, voffA);
            PG8_WAIT_V(8); PG8_WAIT_L(0); PG8_BAR; PG8_MMA(1, 0, At, B0); PG8_MMA(1, 1, At, B1); PG8_BAR; PG8_SCHED;
        }
        if constexpr (ALIGN_EPI) { if (wr == 0) PG8_BAR; }
        E(acc, cur, wr, wc, fr, fq);
        if (!has_next) break;
#pragma unroll
        for (int a = 0; a < 2; ++a)
#pragma unroll
            for (int b = 0; b < 2; ++b)
#pragma unroll
                for (int m = 0; m < 4; ++m)
#pragma unroll
                    for (int n = 0; n < 2; ++n) acc[a][b][m][n] = (f32x4){0.f, 0.f, 0.f, 0.f};
        cur = nxt; cA = nA; cB = nB; ++ui;
        if constexpr (ALIGN_EPI) { if (wr == 1) PG8_BAR; }
    }
    PG8_WAIT_V(0);
    if constexpr (!ALIGN_EPI) { if (wr == 0) PG8_BAR; }
    PG8_BAR;
#undef PG8_SA
#undef PG8_SB
#undef PG8_STAGE
#undef PG8_LDA
#undef PG8_LDB
#undef PG8_MMA
#undef PG8_WAIT_V
#undef PG8_WAIT_L
#undef PG8_BAR
#undef PG8_SCHED
}
}

constexpr int NWAVES = 8, NTHR = 512, GRID = 256;
constexpr int RING_BYTES = 131072, XCH_OFF = RING_BYTES, LDS_BYTES = 147456;
struct Args { const float* in[22]; float* out; unsigned char* ws; int ph_lo, ph_hi; };
enum { I_X = 0, I_MEM, I_NORM_MIX, I_W_IN, I_SG_VG, I_SG_W, I_SG_B, I_GLA_WG, I_GLA_BG, I_GLA_OG, I_W_OUT, I_NORM_MEM, I_MEM_GAIN, I_W_CQ, I_W_CKV, I_W_CO, I_NORM_FFN, I_PEER_WQ, I_PEER_SK, I_PEER_U, I_PEER_V, I_FINAL_G };

struct Frame {
    LAS unsigned char* lds; int tid, lane, wave, bx, gw; static constexpr int G = GRID, NGW = GRID * NWAVES;
    float* X; unsigned char* ws;
};
#define INP(i) (args.in[(i)])

#define XB_TMO      128
#define XB_XCNT(j)  (256  + 64 * (j))
#define XB_XSUB(j)  (1280 + 64 * (j))
#define XB_XGEN(j)  (2304 + 64 * (j))
#define XB_TOP      3328
#define XB_TOPGEN   3392
#define XCD_BAR_WORDS 3456
#define XB_SPIN_CAP (1u << 22)
DI unsigned xb_ld(unsigned* p)              { return __hip_atomic_load(p, __ATOMIC_RELAXED, __HIP_MEMORY_SCOPE_AGENT); }
DI unsigned xb_add(unsigned* p, unsigned v) { return __hip_atomic_fetch_add(p, v, __ATOMIC_RELAXED, __HIP_MEMORY_SCOPE_AGENT); }
DI unsigned xb_xcc_id() { return (unsigned)__builtin_amdgcn_s_getreg((3 << 11) | 20) & 0xFu; }
#define XB_SPIN(cond, bar) do { unsigned _sp = 0; while (cond) { __builtin_amdgcn_s_sleep(1); \
    if ((++_sp & 255u) == 0u) { if (xb_ld(&(bar)[XB_TMO])) break; if (_sp > XB_SPIN_CAP) { atomicAdd(&(bar)[XB_TMO], 1u); break; } } } } while (0)
struct XcdBarrier { unsigned* bar; unsigned x; volatile LAS unsigned* st; };
DI XcdBarrier xcd_barrier_post(unsigned* bar, volatile LAS unsigned* st) {
    XcdBarrier b; b.bar = bar; b.x = xb_xcc_id(); b.st = st;
    if (threadIdx.x == 0) (void)xb_add(&bar[XB_XCNT(b.x)], 1u);
    return b;
}
DI void xcd_barrier_complete(unsigned* bar, unsigned x, unsigned& nloc, unsigned& nx) {
    const unsigned G = gridDim.x * gridDim.y * gridDim.z;
    unsigned sum, cnt, mine, sp = 0u;
    for (;;) {
        sum = 0u; cnt = 0u; mine = 0u;
#pragma unroll
        for (unsigned j = 0; j < 16; ++j) { const unsigned c = xb_ld(&bar[XB_XCNT(j)]); sum += c; cnt += (c > 0u) ? 1u : 0u; mine = (j == x) ? c : mine; }
        if (sum == G) break;
        __builtin_amdgcn_s_sleep(1);
        if ((++sp & 255u) == 0u) { if (xb_ld(&bar[XB_TMO])) break; if (sp > XB_SPIN_CAP) { atomicAdd(&bar[XB_TMO], 1u); break; } }
    }
    nloc = mine > 0u ? mine : 1u; nx = cnt > 0u ? cnt : 1u;
}
DI void xcd_barrier(const XcdBarrier& b) {
    asm volatile("s_waitcnt vmcnt(0)" ::: "memory");
    __syncthreads();
    if (threadIdx.x == 0) {
        unsigned* bar = b.bar;
        __builtin_amdgcn_s_waitcnt(0);
        unsigned nloc = b.st[0], nx = b.st[1];
        if (nloc == 0u) { xcd_barrier_complete(bar, b.x, nloc, nx); b.st[0] = nloc; b.st[1] = nx; }
        const unsigned old = xb_add(&bar[XB_XSUB(b.x)], 1u);
        const unsigned gen = old / nloc;
        if (old + 1u == (gen + 1u) * nloc) {
            __builtin_amdgcn_fence(__ATOMIC_RELEASE, "agent");
            asm volatile("s_waitcnt vmcnt(0)" ::: "memory");
            const unsigned og = xb_add(&bar[XB_TOP], 1u);
            const unsigned tg = og / nx;
            if (og + 1u == (tg + 1u) * nx) xb_add(&bar[XB_TOPGEN], 1u);
            else XB_SPIN(xb_ld(&bar[XB_TOPGEN]) == tg, bar);
            __builtin_amdgcn_fence(__ATOMIC_ACQUIRE, "agent");
            xb_add(&bar[XB_XGEN(b.x)], 1u);
            asm volatile("s_waitcnt vmcnt(0)" ::: "memory");
        } else {
            XB_SPIN(xb_ld(&bar[XB_XGEN(b.x)]) == gen, bar);
            __builtin_amdgcn_fence(__ATOMIC_ACQUIRE, "agent");
            asm volatile("s_waitcnt vmcnt(0)" ::: "memory");
        }
    }
    __syncthreads();
}

DI void p0_transpose_item(const float* W, int ldw, int N, int K, const float* gain, bf16_t* WT, LAS float* scr, int item, int lane) {
    const int nblk = N / 32, kb = item / nblk, nb = item % nblk, k0 = 64 * kb, n0 = 32 * nb;
#pragma unroll 8
    for (int i = 0; i < 32; ++i) { const int kk = 2 * i + (lane >> 5); float w = W[(size_t)(k0 + kk) * ldw + n0 + (lane & 31)]; if (gain) w *= gain[k0 + kk]; scr[kk * 33 + (lane & 31)] = w; }
    LDS_WAIT(); asm volatile("" ::: "memory");
    const int c = lane & 7;
#pragma unroll
    for (int j = 0; j < 4; ++j) { const int n = (lane >> 3) + 8 * j; const LAS float* s = scr + (8 * c) * 33 + n;
        u32x4 o; o.x = cvtpk(s[0 * 33], s[1 * 33]); o.y = cvtpk(s[2 * 33], s[3 * 33]); o.z = cvtpk(s[4 * 33], s[5 * 33]); o.w = cvtpk(s[6 * 33], s[7 * 33]);
        *(u32x4*)(WT + (size_t)(n0 + n) * K + k0 + 8 * c) = o; }
    LDS_WAIT(); asm volatile("" ::: "memory");
}
DI unsigned fp4x8(const f32x4 a, const f32x4 b, float inv) {
    unsigned w = 0;
    w = __builtin_amdgcn_cvt_scalef32_pk_fp4_f32(w, a[0] * inv, a[1] * inv, 1.0f, 0); w = __builtin_amdgcn_cvt_scalef32_pk_fp4_f32(w, a[2] * inv, a[3] * inv, 1.0f, 1);
    w = __builtin_amdgcn_cvt_scalef32_pk_fp4_f32(w, b[0] * inv, b[1] * inv, 1.0f, 2); w = __builtin_amdgcn_cvt_scalef32_pk_fp4_f32(w, b[2] * inv, b[3] * inv, 1.0f, 3);
    return w;
}
DI float wave_max(float v) {
    v = fmaxf(v, DPP_F(v, 0xB1)); v = fmaxf(v, DPP_F(v, 0x4E)); v = fmaxf(v, DPP_F(v, 0x141)); v = fmaxf(v, DPP_F(v, 0x140));
    const int vi = __builtin_bit_cast(int, v);
    return fmaxf(fmaxf(__builtin_bit_cast(float, __builtin_amdgcn_readlane(vi, 0)), __builtin_bit_cast(float, __builtin_amdgcn_readlane(vi, 16))),
                 fmaxf(__builtin_bit_cast(float, __builtin_amdgcn_readlane(vi, 32)), __builtin_bit_cast(float, __builtin_amdgcn_readlane(vi, 48))));
}
DI void convert_tables(const Frame& F, const Args& args, int l, int wv, int nwv) {
    const float* gn = INP(I_NORM_FFN) + l * 1024 + 16 * F.lane;
    f32x4 g[4];
#pragma unroll
    for (int q = 0; q < 4; ++q) g[q] = *(const f32x4*)(gn + 4 * q);
    for (int r0 = wv; r0 < 2 * 16384; r0 += 4 * nwv) {
        f32x4 v[4][4];
#pragma unroll
        for (int j = 0; j < 4; ++j) { const int r = min(r0 + j * nwv, 2 * 16384 - 1), isv = r >= 16384, e = r & 16383;
            const float* src = (isv ? INP(I_PEER_V) : INP(I_PEER_U)) + ((size_t)l * 16384 + e) * 1024 + 16 * F.lane;
#pragma unroll
            for (int q = 0; q < 4; ++q) v[j][q] = *(const f32x4*)(src + 4 * q); }
#pragma unroll
        for (int j = 0; j < 4; ++j) { const int r = r0 + j * nwv, isv = r >= 16384, e = r & 16383; float am = 0.f;
            if (r < 2 * 16384) {
#pragma unroll
            for (int q = 0; q < 4; ++q) { if (!isv) v[j][q] = v[j][q] * g[q];
                am = fmaxf(am, fmaxf(fmaxf(fabsf(v[j][q][0]), fabsf(v[j][q][1])), fmaxf(fabsf(v[j][q][2]), fabsf(v[j][q][3])))); }
            am = wave_max(am);
            const float sc = bf2f(cvt1(am > 0.f ? am * (1.0f / 6.0f) : 1.0f)), inv = 1.0f / sc;
            u32x2 w; w.x = fp4x8(v[j][0], v[j][1], inv); w.y = fp4x8(v[j][2], v[j][3], inv);
            *(u32x2*)(F.ws + WS_TAB + (size_t)l * 16 * MiB + (size_t)isv * 8 * MiB + (size_t)e * 512 + 8 * F.lane) = w;
            if (F.lane == 0) ((bf16_t*)(F.ws + WS_TAB + 32 * MiB))[((size_t)l * 16384 + e) * 2 + isv] = cvt1(sc); } }
    }
}
struct TDesc { const float* W; const float* gain; bf16_t* WT; int ldw, nblk; };
DI TDesc tdesc(const Frame& F, const Args& args, int l, int t) {
    TDesc D; D.gain = nullptr; D.ldw = 1024; D.nblk = 32; size_t woff;
    switch (t) {
    case 0: D.W = INP(I_W_IN) + (size_t)l * 1024 * INW; D.ldw = INW; D.nblk = 88; D.gain = INP(I_NORM_MIX) + l * 1024; woff = W_IN; break;
    case 1: D.W = INP(I_W_OUT) + (size_t)l * 1024 * 1024; woff = W_OUT; break;
    case 2: D.W = INP(I_W_CQ) + (size_t)l * 1024 * 1024; D.gain = INP(I_NORM_MEM) + l * 1024; woff = W_CQ; break;
    case 3: D.W = INP(I_W_CKV) + (size_t)l * 1024 * 2048; D.ldw = 2048; D.nblk = 64; D.gain = INP(I_MEM_GAIN) + l * 1024; woff = W_CKV; break;
    case 4: D.W = INP(I_W_CO) + (size_t)l * 1024 * 1024; woff = W_CO; break;
    default: D.W = INP(I_PEER_WQ) + (size_t)l * 1024 * 1024; D.gain = INP(I_NORM_FFN) + l * 1024; woff = W_PQ; break;
    }
    D.WT = (bf16_t*)(F.ws + WS_W + l * W_LAYER + woff); return D;
}
DI void titem_load(const TDesc& D, int item, int lane, float (&v)[32]) {
    const int kb = item / D.nblk, nb = item % D.nblk, k0 = 64 * kb, n0 = 32 * nb;
#pragma unroll
    for (int i = 0; i < 32; ++i) { const int kk = 2 * i + (lane >> 5); float w = D.W[(size_t)(k0 + kk) * D.ldw + n0 + (lane & 31)]; if (D.gain) w *= D.gain[k0 + kk]; v[i] = w; }
}
DI void titem_store(const TDesc& D, int item, int lane, LAS float* scr, const float (&v)[32]) {
    const int kb = item / D.nblk, nb = item % D.nblk, k0 = 64 * kb, n0 = 32 * nb;
#pragma unroll
    for (int i = 0; i < 32; ++i) scr[(2 * i + (lane >> 5)) * 33 + (lane & 31)] = v[i];
    LDS_WAIT(); asm volatile("" ::: "memory");
    const int c = lane & 7;
#pragma unroll
    for (int j = 0; j < 4; ++j) { const int n = (lane >> 3) + 8 * j; const LAS float* s = scr + (8 * c) * 33 + n;
        u32x4 o; o.x = cvtpk(s[0 * 33], s[1 * 33]); o.y = cvtpk(s[2 * 33], s[3 * 33]); o.z = cvtpk(s[4 * 33], s[5 * 33]); o.w = cvtpk(s[6 * 33], s[7 * 33]);
        *(u32x4*)(D.WT + (size_t)(n0 + n) * 1024 + k0 + 8 * c) = o; }
    LDS_WAIT(); asm volatile("" ::: "memory");
}
DI int tl_index(int part, int e) {
    if (part == 0) return e < 1408 ? e : e < 2432 ? 2432 + (e - 1408) : 4480 + 2432 + (e - 2432);
    return e < 1024 ? 1408 + e : e < 2048 ? 3456 + (e - 1024) : e < 4480 ? 4480 + (e - 2048) : 4480 + 3456 + (e - 4480);
}
DI void transpose_list(const Frame& F, const Args& args, LAS float* scr, int wv, int nwv, int part) {
    constexpr int NIT_L = 16 * 88 + 4 * 16 * 32 + 16 * 64;
    const int NIT = part == 0 ? 3456 : 5504;
    float va[32], vb[32]; TDesc Da{}, Db{}; int la = 0, lb = 0;
#define TI_DECODE(e_, D_, loc_) do { const int it_ = tl_index(part, (e_)); const int l_ = it_ / NIT_L; int r_ = it_ % NIT_L; int t_; \
        if (r_ < 1408) t_ = 0; else if (r_ < 1920) { t_ = 1; r_ -= 1408; } else if (r_ < 2432) { t_ = 2; r_ -= 1920; } else if (r_ < 3456) { t_ = 3; r_ -= 2432; } else if (r_ < 3968) { t_ = 4; r_ -= 3456; } else { t_ = 5; r_ -= 3968; } \
        D_ = tdesc(F, args, l_, t_); loc_ = r_; } while (0)
    int it = wv;
    if (it < NIT) { TI_DECODE(it, Da, la); titem_load(Da, la, F.lane, va); }
    for (;;) {
        int itn = it + nwv;
        if (itn < NIT) { TI_DECODE(itn, Db, lb); titem_load(Db, lb, F.lane, vb); }
        if (it < NIT) titem_store(Da, la, F.lane, scr, va);
        it = itn; if (it >= NIT) break;
        itn = it + nwv;
        if (itn < NIT) { TI_DECODE(itn, Da, la); titem_load(Da, la, F.lane, va); }
        titem_store(Db, lb, F.lane, scr, vb);
        it = itn; if (it >= NIT) break;
    }
#undef TI_DECODE
}
DI void p0_prologue(const Frame& F, const Args& args) {
    LAS float* scr = (LAS float*)(F.lds + F.wave * 16384);
    transpose_list(F, args, scr, F.gw, F.NGW, 0);
    const int gt = F.bx * NTHR + F.tid, nthr = F.G * NTHR;
    for (int i = gt; i < DEPTH * 256 * 1024; i += nthr) {
        const int l = i / (256 * 1024), r = i % (256 * 1024), j = r >> 10, k = r & 1023;
        bf16_t* Wi = (bf16_t*)(F.ws + WS_W + l * W_LAYER) + W_IN / 2;
        float v = 0.f;
        if (j < 128) {
            const float* wi = INP(I_W_IN) + (size_t)l * 1024 * INW + (size_t)k * INW + 2816; const float* wg = INP(I_GLA_WG) + l * 16 * 128 + j;
#pragma unroll
            for (int q4 = 0; q4 < 4; ++q4) { const f32x4 w4 = *(const f32x4*)(wi + 4 * q4);
#pragma unroll
                for (int e = 0; e < 4; ++e) v += w4[e] * wg[(4 * q4 + e) * 128]; }
            v *= INP(I_NORM_MIX)[l * 1024 + k];
        }
        Wi[(size_t)(2816 + j) * 1024 + k] = cvt1(v);
    }
    { bf16_t* WSP = (bf16_t*)(F.ws + WS_WSP); const float* sw = INP(I_SG_W);
      for (int i = gt; i < DEPTH * 4 * 128 * 128; i += nthr) { const int s = i & 127, t = (i >> 7) & 127; WSP[i] = cvt1(s <= t ? sw[i] : 0.f); }
      bf16_t* SK = (bf16_t*)(F.ws + WS_SUBK); const float* sk = INP(I_PEER_SK);
      for (int i = gt; i < DEPTH * 8 * 2 * 128 * 64; i += nthr) SK[i] = cvt1(sk[i]); }
    { float* SS = (float*)(F.ws + WS_SS); bf16_t* XB = (bf16_t*)(F.ws + WS_XB); const float* x = INP(I_X);
      static_assert(MTOK % (NWAVES * GRID) == 0, "rows per wave");
      constexpr int RPW = MTOK / (NWAVES * GRID);
      for (int m0 = F.gw * RPW; m0 < (F.gw + 1) * RPW; m0 += 2) {
          f32x4 v[2][4];
#pragma unroll
          for (int i = 0; i < 2; ++i) { const f32x4* xr = (const f32x4*)(x + (size_t)(m0 + i) * 1024) + F.lane;
#pragma unroll
              for (int j = 0; j < 4; ++j) v[i][j] = xr[64 * j]; }
#pragma unroll
          for (int i = 0; i < 2; ++i) { const int m = m0 + i; float s = 0.f; u32x2 w[4];
#pragma unroll
              for (int j = 0; j < 4; ++j) { w[j].x = cvtpk(v[i][j][0], v[i][j][1]); w[j].y = cvtpk(v[i][j][2], v[i][j][3]);
                  s += (bflo(w[j].x) * bflo(w[j].x) + bfhi(w[j].x) * bfhi(w[j].x)) + (bflo(w[j].y) * bflo(w[j].y) + bfhi(w[j].y) * bfhi(w[j].y)); }
              s = wave_sum(s);
              u32x2* xb = (u32x2*)(XB + (size_t)m * 1024) + F.lane;
#pragma unroll
              for (int j = 0; j < 4; ++j) xb[64 * j] = w[j];
              if (F.lane < 16) SS[(size_t)m * 16 + F.lane] = F.lane == 0 ? s : 0.f; }
      }
      bf16_t* MB = (bf16_t*)(F.ws + WS_MEMB); float* RM = (float*)(F.ws + WS_RSTDM); const float* mem = INP(I_MEM);
      for (int m = F.gw; m < MMEM; m += F.NGW) {
          const f32x4* xr = (const f32x4*)(mem + (size_t)m * 1024) + F.lane; f32x4 v[4]; float s = 0.f;
#pragma unroll
          for (int j = 0; j < 4; ++j) { v[j] = xr[64 * j]; s += (v[j][0] * v[j][0] + v[j][1] * v[j][1]) + (v[j][2] * v[j][2] + v[j][3] * v[j][3]); }
          s = wave_sum(s);
          u32x2* xb = (u32x2*)(MB + (size_t)m * 1024) + F.lane;
#pragma unroll
          for (int j = 0; j < 4; ++j) { u32x2 w; w.x = cvtpk(v[j][0], v[j][1]); w.y = cvtpk(v[j][2], v[j][3]); xb[64 * j] = w; }
          if (F.lane == 0) RM[m] = 1.0f / sqrtf(s * (1.0f / 1024.0f) + EPS);
      } }
}

constexpr int SBV_PITCH = 192;
DI void sb_unit2(const bf16_t* PROJ, bf16_t* YCAT, int b, int h, int qp, LAS char* vl, int lane) {
    const int q = lane & 31, hh = lane >> 5;
    const size_t rowbase = (size_t)b * SEQ; const int qa = 2 * qp, qb = qa + 1;
    bf16x8 qfA[4], qfB[4];
    { const bf16_t* qrow = PROJ + (rowbase + qa * 32 + q) * LDP + C_SBQ + h * 64 + hh * 8;
#pragma unroll
      for (int s = 0; s < 4; ++s) { qfA[s] = *(const bf16x8*)(qrow + 16 * s); qfB[s] = *(const bf16x8*)(qrow + 32 * LDP + 16 * s); } }
    f32x16 oA0, oA1, oB0, oB1;
#pragma unroll
    for (int r = 0; r < 16; ++r) { oA0[r] = 0.f; oA1[r] = 0.f; oB0[r] = 0.f; oB1[r] = 0.f; }
    float RA = 1.f, RB = 1.f;
    const float zs = 0.125f * LOG2E;
    const int i16 = lane & 15, tq = i16 >> 2, tp = i16 & 3, blk = (lane >> 4) & 1;
    bf16x8 kf[4]; u32x4 vr[4];
#define SB_LOAD_TILE(kt_, kf, vr) do { const bf16_t* krow_ = PROJ + (rowbase + (kt_) * 32 + q) * LDP + C_SBK + h * 64 + hh * 8; \
        _Pragma("unroll") for (int s_ = 0; s_ < 4; ++s_) kf[s_] = *(const bf16x8*)(krow_ + 16 * s_); \
        _Pragma("unroll") for (int i_ = 0; i_ < 4; ++i_) { const int c_ = lane + 64 * i_, row_ = c_ >> 3, ch_ = c_ & 7; vr[i_] = *(const u32x4*)(PROJ + (rowbase + (kt_) * 32 + row_) * LDP + C_SBV + h * 64 + ch_ * 8); } } while (0)
#define SB_MATH(Z, DIAG, R, O0, O1) { \
        float L[16];                                        \
        _Pragma("unroll") for (int r = 0; r < 16; ++r) { \
            const float e = fexp2(fminf(Z[r] * zs, 100.f)), nb = __builtin_amdgcn_rcpf(1.f + e), be = e * nb; \
            const bool valid = !(DIAG) || (crow(r, hh) < q); \
            L[r] = valid ? nb : 1.f; Z[r] = valid ? be : 0.f; } \
        float G[4], Go[4]; \
        _Pragma("unroll") for (int g = 0; g < 4; ++g) { G[g] = (L[4 * g] * L[4 * g + 1]) * (L[4 * g + 2] * L[4 * g + 3]); Go[g] = __shfl_xor(G[g], 32); } \
        float base[4]; float run = 1.f; \
        _Pragma("unroll") for (int g = 3; g >= 0; --g) { base[g] = run * (hh == 0 ? Go[g] : 1.f); run *= G[g] * Go[g]; } \
        float P[16]; \
        _Pragma("unroll") for (int g = 0; g < 4; ++g) { \
            const float c3 = R * base[g], c2 = c3 * L[4 * g + 3], c1 = c2 * L[4 * g + 2], c0 = c1 * L[4 * g + 1]; \
            P[4 * g + 3] = Z[4 * g + 3] * c3; P[4 * g + 2] = Z[4 * g + 2] * c2; P[4 * g + 1] = Z[4 * g + 1] * c1; P[4 * g + 0] = Z[4 * g + 0] * c0; } \
        R *= run; \
        const bf16x8 p0 = pack8(P[0], P[1], P[2], P[3], P[4], P[5], P[6], P[7]), p1 = pack8(P[8], P[9], P[10], P[11], P[12], P[13], P[14], P[15]); \
        _Pragma("unroll") for (int s = 0; s < 2; ++s) { \
            const LAS char* vb = vl + (16 * s + 4 * hh + tq) * SBV_PITCH + blk * 32 + tp * 8; \
            const bf16x8 a0 = cat8(vtr(vb), vtr(vb + 8 * SBV_PITCH)), a1 = cat8(vtr(vb + 64), vtr(vb + 8 * SBV_PITCH + 64)); \
            O0 = MFMA32(a0, s == 0 ? p0 : p1, O0); O1 = MFMA32(a1, s == 0 ? p0 : p1, O1); } }
#define SB_ZERO(Z) _Pragma("unroll") for (int r = 0; r < 16; ++r) Z[r] = 0.f;
#define SB_VTOLDS(VR) _Pragma("unroll") for (int i = 0; i < 4; ++i) { const int c = lane + 64 * i, row = c >> 3, ch = c & 7; *(LAS u32x4*)(vl + row * SBV_PITCH + ch * 16) = VR[i]; }
    SB_LOAD_TILE(qb, kf, vr);
    {
        f32x16 zB; SB_ZERO(zB)
#pragma unroll
        for (int s = 0; s < 4; ++s) zB = MFMA32(kf[s], qfB[s], zB);
        SB_VTOLDS(vr)
        SB_LOAD_TILE(qa, kf, vr);
        SB_MATH(zB, true, RB, oB0, oB1)
    }
#define SB_STEP2(kt) { \
        f32x16 zA, zB; SB_ZERO(zA) SB_ZERO(zB) \
        _Pragma("unroll") for (int s = 0; s < 4; ++s) { zA = MFMA32(kf[s], qfA[s], zA); zB = MFMA32(kf[s], qfB[s], zB); } \
        SB_VTOLDS(vr) \
        if (kt > 0) SB_LOAD_TILE(kt - 1, kf, vr); \
        SB_MATH(zA, (kt == qa), RA, oA0, oA1) \
        SB_MATH(zB, false, RB, oB0, oB1) \
        if (__all(RA < 4.2e-18f && RB < 4.2e-18f)) break;        \
    }
    for (int kt = qa; kt >= 0; --kt) SB_STEP2(kt)
#undef SB_STEP2
#undef SB_VTOLDS
#undef SB_ZERO
#undef SB_MATH
#undef SB_LOAD_TILE
    bf16_t* orow = YCAT + (rowbase + qa * 32 + q) * 1024 + h * 64;
    u32x2 wA0[4], wA1[4], wB0[4], wB1[4];
#pragma unroll
    for (int g = 0; g < 4; ++g) {
        wA0[g].x = cvtpk(oA0[4 * g], oA0[4 * g + 1]); wA0[g].y = cvtpk(oA0[4 * g + 2], oA0[4 * g + 3]);
        wA1[g].x = cvtpk(oA1[4 * g], oA1[4 * g + 1]); wA1[g].y = cvtpk(oA1[4 * g + 2], oA1[4 * g + 3]);
        wB0[g].x = cvtpk(oB0[4 * g], oB0[4 * g + 1]); wB0[g].y = cvtpk(oB0[4 * g + 2], oB0[4 * g + 3]);
        wB1[g].x = cvtpk(oB1[4 * g], oB1[4 * g + 1]); wB1[g].y = cvtpk(oB1[4 * g + 2], oB1[4 * g + 3]);
    }
    store_row32(orow, hh, wA0[0], wA0[1], wA0[2], wA0[3]); store_row32(orow + 32, hh, wA1[0], wA1[1], wA1[2], wA1[3]);
    store_row32(orow + 32 * 1024, hh, wB0[0], wB0[1], wB0[2], wB0[3]); store_row32(orow + 32 * 1024 + 32, hh, wB1[0], wB1[1], wB1[2], wB1[3]);
}

constexpr int SGV_PITCH = 576;
DI void sgu_unit(const Frame& F, const Args& args, int l, int b, int c, const bf16_t* PROJ, bf16_t* YCAT) {
    const size_t m0 = (size_t)b * SEQ + c * 128;
    LAS char* Vn = (LAS char*)F.lds;
    {
      const int t = F.tid >> 2, part = F.tid & 3; const bf16_t* vrow = PROJ + (m0 + t) * LDP + C_SGV + part * 64; const float* gn = INP(I_SG_VG) + l * 256 + part * 64;
      float gv[64]; float s = 0.f;
#pragma unroll
      for (int i = 0; i < 8; ++i) { const u32x4 w = *(const u32x4*)(vrow + 8 * i);
#pragma unroll
          for (int j = 0; j < 4; ++j) { const float a = gelu_tanh(bflo(w[j])), bb = gelu_tanh(bfhi(w[j])); gv[8 * i + 2 * j] = a; gv[8 * i + 2 * j + 1] = bb; s += a * a + bb * bb; } }
      s += __shfl_xor(s, 1); s += __shfl_xor(s, 2);
      const float rstd = 1.0f / sqrtf(s * (1.0f / 256.0f) + EPS);
#pragma unroll
      for (int i = 0; i < 8; ++i) { const f32x4 g0 = *(const f32x4*)(gn + 8 * i), g1 = *(const f32x4*)(gn + 8 * i + 4);
          u32x4 w; w.x = cvtpk(gv[8 * i] * rstd * g0[0], gv[8 * i + 1] * rstd * g0[1]); w.y = cvtpk(gv[8 * i + 2] * rstd * g0[2], gv[8 * i + 3] * rstd * g0[3]);
          w.z = cvtpk(gv[8 * i + 4] * rstd * g1[0], gv[8 * i + 5] * rstd * g1[1]); w.w = cvtpk(gv[8 * i + 6] * rstd * g1[2], gv[8 * i + 7] * rstd * g1[3]);
          *(LAS u32x4*)(Vn + t * SGV_PITCH + (part * 64 + 8 * i) * 2) = w; } }
    WG_SYNC();
    {
      const int g = F.wave >> 1, db = F.wave & 1, lane = F.lane, r32 = lane & 31, hh = lane >> 5;
      const int i16 = lane & 15, tq = i16 >> 2, tp = i16 & 3, blk = (lane >> 4) & 1;
      const bf16_t* Wg = (const bf16_t*)(F.ws + WS_WSP) + ((size_t)(l * 4 + g) * 128) * 128;
      const float* bias = INP(I_SG_B) + (l * 4 + g) * 128;
      const int ch0 = g * 64 + db * 32 + 4 * hh;
#pragma unroll 1
      for (int tb = 0; tb < 4; ++tb) {
          const int t = tb * 32 + r32;
          u32x2 uw[4];
          load_row32(PROJ + (m0 + t) * LDP + C_SGU + g * 64 + db * 32, hh, uw[0], uw[1], uw[2], uw[3]);
          const float bt = bias[t];
          bf16x8 wfa[4][2];
#pragma unroll
          for (int sb = 0; sb < 4; ++sb) if (sb <= tb) {
#pragma unroll
              for (int ks = 0; ks < 2; ++ks) wfa[sb][ks] = *(const bf16x8*)(Wg + (size_t)t * 128 + sb * 32 + 16 * ks + 8 * hh);
          }
          f32x16 acc;
#pragma unroll
          for (int r = 0; r < 16; ++r) acc[r] = 0.f;
#pragma unroll
          for (int sb = 0; sb < 4; ++sb) if (sb <= tb) {
#pragma unroll
              for (int ks = 0; ks < 2; ++ks) {
                  const LAS char* vb = Vn + (sb * 32 + 16 * ks + 8 * hh + tq) * SGV_PITCH + (g * 64 + db * 32 + blk * 16) * 2 + tp * 8;
                  const bf16x8 vf = cat8(vtr(vb), vtr(vb + 4 * SGV_PITCH));
                  acc = MFMA32(vf, wfa[sb][ks], acc);
              }
          }
          u32x2 yv[4];
#pragma unroll
          for (int gi = 0; gi < 4; ++gi) {
              const float y0 = gelu_tanh(bflo(uw[gi].x)) * (acc[4 * gi] + bt), y1 = gelu_tanh(bfhi(uw[gi].x)) * (acc[4 * gi + 1] + bt);
              const float y2 = gelu_tanh(bflo(uw[gi].y)) * (acc[4 * gi + 2] + bt), y3 = gelu_tanh(bfhi(uw[gi].y)) * (acc[4 * gi + 3] + bt);
              yv[gi].x = cvtpk(y0, y1); yv[gi].y = cvtpk(y2, y3);
          }
          store_row32(YCAT + (m0 + t) * 1024 + 512 + g * 64 + db * 32, hh, yv[0], yv[1], yv[2], yv[3]);
      } }
    WG_SYNC();
}

constexpr int GQ_PITCH = 80, GV_PITCH = 192, GS_PITCH = 80;
constexpr int GL_QT = 0, GL_KT = GL_QT + 128 * GQ_PITCH, GL_VV = GL_KT + 128 * GQ_PITCH, GL_ST = GL_VV + 128 * GV_PITCH, GL_SEG = GL_ST + 64 * GS_PITCH,
              GL_D = GL_SEG + 16 * 32 * 4, GL_SSQ = GL_D + 32 * 4, GL_END = GL_SSQ + 128 * 2 * 4;
DI void gla_chain(const Frame& F, const Args& args, int l, int b, int h, const bf16_t* PROJ, bf16_t* YCAT) {
    LAS char* L = (LAS char*)F.lds;
    LAS float* SEG = (LAS float*)(L + GL_SEG); LAS float* Dd = (LAS float*)(L + GL_D); LAS float* SSQ = (LAS float*)(L + GL_SSQ);
    const int tid = F.tid, lane = F.lane, w = F.wave, r32 = lane & 31, hh = lane >> 5;
    const int i16 = lane & 15, tq = i16 >> 2, tp = i16 & 3, blk = (lane >> 4) & 1;
    for (int i = tid; i < 64 * GS_PITCH / 4; i += NTHR) ((LAS unsigned*)(L + GL_ST))[i] = 0u;
    f32x16 st;
#pragma unroll
    for (int r = 0; r < 16; ++r) st[r] = 0.f;
    const int j = tid & 31, seg = tid >> 5;
    const float bg = INP(I_GLA_BG)[l * 128 + h * 32 + j];
    const int tb = w & 3, dh = w >> 2;
    float ga[8], kr[8], qr[8]; u32x4 vv[2];
#define GC_LOAD(c_) do { const size_t m0_ = (size_t)b * SEQ + (c_) * 128; \
        _Pragma("unroll") for (int i_ = 0; i_ < 8; ++i_) { const bf16_t* p_ = PROJ + (m0_ + seg * 8 + i_) * LDP + h * 32 + j; ga[i_] = bf2f(p_[C_GA]); kr[i_] = bf2f(p_[C_GK]); qr[i_] = bf2f(p_[C_GQ]); } \
        _Pragma("unroll") for (int i_ = 0; i_ < 2; ++i_) { const int cc_ = tid + 512 * i_, row_ = cc_ >> 3, ch_ = cc_ & 7; vv[i_] = *(const u32x4*)(PROJ + (m0_ + row_) * LDP + C_GV + h * 64 + ch_ * 8); } } while (0)
    GC_LOAD(0);
    LDS_SYNC();
#pragma unroll 1
    for (int c = 0; c < 16; ++c) {
        const size_t m0 = (size_t)b * SEQ + c * 128;
        float bc[8]; float run = 0.f;
#pragma unroll
        for (int i = 0; i < 8; ++i) {
            const float g = ga[i] + bg;
            const float sp = fmaxf(-g, 0.f) + flog2(1.f + fexp2(-fabsf(g) * LOG2E)) * 0.6931471805599453f;
            run += -sp * (1.0f / 16.0f); bc[i] = run;
        }
        SEG[seg * 32 + j] = run;
#pragma unroll
        for (int i = 0; i < 2; ++i) { const int cc = tid + 512 * i, row = cc >> 3, ch = cc & 7; *(LAS u32x4*)(L + GL_VV + row * GV_PITCH + ch * 16) = vv[i]; }
        LDS_SYNC();
        float pre = 0.f;
#pragma unroll
        for (int s2 = 0; s2 < 15; ++s2) { const float v_ = SEG[s2 * 32 + j]; pre += s2 < seg ? v_ : 0.f; }
#pragma unroll
        for (int i = 0; i < 8; ++i) {
            const int t = seg * 8 + i; const float bb = pre + bc[i];
            *(LAS bf16_t*)(L + GL_QT + t * GQ_PITCH + j * 2) = cvt1(qr[i] * 0.17677669529663687f * fexp2(bb * LOG2E));
            *(LAS bf16_t*)(L + GL_KT + t * GQ_PITCH + j * 2) = cvt1(kr[i] * fexp2(-bb * LOG2E));
            if (t == 127) Dd[j] = fexp2(bb * LOG2E);
        }
        if (c < 15) GC_LOAD(c + 1);
        u32x2 gov[4];
        { const bf16_t* go = PROJ + (m0 + tb * 32 + r32) * LDP + C_GO + h * 64 + dh * 32 + 4 * hh;
#pragma unroll
          for (int g = 0; g < 4; ++g) gov[g] = *(const u32x2*)(go + 8 * g); }
        LDS_SYNC();
        f32x16 o;
#pragma unroll
        for (int r = 0; r < 16; ++r) o[r] = 0.f;
        bf16x8 qf[2];
#pragma unroll
        for (int ks = 0; ks < 2; ++ks) qf[ks] = *(LAS const bf16x8*)(L + GL_QT + (tb * 32 + r32) * GQ_PITCH + (16 * ks + 8 * hh) * 2);
        for (int sb = 0; sb <= tb; ++sb) {
            f32x16 sT;
#pragma unroll
            for (int r = 0; r < 16; ++r) sT[r] = 0.f;
#pragma unroll
            for (int ks = 0; ks < 2; ++ks) { const bf16x8 kf = *(LAS const bf16x8*)(L + GL_KT + (sb * 32 + r32) * GQ_PITCH + (16 * ks + 8 * hh) * 2); sT = MFMA32(kf, qf[ks], sT); }
            if (sb == tb) {
#pragma unroll
                for (int r = 0; r < 16; ++r) if (crow(r, hh) > r32) sT[r] = 0.f;
            }
            const bf16x8 p0 = pack8(sT[0], sT[1], sT[2], sT[3], sT[4], sT[5], sT[6], sT[7]), p1 = pack8(sT[8], sT[9], sT[10], sT[11], sT[12], sT[13], sT[14], sT[15]);
#pragma unroll
            for (int s = 0; s < 2; ++s) {
                const LAS char* vb = L + GL_VV + (sb * 32 + 16 * s + 4 * hh + tq) * GV_PITCH + (dh * 32 + blk * 16) * 2 + tp * 8;
                const bf16x8 a = cat8(vtr(vb), vtr(vb + 8 * GV_PITCH));
                o = MFMA32(a, s == 0 ? p0 : p1, o);
            }
        }
#pragma unroll
        for (int ks = 0; ks < 2; ++ks) {
            const bf16x8 a = *(LAS const bf16x8*)(L + GL_ST + (dh * 32 + r32) * GS_PITCH + (16 * ks + 8 * hh) * 2);
            o = MFMA32(a, qf[ks], o);
        }
        if (tb == 0) {
#pragma unroll
            for (int ks = 0; ks < 8; ++ks) {
                const LAS char* kb = L + GL_KT + (16 * ks + 8 * hh + tq) * GQ_PITCH + (blk * 16) * 2 + tp * 8;
                const bf16x8 a = cat8(vtr(kb), vtr(kb + 4 * GQ_PITCH));
                const LAS char* vb = L + GL_VV + (16 * ks + 8 * hh + tq) * GV_PITCH + (dh * 32 + blk * 16) * 2 + tp * 8;
                const bf16x8 bfr = cat8(vtr(vb), vtr(vb + 4 * GV_PITCH));
                st = MFMA32(a, bfr, st);
            }
#pragma unroll
            for (int r = 0; r < 16; ++r) st[r] *= Dd[crow(r, hh)];
        }
        float ssq = 0.f;
#pragma unroll
        for (int r = 0; r < 16; ++r) ssq += o[r] * o[r];
        ssq += __shfl_xor(ssq, 32);
        if (hh == 0) SSQ[(tb * 32 + r32) * 2 + dh] = ssq;
        LDS_SYNC();
        {
            const int t = tb * 32 + r32; const float tot = SSQ[t * 2] + SSQ[t * 2 + 1]; const float rstd = 1.0f / sqrtf(tot * (1.0f / 64.0f) + EPS);
            const float* gn = INP(I_GLA_OG) + l * 256 + h * 64 + dh * 32 + 4 * hh;
            bf16_t* yo = YCAT + (m0 + t) * 1024 + 768 + h * 64 + dh * 32 + 4 * hh;
#pragma unroll
            for (int g = 0; g < 4; ++g) {
                const u32x2 gw = gov[g]; const f32x4 gg = *(const f32x4*)(gn + 8 * g);
                const float y0 = o[4 * g] * rstd * gg[0] * silu(bflo(gw.x)), y1 = o[4 * g + 1] * rstd * gg[1] * silu(bfhi(gw.x));
                const float y2 = o[4 * g + 2] * rstd * gg[2] * silu(bflo(gw.y)), y3 = o[4 * g + 3] * rstd * gg[3] * silu(bfhi(gw.y));
                u32x2 wv; wv.x = cvtpk(y0, y1); wv.y = cvtpk(y2, y3); *(u32x2*)(yo + 8 * g) = wv;
            }
        }
        if (tb == 0) {
#pragma unroll
            for (int g = 0; g < 4; ++g) { u32x2 wv; wv.x = cvtpk(st[4 * g], st[4 * g + 1]); wv.y = cvtpk(st[4 * g + 2], st[4 * g + 3]);
                *(LAS u32x2*)(L + GL_ST + (dh * 32 + r32) * GS_PITCH + (8 * g + 4 * hh) * 2) = wv; }
        }
        LDS_SYNC();
    }
#undef GC_LOAD
}

constexpr int XA_PITCH = 528;
template <int PITCH, int I0, int N> DI void xattn_load(const bf16_t* src, int tid, u32x4 (&v)[N]) {
    const bf16_t* p = src + (size_t)(tid >> 5) * PITCH + (tid & 31) * 8;
#pragma unroll
    for (int i = 0; i < N; ++i) v[i] = *(const u32x4*)(p + (size_t)(I0 + i) * 16 * PITCH);
}
template <int I0, int N> DI void xattn_store(LAS char* img, int tid, const u32x4 (&v)[N]) {
    LAS char* d = img + (tid >> 5) * XA_PITCH + (tid & 31) * 16;
#pragma unroll
    for (int i = 0; i < N; ++i) *(LAS u32x4*)(d + (I0 + i) * 16 * XA_PITCH) = v[i];
}
DI void xattn_unit(const Frame& F, const bf16_t* CQ, const bf16_t* Kl, const bf16_t* VTl, bf16_t* O, int pm, int h) {
    LAS char* img = (LAS char*)F.lds;
    const int lane = F.lane, r32 = lane & 31, hh = lane >> 5, b = pm >> 3;
    const size_t tok = (size_t)pm * 256 + F.wave * 32 + r32;
    { u32x4 sk[16]; xattn_load<1024, 0, 16>(Kl + (size_t)b * 256 * 1024 + h * 256, F.tid, sk); xattn_store<0, 16>(img, F.tid, sk); }
    const bf16_t* qrow = CQ + tok * 1024 + h * 256 + 8 * hh;
    bf16x8 qn = *(const bf16x8*)qrow;
    LDS_SYNC();
    u32x4 sv0[8]; xattn_load<256, 0, 8>(VTl + (size_t)(b * 4 + h) * 256 * 256, F.tid, sv0);
    f32x16 acc[8];
#pragma unroll
    for (int kb = 0; kb < 8; ++kb)
#pragma unroll
        for (int r = 0; r < 16; ++r) acc[kb][r] = 0.f;
#pragma unroll 1
    for (int ks = 0; ks < 16; ++ks) {
        const bf16x8 q = qn;
        qn = *(const bf16x8*)(qrow + 16 * (ks < 15 ? ks + 1 : ks));
        const LAS char* kp = img + r32 * XA_PITCH + (16 * ks + 8 * hh) * 2;
#pragma unroll
        for (int kb = 0; kb < 8; ++kb) acc[kb] = MFMA32(*(LAS const bf16x8*)(kp + kb * 32 * XA_PITCH), q, acc[kb]);
    }
    float mx = -INFINITY;
#pragma unroll
    for (int kb = 0; kb < 8; ++kb)
#pragma unroll
        for (int r = 0; r < 16; ++r) mx = fmaxf(mx, acc[kb][r]);
    mx = fmaxf(mx, __shfl_xor(mx, 32));
    float sum = 0.f;
#pragma unroll
    for (int kb = 0; kb < 8; ++kb)
#pragma unroll
        for (int r = 0; r < 16; ++r) { const float p = fexp2(acc[kb][r] - mx); acc[kb][r] = p; sum += p; }
    sum += __shfl_xor(sum, 32);
    const float inv = 1.0f / sum;
    bf16x8 pf[8][2];
#pragma unroll
    for (int kb = 0; kb < 8; ++kb) {
        pf[kb][0] = pack8(acc[kb][0], acc[kb][1], acc[kb][2], acc[kb][3], acc[kb][4], acc[kb][5], acc[kb][6], acc[kb][7]);
        pf[kb][1] = pack8(acc[kb][8], acc[kb][9], acc[kb][10], acc[kb][11], acc[kb][12], acc[kb][13], acc[kb][14], acc[kb][15]);
    }
    LDS_SYNC();
    { u32x4 sv1[8]; xattn_load<256, 8, 8>(VTl + (size_t)(b * 4 + h) * 256 * 256, F.tid, sv1); xattn_store<0, 8>(img, F.tid, sv0); xattn_store<8, 8>(img, F.tid, sv1); }
    LDS_SYNC();
    bf16_t* orow = O + tok * 1024 + h * 256;
#pragma unroll 1
    for (int db = 0; db < 8; ++db) {
        f32x16 o;
#pragma unroll
        for (int r = 0; r < 16; ++r) o[r] = 0.f;
#pragma unroll
        for (int kb = 0; kb < 8; ++kb)
#pragma unroll
            for (int s2 = 0; s2 < 2; ++s2) {
                const LAS char* vp = img + (db * 32 + r32) * XA_PITCH + (32 * kb + 16 * s2 + 4 * hh) * 2;
                const bf16x8 vf = cat8(*(LAS const s16x4*)vp, *(LAS const s16x4*)(vp + 16));
                o = MFMA32(vf, pf[kb][s2], o);
            }
        u32x2 ow[4];
#pragma unroll
        for (int g = 0; g < 4; ++g) { ow[g].x = cvtpk(o[4 * g] * inv, o[4 * g + 1] * inv); ow[g].y = cvtpk(o[4 * g + 2] * inv, o[4 * g + 3] * inv); }
        store_row32(orow + 32 * db, hh, ow[0], ow[1], ow[2], ow[3]);
    }
    LDS_SYNC();
}

DI unsigned key_pack(float v, unsigned tag, unsigned mask) { const unsigned b = __float_as_uint(v); const unsigned mono = b ^ ((unsigned)((int)b >> 31) | 0x80000000u); return (mono & ~mask) | tag; }
DI float key_val(unsigned k, unsigned mask) { const unsigned mono = k & ~mask; const unsigned b = (mono & 0x80000000u) ? (mono ^ 0x80000000u) : ~mono; return __uint_as_float(b); }
#define CE(a, b) do { const unsigned _h = (a) > (b) ? (a) : (b); const unsigned _l = (a) > (b) ? (b) : (a); (a) = _h; (b) = _l; } while (0)
#define SORT16_DESC(v) do { CE(v[0], v[1]); CE(v[2], v[3]); CE(v[0], v[2]); CE(v[1], v[3]); CE(v[1], v[2]); CE(v[4], v[5]); CE(v[6], v[7]); CE(v[4], v[6]); CE(v[5], v[7]); CE(v[5], v[6]); CE(v[0], v[4]); CE(v[2], v[6]); CE(v[2], v[4]); CE(v[1], v[5]); CE(v[3], v[7]); CE(v[3], v[5]); CE(v[1], v[2]); CE(v[3], v[4]); CE(v[5], v[6]); CE(v[8], v[9]); CE(v[10], v[11]); CE(v[8], v[10]); CE(v[9], v[11]); CE(v[9], v[10]); CE(v[12], v[13]); CE(v[14], v[15]); CE(v[12], v[14]); CE(v[13], v[15]); CE(v[13], v[14]); CE(v[8], v[12]); CE(v[10], v[14]); CE(v[10], v[12]); CE(v[9], v[13]); CE(v[11], v[15]); CE(v[11], v[13]); CE(v[9], v[10]); CE(v[11], v[12]); CE(v[13], v[14]); CE(v[0], v[8]); CE(v[4], v[12]); CE(v[4], v[8]); CE(v[2], v[10]); CE(v[6], v[14]); CE(v[6], v[10]); CE(v[2], v[4]); CE(v[6], v[8]); CE(v[10], v[12]); CE(v[1], v[9]); CE(v[5], v[13]); CE(v[5], v[9]); CE(v[3], v[11]); CE(v[7], v[15]); CE(v[7], v[11]); CE(v[3], v[5]); CE(v[7], v[9]); CE(v[11], v[13]); CE(v[1], v[2]); CE(v[3], v[4]); CE(v[5], v[6]); CE(v[7], v[8]); CE(v[9], v[10]); CE(v[11], v[12]); CE(v[13], v[14]); } while (0)
#define BITONIC16_DESC(v) do { CE(v[0], v[8]); CE(v[1], v[9]); CE(v[2], v[10]); CE(v[3], v[11]); CE(v[4], v[12]); CE(v[5], v[13]); CE(v[6], v[14]); CE(v[7], v[15]); CE(v[0], v[4]); CE(v[1], v[5]); CE(v[2], v[6]); CE(v[3], v[7]); CE(v[8], v[12]); CE(v[9], v[13]); CE(v[10], v[14]); CE(v[11], v[15]); CE(v[0], v[2]); CE(v[1], v[3]); CE(v[4], v[6]); CE(v[5], v[7]); CE(v[8], v[10]); CE(v[9], v[11]); CE(v[12], v[14]); CE(v[13], v[15]); CE(v[0], v[1]); CE(v[2], v[3]); CE(v[4], v[5]); CE(v[6], v[7]); CE(v[8], v[9]); CE(v[10], v[11]); CE(v[12], v[13]); CE(v[14], v[15]); } while (0)
#define MERGE_TOP16(T, v) do { _Pragma("unroll") for (int _i = 0; _i < 16; ++_i) T[_i] = T[_i] > v[15 - _i] ? T[_i] : v[15 - _i]; BITONIC16_T(T); } while (0)
DI void bitonic16(unsigned (&v)[16]) { BITONIC16_DESC(v); }
#define BITONIC16_T(T) bitonic16(T)
DI void route_level1(const bf16_t* PQ, const bf16_t* SK  , int tile, int h, int lane, unsigned (&tpk)[2][16]) {
    const int r32 = lane & 31, hh = lane >> 5; const size_t m = (size_t)tile * 32 + r32;
    bf16x8 qfa[2][4];
#pragma unroll
    for (int p = 0; p < 2; ++p)
#pragma unroll
        for (int ks = 0; ks < 4; ++ks) qfa[p][ks] = *(const bf16x8*)(PQ + m * 1024 + h * 128 + p * 64 + 16 * ks + 8 * hh);
    bf16x8 an[4];
#define RT_LOADA(p_, nb_) do { const bf16_t* skp_ = SK + ((size_t)(h * 2 + (p_)) * 128) * 64; _Pragma("unroll") for (int ks_ = 0; ks_ < 4; ++ks_) an[ks_] = *(const bf16x8*)(skp_ + (size_t)((nb_) * 32 + r32) * 64 + 16 * ks_ + 8 * hh); } while (0)
    RT_LOADA(0, 0);
#pragma unroll
    for (int p = 0; p < 2; ++p) {
        unsigned T[16];
#pragma unroll
        for (int i = 0; i < 16; ++i) T[i] = 0u;
#pragma unroll 1
        for (int nb = 0; nb < 4; ++nb) {
            bf16x8 a[4];
#pragma unroll
            for (int ks = 0; ks < 4; ++ks) a[ks] = an[ks];
            if (nb < 3) RT_LOADA(p, nb + 1); else if (p == 0) RT_LOADA(1, 0);
            f32x16 acc;
#pragma unroll
            for (int r = 0; r < 16; ++r) acc[r] = 0.f;
#pragma unroll
            for (int ks = 0; ks < 4; ++ks) acc = MFMA32(a[ks], qfa[p][ks], acc);
            unsigned v[16];
#pragma unroll
            for (int r = 0; r < 16; ++r) v[r] = key_pack(acc[r], (unsigned)(nb * 32 + crow(r, hh)), 127u);
            SORT16_DESC(v);
            MERGE_TOP16(T, v);
        }
        unsigned pv[16];
#pragma unroll
        for (int i = 0; i < 16; ++i) pv[i] = (unsigned)__shfl_xor((int)T[i], 32);
        MERGE_TOP16(T, pv);
#pragma unroll
        for (int i = 0; i < 16; ++i) tpk[p][i] = T[i];
    }
#undef RT_LOADA
}
DI void route_level2(const unsigned (&tpk)[2][16], size_t m, int h, int lane, int* IDX, float* Gw, unsigned* SCL, const LAS unsigned* SCT  , LAS char* scr  ) {
    { u32x4 w0, w1, w2, w3;
#pragma unroll
      for (int q = 0; q < 4; ++q) {
          w0[q] = (tpk[0][4 * q] & 127u) | ((tpk[0][4 * q + 1] & 127u) << 8) | ((tpk[0][4 * q + 2] & 127u) << 16) | ((tpk[0][4 * q + 3] & 127u) << 24);
          w1[q] = (tpk[1][4 * q] & 127u) | ((tpk[1][4 * q + 1] & 127u) << 8) | ((tpk[1][4 * q + 2] & 127u) << 16) | ((tpk[1][4 * q + 3] & 127u) << 24); }
      (void)w2; (void)w3;
      *(LAS u32x4*)(scr + lane * 48) = w0; *(LAS u32x4*)(scr + lane * 48 + 16) = w1; }
    float av[16], bv[16];
#pragma unroll
    for (int i = 0; i < 16; ++i) { av[i] = key_val(tpk[0][i], 127u); bv[i] = key_val(tpk[1][i], 127u); }
    unsigned cv[16];
#pragma unroll
    for (int i = 0; i < 16; ++i) cv[i] = 0u;
#pragma unroll
    for (int i = 0; i < 16; ++i)
#pragma unroll
        for (int jj = 0; jj < 16; ++jj) if ((i + 1) * (jj + 1) <= 16) {
            unsigned x = key_pack(av[i] + bv[jj], (unsigned)(i * 16 + jj), 255u);
#pragma unroll
            for (int pos = (i + 1) * (jj + 1) - 1; pos < 16; ++pos) CE(cv[pos], x);
        }
    const float cmax = key_val(cv[0], 255u);
    float e[16]; float sum = 0.f;
#pragma unroll
    for (int k = 0; k < 16; ++k) { e[k] = fexp2((key_val(cv[k], 255u) - cmax) * LOG2E); sum += e[k]; }
    const float inv = 1.0f / sum;
    int id[16];
#pragma unroll
    for (int k = 0; k < 16; ++k) {
        const unsigned ij = cv[k] & 255u;
        const unsigned n0 = *(LAS const unsigned char*)(scr + lane * 48 + (ij >> 4)), n1 = *(LAS const unsigned char*)(scr + lane * 48 + 16 + (ij & 15u));
        id[k] = (int)(n0 * 128u + n1);
    }
    { int* ip = IDX + m * 128 + h * 16;
#pragma unroll
      for (int k = 0; k < 16; k += 4) *(int4*)(ip + k) = make_int4(id[k], id[k + 1], id[k + 2], id[k + 3]);
      if (SCT != nullptr) {
      unsigned* sp = SCL + m * 128 + h * 16;
#pragma unroll
      for (int k = 0; k < 16; k += 4) { u32x4 w;
#pragma unroll
          for (int q = 0; q < 4; ++q) w[q] = SCT[id[k + q]];
          *(u32x4*)(sp + k) = w; } }
      float* gp = Gw + m * 128 + h * 16;
#pragma unroll
      for (int k = 0; k < 16; k += 4) *(f32x4*)(gp + k) = (f32x4){e[k] * inv, e[k + 1] * inv, e[k + 2] * inv, e[k + 3] * inv}; }
}
DI void route_pair(const bf16_t* PQ, const bf16_t* SK, int* IDX, float* Gw, unsigned* SCL, const LAS unsigned* SCT, int tileA, int h, int lane, LAS char* scr) {
    unsigned tA[2][16], tB[2][16];
    route_level1(PQ, SK, tileA, h, lane, tA);
    route_level1(PQ, SK, tileA + 1, h, lane, tB);
    const bool hi = lane >= 32;
#pragma unroll
    for (int p = 0; p < 2; ++p)
#pragma unroll
        for (int i = 0; i < 16; ++i) tA[p][i] = hi ? tB[p][i] : tA[p][i];
    route_level2(tA, (size_t)(tileA + (hi ? 1 : 0)) * 32 + (lane & 31), h, lane, IDX, Gw, SCL, SCT, scr);
}

DI void route_heads(const bf16_t* PQ, const bf16_t* SK, int* IDX, float* Gw, int tile, int ha, int lane, LAS char* scr) {
    unsigned tA[2][16], tB[2][16];
    route_level1(PQ, SK, tile, ha, lane, tA);
    route_level1(PQ, SK, tile, ha + 1, lane, tB);
    const bool hi = lane >= 32;
#pragma unroll
    for (int p = 0; p < 2; ++p)
#pragma unroll
        for (int i = 0; i < 16; ++i) tA[p][i] = hi ? tB[p][i] : tA[p][i];
    route_level2(tA, (size_t)tile * 32 + (lane & 31), hi ? ha + 1 : ha, lane, IDX, Gw, nullptr, nullptr, scr);
}

#define FP4PAIR(w, bsel) __builtin_amdgcn_cvt_scalef32_pk_f32_fp4((w), 1.0f, (bsel))
typedef __bf16 bf16p_t __attribute__((ext_vector_type(2)));
#define FP4BF(w, bsel) __builtin_amdgcn_cvt_scalef32_pk_bf16_fp4((w), 1.0f, (bsel))
#define DOT2(accf, xw, ub) accf = __builtin_amdgcn_fdot2_f32_bf16(__builtin_bit_cast(bf16p_t, (xw)), (ub), accf, false)
typedef int v8i_t __attribute__((ext_vector_type(8)));
typedef short s16x2_t __attribute__((ext_vector_type(2)));
DI f32x4 mfma_x4u4(const u32x4 a, const u32x4 b, const f32x4 c) {
    const v8i_t aa = {(int)a.x, (int)a.y, (int)a.z, (int)a.w, 0, 0, 0, 0}, bb = {(int)b.x, (int)b.y, (int)b.z, (int)b.w, 0, 0, 0, 0};
    return __builtin_amdgcn_mfma_scale_f32_16x16x128_f8f6f4(aa, bb, c, 4, 4, 0, 0x7F7F7F7F, 0, 0x7F7F7F7F);
}
constexpr int PJ_NR = 1, PJ_T0 = 2;
constexpr int PJ_XS = 0, PJ_ZR = NWAVES * 1536, PJ_STG = PJ_ZR + 1024, PJ_UPITCH = 528, PJ_SCR = PJ_STG + NWAVES * 16 * PJ_UPITCH;
constexpr int PJ_FLG = PJ_SCR + PJ_NR * 3072;
static_assert(PJ_FLG + 32 <= LDS_BYTES - 64, "PEER phase LDS map");
constexpr int PJ_SCR0 = PJ_FLG + 32;
static_assert(PJ_SCR0 + NWAVES * 3072 <= LDS_BYTES - 64, "PEER phase LDS map");
#define PJ_TOK(t_) ((size_t)(F.bx + GRID * ((t_) >> 5)) * 32 + ((t_) & 31))
DI void pj_wait_tile(const Frame& F, int tile) {
    volatile LAS unsigned* fl = (volatile LAS unsigned*)(F.lds + PJ_FLG);
    const unsigned need = tile < PJ_T0 ? 4u : (unsigned)PJ_NR;
    while (fl[tile] < need) __builtin_amdgcn_s_sleep(2);
    asm volatile("" ::: "memory");
}
DI int pj_pop(const Frame& F) { int v = 0; if (F.lane == 0) v = (int)__atomic_fetch_add((LAS unsigned*)(F.lds + PJ_FLG) + 4, 1u, __ATOMIC_RELAXED); return __builtin_amdgcn_readfirstlane(v); }
DI void peer_u_stream(const Frame& F, const unsigned char* Ub, const unsigned* SCTg, const int* IDX, const float* Gw, const bf16_t* XB, const float* SS, int uw, float* cs) {
    const int lane = F.lane, j16 = lane & 15, kb = lane >> 4;
    LAS unsigned char* xs = F.lds + PJ_XS + uw * 1536;
    LAS unsigned char* zr = F.lds + PJ_ZR;
    { unsigned zz; asm volatile("v_mov_b32 %0, 0" : "=v"(zz)); *(LAS u32x4*)(zr + 16 * lane) = (u32x4){zz, zz, zz, zz}; }
    const LAS unsigned char* xrd = j16 < 3 ? xs + 512 * j16 + 16 * kb : zr;
    constexpr int UPITCH = PJ_UPITCH;
    LAS unsigned char* stg = F.lds + PJ_STG + uw * (16 * UPITCH);
    LAS unsigned char* stw = stg + (lane >> 5) * UPITCH + 16 * (lane & 31);
    const LAS unsigned char* strd = stg + j16 * UPITCH + 16 * kb;
    u32x4 UA[8], UB[8];
#define PU_ISSUE(buf, idv, sub) do { _Pragma("unroll") for (int i_ = 0; i_ < 8; ++i_) { const int e_ = __shfl(idv, (sub) * 16 + 2 * i_ + (lane >> 5)); \
            buf[i_] = *(const u32x4*)(Ub + (size_t)e_ * 512 + 16 * (lane & 31)); } } while (0)
#define PU_DOTS(buf, sub, dreg) do { f32x4 c_ = {0.f, 0.f, 0.f, 0.f}; asm volatile("" ::: "memory"); \
        _Pragma("unroll") for (int i_ = 0; i_ < 8; ++i_) *(LAS u32x4*)(stw + i_ * (2 * UPITCH)) = buf[i_];        \
        _Pragma("unroll") for (int s_ = 0; s_ < 8; ++s_) { const u32x4 xq_ = *(const LAS u32x4*)(xrd + 64 * s_), bq_ = *(const LAS u32x4*)(strd + 64 * s_); c_ = mfma_x4u4(xq_, bq_, c_); } \
        __builtin_amdgcn_sched_group_barrier(0x100, 6, 0); \
        _Pragma("unroll") for (int s_ = 0; s_ < 5; ++s_) { __builtin_amdgcn_sched_group_barrier(0x008, 1, 0); __builtin_amdgcn_sched_group_barrier(0x100, 2, 0); } \
        __builtin_amdgcn_sched_group_barrier(0x008, 3, 0); \
        dreg = fmaf(c_[2], xs3, fmaf(c_[1], xs2, c_[0] * xs1)); } while (0)
    int t = pj_pop(F);
    if (t >= 128) return;
    pj_wait_tile(F, t >> 5);
    size_t m = PJ_TOK(t);
    u32x4 xa = *(const u32x4*)(XB + m * 1024 + 16 * lane), xb = *(const u32x4*)(XB + m * 1024 + 16 * lane + 8);
    int id0 = IDX[m * 128 + lane], id1 = IDX[m * 128 + 64 + lane];
    float g0 = Gw[m * 128 + lane], g1 = Gw[m * 128 + 64 + lane];
    float ssl = lane < 16 ? SS[m * 16 + lane] : 0.f;
    PU_ISSUE(UA, id0, 0);
#pragma unroll 1
    for (int tnx = 0; t < 128; t = tnx) {
        unsigned xp[8];
#pragma unroll
        for (int i = 0; i < 4; ++i) { xp[i] = xa[i]; xp[4 + i] = xb[i]; }
        PU_ISSUE(UB, id0, 1);
        const unsigned sc0 = SCTg[id0], sc1 = SCTg[id1];
        float xs1, xs2, xs3;
        {
          float xr_[16]; float am = 0.f;
#pragma unroll
          for (int i = 0; i < 8; ++i) { xr_[2 * i] = bflo(xp[i]); xr_[2 * i + 1] = bfhi(xp[i]); am = fmaxf(am, fmaxf(fabsf(xr_[2 * i]), fabsf(xr_[2 * i + 1]))); }
          am = wave_max(am);
          int eb = (int)((__builtin_bit_cast(unsigned, am) >> 23) & 0xFFu); eb = eb < 40 ? 40 : eb;
          xs1 = __builtin_bit_cast(float, (unsigned)(eb - 1) << 23); xs2 = xs1 * 0.25f; xs3 = xs1 * 0.03125f;
#pragma unroll
          for (int t = 0; t < 3; ++t) {
              const float sc_ = t == 0 ? xs1 : t == 1 ? xs2 : xs3;
              u32x2 w;
#pragma unroll
              for (int hw = 0; hw < 2; ++hw) {
                  unsigned ww = 0;
                  ww = __builtin_amdgcn_cvt_scalef32_pk_fp4_f32(ww, xr_[8 * hw + 0], xr_[8 * hw + 1], sc_, 0); ww = __builtin_amdgcn_cvt_scalef32_pk_fp4_f32(ww, xr_[8 * hw + 2], xr_[8 * hw + 3], sc_, 1);
                  ww = __builtin_amdgcn_cvt_scalef32_pk_fp4_f32(ww, xr_[8 * hw + 4], xr_[8 * hw + 5], sc_, 2); ww = __builtin_amdgcn_cvt_scalef32_pk_fp4_f32(ww, xr_[8 * hw + 6], xr_[8 * hw + 7], sc_, 3);
                  w[hw] = ww;
                  if (t < 2) {
                      const f32x2 q0 = __builtin_amdgcn_cvt_scalef32_pk_f32_fp4(ww, sc_, 0), q1 = __builtin_amdgcn_cvt_scalef32_pk_f32_fp4(ww, sc_, 1), q2 = __builtin_amdgcn_cvt_scalef32_pk_f32_fp4(ww, sc_, 2), q3 = __builtin_amdgcn_cvt_scalef32_pk_f32_fp4(ww, sc_, 3);
                      xr_[8 * hw + 0] -= q0.x; xr_[8 * hw + 1] -= q0.y; xr_[8 * hw + 2] -= q1.x; xr_[8 * hw + 3] -= q1.y; xr_[8 * hw + 4] -= q2.x; xr_[8 * hw + 5] -= q2.y; xr_[8 * hw + 6] -= q3.x; xr_[8 * hw + 7] -= q3.y;
                  }
              }
              *(LAS u32x2*)(xs + 512 * t + 8 * lane) = w;
          }
        }
        tnx = pj_pop(F);
        const int tn = tnx < 128 ? tnx : t;
        pj_wait_tile(F, tn >> 5);
        const size_t mn = PJ_TOK(tn);
        const u32x4 nxa = *(const u32x4*)(XB + mn * 1024 + 16 * lane), nxb = *(const u32x4*)(XB + mn * 1024 + 16 * lane + 8);
        const int nid0 = IDX[mn * 128 + lane], nid1 = IDX[mn * 128 + 64 + lane];
        const float ng0 = Gw[mn * 128 + lane], ng1 = Gw[mn * 128 + 64 + lane];
        const float nssl = lane < 16 ? SS[mn * 16 + lane] : 0.f;
        const float rstd = 1.0f / sqrtf(wave_sum(ssl) * (1.0f / 1024.0f) + EPS);
        float dp[8];
        PU_DOTS(UA, 0, dp[0]); PU_ISSUE(UA, id0, 2);
        PU_DOTS(UB, 1, dp[1]); PU_ISSUE(UB, id0, 3);
        PU_DOTS(UA, 2, dp[2]); PU_ISSUE(UA, id1, 0);
        PU_DOTS(UB, 3, dp[3]); PU_ISSUE(UB, id1, 1);
        PU_DOTS(UA, 0, dp[4]); PU_ISSUE(UA, id1, 2);
        PU_DOTS(UB, 1, dp[5]); PU_ISSUE(UB, id1, 3);
        PU_DOTS(UA, 2, dp[6]); PU_ISSUE(UA, nid0, 0);
        PU_DOTS(UB, 3, dp[7]);
        float d0 = 0.f, d1 = 0.f;
        { float tv[8];
#pragma unroll
          for (int b_ = 0; b_ < 8; ++b_) tv[b_] = __shfl(dp[b_], j16);
#pragma unroll
          for (int b_ = 0; b_ < 4; ++b_) { if (kb == b_) { d0 = tv[b_]; d1 = tv[4 + b_]; } } }
        const float c0 = g0 * gelu_tanh(d0 * (bflo(sc0) * rstd)) * bfhi(sc0), c1 = g1 * gelu_tanh(d1 * (bflo(sc1) * rstd)) * bfhi(sc1);
        m = PJ_TOK(t); cs[m * 128 + lane] = c0; cs[m * 128 + 64 + lane] = c1;
        xa = nxa; xb = nxb; id0 = nid0; id1 = nid1; g0 = ng0; g1 = ng1; ssl = nssl;
    }
#undef PU_ISSUE
#undef PU_DOTS
}
DI void peer_v_pass(const Frame& F, const Args& args, bool last, const unsigned char* Vb, const int* IDX, bf16_t* XB, float* SS, const float* csw) {
    const int lane = F.lane;
    u32x2 A[16], B[16];
#define PW_ISSUE(buf, tab, idv, sub) do { _Pragma("unroll") for (int i_ = 0; i_ < 16; ++i_) { const int e_ = __builtin_amdgcn_readlane(idv, (sub) * 16 + i_); buf[i_] = *(const u32x2*)((tab) + (size_t)e_ * 512 + 8 * lane); } } while (0)
#define PW_ACCUM(buf, cv, sub) do { _Pragma("unroll") for (int i_ = 0; i_ < 16; ++i_) { \
            const float cf_ = __builtin_bit_cast(float, __builtin_amdgcn_readlane(__builtin_bit_cast(int, cv), (sub) * 16 + i_)); const f32x2 cf2_ = {cf_, cf_}; \
            _Pragma("unroll") for (int q_ = 0; q_ < 2; ++q_) { acc[4 * q_] += cf2_ * FP4PAIR(buf[i_][q_], 0); acc[4 * q_ + 1] += cf2_ * FP4PAIR(buf[i_][q_], 1); acc[4 * q_ + 2] += cf2_ * FP4PAIR(buf[i_][q_], 2); acc[4 * q_ + 3] += cf2_ * FP4PAIR(buf[i_][q_], 3); } } } while (0)
#define PV_TOK(t_) ((size_t)(F.bx + GRID * ((t_) >> 5)) * 32 + ((t_) & 31))
    const int t0 = F.wave * 16;
    size_t m = PV_TOK(t0);
    u32x4 xa = *(const u32x4*)(XB + m * 1024 + 16 * lane), xb = *(const u32x4*)(XB + m * 1024 + 16 * lane + 8);
    int id0 = IDX[m * 128 + lane], id1 = IDX[m * 128 + 64 + lane];
    PW_ISSUE(A, Vb, id0, 0);
#pragma unroll 1
    for (int it = 0; it < 16; ++it) {
        m = PV_TOK(t0 + it);
        unsigned xp[8];
#pragma unroll
        for (int i = 0; i < 4; ++i) { xp[i] = xa[i]; xp[4 + i] = xb[i]; }
        const float c0 = csw[m * 128 + lane], c1 = csw[m * 128 + 64 + lane];
        const size_t mn = PV_TOK(t0 + (it < 15 ? it + 1 : it));
        const u32x4 nxa = *(const u32x4*)(XB + mn * 1024 + 16 * lane), nxb = *(const u32x4*)(XB + mn * 1024 + 16 * lane + 8);
        const int nid0 = IDX[mn * 128 + lane], nid1 = IDX[mn * 128 + 64 + lane];
        f32x2 acc[8];
#pragma unroll
        for (int q = 0; q < 8; ++q) acc[q] = (f32x2){0.f, 0.f};
        PW_ISSUE(B, Vb, id0, 1); PW_ACCUM(A, c0, 0);
        PW_ISSUE(A, Vb, id0, 2); PW_ACCUM(B, c0, 1);
        PW_ISSUE(B, Vb, id0, 3); PW_ACCUM(A, c0, 2);
        PW_ISSUE(A, Vb, id1, 0); PW_ACCUM(B, c0, 3);
        PW_ISSUE(B, Vb, id1, 1); PW_ACCUM(A, c1, 0);
        PW_ISSUE(A, Vb, id1, 2); PW_ACCUM(B, c1, 1);
        PW_ISSUE(B, Vb, id1, 3); PW_ACCUM(A, c1, 2);
        PW_ISSUE(A, Vb, nid0, 0); PW_ACCUM(B, c1, 3);
        float xo[16]; float s = 0.f;
#pragma unroll
        for (int q = 0; q < 8; ++q) { xo[2 * q] = bflo(xp[q]) + acc[q].x; xo[2 * q + 1] = bfhi(xp[q]) + acc[q].y; }
        if (!last) {
            u32x4 w0, w1;
#pragma unroll
            for (int q = 0; q < 4; ++q) { w0[q] = cvtpk(xo[2 * q], xo[2 * q + 1]); w1[q] = cvtpk(xo[8 + 2 * q], xo[8 + 2 * q + 1]);
                s += (bflo(w0[q]) * bflo(w0[q]) + bfhi(w0[q]) * bfhi(w0[q])) + (bflo(w1[q]) * bflo(w1[q]) + bfhi(w1[q]) * bfhi(w1[q])); }
            s = wave_sum(s);
            *(u32x4*)(XB + (size_t)m * 1024 + 16 * lane) = w0; *(u32x4*)(XB + (size_t)m * 1024 + 16 * lane + 8) = w1;
            if (lane < 16) SS[(size_t)m * 16 + lane] = lane == 0 ? s : 0.f;
        } else {
#pragma unroll
            for (int q = 0; q < 16; ++q) s += xo[q] * xo[q];
            s = wave_sum(s);
            const float rf = 1.0f / sqrtf(s * (1.0f / 1024.0f) + EPS); const float* fg = INP(I_FINAL_G) + 16 * lane; float* xr = F.X + (size_t)m * 1024 + 16 * lane;
#pragma unroll
            for (int q = 0; q < 4; ++q) { const f32x4 gq = *(const f32x4*)(fg + 4 * q); *(f32x4*)(xr + 4 * q) = (f32x4){xo[4 * q], xo[4 * q + 1], xo[4 * q + 2], xo[4 * q + 3]} * rf * gq; }
        }
        xa = nxa; xb = nxb; id0 = nid0; id1 = nid1;
    }
#undef PV_TOK
#undef PW_ISSUE
#undef PW_ACCUM
}

constexpr int PPL = 7;
constexpr int NPHASE = 1 + DEPTH * PPL;
__global__ void __launch_bounds__(NTHR, 2) trunk_fwd(Args args) {
    extern __shared__ __attribute__((aligned(16))) unsigned char lds_raw[];
    Frame F;
    F.lds = (LAS unsigned char*)lds_raw;
    F.tid = threadIdx.x; F.lane = F.tid & 63; F.wave = __builtin_amdgcn_readfirstlane(F.tid >> 6);
    F.bx = blockIdx.x; F.gw = F.bx * NWAVES + F.wave;
    F.X = args.out; F.ws = args.ws;
    const int lo = args.ph_lo, hi = args.ph_hi;
#if MK_ONE_LAUNCH
    volatile LAS unsigned* bst = (volatile LAS unsigned*)(F.lds + LDS_BYTES - 64);
    if (F.tid < 16) bst[F.tid] = 0u;
    __syncthreads();
    const XcdBarrier gbar = xcd_barrier_post((unsigned*)(args.ws + WS_CTL) + 4096, bst);
#endif
#define REFRESH() int t_ = threadIdx.x; asm volatile("" : "+v"(t_)); F.tid = t_; F.lane = t_ & 63; F.wave = __builtin_amdgcn_readfirstlane(t_ >> 6); \
    F.gw = F.bx * NWAVES + F.wave; size_t z_ = 0; asm volatile("" : "+s"(z_)); unsigned char* ws = args.ws + z_; F.ws = ws; \
    bf16_t* XB = (bf16_t*)(ws + WS_XB); float* SS = (float*)(ws + WS_SS); bf16_t* YC = (bf16_t*)(ws + WS_YCAT); bf16_t* PROJ = (bf16_t*)(ws + WS_PROJ); \
    bf16_t* CQ = PROJ; bf16_t* PP = (bf16_t*)(ws + WS_PROJ + 64 * MiB); int* IDX = (int*)(ws + WS_PROJ + 64 * MiB); float* GW = (float*)(ws + WS_PROJ + 80 * MiB); \
    bf16_t* Wl = (bf16_t*)(ws + WS_W + l * W_LAYER); bf16_t* Kl = (bf16_t*)(ws + WS_KMEM + (size_t)l * 16 * MiB); bf16_t* VTl = Kl + (size_t)4096 * 1024; \
    (void)XB; (void)SS; (void)YC; (void)PROJ; (void)CQ; (void)PP; (void)IDX; (void)GW; (void)Wl; (void)Kl; (void)VTl;
#pragma unroll 1
    for (int ph = lo; ph < hi; ++ph) {
        const int l = ph == 0 ? 0 : (ph - 1) / PPL, k = ph == 0 ? -1 : (ph - 1) % PPL;
        for (int rep = 0; rep < ((k == PROBE_REP_K) ? 2 : 1); ++rep) {
        if (rep) { WG_SYNC(); xcd_barrier(gbar); }
        switch (k) {
        case -1: if (EN(0)) { REFRESH(); p0_prologue(F, args); } break;
        case 0: case 3: case 5: if (EN(1)) {
            REFRESH();
            if (k == 0 && l == 0) {
#pragma unroll 1
                for (int l2 = 0; l2 < DEPTH; ++l2) {
                    bf16_t* W2 = (bf16_t*)(ws + WS_W + l2 * W_LAYER); bf16_t* K2 = (bf16_t*)(ws + WS_KMEM + (size_t)l2 * 16 * MiB);
                    pg8::Gemm g{(const bf16_t*)(ws + WS_MEMB), W2 + W_CKV / 2, 1024, 1024, 1024}; pg8::StaticOrder S; S.init(MMEM, 2048, F.G, (F.bx + 128 * l2) % F.G, 1024, 1024);
                    pg8::EpiKV E{K2, K2 + (size_t)4096 * 1024, (const float*)(ws + WS_RSTDM)};
                    pg8::gemm_phase<pg8::EpiKV, pg8::StaticOrder, true>(F.lds, g, S, E);
                }
            }
            const bf16_t* Bt = Wl + (k == 0 ? W_IN : k == 3 ? W_CQ : W_PQ) / 2; const int N = k == 0 ? NPROJ : 1024, ldc = k == 0 ? LDP : 1024;
            pg8::Gemm g{XB, Bt, 1024, 1024, 1024}; pg8::StaticOrder S; S.init(MTOK, N, F.G, F.bx, 1024, 1024);
            pg8::EpiBf16 E{k == 0 ? PROJ : CQ, ldc, SS, k == 3 ? 0.0625f * LOG2E : 1.0f, ldc};
            pg8::gemm_phase<pg8::EpiBf16, pg8::StaticOrder, true>(F.lds, g, S, E);
            if (k == 3) {
                pg8::Unit u;
                for (int i = 0; S.next(i, u); ++i) xattn_unit(F, CQ, Kl, VTl, YC, u.pm, u.pn);
            }
        } break;
        case 1: {
            REFRESH();
            if (F.bx < 64) { if (EN(2)) gla_chain(F, args, l, F.bx >> 2, F.bx & 3, PROJ, YC); }
            else {
                if (l == 0) {
                    const int wv = (F.bx - 64) * NWAVES + F.wave, nwv = (F.G - 64) * NWAVES;
                    transpose_list(F, args, (LAS float*)(F.lds + F.wave * 16384), wv, nwv, 1);
                    convert_tables(F, args, 0, wv, nwv); convert_tables(F, args, 1, wv, nwv);
                    WG_SYNC();
                }
                if (EN(3)) { for (int u = F.bx - 64; u < 256; u += F.G - 64) sgu_unit(F, args, l, u >> 4, u & 15, PROJ, YC); }
            }
            if (EN(4)) { LAS char* vl = (LAS char*)F.lds + F.wave * 8192; unsigned* ctr = (unsigned*)(ws + WS_CTL) + 15360 + 64 * l;
                for (;;) { int u0 = 0; if (F.lane == 0) u0 = (int)atomicAdd(ctr, 2u); u0 = __builtin_amdgcn_readfirstlane(u0); if (u0 >= BATCH * 8 * 32) break;
                    for (int u = u0; u < u0 + 2; ++u) sb_unit2(PROJ, YC, u >> 8, (u >> 5) & 7, u & 31, vl, F.lane); } }
        } break;
        case 2: case 4: if (EN(5)) {
            REFRESH();
            pg8::Gemm g{YC, Wl + (k == 2 ? W_OUT : W_CO) / 2, 1024, 1024, 1024}; pg8::StaticOrder S; S.init(MTOK, 1024, F.G, F.bx, 1024, 1024);
            pg8::EpiResid E{XB, SS};
            pg8::gemm_phase<pg8::EpiResid, pg8::StaticOrder, true>(F.lds, g, S, E);
        } break;
        default: if (EN(12)) {
            REFRESH();
            const unsigned char* Ub = ws + WS_TAB + (size_t)l * 16 * MiB; const unsigned char* Vb = Ub + 8 * MiB;
            const bf16_t* SK = (const bf16_t*)(ws + WS_SUBK) + (size_t)l * 8 * 2 * 128 * 64;
            const unsigned* SCTg = (const unsigned*)(ws + WS_TAB + 32 * MiB + (size_t)l * 65536);
            float* cs = (float*)(ws + WS_PROJ + 96 * MiB);
            if (F.tid < 8) ((volatile LAS unsigned*)(F.lds + PJ_FLG))[F.tid] = 0u;
            LDS_SYNC();
            {
                static_assert(PJ_T0 == 2, "leading tiles: one per half of the workgroup");
                const int st = F.wave >> 2;
                route_heads(CQ, SK, IDX, GW, F.bx + GRID * st, 2 * (F.wave & 3), F.lane, (LAS char*)F.lds + PJ_SCR0 + F.wave * 3072);
                asm volatile("s_waitcnt vmcnt(0)" ::: "memory");
                if (F.lane == 0) __atomic_fetch_add((LAS unsigned*)(F.lds + PJ_FLG) + st, 1u, __ATOMIC_RELAXED);
            }
            if (F.wave < PJ_NR) {
#pragma unroll 1
                for (int st = PJ_T0; st < 4; ++st) {
#pragma unroll 1
                    for (int hq = 0; hq < 8 / (2 * PJ_NR); ++hq) route_heads(CQ, SK, IDX, GW, F.bx + GRID * st, (8 / PJ_NR) * F.wave + 2 * hq, F.lane, (LAS char*)F.lds + PJ_SCR + F.wave * 3072);
                    asm volatile("s_waitcnt vmcnt(0)" ::: "memory");
                    if (F.lane == 0) __atomic_fetch_add((LAS unsigned*)(F.lds + PJ_FLG) + st, 1u, __ATOMIC_RELAXED);
                }
            }
            peer_u_stream(F, Ub, SCTg, IDX, GW, XB, SS, F.wave, cs);
            WG_SYNC();
            peer_v_pass(F, args, l == DEPTH - 1, Vb, IDX, XB, SS, cs);
        } break;
        }
        }
        WG_SYNC();
#if MK_ONE_LAUNCH
        if (ph + 1 < hi) xcd_barrier(gbar);
#endif
    }
#undef REFRESH
}

extern "C" void kernel_launch(void* const* d_in, const int* in_sizes, int n_in, void* d_out, int out_size, void* d_ws, size_t ws_size, hipStream_t stream) {
    static int grid = 0;
    if (grid == 0) {
        if (n_in != 22 || out_size != MTOK * DM || ws_size < WS_END) { fprintf(stderr, "kernel_launch: unexpected problem (n_in %d out %d ws %zu)\n", n_in, out_size, ws_size); grid = -1; return; }
        int dev = 0, cus = 0, per_cu = 0;
        if (hipGetDevice(&dev) != hipSuccess || hipDeviceGetAttribute(&cus, hipDeviceAttributeMultiprocessorCount, dev) != hipSuccess) { grid = -1; return; }
        if (hipFuncSetAttribute((const void*)trunk_fwd, hipFuncAttributeMaxDynamicSharedMemorySize, LDS_BYTES) != hipSuccess) { fprintf(stderr, "kernel_launch: hipFuncSetAttribute failed\n"); grid = -1; return; }
        if (hipOccupancyMaxActiveBlocksPerMultiprocessor(&per_cu, (const void*)trunk_fwd, NTHR, LDS_BYTES) != hipSuccess || per_cu < 1) { fprintf(stderr, "kernel_launch: occupancy query says %d\n", per_cu); (void)hipGetLastError(); grid = -1; return; }
        if (cus * per_cu < GRID) { fprintf(stderr, "kernel_launch: built for a %d-workgroup resident grid, this device holds %d\n", GRID, cus * per_cu); grid = -1; return; }
        grid = GRID;
    }
    if (grid < 0) return;
    Args a{};
    for (int i = 0; i < 22; ++i) a.in[i] = (const float*)d_in[i];
    a.out = (float*)d_out; a.ws = (unsigned char*)d_ws;
#if MK_ONE_LAUNCH
    if (hipMemsetAsync((char*)d_ws + WS_CTL, 0, 65536, stream) != hipSuccess) { fprintf(stderr, "kernel_launch: memset of the control words failed\n"); return; }
    a.ph_lo = 0; a.ph_hi = NPHASE;
    void* kargs[] = {&a};
    hipError_t e = hipLaunchCooperativeKernel((const void*)trunk_fwd, dim3(grid), dim3(NTHR), kargs, LDS_BYTES, stream);
    if (e != hipSuccess) fprintf(stderr, "cooperative launch failed: %s (grid %d)\n", hipGetErrorString(e), grid);
#else
    for (int p = 0; p < NPHASE; ++p) { a.ph_lo = p; a.ph_hi = p + 1; hipLaunchKernelGGL(trunk_fwd, dim3(grid), dim3(NTHR), LDS_BYTES, stream, a); }
#endif
}
```
